# Optimizing an MI355X kernel written in HIP

```python
import jax
import jax.numpy as jnp
from jax import lax
import numpy as np

D_MODEL = 1024
BATCH = 4
SEQ = 4096
DEPTH = 4
DEC_BATCH = 32
DEC_SEQ = 1
PAST_LEN = 8192
PAGE_SIZE = 128

N_A_LAYERS = DEPTH // 2
N_B_LAYERS = DEPTH - N_A_LAYERS
D_PLE = 256
EPS = 1e-6
D_RNN = (5 * D_MODEL) // 4
N_RG_BLOCKS = 16
RG_BLOCK = D_RNN // N_RG_BLOCKS
RG_CONV_W = 4
RG_C = 8.0
D_FF = 3 * D_MODEL
FFN_CONV_W = 3
HEAD_DIM = 64
N_HEADS = D_MODEL // HEAD_DIM
N_KV_HEADS = 2
HPG = N_HEADS // N_KV_HEADS
L_CMP = 32
D_CMP = 16
CMP_HIDDEN = 2 * HEAD_DIM
L_SLC = 64
N_SEL = 16
WINDOW = 512
Q_BLOCK = 128
ROPE_THETA = 10000.0
NEG = -1e30

kernel_name = 'hawk_nsa_yoco_decoder_step'


def rms_norm(x, g):
    xf = x.astype(jnp.float32)
    y = xf * lax.rsqrt(jnp.mean(xf * xf, axis=-1, keepdims=True) + EPS)
    return (y * g.astype(jnp.float32)).astype(x.dtype)


def rope(x, pos):
    half = HEAD_DIM // 2
    inv_freq = ROPE_THETA ** (-jnp.arange(half, dtype=jnp.float32) / half)
    ang = pos.astype(jnp.float32)[:, None] * inv_freq[None, :]
    cos = jnp.cos(ang)[None, :, None, :].astype(x.dtype)
    sin = jnp.sin(ang)[None, :, None, :].astype(x.dtype)
    x1, x2 = x[..., :half], x[..., half:]
    return jnp.concatenate([x1 * cos - x2 * sin, x2 * cos + x1 * sin], axis=-1)


def causal_dwconv(x_hist, w, b):
    width = w.shape[0]
    t = x_hist.shape[1] - width + 1
    out = b + x_hist[:, 0:t] * w[0]
    for k in range(1, width):
        out = out + x_hist[:, k:k + t] * w[k]
    return out


def masked_softmax(s, mask):
    s = jnp.where(mask, s.astype(jnp.float32), NEG)
    return jnp.where(mask, jax.nn.softmax(s, axis=-1), 0.0)


def linear_combine(left, right):
    a1, b1 = left
    a2, b2 = right
    return a1 * a2, a2 * b1 + b2


def rg_lru_block(h, conv_hist, h0, pos, w_in, conv_w, conv_b, w_a, b_a, w_x, b_x, lam, w_out):
    b, t, _ = h.shape
    proj = h @ w_in
    y = jax.nn.gelu(proj[..., :D_RNN])
    xr = proj[..., D_RNN:]
    xh = jnp.concatenate([conv_hist.astype(xr.dtype), xr], axis=1)
    new_hist = xh[:, xh.shape[1] - (RG_CONV_W - 1):]
    xc = causal_dwconv(xh, conv_w, conv_b)
    xb = xc.reshape(b, t, N_RG_BLOCKS, RG_BLOCK)
    r = jax.nn.sigmoid(jnp.einsum('btnk,nkj->btnj', xb, w_a) + b_a).reshape(b, t, D_RNN)
    i = jax.nn.sigmoid(jnp.einsum('btnk,nkj->btnj', xb, w_x) + b_x).reshape(b, t, D_RNN)
    log_a = -RG_C * r.astype(jnp.float32) * jax.nn.softplus(-lam.astype(jnp.float32))
    a = jnp.exp(log_a)
    mult = jnp.where((pos == 0)[None, :, None], 1.0, jnp.sqrt(-jnp.expm1(2.0 * log_a)))
    u = mult * (i * xc).astype(jnp.float32)
    u = u.at[:, 0].add(a[:, 0] * h0.astype(jnp.float32))
    _, hs = lax.associative_scan(linear_combine, (a, u), axis=1)
    out = (y * hs.astype(h.dtype)) @ w_out
    return out, new_hist, hs[:, -1].astype(h.dtype)


def conv_ffn(h, conv_hist, w_up, conv_w, conv_b, w_down):
    up = h @ w_up
    uh = jnp.concatenate([conv_hist.astype(up.dtype), up], axis=1)
    new_hist = uh[:, uh.shape[1] - (FFN_CONV_W - 1):]
    uc = causal_dwconv(uh, conv_w, conv_b)
    return (jax.nn.gelu(uc[..., :D_FF]) * uc[..., D_FF:]) @ w_down, new_hist


def per_layer_embed(x, p, g, w_in, w_gate):
    return (p @ w_in) * jax.nn.sigmoid(rms_norm(x, g) @ w_gate)


def shared_kv(u, pos, w_kv):
    b, t, _ = u.shape
    kv = (u @ w_kv).reshape(b, t, 6, N_KV_HEADS, HEAD_DIM)
    cmp_kv = kv[:, :, 0:2]
    slc_kv = jnp.stack([rope(kv[:, :, 2], pos), kv[:, :, 3]], axis=2)
    win_kv = jnp.stack([rope(kv[:, :, 4], pos), kv[:, :, 5]], axis=2)
    return cmp_kv, slc_kv, win_kv


def compress(raw_kv, pos_emb, w1, b1, w2):
    b, t = raw_kv.shape[0], raw_kv.shape[1]
    n_cb = (t - L_CMP) // D_CMP + 1
    idx = jnp.arange(n_cb, dtype=jnp.int32)[:, None] * D_CMP + jnp.arange(L_CMP, dtype=jnp.int32)[None, :]
    blk = raw_kv[:, idx] + pos_emb[None, None, :, :, None, :]
    flat = jnp.transpose(blk, (0, 1, 4, 3, 2, 5)).reshape(b, n_cb, N_KV_HEADS, 2, L_CMP * HEAD_DIM)
    hid = jax.nn.gelu(jnp.einsum('bcgjf,jfe->bcgje', flat, w1) + b1)
    out = jnp.einsum('bcgje,jed->bcgjd', hid, w2)
    ends = jnp.arange(n_cb, dtype=jnp.int32) * D_CMP + (L_CMP - 1)
    return out[..., 0, :], out[..., 1, :], ends


def cmp_to_slc(n_cb, n_sb):
    c0 = jnp.arange(n_cb, dtype=jnp.int32)[:, None] * D_CMP
    s0 = jnp.arange(n_sb, dtype=jnp.int32)[None, :] * L_SLC
    return ((c0 < s0 + L_SLC) & (c0 + L_CMP > s0)).astype(jnp.float32)


def nsa_query(h, pos, w_qg):
    b, t, _ = h.shape
    proj = h @ w_qg
    q = proj[..., :N_HEADS * HEAD_DIM].reshape(b, t, N_HEADS, HEAD_DIM)
    gates = jax.nn.sigmoid(proj[..., N_HEADS * HEAD_DIM:].reshape(b, t, N_HEADS, 3))
    return q, rope(q, pos), gates


def nsa_core(q, q_rot, gates, q_pos, kc, vc, c_end, slc_blk, win_kv, w_pos):
    b, t = q.shape[0], q.shape[1]
    scale = HEAD_DIM ** -0.5
    qg = q.reshape(b, t, N_KV_HEADS, HPG, HEAD_DIM)
    qr = q_rot.reshape(b, t, N_KV_HEADS, HPG, HEAD_DIM)
    s_c = jnp.einsum('btghd,bcgd->bgthc', qg, kc, preferred_element_type=jnp.float32) * scale
    m_c = c_end[None, :] <= q_pos[:, None]
    p_c = masked_softmax(s_c, m_c[None, None, :, None, :])
    o_c = jnp.einsum('bgthc,bcgd->btghd', p_c.astype(vc.dtype), vc)
    n_sb = slc_blk.shape[1]
    imp = jnp.einsum('bgthc,cs->bgts', p_c, cmp_to_slc(kc.shape[1], n_sb))
    blk = jnp.arange(n_sb, dtype=jnp.int32)[None, :]
    cur = (q_pos // L_SLC)[:, None]
    forced = (blk == 0) | (blk == cur) | (blk == cur - 1)
    imp = jnp.where(forced, jnp.inf, imp)
    imp = jnp.where(blk * L_SLC <= q_pos[:, None], imp, -jnp.inf)
    n_top = min(N_SEL, n_sb)
    _, sel = lax.top_k(imp, n_top)
    blk_g = jnp.transpose(slc_blk, (0, 4, 1, 2, 3, 5))
    gath = jax.vmap(jax.vmap(lambda kb, ib: kb[ib]))(blk_g, sel)
    n_rows = n_top * L_SLC
    k_s = gath[..., 0, :]
    v_s = gath[..., 1, :].reshape(b, N_KV_HEADS, t, n_rows, HEAD_DIM)
    kpos = sel[..., None] * L_SLC + jnp.arange(L_SLC, dtype=jnp.int32)
    m_s = (kpos <= q_pos[None, None, :, None, None]).reshape(b, N_KV_HEADS, t, 1, n_rows)
    s_s = jnp.einsum('btghd,bgtkld->bgthkl', qr, k_s, preferred_element_type=jnp.float32) * scale
    p_s = masked_softmax(s_s.reshape(b, N_KV_HEADS, t, HPG, n_rows), m_s)
    o_s = jnp.einsum('bgthn,bgtnd->btghd', p_s.astype(v_s.dtype), v_s)
    k_w = win_kv[:, :, 0]
    v_w = win_kv[:, :, 1]
    dist = q_pos[:, None] - w_pos[None, :]
    m_w = (dist >= 0) & (dist < WINDOW) & (w_pos[None, :] >= 0)
    s_w = jnp.einsum('btghd,bwgd->bgthw', qr, k_w, preferred_element_type=jnp.float32) * scale
    p_w = masked_softmax(s_w, m_w[None, None, :, None, :])
    o_w = jnp.einsum('bgthw,bwgd->btghd', p_w.astype(v_w.dtype), v_w)
    g = gates.reshape(b, t, N_KV_HEADS, HPG, 3)
    o = o_c * g[..., 0:1] + o_s * g[..., 1:2] + o_w * g[..., 2:3]
    return o.reshape(b, t, N_HEADS * HEAD_DIM)


def gather_pages(cache, page_table):
    rows = cache[page_table]
    return rows.reshape(page_table.shape[0], page_table.shape[1] * PAGE_SIZE, *cache.shape[2:])


def setup_inputs(seed: int = 0) -> dict:
    key = jax.random.key(seed)
    ks = iter(jax.random.split(key, 48))

    def nrm(shape, scale):
        return jax.random.normal(next(ks), shape, jnp.float32) * scale

    def gain(shape):
        return 1.0 + nrm(shape, 0.01)

    n_pages = PAST_LEN // PAGE_SIZE
    n_used = DEC_BATCH * n_pages
    n_phys = (5 * n_used + 3) // 4
    page_table = jax.random.permutation(next(ks), n_phys)[:n_used].reshape(DEC_BATCH, n_pages).astype(jnp.int32)
    w_buf = min(WINDOW, PAST_LEN)
    a0 = jax.random.uniform(next(ks), (N_A_LAYERS, D_RNN), jnp.float32, 0.9, 0.999)
    a_base = a0 ** (1.0 / RG_C)
    rg_lambda = jnp.log(a_base) - jnp.log1p(-a_base)
    return {
        'x_prompt': nrm((BATCH, SEQ, D_MODEL), 1.0),
        'x_sample': nrm((DEC_BATCH, DEC_SEQ, D_MODEL), 1.0),
        'p_prompt': nrm((DEPTH, BATCH, SEQ, D_PLE), 1.0),
        'p_sample': nrm((DEPTH, DEC_BATCH, DEC_SEQ, D_PLE), 1.0),
        'cache_cmp_kv': nrm((n_phys, PAGE_SIZE, 2, N_KV_HEADS, HEAD_DIM), 1.0),
        'cache_slc_kv': nrm((n_phys, PAGE_SIZE, 2, N_KV_HEADS, HEAD_DIM), 1.0),
        'cache_win_kv': nrm((DEC_BATCH, w_buf, 2, N_KV_HEADS, HEAD_DIM), 1.0),
        'state_rg_conv': nrm((N_A_LAYERS, DEC_BATCH, RG_CONV_W - 1, D_RNN), 1.0),
        'state_rg_h': nrm((N_A_LAYERS, DEC_BATCH, D_RNN), 0.5),
        'state_ffn_conv': nrm((DEPTH, DEC_BATCH, FFN_CONV_W - 1, 2 * D_FF), 1.0),
        'page_table': page_table,
        'g_mix': gain((DEPTH, D_MODEL)),
        'g_ffn': gain((DEPTH, D_MODEL)),
        'g_ple': gain((DEPTH, D_MODEL)),
        'g_final': gain((D_MODEL,)),
        'rg_w_in': nrm((N_A_LAYERS, D_MODEL, 2 * D_RNN), D_MODEL ** -0.5),
        'rg_conv_w': nrm((N_A_LAYERS, RG_CONV_W, D_RNN), RG_CONV_W ** -0.5),
        'rg_conv_b': nrm((N_A_LAYERS, D_RNN), 0.01),
        'rg_w_a': nrm((N_A_LAYERS, N_RG_BLOCKS, RG_BLOCK, RG_BLOCK), RG_BLOCK ** -0.5),
        'rg_b_a': nrm((N_A_LAYERS, N_RG_BLOCKS, RG_BLOCK), 0.01),
        'rg_w_x': nrm((N_A_LAYERS, N_RG_BLOCKS, RG_BLOCK, RG_BLOCK), RG_BLOCK ** -0.5),
        'rg_b_x': nrm((N_A_LAYERS, N_RG_BLOCKS, RG_BLOCK), 0.01),
        'rg_lambda': rg_lambda,
        'rg_w_out': nrm((N_A_LAYERS, D_RNN, D_MODEL), D_RNN ** -0.5),
        'g_kv': gain((D_MODEL,)),
        'w_kv': nrm((D_MODEL, 6 * N_KV_HEADS * HEAD_DIM), D_MODEL ** -0.5),
        'cmp_pos': nrm((L_CMP, 2, HEAD_DIM), 0.1),
        'cmp_w1': nrm((2, L_CMP * HEAD_DIM, CMP_HIDDEN), (L_CMP * HEAD_DIM) ** -0.5),
        'cmp_b1': nrm((2, CMP_HIDDEN), 0.01),
        'cmp_w2': nrm((2, CMP_HIDDEN, HEAD_DIM), CMP_HIDDEN ** -0.5),
        'attn_w_qg': nrm((N_B_LAYERS, D_MODEL, N_HEADS * HEAD_DIM + 3 * N_HEADS), D_MODEL ** -0.5),
        'attn_w_o': nrm((N_B_LAYERS, N_HEADS * HEAD_DIM, D_MODEL), (N_HEADS * HEAD_DIM) ** -0.5),
        'ffn_w_up': nrm((DEPTH, D_MODEL, 2 * D_FF), D_MODEL ** -0.5),
        'ffn_conv_w': nrm((DEPTH, FFN_CONV_W, 2 * D_FF), FFN_CONV_W ** -0.5),
        'ffn_conv_b': nrm((DEPTH, 2 * D_FF), 0.01),
        'ffn_w_down': nrm((DEPTH, D_FF, D_MODEL), D_FF ** -0.5),
        'ple_w_in': nrm((DEPTH, D_PLE, D_MODEL), D_PLE ** -0.5),
        'ple_w_gate': nrm((DEPTH, D_MODEL, D_MODEL), D_MODEL ** -0.5),
    }


def reference(x_prompt, x_sample, p_prompt, p_sample,
              cache_cmp_kv, cache_slc_kv, cache_win_kv,
              state_rg_conv, state_rg_h, state_ffn_conv, page_table,
              g_mix, g_ffn, g_ple, g_final,
              rg_w_in, rg_conv_w, rg_conv_b, rg_w_a, rg_b_a, rg_w_x, rg_b_x, rg_lambda, rg_w_out,
              g_kv, w_kv, cmp_pos, cmp_w1, cmp_b1, cmp_w2,
              attn_w_qg, attn_w_o,
              ffn_w_up, ffn_conv_w, ffn_conv_b, ffn_w_down,
              ple_w_in, ple_w_gate):

    def prompt_kv_side(stream):
        b, t = stream.shape[0], stream.shape[1]
        pos = jnp.arange(t, dtype=jnp.int32)
        cmp_kv, slc_kv, win_kv = shared_kv(rms_norm(stream, g_kv), pos, w_kv)
        kc, vc, c_end = compress(cmp_kv, cmp_pos, cmp_w1, cmp_b1, cmp_w2)
        slc_blk = slc_kv.reshape(b, t // L_SLC, L_SLC, 2, N_KV_HEADS, HEAD_DIM)
        win_pad = jnp.pad(win_kv, ((0, 0), (WINDOW, 0), (0, 0), (0, 0), (0, 0)))
        nqb = t // Q_BLOCK

        def blockify(a):
            return a.reshape(b, nqb, Q_BLOCK, *a.shape[2:]).swapaxes(0, 1)

        def one_block(args):
            qb, qrb, gb, start = args
            qpos = start + jnp.arange(Q_BLOCK, dtype=jnp.int32)
            kw = lax.dynamic_slice_in_dim(win_pad, start, WINDOW + Q_BLOCK, axis=1)
            wpos = start - WINDOW + jnp.arange(WINDOW + Q_BLOCK, dtype=jnp.int32)
            return nsa_core(qb, qrb, gb, qpos, kc, vc, c_end, slc_blk, kw, wpos)

        def attend(h, w_qg, w_o):
            q, qr, gates = nsa_query(h, pos, w_qg)
            starts = jnp.arange(nqb, dtype=jnp.int32) * Q_BLOCK
            o = lax.map(one_block, (blockify(q), blockify(qr), blockify(gates), starts))
            return o.swapaxes(0, 1).reshape(b, t, N_HEADS * HEAD_DIM) @ w_o

        return attend, (cmp_kv, slc_kv, win_kv[:, t - min(WINDOW, t):])

    def sample_kv_side(stream):
        db, tn = stream.shape[0], stream.shape[1]
        pos = PAST_LEN + jnp.arange(tn, dtype=jnp.int32)
        cmp_new, slc_new, win_new = shared_kv(rms_norm(stream, g_kv), pos, w_kv)
        t = PAST_LEN + tn
        cmp_full = jnp.concatenate([gather_pages(cache_cmp_kv, page_table).astype(cmp_new.dtype), cmp_new], axis=1)
        slc_full = jnp.concatenate([gather_pages(cache_slc_kv, page_table).astype(slc_new.dtype), slc_new], axis=1)
        kc, vc, c_end = compress(cmp_full, cmp_pos, cmp_w1, cmp_b1, cmp_w2)
        n_sb = -(-t // L_SLC)
        slc_blk = jnp.pad(slc_full, ((0, 0), (0, n_sb * L_SLC - t), (0, 0), (0, 0), (0, 0)))
        slc_blk = slc_blk.reshape(db, n_sb, L_SLC, 2, N_KV_HEADS, HEAD_DIM)
        w_buf = cache_win_kv.shape[1]
        win_full = jnp.concatenate([cache_win_kv.astype(win_new.dtype), win_new], axis=1)
        w_pos = PAST_LEN - w_buf + jnp.arange(w_buf + tn, dtype=jnp.int32)

        def attend(h, w_qg, w_o):
            q, qr, gates = nsa_query(h, pos, w_qg)
            return nsa_core(q, qr, gates, pos, kc, vc, c_end, slc_blk, win_full, w_pos) @ w_o

        keep = min(WINDOW, t)
        return attend, (cmp_new, slc_new, win_full[:, win_full.shape[1] - keep:])

    def run_group(x, p, pos, rg_conv0, rg_h0, ffn_conv0, kv_side):
        rg_conv_new, rg_h_new, ffn_conv_new = [], [], []
        attend, kv_state = None, None
        for i in range(DEPTH):
            if i == N_A_LAYERS:
                attend, kv_state = kv_side(x)
            h = rms_norm(x, g_mix[i])
            if i < N_A_LAYERS:
                o, c_hist, h_last = rg_lru_block(h, rg_conv0[i], rg_h0[i], pos, rg_w_in[i], rg_conv_w[i], rg_conv_b[i],
                                                 rg_w_a[i], rg_b_a[i], rg_w_x[i], rg_b_x[i], rg_lambda[i], rg_w_out[i])
                rg_conv_new.append(c_hist)
                rg_h_new.append(h_last)
            else:
                j = i - N_A_LAYERS
                o = attend(h, attn_w_qg[j], attn_w_o[j])
            x = x + o
            f, f_hist = conv_ffn(rms_norm(x, g_ffn[i]), ffn_conv0[i], ffn_w_up[i], ffn_conv_w[i], ffn_conv_b[i], ffn_w_down[i])
            x = x + f
            ffn_conv_new.append(f_hist)
            x = x + per_layer_embed(x, p[i], g_ple[i], ple_w_in[i], ple_w_gate[i])
        return rms_norm(x, g_final), jnp.stack(rg_conv_new), jnp.stack(rg_h_new), jnp.stack(ffn_conv_new), kv_state

    bp, sp = x_prompt.shape[0], x_prompt.shape[1]
    dt = x_prompt.dtype
    y_prompt, rgc_p, rgh_p, ffc_p, kv_p = run_group(
        x_prompt, p_prompt, jnp.arange(sp, dtype=jnp.int32),
        jnp.zeros((N_A_LAYERS, bp, RG_CONV_W - 1, D_RNN), dt),
        jnp.zeros((N_A_LAYERS, bp, D_RNN), dt),
        jnp.zeros((DEPTH, bp, FFN_CONV_W - 1, 2 * D_FF), dt),
        prompt_kv_side)
    y_sample, rgc_s, rgh_s, ffc_s, kv_s = run_group(
        x_sample, p_sample, PAST_LEN + jnp.arange(x_sample.shape[1], dtype=jnp.int32),
        state_rg_conv, state_rg_h, state_ffn_conv, sample_kv_side)
    cmp_p, slc_p, win_p = kv_p
    cmp_s, slc_s, win_s = kv_s
    return (y_prompt, y_sample, cmp_p, cmp_s, slc_p, slc_s, win_p, win_s,
            rgc_p, rgc_s, rgh_p, rgh_s, ffc_p, ffc_s)
```

```cpp
#include <hip/hip_runtime.h>
#include <hip/hip_cooperative_groups.h>
#include <cstdio>
#include <cstdint>
#include <cmath>
namespace cg = cooperative_groups;
#ifndef PROBE_DUP
#define PROBE_DUP 0
#endif


#define LAS __attribute__((address_space(3)))
#define GAS __attribute__((address_space(1)))
typedef unsigned short bf16;
typedef short bf16x8 __attribute__((ext_vector_type(8)));
typedef float f32x4 __attribute__((ext_vector_type(4)));
typedef float f32x2 __attribute__((ext_vector_type(2)));
typedef float f32x16 __attribute__((ext_vector_type(16)));
typedef unsigned u32x4 __attribute__((ext_vector_type(4)));
typedef unsigned u32x2 __attribute__((ext_vector_type(2)));

constexpr int DM = 1024, SEQ = 4096, NB = 4, MP = NB * SEQ, MS = 32, MTOT = MP + MS, MPAD = 16640, NMT = MPAD / 256;
constexpr int DRNN = 1280, DFF = 3072, DFF2 = 6144, DPLE = 256, NRGB = 16, RGB = 80;
constexpr int PAST = 8192, NPG = 64, PGSZ = 128, HD = 64, NH = 16, NG = 2, HPG = 8;
constexpr int NCB_P = 255, NCB_S = 511, NSB_S = 129;
constexpr int NQG = 1072, NQGP = 1280, NKV = 768;
constexpr float EPS = 1e-6f;
constexpr float C2 = 0.125f * 1.4426950408889634f;
constexpr int CMP_ROWS_P = NG * NB * 256, CMP_ROWS_S = NG * MS * 512, CMP_ROWS = CMP_ROWS_P + CMP_ROWS_S;

constexpr size_t O_Y_P = 0;
constexpr size_t O_Y_S = O_Y_P + (size_t)MP * DM;
constexpr size_t O_CMP_P = O_Y_S + (size_t)MS * DM;
constexpr size_t O_CMP_S = O_CMP_P + (size_t)MP * 256;
constexpr size_t O_SLC_P = O_CMP_S + (size_t)MS * 256;
constexpr size_t O_SLC_S = O_SLC_P + (size_t)MP * 256;
constexpr size_t O_WIN_P = O_SLC_S + (size_t)MS * 256;
constexpr size_t O_WIN_S = O_WIN_P + (size_t)NB * 512 * 256;
constexpr size_t O_RGC_P = O_WIN_S + (size_t)MS * 512 * 256;
constexpr size_t O_RGC_S = O_RGC_P + (size_t)2 * NB * 3 * DRNN;
constexpr size_t O_RGH_P = O_RGC_S + (size_t)2 * MS * 3 * DRNN;
constexpr size_t O_RGH_S = O_RGH_P + (size_t)2 * NB * DRNN;
constexpr size_t O_FFC_P = O_RGH_S + (size_t)2 * MS * DRNN;
constexpr size_t O_FFC_S = O_FFC_P + (size_t)4 * NB * 2 * DFF2;
constexpr size_t O_END = O_FFC_S + (size_t)4 * MS * 2 * DFF2;
static_assert(O_END == 32071680, "d_out size");

constexpr size_t al256(size_t x) { return (x + 255) & ~(size_t)255; }
constexpr size_t WS_CTL = 0;
constexpr size_t WS_WIN = WS_CTL + 65536;
constexpr size_t WS_WOUT = WS_WIN + (size_t)2 * 2560 * 1024 * 2;
constexpr size_t WS_WUP = WS_WOUT + (size_t)2 * 1024 * 1280 * 2;
constexpr size_t WS_WDN = WS_WUP + (size_t)4 * 6144 * 1024 * 2;
constexpr size_t WS_WPI = WS_WDN + (size_t)4 * 1024 * 3072 * 2;
constexpr size_t WS_WPG = WS_WPI + (size_t)4 * 1024 * 256 * 2;
constexpr size_t WS_WKV = WS_WPG + (size_t)4 * 1024 * 1024 * 2;
constexpr size_t WS_WQG = WS_WKV + (size_t)768 * 1024 * 2;
constexpr size_t WS_WO = WS_WQG + (size_t)2 * 1280 * 1024 * 2;
constexpr size_t WS_WC1 = WS_WO + (size_t)2 * 1024 * 1024 * 2;
constexpr size_t WS_WGA = WS_WC1 + (size_t)2 * 256 * 1024 * 2;
constexpr size_t WS_B1F = al256(WS_WGA + (size_t)2 * 2 * 16 * 80 * 96 * 2);
constexpr size_t WS_ROPE = al256(WS_B1F + 32 * 2 * 128 * 4);
constexpr size_t WS_PSS = al256(WS_ROPE + (size_t)4097 * 64 * 4);
constexpr size_t WS_X = al256(WS_PSS + (size_t)2 * 16 * MPAD * 4);
constexpr size_t WS_XB = WS_X + (size_t)MPAD * 1024 * 4;
__host__ __device__ constexpr size_t xb_off(int L) { return (L & 1) ? WS_X : WS_XB; }
constexpr size_t WS_PB = WS_XB + (size_t)MPAD * 1024 * 2;
constexpr size_t WS_Y = WS_PB + (size_t)4 * MPAD * 256 * 2;
constexpr size_t WS_G = WS_Y + (size_t)MPAD * 1280 * 2;
constexpr size_t WS_S = WS_G + (size_t)MPAD * 1280 * 2;
constexpr size_t WS_Q = WS_S + (size_t)MPAD * 1024 * 2;
constexpr size_t WS_QR = WS_Q + (size_t)MPAD * 1024 * 2;
constexpr size_t WS_O = WS_QR + (size_t)MPAD * 1024 * 2;
constexpr size_t WS_GT = WS_O + (size_t)MPAD * 1024 * 2;
constexpr size_t WS_KS = al256(WS_GT + (size_t)MPAD * 48 * 4);
constexpr size_t WS_VTS = WS_KS + (size_t)NB * NG * SEQ * 64 * 2;
constexpr size_t WS_KW = WS_VTS + (size_t)NB * NG * SEQ * 64 * 2;
constexpr size_t WS_VTW = WS_KW + (size_t)NB * NG * SEQ * 64 * 2;
constexpr size_t WS_KC = WS_VTW + (size_t)NB * NG * SEQ * 64 * 2;
constexpr size_t WS_VCT = WS_KC + (size_t)NB * NG * 256 * 64 * 2;
constexpr size_t WS_KCS = WS_VCT + (size_t)NB * NG * 256 * 64 * 2;
constexpr size_t WS_VCS = WS_KCS + (size_t)MS * NG * 512 * 64 * 4;
constexpr size_t WS_CMPA = WS_VCS + (size_t)MS * NG * 512 * 64 * 4;
constexpr size_t WS_T = WS_CMPA + (size_t)2 * CMP_ROWS * 1024 * 2;
constexpr size_t WS_BIG = WS_T + (size_t)2 * CMP_ROWS * 256 * 4;
constexpr size_t WS_XR = WS_BIG;
constexpr size_t WS_HL = WS_XR + (size_t)MPAD * 1280 * 4;
constexpr size_t WS_AC = WS_HL + (size_t)MPAD * 1280 * 4;
constexpr size_t WS_UP = WS_BIG;
constexpr size_t WS_ACT = WS_UP + (size_t)MPAD * 6144 * 2;
constexpr size_t WS_UPH = WS_ACT + (size_t)MPAD * 3072 * 2;
constexpr size_t WS_PIN = WS_UPH + (size_t)64 * 4 * 6144 * 4;
constexpr size_t WS_STASH = WS_PIN + (size_t)4 * MPAD * 1024 * 2;
constexpr size_t WS_SPSS = WS_STASH + (size_t)256 * 8 * 2048 * 4;
constexpr size_t WS_END_A = WS_AC + (size_t)MPAD * 1280 * 4, WS_END_B = WS_SPSS + (size_t)2 * 64 * 32 * 4;
constexpr size_t WS_END = WS_END_A > WS_END_B ? WS_END_A : WS_END_B;
static_assert(WS_END < (size_t)1300 * 1024 * 1024, "workspace budget");

constexpr int LDS_RING = 0, LDS_RING_BYTES = 131072;
constexpr int LDS_RS = LDS_RING_BYTES;
constexpr int LDS_MISC = 163840 - 256;
constexpr int LDS_HALO = LDS_RS + 8 * 1024;
constexpr int LDS_BYTES = 163840;

struct Params { const void* in[38]; float* out; unsigned char* ws; int ph_lo, ph_hi; };
typedef const __attribute__((address_space(4))) Params* KP;
__device__ __forceinline__ KP launder(KP p) { asm volatile("" : "+s"(p)); return p; }
__device__ __forceinline__ int launder_v(int x) { asm volatile("" : "+v"(x)); return x; }
__device__ __forceinline__ int launder_s(int x) { asm volatile("" : "+s"(x)); return x; }

__device__ __forceinline__ unsigned f2bf(float f) { unsigned u = __builtin_bit_cast(unsigned, f); return (u + 0x7fffu + ((u >> 16) & 1u)) >> 16; }
typedef __bf16 bf16x2_t __attribute__((ext_vector_type(2)));
__device__ __forceinline__ unsigned pk2(float lo, float hi) { const f32x2 v = {lo, hi}; return __builtin_bit_cast(unsigned, __builtin_convertvector(v, bf16x2_t)); }
__device__ __forceinline__ f32x4 unpack4(u32x2 w);
__device__ __forceinline__ void unpack8(u32x4 w, f32x4& lo, f32x4& hi) { lo = unpack4((u32x2){w.x, w.y}); hi = unpack4((u32x2){w.z, w.w}); }
__device__ __forceinline__ f32x4 unpack4(u32x2 w) { f32x4 v; v[0] = __builtin_bit_cast(float, w.x << 16); v[1] = __builtin_bit_cast(float, w.x & 0xffff0000u); v[2] = __builtin_bit_cast(float, w.y << 16); v[3] = __builtin_bit_cast(float, w.y & 0xffff0000u); return v; }
__device__ __forceinline__ float bf2f(unsigned short b) { return __builtin_bit_cast(float, ((unsigned)b) << 16); }
__device__ __forceinline__ float gelu_tanh(float x) {
    const float u = 0.7978845608028654f * (x + 0.044715f * x * x * x);
    return x * __builtin_amdgcn_rcpf(1.0f + __expf(-2.0f * u));
}
__device__ __forceinline__ float sigmoidf_(float x) { return __builtin_amdgcn_rcpf(1.0f + __expf(-x)); }
__device__ __forceinline__ float wave_sum(float v) {
#pragma unroll
    for (int o = 1; o < 64; o <<= 1) v += __shfl_xor(v, o);
    return v;
}
namespace pg8 {
#define PG8_LAS __attribute__((address_space(3)))
typedef unsigned short bf16_t;
typedef short bf16x8 __attribute__((ext_vector_type(8)));
typedef float f32x4 __attribute__((ext_vector_type(4)));
typedef unsigned u32x4 __attribute__((ext_vector_type(4)));
constexpr int BM = 256, BK = 64, HALF = 128, HTB = HALF * BK * 2  , STAGE_BYTES = 8 * HTB, NXCD = 8, WGM = 8;

__host__ __device__ __forceinline__ int lds_byte(int r, int c) { const int st = (r >> 4) * 2 + (c >> 5), rr = r & 15, cc = c & 31, ob = rr * 64 + cc * 2; return st * 1024 + (ob ^ (((ob >> 9) & 1) << 5)); }
__host__ __device__ __forceinline__ void stage_rc(int b, int& R, int& C) { const int st = b / 1024, sb = b % 1024, swz = sb ^ (((sb >> 9) & 1) << 5); R = (st >> 1) * 16 + swz / 64; C = (st & 1) * 32 + (swz % 64) / 2; }
__host__ __device__ __forceinline__ int perm32(int rho) { const int n = rho >> 4, i = rho & 15; return 8 * (i >> 2) + 4 * n + (i & 3); }

struct Unit { int pm, pn; };
struct Gemm { const bf16_t* A; const bf16_t* Bt; int M, N, K; };

struct StaticOrder {
    int nM, nN, nwg, G, c;
    __host__ __device__ __forceinline__ void init(int M, int N, int G_, int c_) { nM = M / BM; nN = N / BM; nwg = nM * nN; G = G_; c = c_; }
    __host__ __device__ __forceinline__ bool next(int i, Unit& u) const {
        const long L = (long)i * G + c; if (L >= nwg) return false;
        int wgid = (int)L; { const int q = nwg / NXCD, r = nwg % NXCD, xcd = wgid % NXCD, off = wgid / NXCD; wgid = (xcd < r ? xcd * (q + 1) : r * (q + 1) + (xcd - r) * q) + off; }
        const int nig = WGM * nN, gid = wgid / nig, fm = gid * WGM, gsz = (nM - fm) < WGM ? (nM - fm) : WGM;
        u.pm = fm + ((wgid % nig) % gsz); u.pn = (wgid % nig) / gsz; return true;
    }
    __device__ __forceinline__ void a_ready(const Unit&) const {}
    __device__ __forceinline__ void done(const Unit&) const {}
};
__device__ __forceinline__ unsigned cvt_pk_bf16(float lo, float hi) { unsigned r; asm volatile("v_cvt_pk_bf16_f32 %0, %1, %2" : "=v"(r) : "v"(lo), "v"(hi)); return r; }
typedef float f32x2 __attribute__((ext_vector_type(2)));
template <class Epi, class Sched, bool ALIGN_EPI = false, bool SP2 = false>
__device__ __forceinline__ void gemm_phase(PG8_LAS unsigned char* lds, const Gemm g, const Sched& S, const Epi& E) {
    int tid = threadIdx.x; asm volatile("" : "+v"(tid));
    const int wid = __builtin_amdgcn_readfirstlane(tid >> 6), lane = tid & 63, wr = wid >> 2, wc = wid & 3, fr = lane & 15, fq = lane >> 4;
    const int K = g.K, nt = K / BK;
    unsigned voffA[2], voffB[2];
#pragma unroll
    for (int i = 0; i < 2; ++i) { int R, C; stage_rc(tid * 16 + i * 8192, R, C); const int Rb = Epi::PERM ? ((R & ~31) + perm32(R & 31)) : R;
        voffA[i] = (unsigned)(R * K + C) * 2u; voffB[i] = (unsigned)(Rb * K + C) * 2u; }
    const size_t kstep = (size_t)(BK * 2);
    const size_t hstep = (size_t)HALF * K * 2;
    const size_t tstep = 2 * hstep;
    const unsigned ldsw = (unsigned)wid * 1024u;
    const int aoff = lds_byte(wr * 64 + fr, fq * 8), boff = lds_byte(wc * 32 + fr, fq * 8);
#define PG8_SA(b, h) (((b) * 2 + (h)) * HTB)
#define PG8_SB(b, h) ((4 + (b) * 2 + (h)) * HTB)
#define PG8_STAGE(bufoff, gbase, voff) do { _Pragma("unroll") for (int _i = 0; _i < 2; ++_i) \
        __builtin_amdgcn_global_load_lds((const unsigned*)((const char*)(gbase) + (voff)[_i]), (PG8_LAS unsigned*)(lds + (bufoff) + ldsw + _i * 8192), 16, 0, 0); } while (0)
#define PG8_LDA(dst, b, h) do { _Pragma("unroll") for (int m = 0; m < 4; ++m) _Pragma("unroll") for (int k = 0; k < 2; ++k) dst[m][k] = *(const PG8_LAS bf16x8*)(lds + PG8_SA(b, h) + aoff + m * 2048 + k * 1024); } while (0)
#define PG8_LDB(dst, b, h) do { _Pragma("unroll") for (int n = 0; n < 2; ++n) _Pragma("unroll") for (int k = 0; k < 2; ++k) dst[n][k] = *(const PG8_LAS bf16x8*)(lds + PG8_SB(b, h) + boff + n * 2048 + k * 1024); } while (0)
#define PG8_MMA(ai, bj, At, Bt) do { __builtin_amdgcn_s_setprio(1); _Pragma("unroll") for (int m = 0; m < 4; ++m) _Pragma("unroll") for (int n = 0; n < 2; ++n) _Pragma("unroll") for (int k = 0; k < 2; ++k) \
        acc[ai][bj][m][n] = __builtin_amdgcn_mfma_f32_16x16x32_bf16(Bt[n][k], At[m][k], acc[ai][bj][m][n], 0, 0, 0); __builtin_amdgcn_s_setprio(0); } while (0)
#define PG8_WAIT_V(n) asm volatile("s_waitcnt vmcnt(" #n ")" ::: "memory")
#define PG8_WAIT_L(n) asm volatile("s_waitcnt lgkmcnt(" #n ")" ::: "memory")
#define PG8_BAR __builtin_amdgcn_s_barrier()
#define PG8_SCHED __builtin_amdgcn_sched_barrier(0)
    Unit cur, nxt; int ui = 0;
    if (!S.next(0, cur)) return;
    f32x4 acc[2][2][4][2];
#pragma unroll
    for (int a = 0; a < 2; ++a)
#pragma unroll
        for (int b = 0; b < 2; ++b)
#pragma unroll
            for (int m = 0; m < 4; ++m)
#pragma unroll
                for (int n = 0; n < 2; ++n) acc[a][b][m][n] = (f32x4){0.f, 0.f, 0.f, 0.f};
    bf16x8 At[4][2], B0[2][2], B1[2][2];
    const char* cA = (const char*)g.A + (size_t)cur.pm * tstep; const char* cB = (const char*)g.Bt + (size_t)cur.pn * tstep;
    S.a_ready(cur);
    if constexpr (SP2) {
        PG8_STAGE(PG8_SB(0, 0), cB, voffB); PG8_STAGE(PG8_SB(0, 1), cB + hstep, voffB); PG8_STAGE(PG8_SA(0, 0), cA, voffA); PG8_STAGE(PG8_SA(0, 1), cA + hstep, voffA);
        if (wr == 1) PG8_BAR;
        PG8_WAIT_V(2); PG8_BAR;
        PG8_STAGE(PG8_SB(1, 0), cB + kstep, voffB); PG8_STAGE(PG8_SA(1, 0), cA + kstep, voffA); PG8_STAGE(PG8_SB(1, 1), cB + hstep + kstep, voffB);
        PG8_WAIT_V(6); PG8_BAR;
    } else {
        PG8_STAGE(PG8_SB(0, 0), cB, voffB); PG8_STAGE(PG8_SA(0, 0), cA, voffA); PG8_STAGE(PG8_SB(0, 1), cB + hstep, voffB); PG8_STAGE(PG8_SA(0, 1), cA + hstep, voffA);
        if (wr == 1) PG8_BAR;
        PG8_WAIT_V(4); PG8_BAR;
        PG8_STAGE(PG8_SB(1, 0), cB + kstep, voffB); PG8_STAGE(PG8_SA(1, 0), cA + kstep, voffA); PG8_STAGE(PG8_SB(1, 1), cB + hstep + kstep, voffB);
        PG8_WAIT_V(6); PG8_BAR;
    }
    for (;;) {
        const bool has_next = S.next(ui + 1, nxt);
        const char* nA = has_next ? (const char*)g.A + (size_t)nxt.pm * tstep : cA; const char* nB = has_next ? (const char*)g.Bt + (size_t)nxt.pn * tstep : cB;
        for (int t = 0; t < nt; t += 2) {
            const bool last = (t == nt - 2);
            const char* a1 = cA + (size_t)(t + 1) * kstep;
            const char* a2 = last ? nA : cA + (size_t)(t + 2) * kstep; const char* b2 = last ? nB : cB + (size_t)(t + 2) * kstep;
            const char* a3 = a2 + kstep; const char* b3 = b2 + kstep;
            if (last && has_next) S.a_ready(nxt);
            if constexpr (SP2) {
            PG8_LDB(B0, 0, 0); PG8_LDB(B1, 0, 1); PG8_SCHED; PG8_LDA(At, 0, 0); PG8_STAGE(PG8_SA(1, 1), a1 + hstep, voffA);
            PG8_WAIT_V(8); PG8_WAIT_L(0); PG8_BAR; PG8_MMA(0, 0, At, B0); PG8_MMA(0, 1, At, B1); PG8_BAR; PG8_SCHED;
            PG8_LDA(At, 0, 1); PG8_STAGE(PG8_SB(0, 0), b2, voffB); PG8_STAGE(PG8_SB(0, 1), b2 + hstep, voffB); PG8_STAGE(PG8_SA(0, 0), a2, voffA);
            PG8_WAIT_V(8); PG8_WAIT_L(0); PG8_BAR; PG8_MMA(1, 0, At, B0); PG8_MMA(1, 1, At, B1); PG8_BAR; PG8_SCHED;
            PG8_LDB(B0, 1, 0); PG8_LDB(B1, 1, 1); PG8_SCHED; PG8_LDA(At, 1, 0); PG8_STAGE(PG8_SA(0, 1), a2 + hstep, voffA);
            PG8_WAIT_V(8); PG8_WAIT_L(0); PG8_BAR; PG8_MMA(0, 0, At, B0); PG8_MMA(0, 1, At, B1); PG8_BAR; PG8_SCHED;
            PG8_LDA(At, 1, 1); PG8_STAGE(PG8_SB(1, 0), b3, voffB); PG8_STAGE(PG8_SB(1, 1), b3 + hstep, voffB); PG8_STAGE(PG8_SA(1, 0), a3, voffA);
            PG8_WAIT_V(8); PG8_WAIT_L(0); PG8_BAR; PG8_MMA(1, 0, At, B0); PG8_MMA(1, 1, At, B1); PG8_BAR; PG8_SCHED;
            } else {
            PG8_LDB(B0, 0, 0); PG8_SCHED; PG8_LDA(At, 0, 0); PG8_STAGE(PG8_SA(1, 1), a1 + hstep, voffA);
            PG8_WAIT_L(8); PG8_BAR; PG8_WAIT_L(0); PG8_MMA(0, 0, At, B0); PG8_BAR; PG8_SCHED;
            PG8_LDB(B1, 0, 1); PG8_STAGE(PG8_SB(0, 0), b2, voffB);
            PG8_BAR; PG8_WAIT_L(0); PG8_MMA(0, 1, At, B1); PG8_BAR;
            PG8_LDA(At, 0, 1); PG8_STAGE(PG8_SA(0, 0), a2, voffA);
            PG8_BAR; PG8_WAIT_L(0); PG8_MMA(1, 0, At, B0); PG8_BAR; PG8_SCHED;
            PG8_STAGE(PG8_SB(0, 1), b2 + hstep, voffB);
            PG8_WAIT_V(6); PG8_BAR; PG8_MMA(1, 1, At, B1); PG8_BAR;
            PG8_LDB(B0, 1, 0); PG8_SCHED; PG8_LDA(At, 1, 0); PG8_STAGE(PG8_SA(0, 1), a2 + hstep, voffA);
            PG8_WAIT_L(8); PG8_BAR; PG8_WAIT_L(0); PG8_MMA(0, 0, At, B0); PG8_BAR; PG8_SCHED;
            PG8_LDB(B1, 1, 1); PG8_STAGE(PG8_SB(1, 0), b3, voffB);
            PG8_BAR; PG8_WAIT_L(0); PG8_MMA(0, 1, At, B1); PG8_BAR;
            PG8_LDA(At, 1, 1); PG8_STAGE(PG8_SA(1, 0), a3, voffA);
            PG8_BAR; PG8_WAIT_L(0); PG8_MMA(1, 0, At, B0); PG8_BAR; PG8_SCHED;
            PG8_STAGE(PG8_SB(1, 1), b3 + hstep, voffB);
            PG8_WAIT_V(6); PG8_BAR; PG8_MMA(1, 1, At, B1); PG8_BAR;
            }
        }
        if constexpr (ALIGN_EPI) { if (wr == 0) PG8_BAR; }
        if constexpr (!Epi::AFTER_DRAIN) { E(acc, cur, wr, wc, fr, fq); S.done(cur); }
        if (!has_next) break;
#pragma unroll
        for (int a = 0; a < 2; ++a)
#pragma unroll
            for (int b = 0; b < 2; ++b)
#pragma unroll
                for (int m = 0; m < 4; ++m)
#pragma unroll
                    for (int n = 0; n < 2; ++n) acc[a][b][m][n] = (f32x4){0.f, 0.f, 0.f, 0.f};
        cur = nxt; cA = nA; cB = nB; ++ui;
        if constexpr (ALIGN_EPI) { if (wr == 1) PG8_BAR; }
    }
    PG8_WAIT_V(0);
    if constexpr (!ALIGN_EPI) { if (wr == 0) PG8_BAR; }
    PG8_BAR;
    if constexpr (Epi::AFTER_DRAIN) { E.fused(acc, cur, wr, wc, fr, fq, lds, wid, lane); S.done(cur); }
#undef PG8_SA
#undef PG8_SB
#undef PG8_STAGE
#undef PG8_LDA
#undef PG8_LDB
#undef PG8_MMA
#undef PG8_WAIT_V
#undef PG8_WAIT_L
#undef PG8_BAR
#undef PG8_SCHED
}
}
#define XB_TMO      128
#define XB_XCNT(j)  (256  + 64 * (j))
#define XB_XSUB(j)  (1280 + 64 * (j))
#define XB_XGEN(j)  (2304 + 64 * (j))
#define XB_TOP      3328
#define XB_TOPGEN   3392
#define XCD_BAR_WORDS 3456
#define XB_SPIN_CAP (1u << 18)

__device__ __forceinline__ unsigned xb_ld(unsigned* p)              { return __hip_atomic_load(p, __ATOMIC_RELAXED, __HIP_MEMORY_SCOPE_AGENT); }
__device__ __forceinline__ unsigned xb_add(unsigned* p, unsigned v) { return __hip_atomic_fetch_add(p, v, __ATOMIC_RELAXED, __HIP_MEMORY_SCOPE_AGENT); }
__device__ __forceinline__ unsigned xb_xcc_id() { return (unsigned)__builtin_amdgcn_s_getreg((3 << 11) | 20) & 0xFu; }
#define XB_SPIN(cond, bar) do { unsigned _sp = 0; while (cond) { __builtin_amdgcn_s_sleep(1); \
    if ((++_sp & 255u) == 0u) { if (xb_ld(&(bar)[XB_TMO])) break; if (_sp > XB_SPIN_CAP) { atomicAdd(&(bar)[XB_TMO], 1u); break; } } } } while (0)

struct XcdBarrier {
    unsigned* bar; unsigned x;
    volatile LAS unsigned* st;
};

__device__ __forceinline__ XcdBarrier xcd_barrier_post(unsigned* bar, volatile LAS unsigned* st) {
    XcdBarrier b; b.bar = bar; b.x = xb_xcc_id(); b.st = st;
    if (threadIdx.x == 0) (void)xb_add(&bar[XB_XCNT(b.x)], 1u);
    return b;
}
__device__ __forceinline__ void xcd_barrier_complete(unsigned* bar, unsigned x, unsigned& nloc, unsigned& nx) {
    const unsigned G = gridDim.x * gridDim.y * gridDim.z;
    unsigned sum, cnt, mine, sp = 0u;
    for (;;) {
        sum = 0u; cnt = 0u; mine = 0u;
#pragma unroll
        for (unsigned j = 0; j < 16; ++j) { const unsigned c = xb_ld(&bar[XB_XCNT(j)]); sum += c; cnt += (c > 0u) ? 1u : 0u; mine = (j == x) ? c : mine; }
        if (sum == G) break;
        __builtin_amdgcn_s_sleep(1);
        if ((++sp & 255u) == 0u) { if (xb_ld(&bar[XB_TMO])) break; if (sp > XB_SPIN_CAP) { atomicAdd(&bar[XB_TMO], 1u); break; } }
    }
    nloc = mine > 0u ? mine : 1u; nx = cnt > 0u ? cnt : 1u;
}

__device__ __forceinline__ void xcd_barrier(const XcdBarrier& b) {
    asm volatile("s_waitcnt vmcnt(0)" ::: "memory");
    __syncthreads();
    if (threadIdx.x == 0) {
        unsigned* bar = b.bar;
        __builtin_amdgcn_s_waitcnt(0);
        unsigned nloc = b.st[0], nx = b.st[1];
        if (nloc == 0u) { xcd_barrier_complete(bar, b.x, nloc, nx); b.st[0] = nloc; b.st[1] = nx; }
        const unsigned old = xb_add(&bar[XB_XSUB(b.x)], 1u);
        const unsigned gen = old / nloc;
        if (old + 1u == (gen + 1u) * nloc) {
            __builtin_amdgcn_fence(__ATOMIC_RELEASE, "agent");
            asm volatile("s_waitcnt vmcnt(0)" ::: "memory");
            const unsigned og = xb_add(&bar[XB_TOP], 1u);
            const unsigned tg = og / nx;
            if (og + 1u == (tg + 1u) * nx) xb_add(&bar[XB_TOPGEN], 1u);
            else XB_SPIN(xb_ld(&bar[XB_TOPGEN]) == tg, bar);
            __builtin_amdgcn_fence(__ATOMIC_ACQUIRE, "agent");
            xb_add(&bar[XB_XGEN(b.x)], 1u);
            asm volatile("s_waitcnt vmcnt(0)" ::: "memory");
        } else {
            XB_SPIN(xb_ld(&bar[XB_XGEN(b.x)]) == gen, bar);
            __builtin_amdgcn_fence(__ATOMIC_ACQUIRE, "agent");
            asm volatile("s_waitcnt vmcnt(0)" ::: "memory");
        }
    }
    __syncthreads();
}


__device__ unsigned g_seam0[10 * 64];
__device__ __forceinline__ void seam0_barrier() {
    asm volatile("s_waitcnt vmcnt(0)" ::: "memory");
    __syncthreads();
    if (threadIdx.x == 0) {
        __builtin_amdgcn_fence(__ATOMIC_RELEASE, "agent");
        asm volatile("s_waitcnt vmcnt(0)" ::: "memory");
        const unsigned G = gridDim.x, s = blockIdx.x & 7u, ns = (G - s + 7u) >> 3, nsh = G < 8u ? G : 8u;
        const unsigned old = xb_add(&g_seam0[s * 64], 1u);
        const unsigned round = old / ns;
        if (old + 1u == (round + 1u) * ns) {
            const unsigned o2 = xb_add(&g_seam0[8 * 64], 1u);
            if ((o2 + 1u) % nsh == 0u) xb_add(&g_seam0[9 * 64], 1u);
        }
        unsigned sp = 0u;
        while ((int)(xb_ld(&g_seam0[9 * 64]) - (round + 1u)) < 0) { __builtin_amdgcn_s_sleep(2); if (++sp > (1u << 24)) break; }
        __builtin_amdgcn_fence(__ATOMIC_ACQUIRE, "agent");
        asm volatile("s_waitcnt vmcnt(0)" ::: "memory");
    }
    __syncthreads();
}
__device__ __forceinline__ int rowmap(int mode, int nn) {
    const int il = (nn & ~63) + 2 * (nn & 31) + ((nn >> 5) & 1);
    if (mode == 1) return nn < 1024 ? il : nn;
    if (mode == 2) { const int j = nn >> 7; return (j == 2 || j == 4) ? il : nn; }
    if (mode == 3) { const int half = nn >= DFF ? 1 : 0, ka = nn - half * DFF; return (ka >> 7) * 256 + half * 128 + (ka & 127); }
    return nn;
}
__device__ __forceinline__ void tr_item(const float* __restrict__ W, int ldn, int Nsrc, bf16* __restrict__ WT, int dstK, const float* __restrict__ gain, int mode, int item, int nblk,
                                        LAS float* scr, int lane) {
    const int kb = item / nblk, nb = item % nblk, k0 = 64 * kb, n0 = 32 * nb;
    const int n = n0 + (lane & 31);
    float wv[32];
#pragma unroll
    for (int i = 0; i < 32; ++i) { const int kk = 2 * i + (lane >> 5); wv[i] = (n < Nsrc) ? W[(size_t)(k0 + kk) * ldn + n] : 0.f; }
#pragma unroll
    for (int i = 0; i < 32; ++i) { const int kk = 2 * i + (lane >> 5); float v = wv[i]; if (gain) v *= gain[k0 + kk]; scr[kk * 33 + (lane & 31)] = v; }
    asm volatile("s_waitcnt lgkmcnt(0)" ::: "memory");
    const int c = lane & 7;
#pragma unroll
    for (int j = 0; j < 4; ++j) {
        const int nl = (lane >> 3) + 8 * j; const LAS float* s = scr + (8 * c) * 33 + nl;
        u32x4 o; o.x = pk2(s[0 * 33], s[1 * 33]); o.y = pk2(s[2 * 33], s[3 * 33]); o.z = pk2(s[4 * 33], s[5 * 33]); o.w = pk2(s[6 * 33], s[7 * 33]);
        const int row = rowmap(mode, n0 + nl);
        *(u32x4*)(WT + (size_t)row * dstK + k0 + 8 * c) = o;
    }
    asm volatile("s_waitcnt lgkmcnt(0)" ::: "memory");
}

__device__ __forceinline__ void phase0(KP P, LAS unsigned char* lds, int tid, int lane, int wave, int G) {
    unsigned char* ws = P->ws;
    const int gw = launder_s(blockIdx.x) * 8 + wave, NGW = G * 8;
    const size_t gt = (size_t)launder_s(blockIdx.x) * 512 + tid, NGT = (size_t)G * 512;
    LAS float* scr = (LAS float*)(lds + wave * 16384);
    {
        const float* g_mix = (const float*)P->in[11]; const float* g_ffn = (const float*)P->in[12]; const float* g_ple = (const float*)P->in[13];
        constexpr int C_WIN = 16 * 80, C_WOUT = 20 * 32, C_WUP = 16 * 192, C_WDN = 48 * 32, C_WPI = 4 * 32, C_WPG = 16 * 32, C_WKV = 16 * 24, C_WQG = 16 * 40, C_WO = 16 * 32, C_WC1 = 16 * 4;
        constexpr int NITEMS = 2 * C_WIN + 2 * C_WOUT + 4 * C_WUP + 4 * C_WDN + 4 * C_WPI + 4 * C_WPG + C_WKV + 2 * C_WQG + 2 * C_WO + 4 * C_WC1;
        for (int it = gw; it < NITEMS; it += NGW) {
            int r = it;
            if (r < 2 * C_WIN) { const int L = r / C_WIN; r %= C_WIN;
                tr_item((const float*)P->in[15] + (size_t)L * 1024 * 2560, 2560, 2560, (bf16*)(ws + WS_WIN) + (size_t)L * 2560 * 1024, 1024, g_mix + L * 1024, 0, r, 80, scr, lane); continue; }
            r -= 2 * C_WIN;
            if (r < 2 * C_WOUT) { const int L = r / C_WOUT; r %= C_WOUT;
                tr_item((const float*)P->in[23] + (size_t)L * 1280 * 1024, 1024, 1024, (bf16*)(ws + WS_WOUT) + (size_t)L * 1024 * 1280, 1280, nullptr, 0, r, 32, scr, lane); continue; }
            r -= 2 * C_WOUT;
            if (r < 4 * C_WUP) { const int L = r / C_WUP; r %= C_WUP;
                tr_item((const float*)P->in[32] + (size_t)L * 1024 * 6144, 6144, 6144, (bf16*)(ws + WS_WUP) + (size_t)L * 6144 * 1024, 1024, g_ffn + L * 1024, 3, r, 192, scr, lane); continue; }
            r -= 4 * C_WUP;
            if (r < 4 * C_WDN) { const int L = r / C_WDN; r %= C_WDN;
                tr_item((const float*)P->in[35] + (size_t)L * 3072 * 1024, 1024, 1024, (bf16*)(ws + WS_WDN) + (size_t)L * 1024 * 3072, 3072, nullptr, 0, r, 32, scr, lane); continue; }
            r -= 4 * C_WDN;
            if (r < 4 * C_WPI) { const int L = r / C_WPI; r %= C_WPI;
                tr_item((const float*)P->in[36] + (size_t)L * 256 * 1024, 1024, 1024, (bf16*)(ws + WS_WPI) + (size_t)L * 1024 * 256, 256, nullptr, 0, r, 32, scr, lane); continue; }
            r -= 4 * C_WPI;
            if (r < 4 * C_WPG) { const int L = r / C_WPG; r %= C_WPG;
                tr_item((const float*)P->in[37] + (size_t)L * 1024 * 1024, 1024, 1024, (bf16*)(ws + WS_WPG) + (size_t)L * 1024 * 1024, 1024, g_ple + L * 1024, 0, r, 32, scr, lane); continue; }
            r -= 4 * C_WPG;
            if (r < C_WKV) { tr_item((const float*)P->in[25], 768, 768, (bf16*)(ws + WS_WKV), 1024, (const float*)P->in[24], 2, r, 24, scr, lane); continue; }
            r -= C_WKV;
            if (r < 2 * C_WQG) { const int L = r / C_WQG; r %= C_WQG;
                tr_item((const float*)P->in[30] + (size_t)L * 1024 * NQG, NQG, NQG, (bf16*)(ws + WS_WQG) + (size_t)L * NQGP * 1024, 1024, g_mix + (2 + L) * 1024, 1, r, 40, scr, lane); continue; }
            r -= 2 * C_WQG;
            if (r < 2 * C_WO) { const int L = r / C_WO; r %= C_WO;
                tr_item((const float*)P->in[31] + (size_t)L * 1024 * 1024, 1024, 1024, (bf16*)(ws + WS_WO) + (size_t)L * 1024 * 1024, 1024, nullptr, 0, r, 32, scr, lane); continue; }
            r -= 2 * C_WO;
            { const int q = r / C_WC1; r %= C_WC1; const int j = q >> 1, half = q & 1;
                tr_item((const float*)P->in[27] + (size_t)j * 2048 * 128 + (size_t)half * 1024 * 128, 128, 128, (bf16*)(ws + WS_WC1) + (size_t)j * 256 * 1024 + (size_t)half * 128 * 1024, 1024, nullptr, 0, r, 4, scr, lane); }
        }
    }
    {
        bf16* XB = (bf16*)(ws + WS_XB); bf16* XB1 = (bf16*)(ws + WS_X); float* PSS = (float*)(ws + WS_PSS);
        for (int m0 = gw; m0 < MPAD; m0 += 2 * NGW) {
          f32x4 vv[2][4];
#pragma unroll
          for (int q = 0; q < 2; ++q) { const int m = m0 + q * NGW;
            const float* src = m < MP ? (const float*)P->in[0] + (size_t)m * 1024 : (const float*)P->in[1] + (size_t)(m - MP) * 1024;
#pragma unroll
            for (int j = 0; j < 4; ++j) { vv[q][j] = (f32x4){0.f, 0.f, 0.f, 0.f}; if (m < MTOT) vv[q][j] = *(const f32x4*)(src + 4 * lane + 256 * j); } }
#pragma unroll
          for (int q = 0; q < 2; ++q) { const int m = m0 + q * NGW; if (m >= MPAD) break;
            float ss = 0.f;
#pragma unroll
            for (int j = 0; j < 4; ++j) {
                f32x4 v = vv[q][j];
                u32x2 w; w.x = pk2(v[0], v[1]); w.y = pk2(v[2], v[3]);
                *(u32x2*)(XB + (size_t)m * 1024 + 4 * lane + 256 * j) = w;
                if (m >= MTOT) *(u32x2*)(XB1 + (size_t)m * 1024 + 4 * lane + 256 * j) = w;
                v = unpack4(w);
                ss += (v[0] * v[0] + v[1] * v[1]) + (v[2] * v[2] + v[3] * v[3]);
            }
            ss = wave_sum(ss);
            if (lane < 16) PSS[(size_t)lane * MPAD + m] = (lane == 0) ? ss : 0.f;
            if (m >= MP && m < MTOT) ((float*)(ws + WS_SPSS))[lane * 32 + (m - MP)] = (lane == 0) ? ss : 0.f;
          }
        }
    }
    {
        bf16* PB = (bf16*)(ws + WS_PB);
        for (size_t i0 = gt; i0 < (size_t)4 * MPAD * 64; i0 += 8 * NGT) {
            f32x4 v[8];
#pragma unroll
            for (int q = 0; q < 8; ++q) { const size_t i = i0 + q * NGT; v[q] = (f32x4){0.f, 0.f, 0.f, 0.f};
                if (i < (size_t)4 * MPAD * 64) { const int c4 = (int)(i & 63); const size_t rm = i >> 6; const int m = (int)(rm % MPAD), L = (int)(rm / MPAD);
                    if (m < MP) v[q] = *(const f32x4*)((const float*)P->in[2] + ((size_t)L * MP + m) * 256 + 4 * c4);
                    else if (m < MTOT) v[q] = *(const f32x4*)((const float*)P->in[3] + ((size_t)L * MS + (m - MP)) * 256 + 4 * c4); } }
#pragma unroll
            for (int q = 0; q < 8; ++q) { const size_t i = i0 + q * NGT;
                if (i < (size_t)4 * MPAD * 64) { u32x2 w; w.x = pk2(v[q][0], v[q][1]); w.y = pk2(v[q][2], v[q][3]); *(u32x2*)(PB + i * 4) = w; } }
        }
    }
    {
        const float* cache = (const float*)P->in[4]; const int* pt = (const int*)P->in[10]; bf16* CA = (bf16*)(ws + WS_CMPA);
        for (int item = launder_s(blockIdx.x); item < MS * NPG; item += G) {
            const int sb = item / NPG, pg = item % NPG;
            const float* src = cache + (size_t)pt[item] * (PGSZ * 256);
            static_assert(PGSZ * 64 == 16 * 512, "page = 16 float4 per thread");
#pragma unroll
            for (int hb = 0; hb < 2; ++hb) {
                f32x4 v[8];
#pragma unroll
                for (int q = 0; q < 8; ++q) v[q] = __builtin_nontemporal_load((const f32x4*)(src + (size_t)(tid + 512 * (8 * hb + q)) * 4));
#pragma unroll
                for (int q = 0; q < 8; ++q) { const int c = tid + 512 * (8 * hb + q);
                    const int f = c * 4, tl = f >> 8, rem = f & 255, j = rem >> 7, g = (rem >> 6) & 1, d = rem & 63;
                    u32x2 w; w.x = pk2(v[q][0], v[q][1]); w.y = pk2(v[q][2], v[q][3]);
                    const size_t row = (size_t)CMP_ROWS_P + (size_t)(g * MS + sb) * 512 + pg * 8 + (tl >> 4);
                    *(u32x2*)(CA + ((size_t)j * CMP_ROWS + row) * 1024 + (tl & 15) * 64 + d) = w; }
            }
        }
    }
    {
        float* RT = (float*)(ws + WS_ROPE);
        for (size_t i = gt; i < (size_t)4097 * 32; i += NGT) {
            const int fi = (int)(i & 31), pi = (int)(i >> 5); const int pos = pi < 4096 ? pi : PAST;
            double f = 1.0; for (int k = 0; k < fi; ++k) f *= 0.7498942093324559;
            const float ang = (float)pos * (float)f;
            const double x = (double)ang; const double kq = __builtin_rint(x * 0.6366197723675814);
            const double r = (x - kq * 1.5707963267948966) - kq * 6.123233995736766e-17, r2 = r * r;
            const double sn = r * (1.0 + r2 * (-1.0 / 6 + r2 * (1.0 / 120 + r2 * (-1.0 / 5040 + r2 * (1.0 / 362880 + r2 * (-1.0 / 39916800 + r2 * (1.0 / 6227020800.0)))))));
            const double cs = 1.0 + r2 * (-0.5 + r2 * (1.0 / 24 + r2 * (-1.0 / 720 + r2 * (1.0 / 40320 + r2 * (-1.0 / 3628800 + r2 * (1.0 / 479001600.0 + r2 * (-1.0 / 87178291200.0)))))));
            const int q = ((int)kq) & 3;
            const double s_ = (q == 0) ? sn : (q == 1) ? cs : (q == 2) ? -sn : -cs;
            const double c_ = (q == 0) ? cs : (q == 1) ? -sn : (q == 2) ? -cs : sn;
            RT[i * 2] = (float)c_; RT[i * 2 + 1] = (float)s_;
        }
    }
    {
        float* B1P = (float*)(ws + WS_B1F); const float* pos = (const float*)P->in[26]; const float* w1 = (const float*)P->in[27];
        for (size_t i = gt; i < (size_t)32 * 2 * 128; i += NGT) {
            const int e = (int)(i & 127), j = (int)((i >> 7) & 1), l = (int)(i >> 8);
            float s = 0.f;
#pragma unroll 16
            for (int d = 0; d < 64; ++d) s += pos[(l * 2 + j) * 64 + d] * w1[((size_t)j * 2048 + l * 64 + d) * 128 + e];
            B1P[i] = s;
        }
    }
    {
        bf16* WG = (bf16*)(ws + WS_WGA);
        for (size_t i = gt; i < (size_t)2 * 2 * 16 * 80 * 96; i += NGT) {
            const int k = (int)(i % 96); size_t r = i / 96; const int j = (int)(r % 80); r /= 80; const int n = (int)(r % 16); r /= 16; const int ax = (int)(r & 1), L = (int)(r >> 1);
            const float* src = (const float*)P->in[ax ? 20 : 18];
            const float v = k < 80 ? src[(((size_t)L * 16 + n) * 80 + k) * 80 + j] : 0.f;
            WG[i] = (bf16)f2bf(v);
        }
    }
    {
        const float* cw = (const float*)P->in[6]; float* o = P->out + O_WIN_S;
        for (size_t i0 = gt; i0 < (size_t)MS * 511 * 64; i0 += 4 * NGT) {
            f32x4 v[4];
#pragma unroll
            for (int q = 0; q < 4; ++q) { const size_t i = i0 + q * NGT; v[q] = (f32x4){0.f, 0.f, 0.f, 0.f};
                if (i < (size_t)MS * 511 * 64) { const int c4 = (int)(i & 63); const size_t rw = i >> 6; const int w = (int)(rw % 511), sb = (int)(rw / 511);
                    v[q] = *(const f32x4*)(cw + ((size_t)sb * 512 + w + 1) * 256 + 4 * c4); } }
#pragma unroll
            for (int q = 0; q < 4; ++q) { const size_t i = i0 + q * NGT;
                if (i < (size_t)MS * 511 * 64) { const int c4 = (int)(i & 63); const size_t rw = i >> 6; const int w = (int)(rw % 511), sb = (int)(rw / 511);
                    *(f32x4*)(o + ((size_t)sb * 512 + w) * 256 + 4 * c4) = v[q]; } }
        }
    }
}

#define EPI_FOR_ROWS _Pragma("unroll") for (int ai = 0; ai < 2; ++ai) _Pragma("unroll") for (int m = 0; m < 4; ++m)
#define EPI_FOR_COLS _Pragma("unroll") for (int bj = 0; bj < 2; ++bj) _Pragma("unroll") for (int n = 0; n < 2; ++n) if (only < 0 || only == bj * 2 + n)
#define EPI_ROWL (ai * 128 + wr * 64 + m * 16 + fr)
#define EPI_COLL (bj * 128 + wc * 32 + n * 16 + 4 * fq)
typedef const f32x4 (&AccRef)[2][2][4][2];

__device__ __forceinline__ u32x2 pack4(f32x4 v) { u32x2 w; w.x = pk2(v[0], v[1]); w.y = pk2(v[2], v[3]); return w; }

__device__ __forceinline__ void rs_sample(const float* SP, LAS float* dst, int tid) {
    const int row = tid >> 4, part = tid & 15; float s = 0.f;
#pragma unroll
    for (int i = 0; i < 4; ++i) s += SP[(part * 4 + i) * 32 + row];
    s += __shfl_xor(s, 1); s += __shfl_xor(s, 2); s += __shfl_xor(s, 4); s += __shfl_xor(s, 8);
    if (part == 0) dst[row] = rsqrtf(s * (1.0f / 1024.0f) + EPS);
}
template <class Sched> __device__ __forceinline__ void rs_prepare(const Sched& S, const float* PSScur, const float* X, LAS float* rsb, int tid, bool thin) {
    pg8::Unit u;
    for (int i = 0; i < 7 && S.next(i, u); ++i) {
        if (tid < 256) { const int mrow = u.pm * 256 + tid; float s = 0.f;
#pragma unroll
            for (int k = 0; k < 16; ++k) s += PSScur[(size_t)k * MPAD + mrow];
            rsb[i * 256 + tid] = rsqrtf(s * (1.0f / 1024.0f) + EPS); }
    }
    if (thin) rs_sample(X, rsb + 7 * 256, tid);
    __syncthreads();
}
template <class E> __device__ __forceinline__ auto warm_call(const E& e, int fr, int fq, int cg, int) -> decltype(e.warm(fr, fq, cg)) { return e.warm(fr, fq, cg); }
template <class E> __device__ __forceinline__ float warm_call(const E&, int, int, int, long) { return 0.f; }
template <class E> __device__ __forceinline__ auto thin_epi(const E& e, f32x4 s0, f32x4 s1, int cg, int fr, int fq, int) -> decltype(e.thin(s0, s1, cg, fr, fq), true) { e.thin(s0, s1, cg, fr, fq); return true; }
template <class E> __device__ __forceinline__ bool thin_epi(const E&, f32x4, f32x4, int, int, int, long) { return false; }
template <int K, class Epi> __device__ __forceinline__ void thin_unit(LAS unsigned char* lds, const bf16* __restrict__ A, const bf16* __restrict__ Bt, int cg, const Epi& E) {
    int tid = threadIdx.x; asm volatile("" : "+v"(tid));
    const int wid = __builtin_amdgcn_readfirstlane(tid >> 6), lane = tid & 63, fr = lane & 15, fq = lane >> 4;
    f32x4 c0 = (f32x4){0.f, 0.f, 0.f, 0.f}, c1 = c0;
    float warm = 0.f; if (wid == 0) warm = warm_call(E, fr, fq, cg, 0);
    const bf16* ap = A + (size_t)(MP + fr) * K + fq * 8;
    const bf16* bp = Bt + (size_t)(cg * 16 + fr) * K + fq * 8;
    constexpr int NI = (K / 32) / 8;
    static_assert((K / 32) % 8 == 0, "thin unit K");
    bf16x8 bb[NI], aa0[NI], aa1[NI];
#pragma unroll
    for (int i = 0; i < NI; ++i) { const int ks = wid + 8 * i; bb[i] = *(const bf16x8*)(bp + ks * 32); aa0[i] = *(const bf16x8*)(ap + ks * 32); aa1[i] = *(const bf16x8*)(ap + (size_t)16 * K + ks * 32); }
#pragma unroll
    for (int i = 0; i < NI; ++i) { c0 = __builtin_amdgcn_mfma_f32_16x16x32_bf16(bb[i], aa0[i], c0, 0, 0, 0); c1 = __builtin_amdgcn_mfma_f32_16x16x32_bf16(bb[i], aa1[i], c1, 0, 0, 0); }
    LAS f32x4* red = (LAS f32x4*)lds;
    red[(wid * 2 + 0) * 64 + lane] = c0; red[(wid * 2 + 1) * 64 + lane] = c1;
    asm volatile("" :: "v"(warm));
    __syncthreads();
    if (wid == 0) {
        f32x4 s0 = red[lane], s1 = red[64 + lane];
#pragma unroll
        for (int w = 1; w < 8; ++w) { s0 += red[(w * 2) * 64 + lane]; s1 += red[(w * 2 + 1) * 64 + lane]; }
      if (!thin_epi(E, s0, s1, cg, fr, fq, 0)) {
        f32x4 acc[2][2][4][2];
        const float z_ = __builtin_bit_cast(float, launder_v(0));
#pragma unroll
        for (int a = 0; a < 2; ++a)
#pragma unroll
            for (int b = 0; b < 2; ++b)
#pragma unroll
                for (int m = 0; m < 4; ++m)
#pragma unroll
                    for (int n = 0; n < 2; ++n) acc[a][b][m][n] = (f32x4){z_, z_, z_, z_};
        const int bj = (cg >> 3) & 1, n = cg & 1;
#pragma unroll
        for (int b = 0; b < 2; ++b)
#pragma unroll
            for (int nn = 0; nn < 2; ++nn) if (b == bj && nn == n) { acc[0][b][0][nn] = s0; acc[0][b][1][nn] = s1; }
        pg8::Unit u; u.pm = MP / 256; u.pn = cg >> 4;
        E.only = bj * 2 + n;
        E(acc, u, 0, (cg >> 1) & 3, fr, fq);
        E.only = -1;
      }
    }
    __syncthreads();
}

struct EpiRG1 {
    static constexpr bool PERM = false, AFTER_DRAIN = false;
    unsigned char* ws; const LAS float* rs; mutable int slot; mutable int only = -1;
    __device__ __forceinline__ void operator()(AccRef acc, const pg8::Unit& u, int wr, int wc, int fr, int fq) const {
        fr = launder_v(fr); fq = launder_v(fq);
        const LAS float* rsl = rs + slot * 256; ++slot;
        bf16* Y = (bf16*)(ws + WS_Y); bf16* XR = (bf16*)(ws + WS_XR);
        EPI_FOR_ROWS { const int rl = EPI_ROWL, row = u.pm * 256 + rl; const float r = rsl[rl];
            EPI_FOR_COLS { const int col = u.pn * 256 + EPI_COLL; f32x4 v = acc[ai][bj][m][n] * r;
                if (row < MTOT) { if (u.pn < 5) { v[0] = gelu_tanh(v[0]); v[1] = gelu_tanh(v[1]); v[2] = gelu_tanh(v[2]); v[3] = gelu_tanh(v[3]); *(u32x2*)(Y + (size_t)row * DRNN + col) = pack4(v); }
                else *(u32x2*)(XR + (size_t)row * DRNN + (col - DRNN)) = pack4(v); } } }
    }
};
struct EpiRes {
    static constexpr bool PERM = false, AFTER_DRAIN = false;
    unsigned char* ws; float* PSSn; size_t soff; float scale; size_t xoff; mutable int only = -1;
    __device__ __forceinline__ float warm(int fr, int fq, int cg) const {
        const bf16* XB = (const bf16*)(ws + xoff); const size_t o0 = (size_t)(MP + fr) * DM + cg * 16 + 4 * fq, o1 = o0 + (size_t)16 * DM;
        float w = bf2f(XB[o0]) + bf2f(XB[o1]);
        if (soff) { const bf16* S = (const bf16*)(ws + soff); w += bf2f(S[o0]) + bf2f(S[o1]); }
        return w; }
    __device__ __forceinline__ void thin(f32x4 s0, f32x4 s1, int cg, int fr, int fq) const {
        bf16* XB = (bf16*)(ws + xoff); const bf16* S = soff ? (const bf16*)(ws + soff) : nullptr;
        const int nx = (int)((PSSn - (float*)(ws + WS_PSS)) / (16 * MPAD));
#pragma unroll
        for (int m = 0; m < 2; ++m) { const size_t o = (size_t)(MP + 16 * m + fr) * DM + cg * 16 + 4 * fq; f32x4 a = (m ? s1 : s0) * scale;
            if (S) a *= unpack4(*(const u32x2*)(S + o));
            const u32x2 xw = pack4(unpack4(*(const u32x2*)(XB + o)) + a); const f32x4 x = unpack4(xw);
            *(u32x2*)(XB + o) = xw;
            float ssq = (x[0] * x[0] + x[1] * x[1]) + (x[2] * x[2] + x[3] * x[3]);
            ssq += __shfl_xor(ssq, 16); ssq += __shfl_xor(ssq, 32);
            if (fq == 0) ((float*)(ws + WS_SPSS))[nx * 2048 + cg * 32 + 16 * m + fr] = ssq; }
    }
    __device__ __forceinline__ void operator()(AccRef acc, const pg8::Unit& u, int wr, int wc, int fr, int fq) const {
        fr = launder_v(fr); fq = launder_v(fq);
        bf16* XB = (bf16*)(ws + xoff); const bf16* S = soff ? (const bf16*)(ws + soff) : nullptr;
#pragma unroll
        for (int ai = 0; ai < 2; ++ai) {
#pragma unroll
          for (int mh = 0; mh < 2; ++mh) {
            u32x2 xv[4][2][2];
#pragma unroll
            for (int m = 2 * mh; m < 2 * mh + 2; ++m) { const int row = u.pm * 256 + EPI_ROWL;
                EPI_FOR_COLS { const int col = u.pn * 256 + EPI_COLL; if (row < MTOT) xv[m][bj][n] = *(const u32x2*)(XB + (size_t)row * DM + col); } }
#pragma unroll
            for (int m = 2 * mh; m < 2 * mh + 2; ++m) { const int rl = EPI_ROWL, row = u.pm * 256 + rl; float ssq = 0.f;
                EPI_FOR_COLS { const int col = u.pn * 256 + EPI_COLL; f32x4 a = acc[ai][bj][m][n] * scale;
                    if (row < MTOT) {
                    if (S) { const u32x2 sw = *(const u32x2*)(S + (size_t)row * DM + col);
                        a[0] *= __builtin_bit_cast(float, sw.x << 16); a[1] *= __builtin_bit_cast(float, sw.x & 0xffff0000u); a[2] *= __builtin_bit_cast(float, sw.y << 16); a[3] *= __builtin_bit_cast(float, sw.y & 0xffff0000u); }
                    const u32x2 xw = pack4(unpack4(xv[m][bj][n]) + a); const f32x4 x = unpack4(xw);
                    *(u32x2*)(XB + (size_t)row * DM + col) = xw;
                    ssq += (x[0] * x[0] + x[1] * x[1]) + (x[2] * x[2] + x[3] * x[3]); } }
                ssq += __shfl_xor(ssq, 16); ssq += __shfl_xor(ssq, 32);
                if (fq == 0) { if (row < MP) PSSn[(size_t)(u.pn * 4 + wc) * MPAD + row] = ssq;
                    else if (only >= 0 && row < MTOT) { const int nx = (int)((PSSn - (float*)(ws + WS_PSS)) / (16 * MPAD));
                        ((float*)(ws + WS_SPSS))[nx * 2048 + (u.pn * 16 + (only >> 1) * 8 + wc * 2 + (only & 1)) * 32 + (row - MP)] = ssq; } } }
          }
        }
    }
};
template <int CTRL> __device__ __forceinline__ float dppf(float x) { return __builtin_bit_cast(float, __builtin_amdgcn_update_dpp(0, __builtin_bit_cast(int, x), CTRL, 0xf, 0xf, true)); }
#define DPPF(src, ctrl) dppf<ctrl>(src)
template <int CTRL> __device__ __forceinline__ float dppf_old(float old, float x) { return __builtin_bit_cast(float, __builtin_amdgcn_update_dpp(__builtin_bit_cast(int, old), __builtin_bit_cast(int, x), CTRL, 0xf, 0xf, false)); }
struct EpiUp {
    static constexpr bool PERM = false, AFTER_DRAIN = false;
    unsigned char* ws; const LAS float* rs; float* out; const float* cw; const float* cb; LAS float* halo; int L; mutable int slot; mutable int only = -1;
    __device__ __forceinline__ void operator()(AccRef acc, const pg8::Unit& u, int wr, int wc, int fr, int fq) const {
        fr = launder_v(fr); fq = launder_v(fq);
        const LAS float* rsl = rs + slot * 256; ++slot;
        bf16* ACT = (bf16*)(ws + WS_ACT); float* UPH = (float*)(ws + WS_UPH) + (size_t)u.pm * 4 * DFF2 + u.pn * 256;
#pragma unroll
        for (int ai = 0; ai < 2; ++ai) { const int band = ai * 2 + wr; const float r3 = rsl[ai * 128 + wr * 64 + 48 + fr], r0 = rsl[ai * 128 + wr * 64 + fr];
#pragma unroll
            for (int bj = 0; bj < 2; ++bj)
#pragma unroll
                for (int n = 0; n < 2; ++n) { const int ci = bj * 128 + wc * 32 + n * 16 + 4 * fq;
                    if (fr >= 14) { const f32x4 v = acc[ai][bj][3][n] * r3; *(LAS f32x4*)(halo + (band * 2 + (fr - 14)) * 256 + ci) = v;
                        if (band == 3) *(f32x4*)(UPH + (size_t)(2 + fr - 14) * DFF2 + ci) = v; }
                    if (band == 0 && fr < 2) *(f32x4*)(UPH + (size_t)fr * DFF2 + ci) = acc[0][bj][0][n] * r0; } }
        asm volatile("s_waitcnt lgkmcnt(0)" ::: "memory"); __builtin_amdgcn_s_barrier(); asm volatile("" ::: "memory");
        const int b = u.pm >> 4; const bool last_tile = (u.pm & 15) == 15, first_tile = (u.pm & 15) == 0;
#pragma unroll
        for (int n = 0; n < 2; ++n) {
            const int ci = wc * 32 + n * 16 + 4 * fq, lca = u.pn * 128 + ci;
            f32x4 w[2][3], bs[2];
#pragma unroll
            for (int bj = 0; bj < 2; ++bj) { bs[bj] = *(const f32x4*)(cb + bj * DFF + lca);
#pragma unroll
                for (int k = 0; k < 3; ++k) w[bj][k] = *(const f32x4*)(cw + k * DFF2 + bj * DFF + lca); }
#pragma unroll
            for (int ai = 0; ai < 2; ++ai) {
                const int band = ai * 2 + wr;
                f32x4 s[4][2];
#pragma unroll
                for (int m = 0; m < 4; ++m) { const float r = rsl[ai * 128 + wr * 64 + m * 16 + fr]; s[m][0] = acc[ai][0][m][n] * r; s[m][1] = acc[ai][1][m][n] * r; }
#pragma unroll
                for (int m = 0; m < 4; ++m) {
                    const int rl = ai * 128 + wr * 64 + m * 16 + fr, row = u.pm * 256 + rl;
                    f32x4 uc[2];
#pragma unroll
                    for (int bj = 0; bj < 2; ++bj) {
                        f32x4 p1, p2;
                        if (m > 0) {
#pragma unroll
                            for (int e = 0; e < 4; ++e) { const float cur_ = s[m][bj][e], prv_ = s[m - 1][bj][e];
                                p1[e] = dppf_old<0x111>(dppf<0x121>(prv_), cur_); p2[e] = dppf_old<0x112>(dppf<0x122>(prv_), cur_); }
                        } else {
                            f32x4 h0 = (f32x4){0.f, 0.f, 0.f, 0.f}, h1 = h0;
                            if (band > 0) { h0 = *(const LAS f32x4*)(halo + ((band - 1) * 2 + 0) * 256 + bj * 128 + ci); h1 = *(const LAS f32x4*)(halo + ((band - 1) * 2 + 1) * 256 + bj * 128 + ci); }
#pragma unroll
                            for (int e = 0; e < 4; ++e) { const float cur_ = s[0][bj][e], h0_ = h0[e], h1_ = h1[e];
                                p1[e] = dppf_old<0x111>(h1_, cur_); p2[e] = dppf_old<0x112>((fr == 0) ? h0_ : h1_, cur_); }
                        }
                        uc[bj] = bs[bj] + w[bj][0] * p2 + w[bj][1] * p1 + w[bj][2] * s[m][bj];
                    }
                    f32x4 a;
#pragma unroll
                    for (int e = 0; e < 4; ++e) a[e] = gelu_tanh(uc[0][e]) * uc[1][e];
                    if (first_tile || rl >= 2) *(u32x2*)(ACT + (size_t)row * DFF + lca) = pack4(a);
                    if (last_tile && rl >= 254) {
                        float* o = out + O_FFC_P + ((size_t)(L * NB + b) * 2 + (rl - 254)) * DFF2 + lca;
                        *(f32x4*)o = s[m][0]; *(f32x4*)(o + DFF) = s[m][1]; }
                }
            }
        }
    }
};
__device__ __forceinline__ void act_fixup(unsigned char* ws, const float* cw, const float* cb, int pm, int tid) {
    if ((pm & 15) == 0) return;
    const float* own = (const float*)(ws + WS_UPH) + (size_t)pm * 4 * DFF2; const float* prv = own - (size_t)4 * DFF2; bf16* ACT = (bf16*)(ws + WS_ACT) + (size_t)pm * 256 * DFF;
#pragma unroll
    for (int k = tid; k < DFF; k += 512) {
        const int pa = (k >> 7) * 256 + (k & 127);
        float uc0[2], uc1[2];
#pragma unroll
        for (int h = 0; h < 2; ++h) { const int p = pa + h * 128, lc = h * DFF + k;
            const float w0 = cw[lc], w1 = cw[DFF2 + lc], w2 = cw[2 * DFF2 + lc], bb = cb[lc];
            const float q2 = prv[2 * DFF2 + p], q3 = prv[3 * DFF2 + p], o0 = own[p], o1 = own[DFF2 + p];
            uc0[h] = bb + w0 * q2 + w1 * q3 + w2 * o0; uc1[h] = bb + w0 * q3 + w1 * o0 + w2 * o1; }
        ACT[k] = (bf16)f2bf(gelu_tanh(uc0[0]) * uc0[1]); ACT[DFF + k] = (bf16)f2bf(gelu_tanh(uc1[0]) * uc1[1]);
    }
}
__device__ __forceinline__ void thin_unit_up(LAS unsigned char* lds, const bf16* __restrict__ A, const bf16* __restrict__ Bt, int pg, unsigned char* ws, const LAS float* rs32, float* out,
                                             const float* cw, const float* cb, const float* st, int L) {
    int tid = threadIdx.x; asm volatile("" : "+v"(tid));
    const int wid = __builtin_amdgcn_readfirstlane(tid >> 6), lane = tid & 63, fr = lane & 15, fq = lane >> 4, K = 1024;
    const int pn = pg >> 3, cgi = pg & 7;
    f32x4 c[2][2];
#pragma unroll
    for (int i = 0; i < 2; ++i) { c[i][0] = (f32x4){0.f, 0.f, 0.f, 0.f}; c[i][1] = c[i][0]; }
    const bf16* ap = A + (size_t)(MP + fr) * K + fq * 8;
    const bf16* bp = Bt + (size_t)(pn * 256 + cgi * 16 + fr) * K + fq * 8;
#pragma unroll
    for (int ks = wid; ks < 32; ks += 8) {
        const bf16x8 a0 = *(const bf16x8*)(ap + ks * 32), a1 = *(const bf16x8*)(ap + (size_t)16 * K + ks * 32);
        const bf16x8 b0 = *(const bf16x8*)(bp + ks * 32), b1 = *(const bf16x8*)(bp + (size_t)128 * K + ks * 32);
        c[0][0] = __builtin_amdgcn_mfma_f32_16x16x32_bf16(b0, a0, c[0][0], 0, 0, 0); c[0][1] = __builtin_amdgcn_mfma_f32_16x16x32_bf16(b0, a1, c[0][1], 0, 0, 0);
        c[1][0] = __builtin_amdgcn_mfma_f32_16x16x32_bf16(b1, a0, c[1][0], 0, 0, 0); c[1][1] = __builtin_amdgcn_mfma_f32_16x16x32_bf16(b1, a1, c[1][1], 0, 0, 0);
    }
    LAS f32x4* red = (LAS f32x4*)lds;
#pragma unroll
    for (int i = 0; i < 2; ++i)
#pragma unroll
        for (int m = 0; m < 2; ++m) red[(wid * 4 + i * 2 + m) * 64 + lane] = c[i][m];
    __syncthreads();
    if (wid == 0) {
        const int lca = pn * 128 + cgi * 16 + 4 * fq;
#pragma unroll
        for (int m = 0; m < 2; ++m) { const int sb = m * 16 + fr; const float r = rs32[sb];
            f32x4 uc[2];
#pragma unroll
            for (int i = 0; i < 2; ++i) { f32x4 s = red[(i * 2 + m) * 64 + lane];
#pragma unroll
                for (int w = 1; w < 8; ++w) s += red[(w * 4 + i * 2 + m) * 64 + lane];
                s = s * r; const int lc = i * DFF + lca; const size_t so = ((size_t)(L * MS + sb) * 2) * DFF2 + lc;
                const f32x4 s0 = *(const f32x4*)(st + so), s1 = *(const f32x4*)(st + so + DFF2);
                uc[i] = *(const f32x4*)(cb + lc) + *(const f32x4*)(cw + lc) * s0 + *(const f32x4*)(cw + DFF2 + lc) * s1 + *(const f32x4*)(cw + 2 * DFF2 + lc) * s;
                *(f32x4*)(out + O_FFC_S + so) = s1; *(f32x4*)(out + O_FFC_S + so + DFF2) = s; }
            f32x4 a;
#pragma unroll
            for (int e = 0; e < 4; ++e) a[e] = gelu_tanh(uc[0][e]) * uc[1][e];
            *(u32x2*)((bf16*)(ws + WS_ACT) + (size_t)(MP + sb) * DFF + lca) = pack4(a); }
    }
    __syncthreads();
}
struct EpiGate {
    static constexpr bool PERM = false, AFTER_DRAIN = false;
    unsigned char* ws; const LAS float* rs; float* PSSn; size_t pinoff; size_t xin, xout; mutable int slot; mutable int only = -1;
    __device__ __forceinline__ float warm(int fr, int fq, int cg) const {
        const bf16* Xr = (const bf16*)(ws + xin); const bf16* PIN = (const bf16*)(ws + pinoff); const size_t o0 = (size_t)(MP + fr) * DM + cg * 16 + 4 * fq, o1 = o0 + (size_t)16 * DM;
        return (bf2f(Xr[o0]) + bf2f(Xr[o1])) + (bf2f(PIN[o0]) + bf2f(PIN[o1])); }
    __device__ __forceinline__ void thin(f32x4 s0, f32x4 s1, int cg, int fr, int fq) const {
        const LAS float* rsl = rs + 7 * 256;
        const bf16* Xr = (const bf16*)(ws + xin); bf16* XB = (bf16*)(ws + xout); const bf16* PIN = (const bf16*)(ws + pinoff);
        const int nx = (int)((PSSn - (float*)(ws + WS_PSS)) / (16 * MPAD));
#pragma unroll
        for (int m = 0; m < 2; ++m) { const size_t o = (size_t)(MP + 16 * m + fr) * DM + cg * 16 + 4 * fq; f32x4 v = (m ? s1 : s0) * rsl[16 * m + fr];
            const f32x4 pv = unpack4(*(const u32x2*)(PIN + o));
            v[0] = sigmoidf_(v[0]) * pv[0]; v[1] = sigmoidf_(v[1]) * pv[1]; v[2] = sigmoidf_(v[2]) * pv[2]; v[3] = sigmoidf_(v[3]) * pv[3];
            const u32x2 xw = pack4(unpack4(*(const u32x2*)(Xr + o)) + v); const f32x4 x = unpack4(xw);
            *(u32x2*)(XB + o) = xw;
            float ssq = (x[0] * x[0] + x[1] * x[1]) + (x[2] * x[2] + x[3] * x[3]);
            ssq += __shfl_xor(ssq, 16); ssq += __shfl_xor(ssq, 32);
            if (fq == 0) ((float*)(ws + WS_SPSS))[nx * 2048 + cg * 32 + 16 * m + fr] = ssq; }
    }
    __device__ __forceinline__ void operator()(AccRef acc, const pg8::Unit& u, int wr, int wc, int fr, int fq) const {
        fr = launder_v(fr); fq = launder_v(fq);
        const LAS float* rsl = rs + slot * 256; ++slot;
        const bf16* __restrict__ Xr = (const bf16*)(ws + xin); bf16* __restrict__ XB = (bf16*)(ws + xout); const bf16* __restrict__ PIN = (const bf16*)(ws + pinoff);
#pragma unroll
        for (int ai = 0; ai < 2; ++ai) {
#pragma unroll
          for (int mh = 0; mh < 2; ++mh) {
            u32x2 xv[4][2][2]; u32x2 pv[4][2][2];
#pragma unroll
            for (int m = 2 * mh; m < 2 * mh + 2; ++m) { const int row = u.pm * 256 + EPI_ROWL;
                EPI_FOR_COLS { const int col = u.pn * 256 + EPI_COLL; if (row < MTOT) { xv[m][bj][n] = *(const u32x2*)(Xr + (size_t)row * DM + col); pv[m][bj][n] = *(const u32x2*)(PIN + (size_t)row * DM + col); } } }
#pragma unroll
            for (int m = 2 * mh; m < 2 * mh + 2; ++m) { const int rl = EPI_ROWL, row = u.pm * 256 + rl; const float r = rsl[rl]; float ssq = 0.f;
                EPI_FOR_COLS { const int col = u.pn * 256 + EPI_COLL;
                    if (row < MTOT) { f32x4 v = acc[ai][bj][m][n] * r; const u32x2 pw = pv[m][bj][n];
                        v[0] = sigmoidf_(v[0]) * __builtin_bit_cast(float, pw.x << 16); v[1] = sigmoidf_(v[1]) * __builtin_bit_cast(float, pw.x & 0xffff0000u);
                        v[2] = sigmoidf_(v[2]) * __builtin_bit_cast(float, pw.y << 16); v[3] = sigmoidf_(v[3]) * __builtin_bit_cast(float, pw.y & 0xffff0000u);
                        const u32x2 xw = pack4(unpack4(xv[m][bj][n]) + v); const f32x4 x = unpack4(xw);
                        *(u32x2*)(XB + (size_t)row * DM + col) = xw;
                        ssq += (x[0] * x[0] + x[1] * x[1]) + (x[2] * x[2] + x[3] * x[3]); } }
                ssq += __shfl_xor(ssq, 16); ssq += __shfl_xor(ssq, 32);
                if (fq == 0) { if (row < MP) PSSn[(size_t)(u.pn * 4 + wc) * MPAD + row] = ssq;
                    else if (only >= 0 && row < MTOT) { const int nx = (int)((PSSn - (float*)(ws + WS_PSS)) / (16 * MPAD));
                        ((float*)(ws + WS_SPSS))[nx * 2048 + (u.pn * 16 + (only >> 1) * 8 + wc * 2 + (only & 1)) * 32 + (row - MP)] = ssq; } } }
          }
        }
    }
};
struct EpiPin {
    static constexpr bool PERM = false, AFTER_DRAIN = false;
    unsigned char* ws; mutable int Lthin = -1; mutable int only = -1;
    __device__ __forceinline__ void operator()(AccRef acc, const pg8::Unit& u, int wr, int wc, int fr, int fq) const {
        fr = launder_v(fr); fq = launder_v(fq);
        const int L = Lthin >= 0 ? Lthin : u.pn >> 2, pm = Lthin >= 0 ? u.pm : u.pm - L * NMT, pn = Lthin >= 0 ? u.pn : u.pn & 3;
        bf16* PIN = (bf16*)(ws + WS_PIN) + (size_t)L * MPAD * DM;
        EPI_FOR_ROWS { const int rl = EPI_ROWL, row = pm * 256 + rl;
            if (row < MTOT) EPI_FOR_COLS { const int col = pn * 256 + EPI_COLL; *(u32x2*)(PIN + (size_t)row * DM + col) = pack4(acc[ai][bj][m][n]); } }
    }
};
struct PinOrder {
    int start, stride, count, Lb;
    __device__ __forceinline__ bool next(int i, pg8::Unit& u) const { if (i >= count) return false; const int idx = start + i * stride; if (idx >= 512) return false; const int L = Lb + (idx >> 8), w = idx & 255; u.pm = L * NMT + (w >> 2); u.pn = L * 4 + (w & 3); return true; }
    __device__ __forceinline__ void a_ready(const pg8::Unit&) const {}
    __device__ __forceinline__ void done(const pg8::Unit&) const {}
};
struct EpiT {
    static constexpr bool PERM = false, AFTER_DRAIN = false;
    bf16* T; mutable int only = -1;
    __device__ __forceinline__ void operator()(AccRef acc, const pg8::Unit& u, int wr, int wc, int fr, int fq) const {
        fr = launder_v(fr); fq = launder_v(fq);
        bf16* Tt = T + (size_t)u.pm * 65536;
        EPI_FOR_ROWS { const int rl = EPI_ROWL;
            EPI_FOR_COLS { *(u32x2*)(Tt + rl * 256 + EPI_COLL) = pack4(acc[ai][bj][m][n]); } }
    }
};
__device__ __forceinline__ f32x4 rope4(f32x4 v, const float* rt  , int d0) {
    const f32x4 cs = *(const f32x4*)(rt + 2 * d0);
    f32x4 o; o[0] = v[0] * cs[0] - v[1] * cs[1]; o[1] = v[1] * cs[0] + v[0] * cs[1]; o[2] = v[2] * cs[2] - v[3] * cs[3]; o[3] = v[3] * cs[2] + v[2] * cs[3]; return o;
}
struct EpiQ {
    static constexpr bool PERM = false, AFTER_DRAIN = false;
    unsigned char* ws; const LAS float* rs; mutable int slot; mutable int only = -1;
    __device__ __forceinline__ void operator()(AccRef acc, const pg8::Unit& u, int wr, int wc, int fr, int fq) const {
        fr = launder_v(fr); fq = launder_v(fq);
        const LAS float* rsl = rs + slot * 256; ++slot;
        bf16* Q = (bf16*)(ws + WS_Q); bf16* QR = (bf16*)(ws + WS_QR); float* GT = (float*)(ws + WS_GT); const float* RT = (const float*)(ws + WS_ROPE);
        EPI_FOR_ROWS { const int rl = EPI_ROWL, row = u.pm * 256 + rl; const float r = rsl[rl];
            const float* rt = RT + (size_t)(row < MP ? (row & (SEQ - 1)) : SEQ) * 64;
            if (row < MTOT) EPI_FOR_COLS { const int col = u.pn * 256 + EPI_COLL;
                if (u.pn < 4) { const f32x4 v = acc[ai][bj][m][n] * (r * C2);
                    *(u32x2*)(Q + (size_t)row * DM + col) = pack4(v);
                    *(u32x2*)(QR + (size_t)row * DM + col) = pack4(rope4(v, rt, (col & 63) >> 1)); }
                else if (col < NQG) { f32x4 v = acc[ai][bj][m][n] * r;
                    v[0] = sigmoidf_(v[0]); v[1] = sigmoidf_(v[1]); v[2] = sigmoidf_(v[2]); v[3] = sigmoidf_(v[3]);
                    *(f32x4*)(GT + (size_t)row * 48 + (col - 1024)) = v; } } }
    }
};
struct EpiKV {
    static constexpr bool PERM = false, AFTER_DRAIN = false;
    float* out; unsigned char* ws; const LAS float* rs; mutable int slot; mutable int only = -1;
    __device__ __forceinline__ void operator()(AccRef acc, const pg8::Unit& u, int wr, int wc, int fr, int fq) const {
        fr = launder_v(fr); fq = launder_v(fq);
        const LAS float* rsl = rs + slot * 256; ++slot;
        bf16* CA = (bf16*)(ws + WS_CMPA); bf16* KS = (bf16*)(ws + WS_KS); bf16* VTS = (bf16*)(ws + WS_VTS); bf16* KW = (bf16*)(ws + WS_KW); bf16* VTW = (bf16*)(ws + WS_VTW); const float* RT = (const float*)(ws + WS_ROPE);
        EPI_FOR_ROWS { const int rl = EPI_ROWL, row = u.pm * 256 + rl; const float r = rsl[rl];
            if (row < MTOT) {
            const bool smp = row >= MP; const int b = row >> 12, t = row & (SEQ - 1), sb = row - MP;
            const float* rt = RT + (size_t)(smp ? SEQ : t) * 64;
            EPI_FOR_COLS { const int col = u.pn * 256 + EPI_COLL; const int j = col >> 7, g = (col >> 6) & 1, e0 = col & 63;
                f32x4 v = acc[ai][bj][m][n] * r;
                if (j < 2) {
                    if (!smp) { *(f32x4*)(out + O_CMP_P + (size_t)row * 256 + col) = v;
                        *(u32x2*)(CA + ((size_t)j * CMP_ROWS + (size_t)(g * NB + b) * 256 + (t >> 4)) * 1024 + (t & 15) * 64 + e0) = pack4(v); }
                    else *(f32x4*)(out + O_CMP_S + (size_t)sb * 256 + col) = v;
                } else if (j == 2 || j == 4) {
                    const int d0 = e0 >> 1; const f32x4 q = rope4(v, rt, d0);
                    const int lc = (j - 2) * 128 + g * 64;
                    float* orow = nullptr;
                    if (j == 2) orow = smp ? out + O_SLC_S + (size_t)sb * 256 : out + O_SLC_P + (size_t)row * 256;
                    else if (smp) orow = out + O_WIN_S + ((size_t)sb * 512 + 511) * 256;
                    else if (t >= SEQ - 512) orow = out + O_WIN_P + ((size_t)b * 512 + (t - (SEQ - 512))) * 256;
                    if (orow) { float* p = orow + (lc & 255) + d0; *(f32x2*)p = (f32x2){q[0], q[2]}; *(f32x2*)(p + 32) = (f32x2){q[1], q[3]}; }
                    if (!smp) *(u32x2*)((j == 2 ? KS : KW) + ((size_t)(b * NG + g) * SEQ + t) * 64 + e0) = pack4(q);
                } else {
                    const int lc = 128 + g * 64 + e0;
                    float* orow = nullptr;
                    if (j == 3) orow = smp ? out + O_SLC_S + (size_t)sb * 256 : out + O_SLC_P + (size_t)row * 256;
                    else if (smp) orow = out + O_WIN_S + ((size_t)sb * 512 + 511) * 256;
                    else if (t >= SEQ - 512) orow = out + O_WIN_P + ((size_t)b * 512 + (t - (SEQ - 512))) * 256;
                    if (orow) *(f32x4*)(orow + lc) = v;
                    if (!smp) { bf16* vt = (j == 3 ? VTS : VTW) + ((size_t)(b * NG + g) * 64 + e0) * SEQ + t;
                        vt[0] = (bf16)f2bf(v[0]); vt[SEQ] = (bf16)f2bf(v[1]); vt[2 * SEQ] = (bf16)f2bf(v[2]); vt[3 * SEQ] = (bf16)f2bf(v[3]); }
                } } } }
    }
};

struct CmpOrder {
    int G, c, lo, hi;
    __device__ __forceinline__ bool next(int i, pg8::Unit& u) const { const int L = lo + i * G + c; if (L >= hi) return false; u.pm = L; u.pn = L / (CMP_ROWS / 256); return true; }
    __device__ __forceinline__ void a_ready(const pg8::Unit&) const {}
    __device__ __forceinline__ void done(const pg8::Unit&) const {}
};

__device__ __forceinline__ float rcp_fast(float x) { return __builtin_amdgcn_rcpf(x); }
__device__ __forceinline__ float softplus_neg(float lam) { const float e = __expf(-lam); return e < 0.03f ? e * (1.0f - e * (0.5f - e * ((1.0f / 3.0f) - 0.25f * e))) : (lam < -20.f ? -lam : __logf(1.0f + e)); }
__device__ __forceinline__ float sigmoid_fast(float x) { return rcp_fast(1.0f + __expf(-x)); }
__device__ __forceinline__ int rg2_unit(int bid, int G, int k) {
    constexpr int NU = 257 * 16;
    if (G != 256) { const int un = bid + k * G; return un < NU ? un : -1; }
    if (bid < 16) return k < 14 ? bid + 256 * k : (k == 14 ? 4096 + bid : -1);
    if (bid < 48) return k < 16 ? bid + 256 * k : (k == 16 ? (bid & 15) + 256 * (14 + ((bid >> 4) - 1)) : -1);
    return k < 16 ? bid + 256 * k : -1;
}
__device__ __forceinline__ void rg2_phase(KP P, LAS unsigned char* lds, int L, int tid, int lane, int wave, int G) {
    unsigned char* ws = P->ws;
    const bf16* XR = (const bf16*)(ws + WS_XR); bf16* HL = (bf16*)(ws + WS_HL); bf16* AC = (bf16*)(ws + WS_AC);
    const bf16* WG = (const bf16*)(ws + WS_WGA) + (size_t)L * 2 * 16 * 80 * 96;
    const float* cw = (const float*)P->in[16] + (size_t)L * 4 * DRNN; const float* cb = (const float*)P->in[17] + (size_t)L * DRNN;
    const float* b_a = (const float*)P->in[19] + (size_t)L * DRNN; const float* b_x = (const float*)P->in[21] + (size_t)L * DRNN; const float* lam = (const float*)P->in[22] + (size_t)L * DRNN;
    const float* st_c = (const float*)P->in[7] + (size_t)L * MS * 3 * DRNN; const float* st_h = (const float*)P->in[8] + (size_t)L * MS * DRNN;
    LAS bf16* wab = (LAS bf16*)(lds);
    LAS float* xrt = (LAS float*)(lds + 33280);
    LAS float* xcf = (LAS float*)(lds + 54720);
    LAS bf16* xcb = (LAS bf16*)(lds + 75200);
    LAS float* af = (LAS float*)(lds + 88512);
    LAS float* uf = (LAS float*)(lds + 108992);
    LAS float* agg = (LAS float*)(lds + 129472);
    LAS float* cws = (LAS float*)(lds + 132032);
    const int NU = 257 * 16, bid = launder_s(blockIdx.x);
    int cur_n = -1; bool have_pf = false; u32x2 pf[3];
    for (int uk = 0, un = rg2_unit(bid, G, 0); un >= 0; ++uk, un = rg2_unit(bid, G, uk)) {
        const int tl = un >> 4, n = un & 15, c0 = n * RGB; const bool smp = (tl == 256);
        const int m0 = tl * 64, t0 = m0 & (SEQ - 1), b = m0 >> 12;
        if (n != cur_n) {
            cur_n = n;
            for (int i = tid; i < 2 * 80 * 12; i += 512) { const int ck = i % 12, rw = i / 12; const int ax = rw / 80, j = rw % 80;
                *(LAS u32x4*)(wab + (size_t)rw * 104 + ck * 8) = *(const u32x4*)(WG + ((size_t)(ax * 16 + n) * 80 + j) * 96 + ck * 8); }
            for (int i = tid; i < 8 * 80; i += 512) { const int k = i / 80, c = i % 80, ch = c0 + c;
                cws[i] = (k < 4) ? cw[k * DRNN + ch] : (k == 4) ? cb[ch] : (k == 5) ? b_a[ch] : (k == 6) ? b_x[ch] : softplus_neg(lam[ch]); }
            for (int i = tid; i < 64 * 24; i += 512) xcb[(i / 24) * 104 + 80 + (i % 24)] = 0;
        }
        if (!smp) {
            if (!have_pf) {
#pragma unroll
                for (int k = 0; k < 3; ++k) { const int i = tid + 512 * k, r = i / 20, q = i % 20; pf[k] = (u32x2){0u, 0u};
                    if (i < 67 * 20 && t0 + r - 3 >= 0) pf[k] = *(const u32x2*)(XR + (size_t)(m0 + r - 3) * DRNN + c0 + 4 * q); } }
#pragma unroll
            for (int k = 0; k < 3; ++k) { const int i = tid + 512 * k, r = i / 20, q = i % 20; if (i < 67 * 20) *(LAS f32x4*)(xrt + r * 80 + 4 * q) = unpack4(pf[k]); }
            { const int un2 = rg2_unit(bid, G, uk + 1); have_pf = false;
              if (un2 >= 0 && (un2 >> 4) != 256) { const int m2 = (un2 >> 4) * 64, t2 = m2 & (SEQ - 1), c2 = (un2 & 15) * RGB; have_pf = true;
#pragma unroll
                for (int k = 0; k < 3; ++k) { const int i = tid + 512 * k, r = i / 20, q = i % 20; pf[k] = (u32x2){0u, 0u};
                    if (i < 67 * 20 && t2 + r - 3 >= 0) pf[k] = *(const u32x2*)(XR + (size_t)(m2 + r - 3) * DRNN + c2 + 4 * q); } } }
            __syncthreads();
            for (int rep_ = 0; rep_ < 1 + 4 * ((PROBE_DUP >> 23) & 1); ++rep_)
#pragma unroll
            for (int i = 0; i < 10; ++i) { const int e = tid + 512 * i, r = e / 80, c = e % 80;
                const float xc = cws[320 + c] + cws[c] * xrt[r * 80 + c] + cws[80 + c] * xrt[(r + 1) * 80 + c] + cws[160 + c] * xrt[(r + 2) * 80 + c] + cws[240 + c] * xrt[(r + 3) * 80 + c];
                xcf[e] = xc; xcb[r * 104 + c] = (bf16)f2bf(xc); }
        } else {
            __syncthreads();
            for (int e = tid; e < 64 * 80; e += 512) { const int r = e / 80, c = e % 80, ch = c0 + c; float xc = 0.f;
                if (r < MS) { xc = cws[320 + c] + cws[240 + c] * bf2f(XR[(size_t)(MP + r) * DRNN + ch]);
#pragma unroll
                    for (int k = 0; k < 3; ++k) xc += cws[k * 80 + c] * st_c[((size_t)r * 3 + k) * DRNN + ch]; }
                xcf[e] = xc; xcb[r * 104 + c] = (bf16)f2bf(xc); }
        }
        __syncthreads();
        for (int rep3_ = 0; rep3_ < 1 + 4 * ((PROBE_DUP >> 24) & 1); ++rep3_)
        { const int mt = wave & 3, jt0 = (wave >> 2) ? 3 : 0, jt1 = (wave >> 2) ? 5 : 3, fr = lane & 15, fq = lane >> 4;
            for (int jt = jt0; jt < jt1; ++jt) {
                f32x4 accA = (f32x4){0.f, 0.f, 0.f, 0.f}, accX = accA;
#pragma unroll
                for (int ks = 0; ks < 3; ++ks) {
                    const bf16x8 a = *(const LAS bf16x8*)(xcb + (size_t)(16 * mt + fr) * 104 + 32 * ks + 8 * fq);
                    const bf16x8 ba = *(const LAS bf16x8*)(wab + (size_t)(16 * jt + fr) * 104 + 32 * ks + 8 * fq);
                    const bf16x8 bx = *(const LAS bf16x8*)(wab + (size_t)(80 + 16 * jt + fr) * 104 + 32 * ks + 8 * fq);
                    accA = __builtin_amdgcn_mfma_f32_16x16x32_bf16(a, ba, accA, 0, 0, 0);
                    accX = __builtin_amdgcn_mfma_f32_16x16x32_bf16(a, bx, accX, 0, 0, 0);
                }
                const int c = 16 * jt + fr, ch = c0 + c;
                const float ba_ = cws[400 + c], bx_ = cws[480 + c], sp = cws[560 + c];
#pragma unroll
                for (int e = 0; e < 4; ++e) { const int r = 16 * mt + 4 * fq + e;
                    const float rg = sigmoid_fast(accA[e] + ba_), ig = sigmoid_fast(accX[e] + bx_);
                    const float la = -8.0f * rg * sp, a = __expf(la), x2 = 2.0f * la;
                    const float em = x2 * (1.0f + x2 * 0.5f * (1.0f + x2 * (1.0f / 3.0f) * (1.0f + x2 * 0.25f * (1.0f + x2 * 0.2f))));
                    float mult = __builtin_amdgcn_sqrtf(-em); if (!smp && t0 + r == 0) mult = 1.0f;
                    const float u = mult * (ig * xcf[r * 80 + c]);
                    if (!smp) { af[r * 80 + c] = a; uf[r * 80 + c] = u; }
                    else if (r < MS) { HL[(size_t)(MP + r) * DRNN + ch] = (bf16)f2bf(a * st_h[(size_t)r * DRNN + ch] + u); AC[(size_t)(MP + r) * DRNN + ch] = 0; } }
            } }
        __syncthreads();
        for (int rep4_ = 0; rep4_ < 1 + 4 * ((PROBE_DUP >> 25) & 1); ++rep4_)
        if (!smp) {
            const int ch = tid % 80, seg = tid / 80; float hs[16], ps[16];
            if (tid < 320) { float h = 0.f, p = 1.f;
#pragma unroll
                for (int r = 0; r < 16; ++r) { const float a = af[(seg * 16 + r) * 80 + ch], u = uf[(seg * 16 + r) * 80 + ch]; h = a * h + u; p *= a; hs[r] = h; ps[r] = p; }
                agg[(seg * 80 + ch) * 2] = p; agg[(seg * 80 + ch) * 2 + 1] = h; }
            __syncthreads();
            if (tid < 320) { float cy = 0.f, pc = 1.f;
                for (int s = 0; s < seg; ++s) { const float pp = agg[(s * 80 + ch) * 2], hh = agg[(s * 80 + ch) * 2 + 1]; cy = pp * cy + hh; pc *= pp; }
                bf16* hp = HL + (size_t)(m0 + seg * 16) * DRNN + c0 + ch; bf16* ap = AC + (size_t)(m0 + seg * 16) * DRNN + c0 + ch;
#pragma unroll
                for (int r = 0; r < 16; ++r) { hp[(size_t)r * DRNN] = (bf16)f2bf(hs[r] + ps[r] * cy); ap[(size_t)r * DRNN] = (bf16)f2bf(ps[r] * pc); } }
            else if (t0 == SEQ - 64 && tid >= 320 && tid < 320 + 80) { const int c = tid - 320;
#pragma unroll
                for (int k = 0; k < 3; ++k) P->out[O_RGC_P + ((size_t)(L * NB + b) * 3 + k) * DRNN + c0 + c] = xrt[(64 + k) * 80 + c]; }
        }
        __syncthreads();
    }
}
__device__ __forceinline__ void rg3_phase(KP P, LAS unsigned char* lds, int L, int tid, int G) {
    unsigned char* ws = P->ws;
    const bf16* HL = (const bf16*)(ws + WS_HL); const bf16* AC = (const bf16*)(ws + WS_AC); const bf16* Y = (const bf16*)(ws + WS_Y); bf16* Gb = (bf16*)(ws + WS_G);
    LAS float* cmb = (LAS float*)lds;
    const int oc = tid % 160, grp = tid / 160, c = oc * 8; const bool act = grp < 3;
    const f32x4 one4 = (f32x4){1.f, 1.f, 1.f, 1.f}, zero4 = (f32x4){0.f, 0.f, 0.f, 0.f};
    {
        const float* st_c = (const float*)P->in[7] + (size_t)L * MS * 3 * DRNN; const bf16* XR = (const bf16*)(ws + WS_XR);
        for (int e = launder_s(blockIdx.x) * 512 + tid; e < MS * 3 * DRNN; e += G * 512) { const int sb = e / (3 * DRNN), k = (e / DRNN) % 3, ch = e % DRNN;
            P->out[O_RGC_S + ((size_t)(L * MS + sb) * 3 + k) * DRNN + ch] = (k < 2) ? st_c[((size_t)sb * 3 + k + 1) * DRNN + ch] : bf2f(XR[(size_t)(MP + sb) * DRNN + ch]); }
    }
    for (int tl = launder_s(blockIdx.x); tl < 257; tl += G) {
        const bool smp = (tl == 256); const int m0 = tl * 64, b = m0 >> 12, kc = smp ? 0 : ((m0 & (SEQ - 1)) >> 6);
        if (act) {
            f32x4 cy0 = zero4, cy1 = zero4, ap0 = one4, ap1 = one4;
            const int lo = grp * kc / 3, hi = (grp + 1) * kc / 3;
            for (int kk = lo; kk < hi; kk += 4) {
                u32x4 aw[4], hw[4];
#pragma unroll
                for (int q = 0; q < 4; ++q) { aw[q] = (u32x4){0x3f803f80u, 0x3f803f80u, 0x3f803f80u, 0x3f803f80u}; hw[q] = (u32x4){0u, 0u, 0u, 0u};
                    if (kk + q < hi) { const size_t mr = (size_t)(b * SEQ + (kk + q) * 64 + 63) * DRNN + c; aw[q] = *(const u32x4*)(AC + mr); hw[q] = *(const u32x4*)(HL + mr); } }
#pragma unroll
                for (int q = 0; q < 4; ++q) { f32x4 a0, a1, h0, h1; unpack8(aw[q], a0, a1); unpack8(hw[q], h0, h1); cy0 = a0 * cy0 + h0; cy1 = a1 * cy1 + h1; ap0 *= a0; ap1 *= a1; }
            }
            *(LAS f32x4*)(cmb + (grp * 2 + 0) * 1280 + c) = ap0; *(LAS f32x4*)(cmb + (grp * 2 + 0) * 1280 + c + 4) = ap1;
            *(LAS f32x4*)(cmb + (grp * 2 + 1) * 1280 + c) = cy0; *(LAS f32x4*)(cmb + (grp * 2 + 1) * 1280 + c + 4) = cy1;
        }
        __syncthreads();
        if (act) {
            f32x4 cy0 = zero4, cy1 = zero4;
#pragma unroll
            for (int g2 = 0; g2 < 3; ++g2) {
                const f32x4 A0 = *(const LAS f32x4*)(cmb + (g2 * 2 + 0) * 1280 + c), A1 = *(const LAS f32x4*)(cmb + (g2 * 2 + 0) * 1280 + c + 4);
                const f32x4 H0 = *(const LAS f32x4*)(cmb + (g2 * 2 + 1) * 1280 + c), H1 = *(const LAS f32x4*)(cmb + (g2 * 2 + 1) * 1280 + c + 4);
                cy0 = A0 * cy0 + H0; cy1 = A1 * cy1 + H1; }
            const int nr = smp ? MS : 64;
            for (int r0 = grp; r0 < nr; r0 += 12) {
                u32x4 hlw[4], acw[4], yw[4];
#pragma unroll
                for (int q = 0; q < 4; ++q) { const int r = r0 + 3 * q; hlw[q] = (u32x4){0u, 0u, 0u, 0u}; acw[q] = hlw[q]; yw[q] = hlw[q];
                    if (r < nr) { const size_t mr = (size_t)(m0 + r) * DRNN + c; hlw[q] = *(const u32x4*)(HL + mr); acw[q] = *(const u32x4*)(AC + mr); yw[q] = *(const u32x4*)(Y + mr); } }
#pragma unroll
                for (int q = 0; q < 4; ++q) { const int r = r0 + 3 * q;
                    if (r < nr) { const size_t mr = (size_t)(m0 + r) * DRNN + c;
                        f32x4 hl0, hl1, ac0, ac1; unpack8(hlw[q], hl0, hl1); unpack8(acw[q], ac0, ac1);
                        const f32x4 h0 = hl0 + ac0 * cy0, h1 = hl1 + ac1 * cy1; u32x4 o;
                        o.x = pk2(__builtin_bit_cast(float, yw[q].x << 16) * h0[0], __builtin_bit_cast(float, yw[q].x & 0xffff0000u) * h0[1]);
                        o.y = pk2(__builtin_bit_cast(float, yw[q].y << 16) * h0[2], __builtin_bit_cast(float, yw[q].y & 0xffff0000u) * h0[3]);
                        o.z = pk2(__builtin_bit_cast(float, yw[q].z << 16) * h1[0], __builtin_bit_cast(float, yw[q].z & 0xffff0000u) * h1[1]);
                        o.w = pk2(__builtin_bit_cast(float, yw[q].w << 16) * h1[2], __builtin_bit_cast(float, yw[q].w & 0xffff0000u) * h1[3]);
                        *(u32x4*)(Gb + mr) = o;
                        if (smp) { float* op = P->out + O_RGH_S + (size_t)(L * MS + r) * DRNN + c; *(f32x4*)op = h0; *(f32x4*)(op + 4) = h1; }
                        else if (kc == 63 && r == 63) { float* op = P->out + O_RGH_P + (size_t)(L * NB + b) * DRNN + c; *(f32x4*)op = h0; *(f32x4*)(op + 4) = h1; } } }
            }
        }
        __syncthreads();
    }
}
__device__ __forceinline__ void cmp2_phase(KP P, LAS unsigned char* lds, int tid, int lane, int wave, int G) {
    unsigned char* ws = P->ws;
    const bf16* T = (const bf16*)(ws + WS_T); const float* B1P = (const float*)(ws + WS_B1F); const float* b1 = (const float*)P->in[28]; const float* w2 = (const float*)P->in[29];
    bf16* KC = (bf16*)(ws + WS_KC); bf16* VCT = (bf16*)(ws + WS_VCT); float* KCS = (float*)(ws + WS_KCS); float* VCS = (float*)(ws + WS_VCS);
    LAS bf16* w2b = (LAS bf16*)lds;
    LAS float* b1s = (LAS float*)(lds + 34816);
    LAS bf16* hidb = (LAS bf16*)(lds + 35840);
    for (int i = tid; i < 2 * 128 * 64; i += 512) { const int d = i & 63, e = (i >> 6) & 127, j = i >> 13; w2b[(j * 64 + d) * 136 + e] = (bf16)f2bf(w2[i]); }
    if (tid < 256) { float s = b1[tid];
        for (int l = 0; l < 32; ++l) s += B1P[l * 256 + tid];
        b1s[tid] = s; }
    __syncthreads();
    const int NU = 2 * CMP_ROWS / 64;
    const int mt = wave & 3, nh = wave >> 2, fr = lane & 15, fq = lane >> 4;
    for (int un = launder_s(blockIdx.x); un < NU; un += G) {
        const int slot0 = un * 64, j = slot0 / CMP_ROWS, row0 = slot0 % CMP_ROWS;
#pragma unroll
        for (int q = 0; q < 4; ++q) { const int idx = tid + 512 * q, r = idx >> 5, e4 = (idx & 31) * 4; const int row = row0 + r;
            const bool smp = row >= CMP_ROWS_P; const int cb = smp ? ((row - CMP_ROWS_P) & 511) : (row & 255); const bool valid = cb < (smp ? NCB_S : NCB_P);
            f32x4 h = (f32x4){0.f, 0.f, 0.f, 0.f};
            if (valid) { const f32x4 a = unpack4(*(const u32x2*)(T + (size_t)(slot0 + r) * 256 + e4)), bq = unpack4(*(const u32x2*)(T + (size_t)(slot0 + r + 1) * 256 + 128 + e4)), bb = *(const LAS f32x4*)(b1s + j * 128 + e4);
#pragma unroll
                for (int k = 0; k < 4; ++k) h[k] = gelu_tanh(a[k] + bq[k] + bb[k]); }
            *(LAS u32x2*)(hidb + r * 136 + e4) = (u32x2){pk2(h[0], h[1]), pk2(h[2], h[3])}; }
        __syncthreads();
        f32x4 acc[2];
#pragma unroll
        for (int n = 0; n < 2; ++n) { acc[n] = (f32x4){0.f, 0.f, 0.f, 0.f};
#pragma unroll
            for (int ks = 0; ks < 4; ++ks) { const bf16x8 a = *(const LAS bf16x8*)(hidb + (16 * mt + fr) * 136 + 32 * ks + 8 * fq);
                const bf16x8 b = *(const LAS bf16x8*)(w2b + (j * 64 + 16 * (2 * nh + n) + fr) * 136 + 32 * ks + 8 * fq);
                acc[n] = __builtin_amdgcn_mfma_f32_16x16x32_bf16(a, b, acc[n], 0, 0, 0); } }
#pragma unroll
        for (int n = 0; n < 2; ++n) { const int d = 16 * (2 * nh + n) + fr;
#pragma unroll
            for (int e = 0; e < 4; ++e) { const int row = row0 + 16 * mt + 4 * fq + e; const float o = acc[n][e];
                if (row < CMP_ROWS_P) { const int g = row >> 10, bb = (row >> 8) & 3, cb = row & 255;
                    if (j == 0) KC[((size_t)(bb * NG + g) * 256 + cb) * 64 + 2 * (d & 31) + (d >> 5)] = (bf16)f2bf(o);
                    else VCT[((size_t)(bb * NG + g) * 64 + d) * 256 + cb] = (bf16)f2bf(o); }
                else { const int rr = row - CMP_ROWS_P, g = rr >> 14, sb = (rr >> 9) & 31, cb = rr & 511;
                    (j == 0 ? KCS : VCS)[((size_t)(sb * NG + g) * 512 + cb) * 64 + d] = o; } } }
        __syncthreads();
    }
}
__device__ __forceinline__ void final_phase(KP P, const float* PSScur, const float* SPcur, int lane, int wave, int G) {
    const bf16* X = (const bf16*)(P->ws + xb_off(4)); const float* gf = (const float*)P->in[14];
    f32x4 gg[4];
#pragma unroll
    for (int jj = 0; jj < 4; ++jj) gg[jj] = *(const f32x4*)(gf + 4 * lane + 256 * jj);
    const int NGW = G * 8;
    for (int m0 = launder_s(blockIdx.x) * 8 + wave; m0 < MTOT; m0 += 2 * NGW) {
        float sp[2]; u32x2 xv[2][4];
#pragma unroll
        for (int q = 0; q < 2; ++q) { const int m = m0 + q * NGW; sp[q] = 0.f;
            if (m < MTOT) {
                if (m < MP) { if (lane < 16) sp[q] = PSScur[(size_t)lane * MPAD + m]; } else sp[q] = SPcur[lane * 32 + (m - MP)];
#pragma unroll
                for (int jj = 0; jj < 4; ++jj) xv[q][jj] = *(const u32x2*)(X + (size_t)m * DM + 4 * lane + 256 * jj); } }
#pragma unroll
        for (int q = 0; q < 2; ++q) { const int m = m0 + q * NGW;
            if (m < MTOT) {
                const float rs = rsqrtf(wave_sum(sp[q]) * (1.0f / 1024.0f) + EPS);
                float* o = m < MP ? P->out + O_Y_P + (size_t)m * DM : P->out + O_Y_S + (size_t)(m - MP) * DM;
#pragma unroll
                for (int jj = 0; jj < 4; ++jj) { const int c = 4 * lane + 256 * jj; *(f32x4*)(o + c) = unpack4(xv[q][jj]) * rs * gg[jj]; } } }
    }
}

constexpr int AT_KT = 0, AT_KTB = 18432, AT_VT = 36864, AT_VTB = 17408, AT_QS = 71680, AT_LS = 79872, AT_MASK = 88064, AT_QF = 88320, AT_STASH = 121088;
constexpr int AT_ROWB = 144, AT_VROWB = 272;
__device__ __forceinline__ unsigned cvtpk(float lo, float hi) { return pk2(lo, hi); }

template <int MODE>
__device__ __forceinline__ void attn_pass(LAS unsigned char* lds, const bf16* __restrict__ Kg, const bf16* __restrict__ Vtg, int vstride, int tb, int te, const LAS unsigned char* qfl,
                                          int klo, int khi, unsigned long long selmask, float& m_run, float& l_run, f32x16& o0, f32x16& o1, float inv_l, int tokrow, int tid, int lane) {
    if (te <= tb) return;
    const int r32 = lane & 31, hi = lane >> 5, lrow = tid >> 3, lch = tid & 7;
    const unsigned kofs = (unsigned)(lrow * AT_ROWB + lch * 16), vofs = (unsigned)(lrow * AT_VROWB + lch * 16);
    const bf16* kp = Kg + (size_t)lrow * 64 + lch * 8; const bf16* vp = Vtg + (size_t)lrow * vstride + lch * 8;
    u32x4 kreg0 = *(const u32x4*)(kp + (size_t)tb * 8192), kreg1 = *(const u32x4*)(kp + (size_t)tb * 8192 + 4096);
    u32x4 vreg0 = (u32x4){0u, 0u, 0u, 0u}, vreg1 = vreg0;
    if (MODE != 0) { vreg0 = *(const u32x4*)(vp + tb * 128); vreg1 = *(const u32x4*)(vp + tb * 128 + 64); }
    *(LAS u32x4*)(lds + AT_KT + kofs) = kreg0; *(LAS u32x4*)(lds + AT_KT + 64 * AT_ROWB + kofs) = kreg1;
    if (MODE != 0) { *(LAS u32x4*)(lds + AT_VT + vofs) = vreg0; *(LAS u32x4*)(lds + AT_VT + 128 + vofs) = vreg1; }
    __syncthreads();
    for (int t = tb; t < te; ++t) {
        const int buf = (t - tb) & 1, key0 = t * 128;
        if (t + 1 < te) { kreg0 = *(const u32x4*)(kp + (size_t)(t + 1) * 8192); kreg1 = *(const u32x4*)(kp + (size_t)(t + 1) * 8192 + 4096);
            if (MODE != 0) { vreg0 = *(const u32x4*)(vp + (t + 1) * 128); vreg1 = *(const u32x4*)(vp + (t + 1) * 128 + 64); } }
        const bool selA = (MODE == 2) ? ((selmask >> (2 * t)) & 1ull) != 0ull : true, selB = (MODE == 2) ? ((selmask >> (2 * t + 1)) & 1ull) != 0ull : true;
        const bool anyA = selA && (key0 <= khi) && (key0 + 63 >= klo), anyB = selB && (key0 + 64 <= khi) && (key0 + 127 >= klo);
        if (__builtin_amdgcn_ballot_w64(anyA || anyB) != 0ull) {
            const LAS unsigned char* Kb = lds + AT_KT + buf * AT_KTB; const LAS unsigned char* Vb = lds + AT_VT + buf * AT_VTB;
            const bool fullA = selA && (key0 >= klo) && (key0 + 63 <= khi), fullB = selB && (key0 + 64 >= klo) && (key0 + 127 <= khi);
            const bool partial = __builtin_amdgcn_ballot_w64((anyA && !fullA) || (anyB && !fullB)) != 0ull;
            const float base = (m_run == -INFINITY) ? 0.f : -m_run;
            const float ciA = (MODE >= 2) ? ((fullA || (partial && anyA)) ? base : -INFINITY) : 0.f, ciB = (MODE >= 2) ? ((fullB || (partial && anyB)) ? base : -INFINITY) : 0.f;
            f32x16 p[4];
#pragma unroll
            for (int r = 0; r < 16; ++r) { p[0][r] = ciA; p[1][r] = ciA; p[2][r] = ciB; p[3][r] = ciB; }
            __builtin_amdgcn_s_setprio(1);
#pragma unroll
            for (int c = 0; c < 4; ++c)
#pragma unroll
                for (int i = 0; i < 4; ++i) { const bf16x8 a = *(const LAS bf16x8*)(Kb + (32 * i + r32) * AT_ROWB + c * 32 + hi * 16);
                    p[i] = __builtin_amdgcn_mfma_f32_32x32x16_bf16(a, *(const LAS bf16x8*)(qfl + c * 1024), p[i], 0, 0, 0);
                    if (i == 3 && (c & 1)) __builtin_amdgcn_sched_barrier(0); }
            __builtin_amdgcn_s_setprio(0);
            float mx = -INFINITY;
            if (!partial && MODE >= 2) {
#pragma unroll
                for (int r = 0; r < 16; ++r) mx = fmaxf(fmaxf(mx, fmaxf(p[0][r], p[1][r])), fmaxf(p[2][r], p[3][r]));
            } else {
#pragma unroll
                for (int i = 0; i < 4; ++i) { const bool sl = (i < 2) ? selA : selB; const int kb0 = key0 + 32 * i + 4 * hi;
#pragma unroll
                    for (int r = 0; r < 16; ++r) { const int k = kb0 + (r & 3) + 8 * (r >> 2); p[i][r] = (sl && k >= klo && k <= khi) ? p[i][r] : -INFINITY; mx = fmaxf(mx, p[i][r]); } }
            }
            float ls = 0.f;
            if (MODE >= 2) {
                mx = fmaxf(mx, __shfl_xor(mx, 32));
                const bool moved = (m_run == -INFINITY) ? (mx != -INFINITY) : (mx > 0.f);
                if (__builtin_amdgcn_ballot_w64(moved) != 0ull) {
                    const float delta = moved ? mx : 0.f;
                    const float alpha = (m_run == -INFINITY) ? 1.f : __builtin_amdgcn_exp2f(-delta);
                    m_run = moved ? ((m_run == -INFINITY) ? mx : m_run + mx) : m_run;
                    l_run *= alpha;
#pragma unroll
                    for (int r = 0; r < 16; ++r) { o0[r] *= alpha; o1[r] *= alpha; p[0][r] -= delta; p[1][r] -= delta; p[2][r] -= delta; p[3][r] -= delta; }
                }
#pragma unroll
                for (int i = 0; i < 4; ++i)
#pragma unroll
                    for (int r = 0; r < 16; ++r) { p[i][r] = __builtin_amdgcn_exp2f(p[i][r]); ls += p[i][r]; }
            } else {
                float m_use;
                if (MODE == 1) { m_use = (m_run == -INFINITY) ? 0.f : m_run; }
                else {
                    mx = fmaxf(mx, __shfl_xor(mx, 32));
                    const float m_new = fmaxf(m_run, mx); m_use = (m_new == -INFINITY) ? 0.f : m_new;
                    const float alpha = __builtin_amdgcn_exp2f(m_run - m_use);
                    l_run *= alpha; m_run = m_new;
                }
#pragma unroll
                for (int i = 0; i < 4; ++i)
#pragma unroll
                    for (int r = 0; r < 16; ++r) { p[i][r] = __builtin_amdgcn_exp2f(p[i][r] - m_use); ls += p[i][r]; }
            }
            if (MODE != 1) l_run += ls;
            if (MODE == 1) {
                LAS float* QS = (LAS float*)(lds + AT_QS); LAS float* LS = (LAS float*)(lds + AT_LS);
#pragma unroll
                for (int i = 0; i < 4; ++i) {
#pragma unroll
                    for (int r = 0; r < 16; ++r) p[i][r] *= inv_l;
#pragma unroll
                    for (int jq = 0; jq < 4; ++jq) {
                        float q0 = (p[i][4 * jq] + p[i][4 * jq + 1]) + (p[i][4 * jq + 2] + p[i][4 * jq + 3]), l0 = p[i][4 * jq + 3];
#pragma unroll
                        for (int o = 1; o < 8; o <<= 1) { q0 += __shfl_xor(q0, o); l0 += __shfl_xor(l0, o); }
                        if ((lane & 7) == 0) { const int qd = 32 * t + 8 * i + 2 * jq + hi; QS[tokrow * 64 + qd] = q0; LS[tokrow * 64 + qd] = l0; }
                    }
                }
            }
            if (MODE != 0) {
#pragma unroll
                for (int j = 0; j < 8; ++j) {
                    const int i = j >> 1, rb = 8 * (j & 1);
                    u32x4 pw; pw.x = cvtpk(p[i][rb], p[i][rb + 1]); pw.y = cvtpk(p[i][rb + 2], p[i][rb + 3]); pw.z = cvtpk(p[i][rb + 4], p[i][rb + 5]); pw.w = cvtpk(p[i][rb + 6], p[i][rb + 7]);
                    const bf16x8 pb = __builtin_bit_cast(bf16x8, pw);
                    { const LAS unsigned char* vq = Vb + r32 * AT_VROWB + (16 * j + 4 * hi) * 2;
                      const u32x2 lo = *(const LAS u32x2*)vq, hh = *(const LAS u32x2*)(vq + 16);
                      o0 = __builtin_amdgcn_mfma_f32_32x32x16_bf16(__builtin_bit_cast(bf16x8, (u32x4){lo.x, lo.y, hh.x, hh.y}), pb, o0, 0, 0, 0); }
                    { const LAS unsigned char* vq = Vb + (32 + r32) * AT_VROWB + (16 * j + 4 * hi) * 2;
                      const u32x2 lo = *(const LAS u32x2*)vq, hh = *(const LAS u32x2*)(vq + 16);
                      o1 = __builtin_amdgcn_mfma_f32_32x32x16_bf16(__builtin_bit_cast(bf16x8, (u32x4){lo.x, lo.y, hh.x, hh.y}), pb, o1, 0, 0, 0); }
                    if (j & 1) __builtin_amdgcn_sched_barrier(0);
                }
            }
        }
        if (t + 1 < te) { LAS unsigned char* kd = lds + AT_KT + (buf ^ 1) * AT_KTB; *(LAS u32x4*)(kd + kofs) = kreg0; *(LAS u32x4*)(kd + 64 * AT_ROWB + kofs) = kreg1;
            if (MODE != 0) { LAS unsigned char* vd = lds + AT_VT + (buf ^ 1) * AT_VTB; *(LAS u32x4*)(vd + vofs) = vreg0; *(LAS u32x4*)(vd + 128 + vofs) = vreg1; } }
        __syncthreads();
    }
}

__device__ __forceinline__ void attn_prompt_unit(KP P, LAS unsigned char* lds, int b, int g, int t0, int tid, int lane, int wave) {
    unsigned char* ws = P->ws;
    const bf16* Q = (const bf16*)(ws + WS_Q); const bf16* QR = (const bf16*)(ws + WS_QR); const float* GT = (const float*)(ws + WS_GT); bf16* O = (bf16*)(ws + WS_O);
    const int bg = b * NG + g;
    const bf16* KS = (const bf16*)(ws + WS_KS) + (size_t)bg * SEQ * 64; const bf16* VTS = (const bf16*)(ws + WS_VTS) + (size_t)bg * 64 * SEQ;
    const bf16* KW = (const bf16*)(ws + WS_KW) + (size_t)bg * SEQ * 64; const bf16* VTW = (const bf16*)(ws + WS_VTW) + (size_t)bg * 64 * SEQ;
    const bf16* KC = (const bf16*)(ws + WS_KC) + (size_t)bg * 256 * 64; const bf16* VCT = (const bf16*)(ws + WS_VCT) + (size_t)bg * 64 * 256;
    const int r32 = lane & 31, hi = lane >> 5, tok_l = r32 >> 3, hl = r32 & 7, tokrow = wave * 4 + tok_l;
    const int t = t0 + tokrow, mrow = b * SEQ + t, h = g * HPG + hl;
    LAS float* QSb = (LAS float*)(lds + AT_QS); LAS float* LSb = (LAS float*)(lds + AT_LS); LAS unsigned long long* MK = (LAS unsigned long long*)(lds + AT_MASK);
    for (int i = tid; i < 32 * 64; i += 512) { QSb[i] = 0.f; LSb[i] = 0.f; }
    LAS unsigned char* qfl = lds + AT_QF + wave * 4096 + lane * 16;
#pragma unroll
    for (int c = 0; c < 4; ++c) *(LAS bf16x8*)(qfl + c * 1024) = *(const bf16x8*)(Q + (size_t)mrow * DM + h * 64 + c * 16 + hi * 8);
    __syncthreads();
    f32x16 o0, o1;
#pragma unroll
    for (int r = 0; r < 16; ++r) { o0[r] = 0.f; o1[r] = 0.f; }
    LAS unsigned* stash = (LAS unsigned*)(lds + AT_STASH) + wave * 1024 + lane;
    const int cmax = (t >= 31) ? ((t - 31) >> 4) : -1;
    const int ntc = (t0 >> 11) + 1;
    {
        float mc = -INFINITY, lc = 0.f;
        attn_pass<0>(lds, KC, VCT, 256, 0, ntc, qfl, 0, cmax, 0ull, mc, lc, o0, o1, 0.f, tokrow, tid, lane);
        lc += __shfl_xor(lc, 32);
        const float invl = lc > 0.f ? 1.0f / lc : 0.f;
        attn_pass<1>(lds, KC, VCT, 256, 0, ntc, qfl, 0, cmax, 0ull, mc, lc, o0, o1, invl, tokrow, tid, lane);
        const float g0 = GT[(size_t)mrow * 48 + h * 3 + 0];
#pragma unroll
        for (int r = 0; r < 16; ++r) { stash[r * 64] = pk2(g0 * o0[r], g0 * o1[r]); o0[r] = 0.f; o1[r] = 0.f; }
    }
    asm volatile("s_waitcnt lgkmcnt(0)" ::: "memory");
    unsigned long long mymask = 0ull;
    {
        const int cur_w = (t0 + wave * 4) >> 6;
#pragma unroll
        for (int tk = 0; tk < 4; ++tk) {
            const int tr = wave * 4 + tk, s = lane;
            float v = QSb[tr * 64 + s] + (s > 0 ? LSb[tr * 64 + s - 1] : 0.f);
            if (s == 0 || s == cur_w || s + 1 == cur_w) v = INFINITY;
            if (s > cur_w) v = -INFINITY;
            int rank = 0;
            for (int i = 0; i < 64; ++i) { const float x = __builtin_bit_cast(float, __builtin_amdgcn_readlane(__builtin_bit_cast(int, v), i)); rank += (x > v || (x == v && i < s)) ? 1 : 0; }
            const unsigned long long mk = __builtin_amdgcn_ballot_w64(rank < 16);
            if (tok_l == tk) mymask = mk;
        }
    }
    (void)MK;
#pragma unroll
    for (int c = 0; c < 4; ++c) *(LAS bf16x8*)(qfl + c * 1024) = *(const bf16x8*)(QR + (size_t)mrow * DM + h * 64 + c * 16 + hi * 8);
    const int cur = t0 >> 6;
    {
        float ms = -INFINITY, lsum = 0.f;
        attn_pass<2>(lds, KS, VTS, SEQ, 0, (cur >> 1) + 1, qfl, 0, t, mymask, ms, lsum, o0, o1, 0.f, tokrow, tid, lane);
        lsum += __shfl_xor(lsum, 32);
        const float sc = GT[(size_t)mrow * 48 + h * 3 + 1] / lsum;
#pragma unroll
        for (int r = 0; r < 16; ++r) { const unsigned w = stash[r * 64]; stash[r * 64] = pk2(__builtin_bit_cast(float, w << 16) + sc * o0[r], __builtin_bit_cast(float, w & 0xffff0000u) + sc * o1[r]); o0[r] = 0.f; o1[r] = 0.f; }
    }
    f32x16 out0, out1;
    {
        float mw = -INFINITY, lw = 0.f;
        const int wlo = (t0 - 511) > 0 ? (t0 - 511) >> 7 : 0;
        attn_pass<3>(lds, KW, VTW, SEQ, wlo, (cur >> 1) + 1, qfl, t - 511, t, 0ull, mw, lw, o0, o1, 0.f, tokrow, tid, lane);
        lw += __shfl_xor(lw, 32);
        const float sc = GT[(size_t)mrow * 48 + h * 3 + 2] / lw;
#pragma unroll
        for (int r = 0; r < 16; ++r) { const unsigned w = stash[r * 64]; out0[r] = __builtin_bit_cast(float, w << 16) + sc * o0[r]; out1[r] = __builtin_bit_cast(float, w & 0xffff0000u) + sc * o1[r]; }
    }
    bf16* op = O + (size_t)mrow * DM + h * 64 + 4 * hi;
#pragma unroll
    for (int jq = 0; jq < 4; ++jq) {
        u32x2 w0; w0.x = cvtpk(out0[4 * jq], out0[4 * jq + 1]); w0.y = cvtpk(out0[4 * jq + 2], out0[4 * jq + 3]); *(u32x2*)(op + 8 * jq) = w0;
        u32x2 w1; w1.x = cvtpk(out1[4 * jq], out1[4 * jq + 1]); w1.y = cvtpk(out1[4 * jq + 2], out1[4 * jq + 3]); *(u32x2*)(op + 32 + 8 * jq) = w1;
    }
}

constexpr int SM_QN = 0, SM_QR = 2048, SM_SC = 4096, SM_IMP = 36864, SM_SEL = 37888, SM_PTR = 38144, SM_OP = 46336;
__device__ __forceinline__ void smp_scores(const float* __restrict__ kp, const LAS float* q, LAS float* sc, int col, bool valid) {
    float s[8];
#pragma unroll
    for (int hl = 0; hl < 8; ++hl) s[hl] = 0.f;
    if (valid) {
#pragma unroll 4
        for (int d4 = 0; d4 < 16; ++d4) { const f32x4 kv = *(const f32x4*)(kp + 4 * d4);
#pragma unroll
            for (int hl = 0; hl < 8; ++hl) { const f32x4 qv = *(const LAS f32x4*)(q + hl * 64 + 4 * d4); s[hl] += (kv[0] * qv[0] + kv[1] * qv[1]) + (kv[2] * qv[2] + kv[3] * qv[3]); } }
    }
#pragma unroll
    for (int hl = 0; hl < 8; ++hl) sc[hl * 1024 + col] = valid ? s[hl] : -INFINITY;
}
__device__ __forceinline__ void smp_softmax(LAS float* sc, int n, int lane, int wave) {
    LAS float* row = sc + wave * 1024; float mx = -INFINITY;
    for (int i = lane; i < n; i += 64) mx = fmaxf(mx, row[i]);
#pragma unroll
    for (int o = 1; o < 64; o <<= 1) mx = fmaxf(mx, __shfl_xor(mx, o));
    float sum = 0.f;
    for (int i = lane; i < n; i += 64) { const float e = __builtin_amdgcn_exp2f(row[i] - mx); row[i] = e; sum += e; }
    sum = wave_sum(sum); const float inv = 1.0f / sum;
    for (int i = lane; i < n; i += 64) row[i] *= inv;
}
template <bool PTR> __device__ __forceinline__ void smp_pv(const LAS float* sc, const LAS unsigned long long* rp, const float* __restrict__ vbase, int n, LAS float* opart, int tid) {
    const int sl = tid >> 4, dq = tid & 15;
    f32x4 acc[8];
#pragma unroll
    for (int q = 0; q < 8; ++q) acc[q] = (f32x4){0.f, 0.f, 0.f, 0.f};
#pragma unroll 4
    for (int kk = sl; kk < n; kk += 32) {
        f32x4 v = (f32x4){0.f, 0.f, 0.f, 0.f};
        if (PTR) { const float* kp = (const float*)(uintptr_t)rp[kk]; if (kp) v = *(const f32x4*)(kp + 128 + 4 * dq); }
        else v = *(const f32x4*)(vbase + (size_t)kk * 64 + 4 * dq);
#pragma unroll
        for (int q = 0; q < 8; ++q) acc[q] += sc[q * 1024 + kk] * v;
    }
#pragma unroll
    for (int q = 0; q < 8; ++q) *(LAS f32x4*)(opart + (sl * 8 + q) * 64 + 4 * dq) = acc[q];
}
__device__ __forceinline__ float smp_pv_reduce(const LAS float* opart, int hl, int d) {
    float s = 0.f;
#pragma unroll 8
    for (int k = 0; k < 32; ++k) s += opart[(k * 8 + hl) * 64 + d];
    return s;
}
__device__ __forceinline__ void attn_sample_unit(KP P, LAS unsigned char* lds, int sb, int g, int tid, int lane, int wave) {
    unsigned char* ws = P->ws;
    const bf16* Q = (const bf16*)(ws + WS_Q); const bf16* QR = (const bf16*)(ws + WS_QR); const float* GT = (const float*)(ws + WS_GT); bf16* O = (bf16*)(ws + WS_O);
    const float* KCS = (const float*)(ws + WS_KCS) + (size_t)(sb * NG + g) * 512 * 64; const float* VCS = (const float*)(ws + WS_VCS) + (size_t)(sb * NG + g) * 512 * 64;
    const float* cslc = (const float*)P->in[5]; const float* cwin = (const float*)P->in[6]; const int* pt = (const int*)P->in[10] + sb * NPG;
    LAS float* qn = (LAS float*)(lds + SM_QN); LAS float* qr = (LAS float*)(lds + SM_QR); LAS float* sc = (LAS float*)(lds + SM_SC); LAS float* imp = (LAS float*)(lds + SM_IMP);
    LAS int* sel = (LAS int*)(lds + SM_SEL); LAS unsigned long long* rp = (LAS unsigned long long*)(lds + SM_PTR); LAS float* opart = (LAS float*)(lds + SM_OP);
    const int mrow = MP + sb, hl = tid >> 6, d = tid & 63, h = g * HPG + hl;
    { const int e = 2 * (d & 31) + (d >> 5);
      qn[hl * 64 + d] = bf2f(Q[(size_t)mrow * DM + h * 64 + e]); qr[hl * 64 + d] = bf2f(QR[(size_t)mrow * DM + h * 64 + e]); }
    __syncthreads();
    smp_scores(KCS + (size_t)tid * 64, qn, sc, tid, tid < NCB_S);
    __syncthreads();
    smp_softmax(sc, 512, lane, wave);
    __syncthreads();
    smp_pv<false>(sc, rp, VCS, NCB_S, opart, tid);
    if (tid < NSB_S) { float v = 0.f; const int c0 = tid * 4 - 1;
        for (int c = (c0 < 0 ? 0 : c0); c <= c0 + 4 && c < NCB_S; ++c)
#pragma unroll
            for (int q = 0; q < 8; ++q) v += sc[q * 1024 + c];
        if (tid == 0 || tid == 127 || tid == 128) v = INFINITY;
        imp[tid] = v; }
    __syncthreads();
    const float oc = smp_pv_reduce(opart, hl, d);
    if (tid < NSB_S) { const float v = imp[tid]; int rank = 0;
        for (int i = 0; i < NSB_S; ++i) { const float x = imp[i]; rank += (x > v || (x == v && i < tid)) ? 1 : 0; }
        if (rank < 16) sel[rank] = tid; }
    __syncthreads();
#pragma unroll
    for (int q = 0; q < 2; ++q) { const int kk = tid + 512 * q, blk = sel[kk >> 6], pos = blk * 64 + (kk & 63);
        const float* kp = nullptr;
        if (pos < PAST) kp = cslc + ((size_t)pt[pos >> 7] * PGSZ + (pos & 127)) * 256 + g * 64;
        else if (pos == PAST) kp = P->out + O_SLC_S + (size_t)sb * 256 + g * 64;
        rp[kk] = (unsigned long long)(uintptr_t)kp;
        smp_scores(kp, qr, sc, kk, kp != nullptr); }
    __syncthreads();
    smp_softmax(sc, 1024, lane, wave);
    __syncthreads();
    smp_pv<true>(sc, rp, nullptr, 1024, opart, tid);
    __syncthreads();
    const float os = smp_pv_reduce(opart, hl, d);
    __syncthreads();
    { const float* kp = (tid < 511) ? cwin + ((size_t)sb * 512 + tid + 1) * 256 + g * 64 : P->out + O_WIN_S + ((size_t)sb * 512 + 511) * 256 + g * 64;
      rp[tid] = (unsigned long long)(uintptr_t)kp;
      smp_scores(kp, qr, sc, tid, true); }
    __syncthreads();
    smp_softmax(sc, 512, lane, wave);
    __syncthreads();
    smp_pv<true>(sc, rp, nullptr, 512, opart, tid);
    __syncthreads();
    const float ow = smp_pv_reduce(opart, hl, d);
    const float g0 = GT[(size_t)mrow * 48 + h * 3 + 0], g1 = GT[(size_t)mrow * 48 + h * 3 + 1], g2 = GT[(size_t)mrow * 48 + h * 3 + 2];
    O[(size_t)mrow * DM + h * 64 + d] = (bf16)f2bf(g0 * oc + g1 * os + g2 * ow);
    __syncthreads();
}

__device__ __forceinline__ void attn_phase(KP P, LAS unsigned char* lds, int qidx, int tid, int lane, int wave, int G) {
    unsigned* head = (unsigned*)(P->ws + WS_CTL) + 4096 + 64 * qidx;
    volatile LAS int* slot = (volatile LAS int*)(lds + LDS_MISC + 64);
    for (;;) {
        if (tid == 0) slot[0] = (int)__hip_atomic_fetch_add(head, 1u, __ATOMIC_RELAXED, __HIP_MEMORY_SCOPE_AGENT);
        __syncthreads();
        const int un = slot[0];
        __syncthreads();
        if (un >= 64 + 1024) break;
        if (un < 64) attn_sample_unit(P, lds, un >> 1, un & 1, tid, lane, wave);
        else { const int k = un - 64, bg = k & 7, tb = 127 - (k >> 3);
            attn_prompt_unit(P, lds, bg >> 1, bg & 1, tb * 32, tid, lane, wave); }
        __syncthreads();
    }
}

constexpr int NPHASES = 30;
#define DUPK(k) for (int dup_ = 0; dup_ < 1 + ((PROBE_DUP >> (k)) & 1); ++dup_)
#ifndef MK_MULTI
#define MK_MULTI 0
#endif
__global__ void __launch_bounds__(512, 2) mega(Params Pv) {
    extern __shared__ __attribute__((aligned(16))) unsigned char lds_raw[];
    LAS unsigned char* lds = (LAS unsigned char*)lds_raw;

    const KP Pk = (KP)__builtin_amdgcn_kernarg_segment_ptr();
    LAS float* rsb = (LAS float*)(lds + LDS_RS);
    int ph = 0, cur = 0;
    if (Pk->ph_hi - Pk->ph_lo > 1) {
        if (blockIdx.x == 0) { unsigned* ctl = (unsigned*)(Pk->ws + WS_CTL); for (int i = threadIdx.x; i < 8192; i += 512) ctl[i] = 0u; }
        if (threadIdx.x < 16) ((volatile LAS unsigned*)(lds + LDS_MISC))[threadIdx.x] = 0u;
        __syncthreads();
    }
#define RUN (ph >= Pk->ph_lo && ph < Pk->ph_hi)
#define FRESH const int tid = launder_v(threadIdx.x), lane = tid & 63, wave = __builtin_amdgcn_readfirstlane(tid >> 6), G = launder_s(gridDim.x), bid = launder_s(blockIdx.x); (void)lane; (void)wave; (void)bid
#define GRID_BAR do { if (ph == 0) { seam0_barrier(); (void)xcd_barrier_post((unsigned*)(Pk->ws + WS_CTL), (volatile LAS unsigned*)(lds + LDS_MISC) + 8); } else { XcdBarrier b_; b_.bar = (unsigned*)(launder(Pk)->ws + WS_CTL); b_.x = xb_xcc_id(); b_.st = (volatile LAS unsigned*)(lds + LDS_MISC) + 8; xcd_barrier(b_); } } while (0)
#define END_PHASE do { if (RUN && ph + 1 < Pk->ph_hi) { GRID_BAR; if ((PROBE_DUP >> 20) & 1) { if (ph > 0) GRID_BAR; } } ++ph; } while (0)
#define PSS_OF(ws_, c_) ((float*)((ws_) + WS_PSS) + (size_t)(c_) * 16 * MPAD)
#define GEMM_RS(EpiT_, AOFF, BOFF, N_, NTHIN_, K_, ...) GEMM_RS_B(0, EpiT_, AOFF, BOFF, N_, NTHIN_, K_, __VA_ARGS__)
#define GEMM_RS_B(REV_, EpiT_, AOFF, BOFF, N_, NTHIN_, K_, ...) do { const int tid = launder_v(threadIdx.x), G = launder_s(gridDim.x), bid = (REV_) ? G - 1 - launder_s(blockIdx.x) : launder_s(blockIdx.x); const KP P = launder(Pk); unsigned char* ws = P->ws; \
        pg8::Gemm g_{(const bf16*)(ws + (AOFF)), (const bf16*)(ws + (BOFF)), MP, (N_), (K_)}; pg8::StaticOrder S_; S_.init(MP, (N_), G, bid); \
        const int tcg_ = G - 1 - bid; const bool thin_ = tcg_ < (NTHIN_); \
        rs_prepare(S_, PSS_OF(ws, cur), (const float*)(ws + WS_SPSS) + cur * 2048, rsb, tid, thin_); EpiT_ E_{__VA_ARGS__}; \
          \
          \
        { const int tstr_ = ((NTHIN_) > G / 2 && (NTHIN_) < G && ((N_) / 256) * (MP / 256) % G == G / 2) ? G / 2 : G; \
          if (tcg_ < tstr_) for (int cg_ = tcg_; cg_ < (NTHIN_); cg_ += tstr_) { E_.slot = 7; thin_unit<(K_)>(lds, g_.A, g_.Bt, cg_, E_); } } E_.slot = 0; \
        pg8::gemm_phase<EpiT_, pg8::StaticOrder, false, true>(lds, g_, S_, E_); } while (0)
#define GEMM_RES(KIND, AOFF, BOFF, K_, SOFF) DUPK(KIND) { FRESH; const KP P = launder(Pk); unsigned char* ws = P->ws; \
        pg8::Gemm g_{(const bf16*)(ws + (AOFF)), (const bf16*)(ws + (BOFF)), MP, 1024, (K_)}; pg8::StaticOrder S_; S_.init(MP, 1024, G, bid); \
        EpiRes E_{ws, PSS_OF(ws, cur ^ 1), (SOFF), dup_ ? 0.0f : 1.0f, xb_off(L)}; \
        const int tcg_ = G - 1 - bid; if (tcg_ < 64) thin_unit<(K_)>(lds, g_.A, g_.Bt, tcg_, E_); \
        pg8::gemm_phase<EpiRes, pg8::StaticOrder, false, true>(lds, g_, S_, E_); }

    if (RUN) DUPK(0) { FRESH; phase0(launder(Pk), lds, tid, lane, wave, G); }
    END_PHASE;

#pragma unroll
    for (int L = 0; L < 4; ++L) {
        if (L < 2) {
            if (RUN) { GEMM_RS(EpiRG1, xb_off(L), WS_WIN + (size_t)L * 2560 * 1024 * 2, 2560, 160, 1024, ws, rsb, 0);
                if (L == 0) { FRESH; const KP P = launder(Pk); unsigned char* ws = P->ws; const int Gh = G >> 1;
                  pg8::Gemm g_{(const bf16*)(ws + WS_PB), (const bf16*)(ws + WS_WPI), 4 * MPAD, 4096, 256}; EpiPin E_{ws};
                  { PinOrder S_; S_.Lb = 0; S_.stride = 1;
                    if (G == 256) { if (bid < 128) { S_.start = bid; S_.count = 1; } else { S_.start = 128 + (bid - 128) * 3; S_.count = 3; } }
                    else { const int per = (512 + G - 1) / G; S_.start = bid * per; S_.count = per; }
                    pg8::gemm_phase<EpiPin, PinOrder, false, true>(lds, g_, S_, E_); }
                  if (bid < Gh) for (int q_ = bid; q_ < 128; q_ += Gh) { const int L_ = (q_ >> 6), cg_ = q_ & 63; E_.Lthin = L_; thin_unit<256>(lds, g_.A + (size_t)L_ * MPAD * 256, g_.Bt + (size_t)L_ * 1024 * 256, cg_, E_); } }
                if (L == 1) { FRESH; const KP P = launder(Pk); unsigned char* ws = P->ws;
                  if (G == 256 && bid >= 128) { constexpr int NCU_ = 2 * (CMP_ROWS / 256);
                    pg8::Gemm g_{(const bf16*)(ws + WS_CMPA), (const bf16*)(ws + WS_WC1), 2 * CMP_ROWS, 256, 1024}; CmpOrder S_{G, bid - 128, NCU_ - 128, NCU_}; EpiT E_{(bf16*)(ws + WS_T)};
                    pg8::gemm_phase<EpiT, CmpOrder, false, true>(lds, g_, S_, E_); } } }
            END_PHASE;
            if (RUN) DUPK(2) { FRESH; rg2_phase(launder(Pk), lds, L, tid, lane, wave, G); }
            END_PHASE;
            if (RUN) DUPK(3) { FRESH; rg3_phase(launder(Pk), lds, L, tid, G); }
            END_PHASE;
            if (RUN) GEMM_RES(13, WS_G, WS_WOUT + (size_t)L * 1024 * 1280 * 2, 1280, (size_t)0);
            END_PHASE; cur ^= 1;
        } else {
            const int j = L - 2;
            if (L == 2) {
                if (RUN) { GEMM_RS(EpiKV, xb_off(L), WS_WKV, NKV, 48, 1024, P->out, ws, rsb, 0);
                    GEMM_RS_B(1, EpiQ, xb_off(L), WS_WQG, NQGP, 67, 1024, ws, rsb, 0); }
                END_PHASE;
                if (RUN) DUPK(8) { FRESH; const KP P = launder(Pk); unsigned char* ws = P->ws;
                    constexpr int NCU_ = 2 * (CMP_ROWS / 256), NSV_ = 128;
                    const bool early_ = (G == 256);
                    pg8::Gemm g_{(const bf16*)(ws + WS_CMPA), (const bf16*)(ws + WS_WC1), 2 * CMP_ROWS, 256, 1024}; CmpOrder S_{G, bid, 0, early_ ? NCU_ - NSV_ : NCU_}; EpiT E_{(bf16*)(ws + WS_T)};
                    pg8::gemm_phase<EpiT, CmpOrder, false, true>(lds, g_, S_, E_);
                    { const int nb2 = 2 * (CMP_ROWS / 256) - G, nf = G - (nb2 > 0 ? nb2 : 0);
                      pg8::Gemm gp_{(const bf16*)(ws + WS_PB), (const bf16*)(ws + WS_WPI), 4 * MPAD, 4096, 256}; EpiPin Ep_{ws};
                      if (early_) {
                          PinOrder Sp_; Sp_.Lb = 2; Sp_.start = 0; Sp_.stride = G - (NCU_ - NSV_); Sp_.count = 0;
                          if (bid >= NCU_ - NSV_) { Sp_.start = bid - (NCU_ - NSV_); Sp_.count = (Sp_.start + 2 * Sp_.stride < 256) ? 3 : 2; }
                          pg8::gemm_phase<EpiPin, PinOrder, false, true>(lds, gp_, Sp_, Ep_); }
                      else if (nf > 0 && bid >= G - nf) { PinOrder Sp_; Sp_.Lb = 2; Sp_.start = bid - (G - nf); Sp_.stride = nf; Sp_.count = (512 + nf - 1) / nf;
                          pg8::gemm_phase<EpiPin, PinOrder, false, true>(lds, gp_, Sp_, Ep_); }
                      else if (nf <= 0) { PinOrder Sp_; Sp_.Lb = 2; Sp_.start = bid; Sp_.stride = G; Sp_.count = (512 + G - 1) / G; pg8::gemm_phase<EpiPin, PinOrder, false, true>(lds, gp_, Sp_, Ep_); }
                      for (int q_ = bid; q_ < 128; q_ += G) { const int L_ = 2 + (q_ >> 6), cg_ = q_ & 63; Ep_.Lthin = L_; thin_unit<256>(lds, gp_.A + (size_t)L_ * MPAD * 256, gp_.Bt + (size_t)L_ * 1024 * 256, cg_, Ep_); } } }
                END_PHASE;
                if (RUN) DUPK(9) { FRESH; cmp2_phase(launder(Pk), lds, tid, lane, wave, G); }
                END_PHASE;
            }
            if (L == 3) { if (RUN) DUPK(10) { GEMM_RS(EpiQ, xb_off(L), WS_WQG + (size_t)j * NQGP * 1024 * 2, NQGP, 67, 1024, ws, rsb, 0);
                { FRESH; const KP P = launder(Pk); unsigned char* ws = P->ws;
                  if (G == 256 && bid >= 64) { pg8::Gemm gp_{(const bf16*)(ws + WS_PB), (const bf16*)(ws + WS_WPI), 4 * MPAD, 4096, 256}; EpiPin Ep_{ws};
                    PinOrder Sp_; Sp_.Lb = 2; Sp_.start = 256 + (bid - 64); Sp_.stride = 192; Sp_.count = 2; pg8::gemm_phase<EpiPin, PinOrder, false, true>(lds, gp_, Sp_, Ep_); } } }
            END_PHASE; }
            if (RUN) DUPK(11) { FRESH; attn_phase(launder(Pk), lds, j + 2 * dup_, tid, lane, wave, G); }
            END_PHASE;
            if (RUN) GEMM_RES(16, WS_O, WS_WO + (size_t)j * 1024 * 1024 * 2, 1024, (size_t)0);
            END_PHASE; cur ^= 1;
        }
        if (RUN) DUPK(4) { FRESH; const KP P = launder(Pk); unsigned char* ws = P->ws;
            pg8::Gemm g_{(const bf16*)(ws + xb_off(L)), (const bf16*)(ws + WS_WUP + (size_t)L * 6144 * 1024 * 2), MP, DFF2, 1024}; pg8::StaticOrder S_; S_.init(MP, DFF2, G, bid);
            const int tpg_ = G - 1 - bid; const bool thin_ = tpg_ < 192;
            rs_prepare(S_, PSS_OF(ws, cur), (const float*)(ws + WS_SPSS) + cur * 2048, rsb, tid, thin_);
            const float* cw_ = (const float*)P->in[33] + (size_t)L * 3 * DFF2; const float* cb_ = (const float*)P->in[34] + (size_t)L * DFF2;
            EpiUp E_{ws, rsb, P->out, cw_, cb_, (LAS float*)(lds + LDS_HALO), L, 0};
            if (thin_) thin_unit_up(lds, g_.A, g_.Bt, tpg_, ws, rsb + 7 * 256, P->out, cw_, cb_, (const float*)P->in[9], L);
            pg8::gemm_phase<EpiUp, pg8::StaticOrder, true, true>(lds, g_, S_, E_); }
        END_PHASE;
        if (RUN) DUPK(14) { FRESH; const KP P = launder(Pk); unsigned char* ws = P->ws;
            pg8::Gemm g_{(const bf16*)(ws + WS_ACT), (const bf16*)(ws + WS_WDN + (size_t)L * 1024 * 3072 * 2), MP, 1024, 3072}; pg8::StaticOrder S_; S_.init(MP, 1024, G, bid);
            { pg8::Unit u_; for (int i_ = 0; S_.next(i_, u_); ++i_) act_fixup(ws, (const float*)P->in[33] + (size_t)L * 3 * DFF2, (const float*)P->in[34] + (size_t)L * DFF2, u_.pm, tid); }
            asm volatile("s_waitcnt vmcnt(0)" ::: "memory"); __syncthreads();
            EpiRes E_{ws, PSS_OF(ws, cur ^ 1), (size_t)0, dup_ ? 0.0f : 1.0f, xb_off(L)};
            const int tcg_ = G - 1 - bid; if (tcg_ < 64) thin_unit<3072>(lds, g_.A, g_.Bt, tcg_, E_);
            pg8::gemm_phase<EpiRes, pg8::StaticOrder, false, true>(lds, g_, S_, E_); }
        END_PHASE; cur ^= 1;
        if (RUN) GEMM_RS(EpiGate, xb_off(L), WS_WPG + (size_t)L * 1024 * 1024 * 2, 1024, 64, 1024, ws, rsb, PSS_OF(ws, cur ^ 1), WS_PIN + (size_t)L * MPAD * DM * 2, xb_off(L), xb_off(L + 1), 0);
        END_PHASE; cur ^= 1;
    }
    if (RUN) DUPK(12) { FRESH; const KP P = launder(Pk); final_phase(P, PSS_OF(P->ws, cur), (const float*)(P->ws + WS_SPSS) + cur * 2048, lane, wave, G); }
    END_PHASE;
}

extern "C" void kernel_launch(void* const* d_in, const int* in_sizes, int n_in, void* d_out, int out_size, void* d_ws, size_t ws_size, hipStream_t stream) {
    static int grid = 0;
    if (grid == 0) {
        if (n_in != 38 || (size_t)out_size != O_END || ws_size < WS_END) { fprintf(stderr, "kernel_launch: unexpected problem: n_in %d out %d ws %zu (need %zu)\n", n_in, out_size, ws_size, (size_t)WS_END); grid = -1; return; }
        int dev = 0, cus = 0, per_cu = 0;
        (void)hipGetDevice(&dev); (void)hipDeviceGetAttribute(&cus, hipDeviceAttributeMultiprocessorCount, dev);
        if (hipFuncSetAttribute((const void*)mega, hipFuncAttributeMaxDynamicSharedMemorySize, LDS_BYTES) != hipSuccess) { fprintf(stderr, "kernel_launch: hipFuncSetAttribute failed\n"); grid = -1; return; }
        if (hipOccupancyMaxActiveBlocksPerMultiprocessor(&per_cu, (const void*)mega, 512, LDS_BYTES) != hipSuccess || per_cu < 1) { fprintf(stderr, "kernel_launch: occupancy query says %d\n", per_cu); per_cu = 1; }
        (void)hipGetLastError();
        grid = cus;
        if (grid > 256) grid = 256;
    }
    if (grid < 0) return;
    Params p{};
    for (int i = 0; i < 38; ++i) p.in[i] = d_in[i];
    p.out = (float*)d_out; p.ws = (unsigned char*)d_ws;
#if MK_MULTI
    for (int ph = 0; ph < NPHASES; ++ph) { p.ph_lo = ph; p.ph_hi = ph + 1; hipLaunchKernelGGL(mega, dim3(grid), dim3(512), LDS_BYTES, stream, p); }
#else
    p.ph_lo = 0; p.ph_hi = NPHASES;
    void* args[] = {&p};
    hipError_t e = hipLaunchCooperativeKernel((const void*)mega, dim3(grid), dim3(512), args, LDS_BYTES, stream);
    if (e != hipSuccess) fprintf(stderr, "kernel_launch: cooperative launch failed: %s (grid %d)\n", hipGetErrorString(e), grid);
#endif
}
```

```cpp
#include <hip/hip_runtime.h>
#include <hip/hip_cooperative_groups.h>
#include <cstdio>
#include <cstdint>
#include <cmath>
namespace cg = cooperative_groups;
#ifndef PROBE_DUP
#define PROBE_DUP 0
#endif


#define LAS __attribute__((address_space(3)))
#define GAS __attribute__((address_space(1)))
typedef unsigned short bf16;
typedef short bf16x8 __attribute__((ext_vector_type(8)));
typedef float f32x4 __attribute__((ext_vector_type(4)));
typedef float f32x2 __attribute__((ext_vector_type(2)));
typedef float f32x16 __attribute__((ext_vector_type(16)));
typedef unsigned u32x4 __attribute__((ext_vector_type(4)));
typedef unsigned u32x2 __attribute__((ext_vector_type(2)));

constexpr int DM = 1024, SEQ = 4096, NB = 4, MP = NB * SEQ, MS = 32, MTOT = MP + MS, MPAD = 16640, NMT = MPAD / 256;
constexpr int DRNN = 1280, DFF = 3072, DFF2 = 6144, DPLE = 256, NRGB = 16, RGB = 80;
constexpr int PAST = 8192, NPG = 64, PGSZ = 128, HD = 64, NH = 16, NG = 2, HPG = 8;
constexpr int NCB_P = 255, NCB_S = 511, NSB_S = 129;
constexpr int NQG = 1072, NQGP = 1280, NKV = 768;
constexpr float EPS = 1e-6f;
constexpr float C2 = 0.125f * 1.4426950408889634f;
constexpr int CMP_ROWS_P = NG * NB * 256, CMP_ROWS_S = NG * MS * 512, CMP_ROWS = CMP_ROWS_P + CMP_ROWS_S;

constexpr size_t O_Y_P = 0;
constexpr size_t O_Y_S = O_Y_P + (size_t)MP * DM;
constexpr size_t O_CMP_P = O_Y_S + (size_t)MS * DM;
constexpr size_t O_CMP_S = O_CMP_P + (size_t)MP * 256;
constexpr size_t O_SLC_P = O_CMP_S + (size_t)MS * 256;
constexpr size_t O_SLC_S = O_SLC_P + (size_t)MP * 256;
constexpr size_t O_WIN_P = O_SLC_S + (size_t)MS * 256;
constexpr size_t O_WIN_S = O_WIN_P + (size_t)NB * 512 * 256;
constexpr size_t O_RGC_P = O_WIN_S + (size_t)MS * 512 * 256;
constexpr size_t O_RGC_S = O_RGC_P + (size_t)2 * NB * 3 * DRNN;
constexpr size_t O_RGH_P = O_RGC_S + (size_t)2 * MS * 3 * DRNN;
constexpr size_t O_RGH_S = O_RGH_P + (size_t)2 * NB * DRNN;
constexpr size_t O_FFC_P = O_RGH_S + (size_t)2 * MS * DRNN;
constexpr size_t O_FFC_S = O_FFC_P + (size_t)4 * NB * 2 * DFF2;
constexpr size_t O_END = O_FFC_S + (size_t)4 * MS * 2 * DFF2;
static_assert(O_END == 32071680, "d_out size");

constexpr size_t al256(size_t x) { return (x + 255) & ~(size_t)255; }
constexpr size_t WS_CTL = 0;
constexpr size_t WS_WIN = WS_CTL + 65536;
constexpr size_t WS_WOUT = WS_WIN + (size_t)2 * 2560 * 1024 * 2;
constexpr size_t WS_WUP = WS_WOUT + (size_t)2 * 1024 * 1280 * 2;
constexpr size_t WS_WDN = WS_WUP + (size_t)4 * 6144 * 1024 * 2;
constexpr size_t WS_WPI = WS_WDN + (size_t)4 * 1024 * 3072 * 2;
constexpr size_t WS_WPG = WS_WPI + (size_t)4 * 1024 * 256 * 2;
constexpr size_t WS_WKV = WS_WPG + (size_t)4 * 1024 * 1024 * 2;
constexpr size_t WS_WQG = WS_WKV + (size_t)768 * 1024 * 2;
constexpr size_t WS_WO = WS_WQG + (size_t)2 * 1280 * 1024 * 2;
constexpr size_t WS_WC1 = WS_WO + (size_t)2 * 1024 * 1024 * 2;
constexpr size_t WS_WGA = WS_WC1 + (size_t)2 * 256 * 1024 * 2;
constexpr size_t WS_B1F = al256(WS_WGA + (size_t)2 * 2 * 16 * 80 * 96 * 2);
constexpr size_t WS_ROPE = al256(WS_B1F + 32 * 2 * 128 * 4);
constexpr size_t WS_PSS = al256(WS_ROPE + (size_t)4097 * 64 * 4);
constexpr size_t WS_X = al256(WS_PSS + (size_t)2 * 16 * MPAD * 4);
constexpr size_t WS_XB = WS_X + (size_t)MPAD * 1024 * 4;
__host__ __device__ constexpr size_t xb_off(int L) { return (L & 1) ? WS_X : WS_XB; }
constexpr size_t WS_PB = WS_XB + (size_t)MPAD * 1024 * 2;
constexpr size_t WS_Y = WS_PB + (size_t)4 * MPAD * 256 * 2;
constexpr size_t WS_G = WS_Y + (size_t)MPAD * 1280 * 2;
constexpr size_t WS_S = WS_G + (size_t)MPAD * 1280 * 2;
constexpr size_t WS_Q = WS_S + (size_t)MPAD * 1024 * 2;
constexpr size_t WS_QR = WS_Q + (size_t)MPAD * 1024 * 2;
constexpr size_t WS_O = WS_QR + (size_t)MPAD * 1024 * 2;
constexpr size_t WS_GT = WS_O + (size_t)MPAD * 1024 * 2;
constexpr size_t WS_KS = al256(WS_GT + (size_t)MPAD * 48 * 4);
constexpr size_t WS_VTS = WS_KS + (size_t)NB * NG * SEQ * 64 * 2;
constexpr size_t WS_KW = WS_VTS + (size_t)NB * NG * SEQ * 64 * 2;
constexpr size_t WS_VTW = WS_KW + (size_t)NB * NG * SEQ * 64 * 2;
constexpr size_t WS_KC = WS_VTW + (size_t)NB * NG * SEQ * 64 * 2;
constexpr size_t WS_VCT = WS_KC + (size_t)NB * NG * 256 * 64 * 2;
constexpr size_t WS_KCS = WS_VCT + (size_t)NB * NG * 256 * 64 * 2;
constexpr size_t WS_VCS = WS_KCS + (size_t)MS * NG * 512 * 64 * 4;
constexpr size_t WS_CMPA = WS_VCS + (size_t)MS * NG * 512 * 64 * 4;
constexpr size_t WS_T = WS_CMPA + (size_t)2 * CMP_ROWS * 1024 * 2;
constexpr size_t WS_BIG = WS_T + (size_t)2 * CMP_ROWS * 256 * 4;
constexpr size_t WS_XR = WS_BIG;
constexpr size_t WS_HL = WS_XR + (size_t)MPAD * 1280 * 4;
constexpr size_t WS_AC = WS_HL + (size_t)MPAD * 1280 * 4;
constexpr size_t WS_UP = WS_BIG;
constexpr size_t WS_ACT = WS_UP + (size_t)MPAD * 6144 * 2;
constexpr size_t WS_UPH = WS_ACT + (size_t)MPAD * 3072 * 2;
constexpr size_t WS_PIN = WS_UPH + (size_t)64 * 4 * 6144 * 4;
constexpr size_t WS_STASH = WS_PIN + (size_t)4 * MPAD * 1024 * 2;
constexpr size_t WS_SPSS = WS_STASH + (size_t)256 * 8 * 2048 * 4;
constexpr size_t WS_END_A = WS_AC + (size_t)MPAD * 1280 * 4, WS_END_B = WS_SPSS + (size_t)2 * 64 * 32 * 4;
constexpr size_t WS_END = WS_END_A > WS_END_B ? WS_END_A : WS_END_B;
static_assert(WS_END < (size_t)1300 * 1024 * 1024, "workspace budget");

constexpr int LDS_RING = 0, LDS_RING_BYTES = 131072;
constexpr int LDS_RS = LDS_RING_BYTES;
constexpr int LDS_MISC = 163840 - 256;
constexpr int LDS_HALO = LDS_RS + 8 * 1024;
constexpr int LDS_BYTES = 163840;

struct Params { const void* in[38]; float* out; unsigned char* ws; int ph_lo, ph_hi; };
typedef const __attribute__((address_space(4))) Params* KP;
__device__ __forceinline__ KP launder(KP p) { asm volatile("" : "+s"(p)); return p; }
__device__ __forceinline__ int launder_v(int x) { asm volatile("" : "+v"(x)); return x; }
__device__ __forceinline__ int launder_s(int x) { asm volatile("" : "+s"(x)); return x; }

__device__ __forceinline__ unsigned f2bf(float f) { unsigned u = __builtin_bit_cast(unsigned, f); return (u + 0x7fffu + ((u >> 16) & 1u)) >> 16; }
typedef __bf16 bf16x2_t __attribute__((ext_vector_type(2)));
__device__ __forceinline__ unsigned pk2(float lo, float hi) { const f32x2 v = {lo, hi}; return __builtin_bit_cast(unsigned, __builtin_convertvector(v, bf16x2_t)); }
__device__ __forceinline__ f32x4 unpack4(u32x2 w);
__device__ __forceinline__ void unpack8(u32x4 w, f32x4& lo, f32x4& hi) { lo = unpack4((u32x2){w.x, w.y}); hi = unpack4((u32x2){w.z, w.w}); }
__device__ __forceinline__ f32x4 unpack4(u32x2 w) { f32x4 v; v[0] = __builtin_bit_cast(float, w.x << 16); v[1] = __builtin_bit_cast(float, w.x & 0xffff0000u); v[2] = __builtin_bit_cast(float, w.y << 16); v[3] = __builtin_bit_cast(float, w.y & 0xffff0000u); return v; }
__device__ __forceinline__ float bf2f(unsigned short b) { return __builtin_bit_cast(float, ((unsigned)b) << 16); }
__device__ __forceinline__ float gelu_tanh(float x) {
    const float u = 0.7978845608028654f * (x + 0.044715f * x * x * x);
    return x * __builtin_amdgcn_rcpf(1.0f + __expf(-2.0f * u));
}
__device__ __forceinline__ float sigmoidf_(float x) { return __builtin_amdgcn_rcpf(1.0f + __expf(-x)); }
__device__ __forceinline__ float wave_sum(float v) {
#pragma unroll
    for (int o = 1; o < 64; o <<= 1) v += __shfl_xor(v, o);
    return v;
}
namespace pg8 {
#define PG8_LAS __attribute__((address_space(3)))
typedef unsigned short bf16_t;
typedef short bf16x8 __attribute__((ext_vector_type(8)));
typedef float f32x4 __attribute__((ext_vector_type(4)));
typedef unsigned u32x4 __attribute__((ext_vector_type(4)));
constexpr int BM = 256, BK = 64, HALF = 128, HTB = HALF * BK * 2  , STAGE_BYTES = 8 * HTB, NXCD = 8, WGM = 8;

__host__ __device__ __forceinline__ int lds_byte(int r, int c) { const int st = (r >> 4) * 2 + (c >> 5), rr = r & 15, cc = c & 31, ob = rr * 64 + cc * 2; return st * 1024 + (ob ^ (((ob >> 9) & 1) << 5)); }
__host__ __device__ __forceinline__ void stage_rc(int b, int& R, int& C) { const int st = b / 1024, sb = b % 1024, swz = sb ^ (((sb >> 9) & 1) << 5); R = (st >> 1) * 16 + swz / 64; C = (st & 1) * 32 + (swz % 64) / 2; }
__host__ __device__ __forceinline__ int perm32(int rho) { const int n = rho >> 4, i = rho & 15; return 8 * (i >> 2) + 4 * n + (i & 3); }

struct Unit { int pm, pn; };
struct Gemm { const bf16_t* A; const bf16_t* Bt; int M, N, K; };

struct StaticOrder {
    int nM, nN, nwg, G, c;
    __host__ __device__ __forceinline__ void init(int M, int N, int G_, int c_) { nM = M / BM; nN = N / BM; nwg = nM * nN; G = G_; c = c_; }
    __host__ __device__ __forceinline__ bool next(int i, Unit& u) const {
        const long L = (long)i * G + c; if (L >= nwg) return false;
        int wgid = (int)L; { const int q = nwg / NXCD, r = nwg % NXCD, xcd = wgid % NXCD, off = wgid / NXCD; wgid = (xcd < r ? xcd * (q + 1) : r * (q + 1) + (xcd - r) * q) + off; }
        const int nig = WGM * nN, gid = wgid / nig, fm = gid * WGM, gsz = (nM - fm) < WGM ? (nM - fm) : WGM;
        u.pm = fm + ((wgid % nig) % gsz); u.pn = (wgid % nig) / gsz; return true;
    }
    __device__ __forceinline__ void a_ready(const Unit&) const {}
    __device__ __forceinline__ void done(const Unit&) const {}
};
__device__ __forceinline__ unsigned cvt_pk_bf16(float lo, float hi) { unsigned r; asm volatile("v_cvt_pk_bf16_f32 %0, %1, %2" : "=v"(r) : "v"(lo), "v"(hi)); return r; }
typedef float f32x2 __attribute__((ext_vector_type(2)));
template <class Epi, class Sched, bool ALIGN_EPI = false, bool SP2 = false>
__device__ __forceinline__ void gemm_phase(PG8_LAS unsigned char* lds, const Gemm g, const Sched& S, const Epi& E) {
    int tid = threadIdx.x; asm volatile("" : "+v"(tid));
    const int wid = __builtin_amdgcn_readfirstlane(tid >> 6), lane = tid & 63, wr = wid >> 2, wc = wid & 3, fr = lane & 15, fq = lane >> 4;
    const int K = g.K, nt = K / BK;
    unsigned voffA[2], voffB[2];
#pragma unroll
    for (int i = 0; i < 2; ++i) { int R, C; stage_rc(tid * 16 + i * 8192, R, C); const int Rb = Epi::PERM ? ((R & ~31) + perm32(R & 31)) : R;
        voffA[i] = (unsigned)(R * K + C) * 2u; voffB[i] = (unsigned)(Rb * K + C) * 2u; }
    const size_t kstep = (size_t)(BK * 2);
    const size_t hstep = (size_t)HALF * K * 2;
    const size_t tstep = 2 * hstep;
    const unsigned ldsw = (unsigned)wid * 1024u;
    const int aoff = lds_byte(wr * 64 + fr, fq * 8), boff = lds_byte(wc * 32 + fr, fq * 8);
#define PG8_SA(b, h) (((b) * 2 + (h)) * HTB)
#define PG8_SB(b, h) ((4 + (b) * 2 + (h)) * HTB)
#define PG8_STAGE(bufoff, gbase, voff) do { _Pragma("unroll") for (int _i = 0; _i < 2; ++_i) \
        __builtin_amdgcn_global_load_lds((const unsigned*)((const char*)(gbase) + (voff)[_i]), (PG8_LAS unsigned*)(lds + (bufoff) + ldsw + _i * 8192), 16, 0, 0); } while (0)
#define PG8_LDA(dst, b, h) do { _Pragma("unroll") for (int m = 0; m < 4; ++m) _Pragma("unroll") for (int k = 0; k < 2; ++k) dst[m][k] = *(const PG8_LAS bf16x8*)(lds + PG8_SA(b, h) + aoff + m * 2048 + k * 1024); } while (0)
#define PG8_LDB(dst, b, h) do { _Pragma("unroll") for (int n = 0; n < 2; ++n) _Pragma("unroll") for (int k = 0; k < 2; ++k) dst[n][k] = *(const PG8_LAS bf16x8*)(lds + PG8_SB(b, h) + boff + n * 2048 + k * 1024); } while (0)
#define PG8_MMA(ai, bj, At, Bt) do { __builtin_amdgcn_s_setprio(1); _Pragma("unroll") for (int m = 0; m < 4; ++m) _Pragma("unroll") for (int n = 0; n < 2; ++n) _Pragma("unroll") for (int k = 0; k < 2; ++k) \
        acc[ai][bj][m][n] = __builtin_amdgcn_mfma_f32_16x16x32_bf16(Bt[n][k], At[m][k], acc[ai][bj][m][n], 0, 0, 0); __builtin_amdgcn_s_setprio(0); } while (0)
#define PG8_WAIT_V(n) asm volatile("s_waitcnt vmcnt(" #n ")" ::: "memory")
#define PG8_WAIT_L(n) asm volatile("s_waitcnt lgkmcnt(" #n ")" ::: "memory")
#define PG8_BAR __builtin_amdgcn_s_barrier()
#define PG8_SCHED __builtin_amdgcn_sched_barrier(0)
    Unit cur, nxt; int ui = 0;
    if (!S.next(0, cur)) return;
    f32x4 acc[2][2][4][2];
#pragma unroll
    for (int a = 0; a < 2; ++a)
#pragma unroll
        for (int b = 0; b < 2; ++b)
#pragma unroll
            for (int m = 0; m < 4; ++m)
#pragma unroll
                for (int n = 0; n < 2; ++n) acc[a][b][m][n] = (f32x4){0.f, 0.f, 0.f, 0.f};
    bf16x8 At[4][2], B0[2][2], B1[2][2];
    const char* cA = (const char*)g.A + (size_t)cur.pm * tstep; const char* cB = (const char*)g.Bt + (size_t)cur.pn * tstep;
    S.a_ready(cur);
    if constexpr (SP2) {
        PG8_STAGE(PG8_SB(0, 0), cB, voffB); PG8_STAGE(PG8_SB(0, 1), cB + hstep, voffB); PG8_STAGE(PG8_SA(0, 0), cA, voffA); PG8_STAGE(PG8_SA(0, 1), cA + hstep, voffA);
        if (wr == 1) PG8_BAR;
        PG8_WAIT_V(2); PG8_BAR;
        PG8_STAGE(PG8_SB(1, 0), cB + kstep, voffB); PG8_STAGE(PG8_SA(1, 0), cA + kstep, voffA); PG8_STAGE(PG8_SB(1, 1), cB + hstep + kstep, voffB);
        PG8_WAIT_V(6); PG8_BAR;
    } else {
        PG8_STAGE(PG8_SB(0, 0), cB, voffB); PG8_STAGE(PG8_SA(0, 0), cA, voffA); PG8_STAGE(PG8_SB(0, 1), cB + hstep, voffB); PG8_STAGE(PG8_SA(0, 1), cA + hstep, voffA);
        if (wr == 1) PG8_BAR;
        PG8_WAIT_V(4); PG8_BAR;
        PG8_STAGE(PG8_SB(1, 0), cB + kstep, voffB); PG8_STAGE(PG8_SA(1, 0), cA + kstep, voffA); PG8_STAGE(PG8_SB(1, 1), cB + hstep + kstep, voffB);
        PG8_WAIT_V(6); PG8_BAR;
    }
    for (;;) {
        const bool has_next = S.next(ui + 1, nxt);
        const char* nA = has_next ? (const char*)g.A + (size_t)nxt.pm * tstep : cA; const char* nB = has_next ? (const char*)g.Bt + (size_t)nxt.pn * tstep : cB;
        for (int t = 0; t < nt; t += 2) {
            const bool last = (t == nt - 2);
            const char* a1 = cA + (size_t)(t + 1) * kstep;
            const char* a2 = last ? nA : cA + (size_t)(t + 2) * kstep; const char* b2 = last ? nB : cB + (size_t)(t + 2) * kstep;
            const char* a3 = a2 + kstep; const char* b3 = b2 + kstep;
            if (last && has_next) S.a_ready(nxt);
            if constexpr (SP2) {
            PG8_LDB(B0, 0, 0); PG8_LDB(B1, 0, 1); PG8_SCHED; PG8_LDA(At, 0, 0); PG8_STAGE(PG8_SA(1, 1), a1 + hstep, voffA);
            PG8_WAIT_V(8); PG8_WAIT_L(0); PG8_BAR; PG8_MMA(0, 0, At, B0); PG8_MMA(0, 1, At, B1); PG8_BAR; PG8_SCHED;
            PG8_LDA(At, 0, 1); PG8_STAGE(PG8_SB(0, 0), b2, voffB); PG8_STAGE(PG8_SB(0, 1), b2 + hstep, voffB); PG8_STAGE(PG8_SA(0, 0), a2, voffA);
            PG8_WAIT_V(8); PG8_WAIT_L(0); PG8_BAR; PG8_MMA(1, 0, At, B0); PG8_MMA(1, 1, At, B1); PG8_BAR; PG8_SCHED;
            PG8_LDB(B0, 1, 0); PG8_LDB(B1, 1, 1); PG8_SCHED; PG8_LDA(At, 1, 0); PG8_STAGE(PG8_SA(0, 1), a2 + hstep, voffA);
            PG8_WAIT_V(8); PG8_WAIT_L(0); PG8_BAR; PG8_MMA(0, 0, At, B0); PG8_MMA(0, 1, At, B1); PG8_BAR; PG8_SCHED;
            PG8_LDA(At, 1, 1); PG8_STAGE(PG8_SB(1, 0), b3, voffB); PG8_STAGE(PG8_SB(1, 1), b3 + hstep, voffB); PG8_STAGE(PG8_SA(1, 0), a3, voffA);
            PG8_WAIT_V(8); PG8_WAIT_L(0); PG8_BAR; PG8_MMA(1, 0, At, B0); PG8_MMA(1, 1, At, B1); PG8_BAR; PG8_SCHED;
            } else {
            PG8_LDB(B0, 0, 0); PG8_SCHED; PG8_LDA(At, 0, 0); PG8_STAGE(PG8_SA(1, 1), a1 + hstep, voffA);
            PG8_WAIT_L(8); PG8_BAR; PG8_WAIT_L(0); PG8_MMA(0, 0, At, B0); PG8_BAR; PG8_SCHED;
            PG8_LDB(B1, 0, 1); PG8_STAGE(PG8_SB(0, 0), b2, voffB);
            PG8_BAR; PG8_WAIT_L(0); PG8_MMA(0, 1, At, B1); PG8_BAR;
            PG8_LDA(At, 0, 1); PG8_STAGE(PG8_SA(0, 0), a2, voffA);
            PG8_BAR; PG8_WAIT_L(0); PG8_MMA(1, 0, At, B0); PG8_BAR; PG8_SCHED;
            PG8_STAGE(PG8_SB(0, 1), b2 + hstep, voffB);
            PG8_WAIT_V(6); PG8_BAR; PG8_MMA(1, 1, At, B1); PG8_BAR;
            PG8_LDB(B0, 1, 0); PG8_SCHED; PG8_LDA(At, 1, 0); PG8_STAGE(PG8_SA(0, 1), a2 + hstep, voffA);
            PG8_WAIT_L(8); PG8_BAR; PG8_WAIT_L(0); PG8_MMA(0, 0, At, B0); PG8_BAR; PG8_SCHED;
            PG8_LDB(B1, 1, 1); PG8_STAGE(PG8_SB(1, 0), b3, voffB);
            PG8_BAR; PG8_WAIT_L(0); PG8_MMA(0, 1, At, B1); PG8_BAR;
            PG8_LDA(At, 1, 1); PG8_STAGE(PG8_SA(1, 0), a3, voffA);
            PG8_BAR; PG8_WAIT_L(0); PG8_MMA(1, 0, At, B0); PG8_BAR; PG8_SCHED;
            PG8_STAGE(PG8_SB(1, 1), b3 + hstep, voffB);
            PG8_WAIT_V(6); PG8_BAR; PG8_MMA(1, 1, At, B1); PG8_BAR;
            }
        }
        if constexpr (ALIGN_EPI) { if (wr == 0) PG8_BAR; }
        if constexpr (!Epi::AFTER_DRAIN) { E(acc, cur, wr, wc, fr, fq); S.done(cur); }
        if (!has_next) break;
#pragma unroll
        for (int a = 0; a < 2; ++a)
#pragma unroll
            for (int b = 0; b < 2; ++b)
#pragma unroll
                for (int m = 0; m < 4; ++m)
#pragma unroll
                    for (int n = 0; n < 2; ++n) acc[a][b][m][n] = (f32x4){0.f, 0.f, 0.f, 0.f};
        cur = nxt; cA = nA; cB = nB; ++ui;
        if constexpr (ALIGN_EPI) { if (wr == 1) PG8_BAR; }
    }
    PG8_WAIT_V(0);
    if constexpr (!ALIGN_EPI) { if (wr == 0) PG8_BAR; }
    PG8_BAR;
    if constexpr (Epi::AFTER_DRAIN) { E.fused(acc, cur, wr, wc, fr, fq, lds, wid, lane); S.done(cur); }
#undef PG8_SA
#undef PG8_SB
#undef PG8_STAGE
#undef PG8_LDA
#undef PG8_LDB
#undef PG8_MMA
#undef PG8_WAIT_V
#undef PG8_WAIT_L
#undef PG8_BAR
#undef PG8_SCHED
}
}
#define XB_TMO      128
#define XB_XCNT(j)  (256  + 64 * (j))
#define XB_XSUB(j)  (1280 + 64 * (j))
#define XB_XGEN(j)  (2304 + 64 * (j))
#define XB_TOP      3328
#define XB_TOPGEN   3392
#define XCD_BAR_WORDS 3456
#define XB_SPIN_CAP (1u << 18)

__device__ __forceinline__ unsigned xb_ld(unsigned* p)              { return __hip_atomic_load(p, __ATOMIC_RELAXED, __HIP_MEMORY_SCOPE_AGENT); }
__device__ __forceinline__ unsigned xb_add(unsigned* p, unsigned v) { return __hip_atomic_fetch_add(p, v, __ATOMIC_RELAXED, __HIP_MEMORY_SCOPE_AGENT); }
__device__ __forceinline__ unsigned xb_xcc_id() { return (unsigned)__builtin_amdgcn_s_getreg((3 << 11) | 20) & 0xFu; }
#define XB_SPIN(cond, bar) do { unsigned _sp = 0; while (cond) { __builtin_amdgcn_s_sleep(1); \
    if ((++_sp & 255u) == 0u) { if (xb_ld(&(bar)[XB_TMO])) break; if (_sp > XB_SPIN_CAP) { atomicAdd(&(bar)[XB_TMO], 1u); break; } } } } while (0)

struct XcdBarrier {
    unsigned* bar; unsigned x;
    volatile LAS unsigned* st;
};

__device__ __forceinline__ XcdBarrier xcd_barrier_post(unsigned* bar, volatile LAS unsigned* st) {
    XcdBarrier b; b.bar = bar; b.x = xb_xcc_id(); b.st = st;
    if (threadIdx.x == 0) (void)xb_add(&bar[XB_XCNT(b.x)], 1u);
    return b;
}
__device__ __forceinline__ void xcd_barrier_complete(unsigned* bar, unsigned x, unsigned& nloc, unsigned& nx) {
    const unsigned G = gridDim.x * gridDim.y * gridDim.z;
    unsigned sum, cnt, mine, sp = 0u;
    for (;;) {
        sum = 0u; cnt = 0u; mine = 0u;
#pragma unroll
        for (unsigned j = 0; j < 16; ++j) { const unsigned c = xb_ld(&bar[XB_XCNT(j)]); sum += c; cnt += (c > 0u) ? 1u : 0u; mine = (j == x) ? c : mine; }
        if (sum == G) break;
        __builtin_amdgcn_s_sleep(1);
        if ((++sp & 255u) == 0u) { if (xb_ld(&bar[XB_TMO])) break; if (sp > XB_SPIN_CAP) { atomicAdd(&bar[XB_TMO], 1u); break; } }
    }
    nloc = mine > 0u ? mine : 1u; nx = cnt > 0u ? cnt : 1u;
}

__device__ __forceinline__ void xcd_barrier(const XcdBarrier& b) {
    asm volatile("s_waitcnt vmcnt(0)" ::: "memory");
    __syncthreads();
    if (threadIdx.x == 0) {
        unsigned* bar = b.bar;
        __builtin_amdgcn_s_waitcnt(0);
        unsigned nloc = b.st[0], nx = b.st[1];
        if (nloc == 0u) { xcd_barrier_complete(bar, b.x, nloc, nx); b.st[0] = nloc; b.st[1] = nx; }
        const unsigned old = xb_add(&bar[XB_XSUB(b.x)], 1u);
        const unsigned gen = old / nloc;
        if (old + 1u == (gen + 1u) * nloc) {
            __builtin_amdgcn_fence(__ATOMIC_RELEASE, "agent");
            asm volatile("s_waitcnt vmcnt(0)" ::: "memory");
            const unsigned og = xb_add(&bar[XB_TOP], 1u);
            const unsigned tg = og / nx;
            if (og + 1u == (tg + 1u) * nx) xb_add(&bar[XB_TOPGEN], 1u);
            else XB_SPIN(xb_ld(&bar[XB_TOPGEN]) == tg, bar);
            __builtin_amdgcn_fence(__ATOMIC_ACQUIRE, "agent");
            xb_add(&bar[XB_XGEN(b.x)], 1u);
            asm volatile("s_waitcnt vmcnt(0)" ::: "memory");
        } else {
            XB_SPIN(xb_ld(&bar[XB_XGEN(b.x)]) == gen, bar);
            __builtin_amdgcn_fence(__ATOMIC_ACQUIRE, "agent");
            asm volatile("s_waitcnt vmcnt(0)" ::: "memory");
        }
    }
    __syncthreads();
}


__device__ unsigned g_seam0[10 * 64];
__device__ __forceinline__ void seam0_barrier() {
    asm volatile("s_waitcnt vmcnt(0)" ::: "memory");
    __syncthreads();
    if (threadIdx.x == 0) {
        __builtin_amdgcn_fence(__ATOMIC_RELEASE, "agent");
        asm volatile("s_waitcnt vmcnt(0)" ::: "memory");
        const unsigned G = gridDim.x, s = blockIdx.x & 7u, ns = (G - s + 7u) >> 3, nsh = G < 8u ? G : 8u;
        const unsigned old = xb_add(&g_seam0[s * 64], 1u);
        const unsigned round = old / ns;
        if (old + 1u == (round + 1u) * ns) {
            const unsigned o2 = xb_add(&g_seam0[8 * 64], 1u);
            if ((o2 + 1u) % nsh == 0u) xb_add(&g_seam0[9 * 64], 1u);
        }
        unsigned sp = 0u;
        while ((int)(xb_ld(&g_seam0[9 * 64]) - (round + 1u)) < 0) { __builtin_amdgcn_s_sleep(2); if (++sp > (1u << 24)) break; }
        __builtin_amdgcn_fence(__ATOMIC_ACQUIRE, "agent");
        asm volatile("s_waitcnt vmcnt(0)" ::: "memory");
    }
    __syncthreads();
}
__device__ __forceinline__ int rowmap(int mode, int nn) {
    const int il = (nn & ~63) + 2 * (nn & 31) + ((nn >> 5) & 1);
    if (mode == 1) return nn < 1024 ? il : nn;
    if (mode == 2) { const int j = nn >> 7; return (j == 2 || j == 4) ? il : nn; }
    if (mode == 3) { const int half = nn >= DFF ? 1 : 0, ka = nn - half * DFF; return (ka >> 7) * 256 + half * 128 + (ka & 127); }
    return nn;
}
__device__ __forceinline__ void tr_item(const float* __restrict__ W, int ldn, int Nsrc, bf16* __restrict__ WT, int dstK, const float* __restrict__ gain, int mode, int item, int nblk,
                                        LAS float* scr, int lane) {
    const int kb = item / nblk, nb = item % nblk, k0 = 64 * kb, n0 = 32 * nb;
    const int n = n0 + (lane & 31);
    float wv[32];
#pragma unroll
    for (int i = 0; i < 32; ++i) { const int kk = 2 * i + (lane >> 5); wv[i] = (n < Nsrc) ? W[(size_t)(k0 + kk) * ldn + n] : 0.f; }
#pragma unroll
    for (int i = 0; i < 32; ++i) { const int kk = 2 * i + (lane >> 5); float v = wv[i]; if (gain) v *= gain[k0 + kk]; scr[kk * 33 + (lane & 31)] = v; }
    asm volatile("s_waitcnt lgkmcnt(0)" ::: "memory");
    const int c = lane & 7;
#pragma unroll
    for (int j = 0; j < 4; ++j) {
        const int nl = (lane >> 3) + 8 * j; const LAS float* s = scr + (8 * c) * 33 + nl;
        u32x4 o; o.x = pk2(s[0 * 33], s[1 * 33]); o.y = pk2(s[2 * 33], s[3 * 33]); o.z = pk2(s[4 * 33], s[5 * 33]); o.w = pk2(s[6 * 33], s[7 * 33]);
        const int row = rowmap(mode, n0 + nl);
        *(u32x4*)(WT + (size_t)row * dstK + k0 + 8 * c) = o;
    }
    asm volatile("s_waitcnt lgkmcnt(0)" ::: "memory");
}

__device__ __forceinline__ void phase0(KP P, LAS unsigned char* lds, int tid, int lane, int wave, int G) {
    unsigned char* ws = P->ws;
    const int gw = launder_s(blockIdx.x) * 8 + wave, NGW = G * 8;
    const size_t gt = (size_t)launder_s(blockIdx.x) * 512 + tid, NGT = (size_t)G * 512;
    LAS float* scr = (LAS float*)(lds + wave * 16384);
    {
        const float* g_mix = (const float*)P->in[11]; const float* g_ffn = (const float*)P->in[12]; const float* g_ple = (const float*)P->in[13];
        constexpr int C_WIN = 16 * 80, C_WOUT = 20 * 32, C_WUP = 16 * 192, C_WDN = 48 * 32, C_WPI = 4 * 32, C_WPG = 16 * 32, C_WKV = 16 * 24, C_WQG = 16 * 40, C_WO = 16 * 32, C_WC1 = 16 * 4;
        constexpr int NITEMS = 2 * C_WIN + 2 * C_WOUT + 4 * C_WUP + 4 * C_WDN + 4 * C_WPI + 4 * C_WPG + C_WKV + 2 * C_WQG + 2 * C_WO + 4 * C_WC1;
        for (int it = gw; it < NITEMS; it += NGW) {
            int r = it;
            if (r < 2 * C_WIN) { const int L = r / C_WIN; r %= C_WIN;
                tr_item((const float*)P->in[15] + (size_t)L * 1024 * 2560, 2560, 2560, (bf16*)(ws + WS_WIN) + (size_t)L * 2560 * 1024, 1024, g_mix + L * 1024, 0, r, 80, scr, lane); continue; }
            r -= 2 * C_WIN;
            if (r < 2 * C_WOUT) { const int L = r / C_WOUT; r %= C_WOUT;
                tr_item((const float*)P->in[23] + (size_t)L * 1280 * 1024, 1024, 1024, (bf16*)(ws + WS_WOUT) + (size_t)L * 1024 * 1280, 1280, nullptr, 0, r, 32, scr, lane); continue; }
            r -= 2 * C_WOUT;
            if (r < 4 * C_WUP) { const int L = r / C_WUP; r %= C_WUP;
                tr_item((const float*)P->in[32] + (size_t)L * 1024 * 6144, 6144, 6144, (bf16*)(ws + WS_WUP) + (size_t)L * 6144 * 1024, 1024, g_ffn + L * 1024, 3, r, 192, scr, lane); continue; }
            r -= 4 * C_WUP;
            if (r < 4 * C_WDN) { const int L = r / C_WDN; r %= C_WDN;
                tr_item((const float*)P->in[35] + (size_t)L * 3072 * 1024, 1024, 1024, (bf16*)(ws + WS_WDN) + (size_t)L * 1024 * 3072, 3072, nullptr, 0, r, 32, scr, lane); continue; }
            r -= 4 * C_WDN;
            if (r < 4 * C_WPI) { const int L = r / C_WPI; r %= C_WPI;
                tr_item((const float*)P->in[36] + (size_t)L * 256 * 1024, 1024, 1024, (bf16*)(ws + WS_WPI) + (size_t)L * 1024 * 256, 256, nullptr, 0, r, 32, scr, lane); continue; }
            r -= 4 * C_WPI;
            if (r < 4 * C_WPG) { const int L = r / C_WPG; r %= C_WPG;
                tr_item((const float*)P->in[37] + (size_t)L * 1024 * 1024, 1024, 1024, (bf16*)(ws + WS_WPG) + (size_t)L * 1024 * 1024, 1024, g_ple + L * 1024, 0, r, 32, scr, lane); continue; }
            r -= 4 * C_WPG;
            if (r < C_WKV) { tr_item((const float*)P->in[25], 768, 768, (bf16*)(ws + WS_WKV), 1024, (const float*)P->in[24], 2, r, 24, scr, lane); continue; }
            r -= C_WKV;
            if (r < 2 * C_WQG) { const int L = r / C_WQG; r %= C_WQG;
                tr_item((const float*)P->in[30] + (size_t)L * 1024 * NQG, NQG, NQG, (bf16*)(ws + WS_WQG) + (size_t)L * NQGP * 1024, 1024, g_mix + (2 + L) * 1024, 1, r, 40, scr, lane); continue; }
            r -= 2 * C_WQG;
            if (r < 2 * C_WO) { const int L = r / C_WO; r %= C_WO;
                tr_item((const float*)P->in[31] + (size_t)L * 1024 * 1024, 1024, 1024, (bf16*)(ws + WS_WO) + (size_t)L * 1024 * 1024, 1024, nullptr, 0, r, 32, scr, lane); continue; }
            r -= 2 * C_WO;
            { const int q = r / C_WC1; r %= C_WC1; const int j = q >> 1, half = q & 1;
                tr_item((const float*)P->in[27] + (size_t)j * 2048 * 128 + (size_t)half * 1024 * 128, 128, 128, (bf16*)(ws + WS_WC1) + (size_t)j * 256 * 1024 + (size_t)half * 128 * 1024, 1024, nullptr, 0, r, 4, scr, lane); }
        }
    }
    {
        bf16* XB = (bf16*)(ws + WS_XB); bf16* XB1 = (bf16*)(ws + WS_X); float* PSS = (float*)(ws + WS_PSS);
        for (int m0 = gw; m0 < MPAD; m0 += 2 * NGW) {
          f32x4 vv[2][4];
#pragma unroll
          for (int q = 0; q < 2; ++q) { const int m = m0 + q * NGW;
            const float* src = m < MP ? (const float*)P->in[0] + (size_t)m * 1024 : (const float*)P->in[1] + (size_t)(m - MP) * 1024;
#pragma unroll
            for (int j = 0; j < 4; ++j) { vv[q][j] = (f32x4){0.f, 0.f, 0.f, 0.f}; if (m < MTOT) vv[q][j] = *(const f32x4*)(src + 4 * lane + 256 * j); } }
#pragma unroll
          for (int q = 0; q < 2; ++q) { const int m = m0 + q * NGW; if (m >= MPAD) break;
            float ss = 0.f;
#pragma unroll
            for (int j = 0; j < 4; ++j) {
                f32x4 v = vv[q][j];
                u32x2 w; w.x = pk2(v[0], v[1]); w.y = pk2(v[2], v[3]);
                *(u32x2*)(XB + (size_t)m * 1024 + 4 * lane + 256 * j) = w;
                if (m >= MTOT) *(u32x2*)(XB1 + (size_t)m * 1024 + 4 * lane + 256 * j) = w;
                v = unpack4(w);
                ss += (v[0] * v[0] + v[1] * v[1]) + (v[2] * v[2] + v[3] * v[3]);
            }
            ss = wave_sum(ss);
            if (lane < 16) PSS[(size_t)lane * MPAD + m] = (lane == 0) ? ss : 0.f;
            if (m >= MP && m < MTOT) ((float*)(ws + WS_SPSS))[lane * 32 + (m - MP)] = (lane == 0) ? ss : 0.f;
          }
        }
    }
    {
        bf16* PB = (bf16*)(ws + WS_PB);
        for (size_t i0 = gt; i0 < (size_t)4 * MPAD * 64; i0 += 8 * NGT) {
            f32x4 v[8];
#pragma unroll
            for (int q = 0; q < 8; ++q) { const size_t i = i0 + q * NGT; v[q] = (f32x4){0.f, 0.f, 0.f, 0.f};
                if (i < (size_t)4 * MPAD * 64) { const int c4 = (int)(i & 63); const size_t rm = i >> 6; const int m = (int)(rm % MPAD), L = (int)(rm / MPAD);
                    if (m < MP) v[q] = *(const f32x4*)((const float*)P->in[2] + ((size_t)L * MP + m) * 256 + 4 * c4);
                    else if (m < MTOT) v[q] = *(const f32x4*)((const float*)P->in[3] + ((size_t)L * MS + (m - MP)) * 256 + 4 * c4); } }
#pragma unroll
            for (int q = 0; q < 8; ++q) { const size_t i = i0 + q * NGT;
                if (i < (size_t)4 * MPAD * 64) { u32x2 w; w.x = pk2(v[q][0], v[q][1]); w.y = pk2(v[q][2], v[q][3]); *(u32x2*)(PB + i * 4) = w; } }
        }
    }
    {
        const float* cache = (const float*)P->in[4]; const int* pt = (const int*)P->in[10]; bf16* CA = (bf16*)(ws + WS_CMPA);
        for (int item = launder_s(blockIdx.x); item < MS * NPG; item += G) {
            const int sb = item / NPG, pg = item % NPG;
            const float* src = cache + (size_t)pt[item] * (PGSZ * 256);
            static_assert(PGSZ * 64 == 16 * 512, "page = 16 float4 per thread");
#pragma unroll
            for (int hb = 0; hb < 2; ++hb) {
                f32x4 v[8];
#pragma unroll
                for (int q = 0; q < 8; ++q) v[q] = __builtin_nontemporal_load((const f32x4*)(src + (size_t)(tid + 512 * (8 * hb + q)) * 4));
#pragma unroll
                for (int q = 0; q < 8; ++q) { const int c = tid + 512 * (8 * hb + q);
                    const int f = c * 4, tl = f >> 8, rem = f & 255, j = rem >> 7, g = (rem >> 6) & 1, d = rem & 63;
                    u32x2 w; w.x = pk2(v[q][0], v[q][1]); w.y = pk2(v[q][2], v[q][3]);
                    const size_t row = (size_t)CMP_ROWS_P + (size_t)(g * MS + sb) * 512 + pg * 8 + (tl >> 4);
                    *(u32x2*)(CA + ((size_t)j * CMP_ROWS + row) * 1024 + (tl & 15) * 64 + d) = w; }
            }
        }
    }
    {
        float* RT = (float*)(ws + WS_ROPE);
        for (size_t i = gt; i < (size_t)4097 * 32; i += NGT) {
            const int fi = (int)(i & 31), pi = (int)(i >> 5); const int pos = pi < 4096 ? pi : PAST;
            double f = 1.0; for (int k = 0; k < fi; ++k) f *= 0.7498942093324559;
            const float ang = (float)pos * (float)f;
            const double x = (double)ang; const double kq = __builtin_rint(x * 0.6366197723675814);
            const double r = (x - kq * 1.5707963267948966) - kq * 6.123233995736766e-17, r2 = r * r;
            const double sn = r * (1.0 + r2 * (-1.0 / 6 + r2 * (1.0 / 120 + r2 * (-1.0 / 5040 + r2 * (1.0 / 362880 + r2 * (-1.0 / 39916800 + r2 * (1.0 / 6227020800.0)))))));
            const double cs = 1.0 + r2 * (-0.5 + r2 * (1.0 / 24 + r2 * (-1.0 / 720 + r2 * (1.0 / 40320 + r2 * (-1.0 / 3628800 + r2 * (1.0 / 479001600.0 + r2 * (-1.0 / 87178291200.0)))))));
            const int q = ((int)kq) & 3;
            const double s_ = (q == 0) ? sn : (q == 1) ? cs : (q == 2) ? -sn : -cs;
            const double c_ = (q == 0) ? cs : (q == 1) ? -sn : (q == 2) ? -cs : sn;
            RT[i * 2] = (float)c_; RT[i * 2 + 1] = (float)s_;
        }
    }
    {
        float* B1P = (float*)(ws + WS_B1F); const float* pos = (const float*)P->in[26]; const float* w1 = (const float*)P->in[27];
        for (size_t i = gt; i < (size_t)32 * 2 * 128; i += NGT) {
            const int e = (int)(i & 127), j = (int)((i >> 7) & 1), l = (int)(i >> 8);
            float s = 0.f;
#pragma unroll 16
            for (int d = 0; d < 64; ++d) s += pos[(l * 2 + j) * 64 + d] * w1[((size_t)j * 2048 + l * 64 + d) * 128 + e];
            B1P[i] = s;
        }
    }
    {
        bf16* WG = (bf16*)(ws + WS_WGA);
        for (size_t i = gt; i < (size_t)2 * 2 * 16 * 80 * 96; i += NGT) {
            const int k = (int)(i % 96); size_t r = i / 96; const int j = (int)(r % 80); r /= 80; const int n = (int)(r % 16); r /= 16; const int ax = (int)(r & 1), L = (int)(r >> 1);
            const float* src = (const float*)P->in[ax ? 20 : 18];
            const float v = k < 80 ? src[(((size_t)L * 16 + n) * 80 + k) * 80 + j] : 0.f;
            WG[i] = (bf16)f2bf(v);
        }
    }
    {
        const float* cw = (const float*)P->in[6]; float* o = P->out + O_WIN_S;
        for (size_t i0 = gt; i0 < (size_t)MS * 511 * 64; i0 += 4 * NGT) {
            f32x4 v[4];
#pragma unroll
            for (int q = 0; q < 4; ++q) { const size_t i = i0 + q * NGT; v[q] = (f32x4){0.f, 0.f, 0.f, 0.f};
                if (i < (size_t)MS * 511 * 64) { const int c4 = (int)(i & 63); const size_t rw = i >> 6; const int w = (int)(rw % 511), sb = (int)(rw / 511);
                    v[q] = *(const f32x4*)(cw + ((size_t)sb * 512 + w + 1) * 256 + 4 * c4); } }
#pragma unroll
            for (int q = 0; q < 4; ++q) { const size_t i = i0 + q * NGT;
                if (i < (size_t)MS * 511 * 64) { const int c4 = (int)(i & 63); const size_t rw = i >> 6; const int w = (int)(rw % 511), sb = (int)(rw / 511);
                    *(f32x4*)(o + ((size_t)sb * 512 + w) * 256 + 4 * c4) = v[q]; } }
        }
    }
}

#define EPI_FOR_ROWS _Pragma("unroll") for (int ai = 0; ai < 2; ++ai) _Pragma("unroll") for (int m = 0; m < 4; ++m)
#define EPI_FOR_COLS _Pragma("unroll") for (int bj = 0; bj < 2; ++bj) _Pragma("unroll") for (int n = 0; n < 2; ++n) if (only < 0 || only == bj * 2 + n)
#define EPI_ROWL (ai * 128 + wr * 64 + m * 16 + fr)
#define EPI_COLL (bj * 128 + wc * 32 + n * 16 + 4 * fq)
typedef const f32x4 (&AccRef)[2][2][4][2];

__device__ __forceinline__ u32x2 pack4(f32x4 v) { u32x2 w; w.x = pk2(v[0], v[1]); w.y = pk2(v[2], v[3]); return w; }

__device__ __forceinline__ void rs_sample(const float* SP, LAS float* dst, int tid) {
    const int row = tid >> 4, part = tid & 15; float s = 0.f;
#pragma unroll
    for (int i = 0; i < 4; ++i) s += SP[(part * 4 + i) * 32 + row];
    s += __shfl_xor(s, 1); s += __shfl_xor(s, 2); s += __shfl_xor(s, 4); s += __shfl_xor(s, 8);
    if (part == 0) dst[row] = rsqrtf(s * (1.0f / 1024.0f) + EPS);
}
template <class Sched> __device__ __forceinline__ void rs_prepare(const Sched& S, const float* PSScur, const float* X, LAS float* rsb, int tid, bool thin) {
    pg8::Unit u;
    for (int i = 0; i < 7 && S.next(i, u); ++i) {
        if (tid < 256) { const int mrow = u.pm * 256 + tid; float s = 0.f;
#pragma unroll
            for (int k = 0; k < 16; ++k) s += PSScur[(size_t)k * MPAD + mrow];
            rsb[i * 256 + tid] = rsqrtf(s * (1.0f / 1024.0f) + EPS); }
    }
    if (thin) rs_sample(X, rsb + 7 * 256, tid);
    __syncthreads();
}
template <class E> __device__ __forceinline__ auto warm_call(const E& e, int fr, int fq, int cg, int) -> decltype(e.warm(fr, fq, cg)) { return e.warm(fr, fq, cg); }
template <class E> __device__ __forceinline__ float warm_call(const E&, int, int, int, long) { return 0.f; }
template <class E> __device__ __forceinline__ auto thin_epi(const E& e, f32x4 s0, f32x4 s1, int cg, int fr, int fq, int) -> decltype(e.thin(s0, s1, cg, fr, fq), true) { e.thin(s0, s1, cg, fr, fq); return true; }
template <class E> __device__ __forceinline__ bool thin_epi(const E&, f32x4, f32x4, int, int, int, long) { return false; }
template <int K, class Epi> __device__ __forceinline__ void thin_unit(LAS unsigned char* lds, const bf16* __restrict__ A, const bf16* __restrict__ Bt, int cg, const Epi& E) {
    int tid = threadIdx.x; asm volatile("" : "+v"(tid));
    const int wid = __builtin_amdgcn_readfirstlane(tid >> 6), lane = tid & 63, fr = lane & 15, fq = lane >> 4;
    f32x4 c0 = (f32x4){0.f, 0.f, 0.f, 0.f}, c1 = c0;
    float warm = 0.f; if (wid == 0) warm = warm_call(E, fr, fq, cg, 0);
    const bf16* ap = A + (size_t)(MP + fr) * K + fq * 8;
    const bf16* bp = Bt + (size_t)(cg * 16 + fr) * K + fq * 8;
    constexpr int NI = (K / 32) / 8;
    static_assert((K / 32) % 8 == 0, "thin unit K");
    bf16x8 bb[NI], aa0[NI], aa1[NI];
#pragma unroll
    for (int i = 0; i < NI; ++i) { const int ks = wid + 8 * i; bb[i] = *(const bf16x8*)(bp + ks * 32); aa0[i] = *(const bf16x8*)(ap + ks * 32); aa1[i] = *(const bf16x8*)(ap + (size_t)16 * K + ks * 32); }
#pragma unroll
    for (int i = 0; i < NI; ++i) { c0 = __builtin_amdgcn_mfma_f32_16x16x32_bf16(bb[i], aa0[i], c0, 0, 0, 0); c1 = __builtin_amdgcn_mfma_f32_16x16x32_bf16(bb[i], aa1[i], c1, 0, 0, 0); }
    LAS f32x4* red = (LAS f32x4*)lds;
    red[(wid * 2 + 0) * 64 + lane] = c0; red[(wid * 2 + 1) * 64 + lane] = c1;
    asm volatile("" :: "v"(warm));
    __syncthreads();
    if (wid == 0) {
        f32x4 s0 = red[lane], s1 = red[64 + lane];
#pragma unroll
        for (int w = 1; w < 8; ++w) { s0 += red[(w * 2) * 64 + lane]; s1 += red[(w * 2 + 1) * 64 + lane]; }
      if (!thin_epi(E, s0, s1, cg, fr, fq, 0)) {
        f32x4 acc[2][2][4][2];
        const float z_ = __builtin_bit_cast(float, launder_v(0));
#pragma unroll
        for (int a = 0; a < 2; ++a)
#pragma unroll
            for (int b = 0; b < 2; ++b)
#pragma unroll
                for (int m = 0; m < 4; ++m)
#pragma unroll
                    for (int n = 0; n < 2; ++n) acc[a][b][m][n] = (f32x4){z_, z_, z_, z_};
        const int bj = (cg >> 3) & 1, n = cg & 1;
#pragma unroll
        for (int b = 0; b < 2; ++b)
#pragma unroll
            for (int nn = 0; nn < 2; ++nn) if (b == bj && nn == n) { acc[0][b][0][nn] = s0; acc[0][b][1][nn] = s1; }
        pg8::Unit u; u.pm = MP / 256; u.pn = cg >> 4;
        E.only = bj * 2 + n;
        E(acc, u, 0, (cg >> 1) & 3, fr, fq);
        E.only = -1;
      }
    }
    __syncthreads();
}

struct EpiRG1 {
    static constexpr bool PERM = false, AFTER_DRAIN = false;
    unsigned char* ws; const LAS float* rs; mutable int slot; mutable int only = -1;
    __device__ __forceinline__ void operator()(AccRef acc, const pg8::Unit& u, int wr, int wc, int fr, int fq) const {
        fr = launder_v(fr); fq = launder_v(fq);
        const LAS float* rsl = rs + slot * 256; ++slot;
        bf16* Y = (bf16*)(ws + WS_Y); bf16* XR = (bf16*)(ws + WS_XR);
        EPI_FOR_ROWS { const int rl = EPI_ROWL, row = u.pm * 256 + rl; const float r = rsl[rl];
            EPI_FOR_COLS { const int col = u.pn * 256 + EPI_COLL; f32x4 v = acc[ai][bj][m][n] * r;
                if (row < MTOT) { if (u.pn < 5) { v[0] = gelu_tanh(v[0]); v[1] = gelu_tanh(v[1]); v[2] = gelu_tanh(v[2]); v[3] = gelu_tanh(v[3]); *(u32x2*)(Y + (size_t)row * DRNN + col) = pack4(v); }
                else *(u32x2*)(XR + (size_t)row * DRNN + (col - DRNN)) = pack4(v); } } }
    }
};
struct EpiRes {
    static constexpr bool PERM = false, AFTER_DRAIN = false;
    unsigned char* ws; float* PSSn; size_t soff; float scale; size_t xoff; mutable int only = -1;
    __device__ __forceinline__ float warm(int fr, int fq, int cg) const {
        const bf16* XB = (const bf16*)(ws + xoff); const size_t o0 = (size_t)(MP + fr) * DM + cg * 16 + 4 * fq, o1 = o0 + (size_t)16 * DM;
        float w = bf2f(XB[o0]) + bf2f(XB[o1]);
        if (soff) { const bf16* S = (const bf16*)(ws + soff); w += bf2f(S[o0]) + bf2f(S[o1]); }
        return w; }
    __device__ __forceinline__ void thin(f32x4 s0, f32x4 s1, int cg, int fr, int fq) const {
        bf16* XB = (bf16*)(ws + xoff); const bf16* S = soff ? (const bf16*)(ws + soff) : nullptr;
        const int nx = (int)((PSSn - (float*)(ws + WS_PSS)) / (16 * MPAD));
#pragma unroll
        for (int m = 0; m < 2; ++m) { const size_t o = (size_t)(MP + 16 * m + fr) * DM + cg * 16 + 4 * fq; f32x4 a = (m ? s1 : s0) * scale;
            if (S) a *= unpack4(*(const u32x2*)(S + o));
            const u32x2 xw = pack4(unpack4(*(const u32x2*)(XB + o)) + a); const f32x4 x = unpack4(xw);
            *(u32x2*)(XB + o) = xw;
            float ssq = (x[0] * x[0] + x[1] * x[1]) + (x[2] * x[2] + x[3] * x[3]);
            ssq += __shfl_xor(ssq, 16); ssq += __shfl_xor(ssq, 32);
            if (fq == 0) ((float*)(ws + WS_SPSS))[nx * 2048 + cg * 32 + 16 * m + fr] = ssq; }
    }
    __device__ __forceinline__ void operator()(AccRef acc, const pg8::Unit& u, int wr, int wc, int fr, int fq) const {
        fr = launder_v(fr); fq = launder_v(fq);
        bf16* XB = (bf16*)(ws + xoff); const bf16* S = soff ? (const bf16*)(ws + soff) : nullptr;
#pragma unroll
        for (int ai = 0; ai < 2; ++ai) {
#pragma unroll
          for (int mh = 0; mh < 2; ++mh) {
            u32x2 xv[4][2][2];
#pragma unroll
            for (int m = 2 * mh; m < 2 * mh + 2; ++m) { const int row = u.pm * 256 + EPI_ROWL;
                EPI_FOR_COLS { const int col = u.pn * 256 + EPI_COLL; if (row < MTOT) xv[m][bj][n] = *(const u32x2*)(XB + (size_t)row * DM + col); } }
#pragma unroll
            for (int m = 2 * mh; m < 2 * mh + 2; ++m) { const int rl = EPI_ROWL, row = u.pm * 256 + rl; float ssq = 0.f;
                EPI_FOR_COLS { const int col = u.pn * 256 + EPI_COLL; f32x4 a = acc[ai][bj][m][n] * scale;
                    if (row < MTOT) {
                    if (S) { const u32x2 sw = *(const u32x2*)(S + (size_t)row * DM + col);
                        a[0] *= __builtin_bit_cast(float, sw.x << 16); a[1] *= __builtin_bit_cast(float, sw.x & 0xffff0000u); a[2] *= __builtin_bit_cast(float, sw.y << 16); a[3] *= __builtin_bit_cast(float, sw.y & 0xffff0000u); }
                    const u32x2 xw = pack4(unpack4(xv[m][bj][n]) + a); const f32x4 x = unpack4(xw);
                    *(u32x2*)(XB + (size_t)row * DM + col) = xw;
                    ssq += (x[0] * x[0] + x[1] * x[1]) + (x[2] * x[2] + x[3] * x[3]); } }
                ssq += __shfl_xor(ssq, 16); ssq += __shfl_xor(ssq, 32);
                if (fq == 0) { if (row < MP) PSSn[(size_t)(u.pn * 4 + wc) * MPAD + row] = ssq;
                    else if (only >= 0 && row < MTOT) { const int nx = (int)((PSSn - (float*)(ws + WS_PSS)) / (16 * MPAD));
                        ((float*)(ws + WS_SPSS))[nx * 2048 + (u.pn * 16 + (only >> 1) * 8 + wc * 2 + (only & 1)) * 32 + (row - MP)] = ssq; } } }
          }
        }
    }
};
template <int CTRL> __device__ __forceinline__ float dppf(float x) { return __builtin_bit_cast(float, __builtin_amdgcn_update_dpp(0, __builtin_bit_cast(int, x), CTRL, 0xf, 0xf, true)); }
#define DPPF(src, ctrl) dppf<ctrl>(src)
template <int CTRL> __device__ __forceinline__ float dppf_old(float old, float x) { return __builtin_bit_cast(float, __builtin_amdgcn_update_dpp(__builtin_bit_cast(int, old), __builtin_bit_cast(int, x), CTRL, 0xf, 0xf, false)); }
struct EpiUp {
    static constexpr bool PERM = false, AFTER_DRAIN = false;
    unsigned char* ws; const LAS float* rs; float* out; const float* cw; const float* cb; LAS float* halo; int L; mutable int slot; mutable int only = -1;
    __device__ __forceinline__ void operator()(AccRef acc, const pg8::Unit& u, int wr, int wc, int fr, int fq) const {
        fr = launder_v(fr); fq = launder_v(fq);
        const LAS float* rsl = rs + slot * 256; ++slot;
        bf16* ACT = (bf16*)(ws + WS_ACT); float* UPH = (float*)(ws + WS_UPH) + (size_t)u.pm * 4 * DFF2 + u.pn * 256;
#pragma unroll
        for (int ai = 0; ai < 2; ++ai) { const int band = ai * 2 + wr; const float r3 = rsl[ai * 128 + wr * 64 + 48 + fr], r0 = rsl[ai * 128 + wr * 64 + fr];
#pragma unroll
            for (int bj = 0; bj < 2; ++bj)
#pragma unroll
                for (int n = 0; n < 2; ++n) { const int ci = bj * 128 + wc * 32 + n * 16 + 4 * fq;
                    if (fr >= 14) { const f32x4 v = acc[ai][bj][3][n] * r3; *(LAS f32x4*)(halo + (band * 2 + (fr - 14)) * 256 + ci) = v;
                        if (band == 3) *(f32x4*)(UPH + (size_t)(2 + fr - 14) * DFF2 + ci) = v; }
                    if (band == 0 && fr < 2) *(f32x4*)(UPH + (size_t)fr * DFF2 + ci) = acc[0][bj][0][n] * r0; } }
        asm volatile("s_waitcnt lgkmcnt(0)" ::: "memory"); __builtin_amdgcn_s_barrier(); asm volatile("" ::: "memory");
        const int b = u.pm >> 4; const bool last_tile = (u.pm & 15) == 15, first_tile = (u.pm & 15) == 0;
#pragma unroll
        for (int n = 0; n < 2; ++n) {
            const int ci = wc * 32 + n * 16 + 4 * fq, lca = u.pn * 128 + ci;
            f32x4 w[2][3], bs[2];
#pragma unroll
            for (int bj = 0; bj < 2; ++bj) { bs[bj] = *(const f32x4*)(cb + bj * DFF + lca);
#pragma unroll
                for (int k = 0; k < 3; ++k) w[bj][k] = *(const f32x4*)(cw + k * DFF2 + bj * DFF + lca); }
#pragma unroll
            for (int ai = 0; ai < 2; ++ai) {
                const int band = ai * 2 + wr;
                f32x4 s[4][2];
#pragma unroll
                for (int m = 0; m < 4; ++m) { const float r = rsl[ai * 128 + wr * 64 + m * 16 + fr]; s[m][0] = acc[ai][0][m][n] * r; s[m][1] = acc[ai][1][m][n] * r; }
#pragma unroll
                for (int m = 0; m < 4; ++m) {
                    const int rl = ai * 128 + wr * 64 + m * 16 + fr, row = u.pm * 256 + rl;
                    f32x4 uc[2];
#pragma unroll
                    for (int bj = 0; bj < 2; ++bj) {
                        f32x4 p1, p2;
                        if (m > 0) {
#pragma unroll
                            for (int e = 0; e < 4; ++e) { const float cur_ = s[m][bj][e], prv_ = s[m - 1][bj][e];
                                p1[e] = dppf_old<0x111>(dppf<0x121>(prv_), cur_); p2[e] = dppf_old<0x112>(dppf<0x122>(prv_), cur_); }
                        } else {
                            f32x4 h0 = (f32x4){0.f, 0.f, 0.f, 0.f}, h1 = h0;
                            if (band > 0) { h0 = *(const LAS f32x4*)(halo + ((band - 1) * 2 + 0) * 256 + bj * 128 + ci); h1 = *(const LAS f32x4*)(halo + ((band - 1) * 2 + 1) * 256 + bj * 128 + ci); }
#pragma unroll
                            for (int e = 0; e < 4; ++e) { const float cur_ = s[0][bj][e], h0_ = h0[e], h1_ = h1[e];
                                p1[e] = dppf_old<0x111>(h1_, cur_); p2[e] = dppf_old<0x112>((fr == 0) ? h0_ : h1_, cur_); }
                        }
                        uc[bj] = bs[bj] + w[bj][0] * p2 + w[bj][1] * p1 + w[bj][2] * s[m][bj];
                    }
                    f32x4 a;
#pragma unroll
                    for (int e = 0; e < 4; ++e) a[e] = gelu_tanh(uc[0][e]) * uc[1][e];
                    if (first_tile || rl >= 2) *(u32x2*)(ACT + (size_t)row * DFF + lca) = pack4(a);
                    if (last_tile && rl >= 254) {
                        float* o = out + O_FFC_P + ((size_t)(L * NB + b) * 2 + (rl - 254)) * DFF2 + lca;
                        *(f32x4*)o = s[m][0]; *(f32x4*)(o + DFF) = s[m][1]; }
                }
            }
        }
    }
};
__device__ __forceinline__ void act_fixup(unsigned char* ws, const float* cw, const float* cb, int pm, int tid) {
    if ((pm & 15) == 0) return;
    const float* own = (const float*)(ws + WS_UPH) + (size_t)pm * 4 * DFF2; const float* prv = own - (size_t)4 * DFF2; bf16* ACT = (bf16*)(ws + WS_ACT) + (size_t)pm * 256 * DFF;
#pragma unroll
    for (int k = tid; k < DFF; k += 512) {
        const int pa = (k >> 7) * 256 + (k & 127);
        float uc0[2], uc1[2];
#pragma unroll
        for (int h = 0; h < 2; ++h) { const int p = pa + h * 128, lc = h * DFF + k;
            const float w0 = cw[lc], w1 = cw[DFF2 + lc], w2 = cw[2 * DFF2 + lc], bb = cb[lc];
            const float q2 = prv[2 * DFF2 + p], q3 = prv[3 * DFF2 + p], o0 = own[p], o1 = own[DFF2 + p];
            uc0[h] = bb + w0 * q2 + w1 * q3 + w2 * o0; uc1[h] = bb + w0 * q3 + w1 * o0 + w2 * o1; }
        ACT[k] = (bf16)f2bf(gelu_tanh(uc0[0]) * uc0[1]); ACT[DFF + k] = (bf16)f2bf(gelu_tanh(uc1[0]) * uc1[1]);
    }
}
__device__ __forceinline__ void thin_unit_up(LAS unsigned char* lds, const bf16* __restrict__ A, const bf16* __restrict__ Bt, int pg, unsigned char* ws, const LAS float* rs32, float* out,
                                             const float* cw, const float* cb, const float* st, int L) {
    int tid = threadIdx.x; asm volatile("" : "+v"(tid));
    const int wid = __builtin_amdgcn_readfirstlane(tid >> 6), lane = tid & 63, fr = lane & 15, fq = lane >> 4, K = 1024;
    const int pn = pg >> 3, cgi = pg & 7;
    f32x4 c[2][2];
#pragma unroll
    for (int i = 0; i < 2; ++i) { c[i][0] = (f32x4){0.f, 0.f, 0.f, 0.f}; c[i][1] = c[i][0]; }
    const bf16* ap = A + (size_t)(MP + fr) * K + fq * 8;
    const bf16* bp = Bt + (size_t)(pn * 256 + cgi * 16 + fr) * K + fq * 8;
#pragma unroll
    for (int ks = wid; ks < 32; ks += 8) {
        const bf16x8 a0 = *(const bf16x8*)(ap + ks * 32), a1 = *(const bf16x8*)(ap + (size_t)16 * K + ks * 32);
        const bf16x8 b0 = *(const bf16x8*)(bp + ks * 32), b1 = *(const bf16x8*)(bp + (size_t)128 * K + ks * 32);
        c[0][0] = __builtin_amdgcn_mfma_f32_16x16x32_bf16(b0, a0, c[0][0], 0, 0, 0); c[0][1] = __builtin_amdgcn_mfma_f32_16x16x32_bf16(b0, a1, c[0][1], 0, 0, 0);
        c[1][0] = __builtin_amdgcn_mfma_f32_16x16x32_bf16(b1, a0, c[1][0], 0, 0, 0); c[1][1] = __builtin_amdgcn_mfma_f32_16x16x32_bf16(b1, a1, c[1][1], 0, 0, 0);
    }
    LAS f32x4* red = (LAS f32x4*)lds;
#pragma unroll
    for (int i = 0; i < 2; ++i)
#pragma unroll
        for (int m = 0; m < 2; ++m) red[(wid * 4 + i * 2 + m) * 64 + lane] = c[i][m];
    __syncthreads();
    if (wid == 0) {
        const int lca = pn * 128 + cgi * 16 + 4 * fq;
#pragma unroll
        for (int m = 0; m < 2; ++m) { const int sb = m * 16 + fr; const float r = rs32[sb];
            f32x4 uc[2];
#pragma unroll
            for (int i = 0; i < 2; ++i) { f32x4 s = red[(i * 2 + m) * 64 + lane];
#pragma unroll
                for (int w = 1; w < 8; ++w) s += red[(w * 4 + i * 2 + m) * 64 + lane];
                s = s * r; const int lc = i * DFF + lca; const size_t so = ((size_t)(L * MS + sb) * 2) * DFF2 + lc;
                const f32x4 s0 = *(const f32x4*)(st + so), s1 = *(const f32x4*)(st + so + DFF2);
                uc[i] = *(const f32x4*)(cb + lc) + *(const f32x4*)(cw + lc) * s0 + *(const f32x4*)(cw + DFF2 + lc) * s1 + *(const f32x4*)(cw + 2 * DFF2 + lc) * s;
                *(f32x4*)(out + O_FFC_S + so) = s1; *(f32x4*)(out + O_FFC_S + so + DFF2) = s; }
            f32x4 a;
#pragma unroll
            for (int e = 0; e < 4; ++e) a[e] = gelu_tanh(uc[0][e]) * uc[1][e];
            *(u32x2*)((bf16*)(ws + WS_ACT) + (size_t)(MP + sb) * DFF + lca) = pack4(a); }
    }
    __syncthreads();
}
struct EpiGate {
    static constexpr bool PERM = false, AFTER_DRAIN = false;
    unsigned char* ws; const LAS float* rs; float* PSSn; size_t pinoff; size_t xin, xout; mutable int slot; mutable int only = -1;
    __device__ __forceinline__ float warm(int fr, int fq, int cg) const {
        const bf16* Xr = (const bf16*)(ws + xin); const bf16* PIN = (const bf16*)(ws + pinoff); const size_t o0 = (size_t)(MP + fr) * DM + cg * 16 + 4 * fq, o1 = o0 + (size_t)16 * DM;
        return (bf2f(Xr[o0]) + bf2f(Xr[o1])) + (bf2f(PIN[o0]) + bf2f(PIN[o1])); }
    __device__ __forceinline__ void thin(f32x4 s0, f32x4 s1, int cg, int fr, int fq) const {
        const LAS float* rsl = rs + 7 * 256;
        const bf16* Xr = (const bf16*)(ws + xin); bf16* XB = (bf16*)(ws + xout); const bf16* PIN = (const bf16*)(ws + pinoff);
        const int nx = (int)((PSSn - (float*)(ws + WS_PSS)) / (16 * MPAD));
#pragma unroll
        for (int m = 0; m < 2; ++m) { const size_t o = (size_t)(MP + 16 * m + fr) * DM + cg * 16 + 4 * fq; f32x4 v = (m ? s1 : s0) * rsl[16 * m + fr];
            const f32x4 pv = unpack4(*(const u32x2*)(PIN + o));
            v[0] = sigmoidf_(v[0]) * pv[0]; v[1] = sigmoidf_(v[1]) * pv[1]; v[2] = sigmoidf_(v[2]) * pv[2]; v[3] = sigmoidf_(v[3]) * pv[3];
            const u32x2 xw = pack4(unpack4(*(const u32x2*)(Xr + o)) + v); const f32x4 x = unpack4(xw);
            *(u32x2*)(XB + o) = xw;
            float ssq = (x[0] * x[0] + x[1] * x[1]) + (x[2] * x[2] + x[3] * x[3]);
            ssq += __shfl_xor(ssq, 16); ssq += __shfl_xor(ssq, 32);
            if (fq == 0) ((float*)(ws + WS_SPSS))[nx * 2048 + cg * 32 + 16 * m + fr] = ssq; }
    }
    __device__ __forceinline__ void operator()(AccRef acc, const pg8::Unit& u, int wr, int wc, int fr, int fq) const {
        fr = launder_v(fr); fq = launder_v(fq);
        const LAS float* rsl = rs + slot * 256; ++slot;
        const bf16* __restrict__ Xr = (const bf16*)(ws + xin); bf16* __restrict__ XB = (bf16*)(ws + xout); const bf16* __restrict__ PIN = (const bf16*)(ws + pinoff);
#pragma unroll
        for (int ai = 0; ai < 2; ++ai) {
#pragma unroll
          for (int mh = 0; mh < 2; ++mh) {
            u32x2 xv[4][2][2]; u32x2 pv[4][2][2];
#pragma unroll
            for (int m = 2 * mh; m < 2 * mh + 2; ++m) { const int row = u.pm * 256 + EPI_ROWL;
                EPI_FOR_COLS { const int col = u.pn * 256 + EPI_COLL; if (row < MTOT) { xv[m][bj][n] = *(const u32x2*)(Xr + (size_t)row * DM + col); pv[m][bj][n] = *(const u32x2*)(PIN + (size_t)row * DM + col); } } }
#pragma unroll
            for (int m = 2 * mh; m < 2 * mh + 2; ++m) { const int rl = EPI_ROWL, row = u.pm * 256 + rl; const float r = rsl[rl]; float ssq = 0.f;
                EPI_FOR_COLS { const int col = u.pn * 256 + EPI_COLL;
                    if (row < MTOT) { f32x4 v = acc[ai][bj][m][n] * r; const u32x2 pw = pv[m][bj][n];
                        v[0] = sigmoidf_(v[0]) * __builtin_bit_cast(float, pw.x << 16); v[1] = sigmoidf_(v[1]) * __builtin_bit_cast(float, pw.x & 0xffff0000u);
                        v[2] = sigmoidf_(v[2]) * __builtin_bit_cast(float, pw.y << 16); v[3] = sigmoidf_(v[3]) * __builtin_bit_cast(float, pw.y & 0xffff0000u);
                        const u32x2 xw = pack4(unpack4(xv[m][bj][n]) + v); const f32x4 x = unpack4(xw);
                        *(u32x2*)(XB + (size_t)row * DM + col) = xw;
                        ssq += (x[0] * x[0] + x[1] * x[1]) + (x[2] * x[2] + x[3] * x[3]); } }
                ssq += __shfl_xor(ssq, 16); ssq += __shfl_xor(ssq, 32);
                if (fq == 0) { if (row < MP) PSSn[(size_t)(u.pn * 4 + wc) * MPAD + row] = ssq;
                    else if (only >= 0 && row < MTOT) { const int nx = (int)((PSSn - (float*)(ws + WS_PSS)) / (16 * MPAD));
                        ((float*)(ws + WS_SPSS))[nx * 2048 + (u.pn * 16 + (only >> 1) * 8 + wc * 2 + (only & 1)) * 32 + (row - MP)] = ssq; } } }
          }
        }
    }
};
struct EpiPin {
    static constexpr bool PERM = false, AFTER_DRAIN = false;
    unsigned char* ws; mutable int Lthin = -1; mutable int only = -1;
    __device__ __forceinline__ void operator()(AccRef acc, const pg8::Unit& u, int wr, int wc, int fr, int fq) const {
        fr = launder_v(fr); fq = launder_v(fq);
        const int L = Lthin >= 0 ? Lthin : u.pn >> 2, pm = Lthin >= 0 ? u.pm : u.pm - L * NMT, pn = Lthin >= 0 ? u.pn : u.pn & 3;
        bf16* PIN = (bf16*)(ws + WS_PIN) + (size_t)L * MPAD * DM;
        EPI_FOR_ROWS { const int rl = EPI_ROWL, row = pm * 256 + rl;
            if (row < MTOT) EPI_FOR_COLS { const int col = pn * 256 + EPI_COLL; *(u32x2*)(PIN + (size_t)row * DM + col) = pack4(acc[ai][bj][m][n]); } }
    }
};
struct PinOrder {
    int start, stride, count, Lb;
    __device__ __forceinline__ bool next(int i, pg8::Unit& u) const { if (i >= count) return false; const int idx = start + i * stride; if (idx >= 512) return false; const int L = Lb + (idx >> 8), w = idx & 255; u.pm = L * NMT + (w >> 2); u.pn = L * 4 + (w & 3); return true; }
    __device__ __forceinline__ void a_ready(const pg8::Unit&) const {}
    __device__ __forceinline__ void done(const pg8::Unit&) const {}
};
struct EpiT {
    static constexpr bool PERM = false, AFTER_DRAIN = false;
    bf16* T; mutable int only = -1;
    __device__ __forceinline__ void operator()(AccRef acc, const pg8::Unit& u, int wr, int wc, int fr, int fq) const {
        fr = launder_v(fr); fq = launder_v(fq);
        bf16* Tt = T + (size_t)u.pm * 65536;
        EPI_FOR_ROWS { const int rl = EPI_ROWL;
            EPI_FOR_COLS { *(u32x2*)(Tt + rl * 256 + EPI_COLL) = pack4(acc[ai][bj][m][n]); } }
    }
};
__device__ __forceinline__ f32x4 rope4(f32x4 v, const float* rt  , int d0) {
    const f32x4 cs = *(const f32x4*)(rt + 2 * d0);
    f32x4 o; o[0] = v[0] * cs[0] - v[1] * cs[1]; o[1] = v[1] * cs[0] + v[0] * cs[1]; o[2] = v[2] * cs[2] - v[3] * cs[3]; o[3] = v[3] * cs[2] + v[2] * cs[3]; return o;
}
struct EpiQ {
    static constexpr bool PERM = false, AFTER_DRAIN = false;
    unsigned char* ws; const LAS float* rs; mutable int slot; mutable int only = -1;
    __device__ __forceinline__ void operator()(AccRef acc, const pg8::Unit& u, int wr, int wc, int fr, int fq) const {
        fr = launder_v(fr); fq = launder_v(fq);
        const LAS float* rsl = rs + slot * 256; ++slot;
        bf16* Q = (bf16*)(ws + WS_Q); bf16* QR = (bf16*)(ws + WS_QR); float* GT = (float*)(ws + WS_GT); const float* RT = (const float*)(ws + WS_ROPE);
        EPI_FOR_ROWS { const int rl = EPI_ROWL, row = u.pm * 256 + rl; const float r = rsl[rl];
            const float* rt = RT + (size_t)(row < MP ? (row & (SEQ - 1)) : SEQ) * 64;
            if (row < MTOT) EPI_FOR_COLS { const int col = u.pn * 256 + EPI_COLL;
                if (u.pn < 4) { const f32x4 v = acc[ai][bj][m][n] * (r * C2);
                    *(u32x2*)(Q + (size_t)row * DM + col) = pack4(v);
                    *(u32x2*)(QR + (size_t)row * DM + col) = pack4(rope4(v, rt, (col & 63) >> 1)); }
                else if (col < NQG) { f32x4 v = acc[ai][bj][m][n] * r;
                    v[0] = sigmoidf_(v[0]); v[1] = sigmoidf_(v[1]); v[2] = sigmoidf_(v[2]); v[3] = sigmoidf_(v[3]);
                    *(f32x4*)(GT + (size_t)row * 48 + (col - 1024)) = v; } } }
    }
};
struct EpiKV {
    static constexpr bool PERM = false, AFTER_DRAIN = false;
    float* out; unsigned char* ws; const LAS float* rs; mutable int slot; mutable int only = -1;
    __device__ __forceinline__ void operator()(AccRef acc, const pg8::Unit& u, int wr, int wc, int fr, int fq) const {
        fr = launder_v(fr); fq = launder_v(fq);
        const LAS float* rsl = rs + slot * 256; ++slot;
        bf16* CA = (bf16*)(ws + WS_CMPA); bf16* KS = (bf16*)(ws + WS_KS); bf16* VTS = (bf16*)(ws + WS_VTS); bf16* KW = (bf16*)(ws + WS_KW); bf16* VTW = (bf16*)(ws + WS_VTW); const float* RT = (const float*)(ws + WS_ROPE);
        EPI_FOR_ROWS { const int rl = EPI_ROWL, row = u.pm * 256 + rl; const float r = rsl[rl];
            if (row < MTOT) {
            const bool smp = row >= MP; const int b = row >> 12, t = row & (SEQ - 1), sb = row - MP;
            const float* rt = RT + (size_t)(smp ? SEQ : t) * 64;
            EPI_FOR_COLS { const int col = u.pn * 256 + EPI_COLL; const int j = col >> 7, g = (col >> 6) & 1, e0 = col & 63;
                f32x4 v = acc[ai][bj][m][n] * r;
                if (j < 2) {
                    if (!smp) { *(f32x4*)(out + O_CMP_P + (size_t)row * 256 + col) = v;
                        *(u32x2*)(CA + ((size_t)j * CMP_ROWS + (size_t)(g * NB + b) * 256 + (t >> 4)) * 1024 + (t & 15) * 64 + e0) = pack4(v); }
                    else *(f32x4*)(out + O_CMP_S + (size_t)sb * 256 + col) = v;
                } else if (j == 2 || j == 4) {
                    const int d0 = e0 >> 1; const f32x4 q = rope4(v, rt, d0);
                    const int lc = (j - 2) * 128 + g * 64;
                    float* orow = nullptr;
                    if (j == 2) orow = smp ? out + O_SLC_S + (size_t)sb * 256 : out + O_SLC_P + (size_t)row * 256;
                    else if (smp) orow = out + O_WIN_S + ((size_t)sb * 512 + 511) * 256;
                    else if (t >= SEQ - 512) orow = out + O_WIN_P + ((size_t)b * 512 + (t - (SEQ - 512))) * 256;
                    if (orow) { float* p = orow + (lc & 255) + d0; *(f32x2*)p = (f32x2){q[0], q[2]}; *(f32x2*)(p + 32) = (f32x2){q[1], q[3]}; }
                    if (!smp) *(u32x2*)((j == 2 ? KS : KW) + ((size_t)(b * NG + g) * SEQ + t) * 64 + e0) = pack4(q);
                } else {
                    const int lc = 128 + g * 64 + e0;
                    float* orow = nullptr;
                    if (j == 3) orow = smp ? out + O_SLC_S + (size_t)sb * 256 : out + O_SLC_P + (size_t)row * 256;
                    else if (smp) orow = out + O_WIN_S + ((size_t)sb * 512 + 511) * 256;
                    else if (t >= SEQ - 512) orow = out + O_WIN_P + ((size_t)b * 512 + (t - (SEQ - 512))) * 256;
                    if (orow) *(f32x4*)(orow + lc) = v;
                    if (!smp) { bf16* vt = (j == 3 ? VTS : VTW) + ((size_t)(b * NG + g) * 64 + e0) * SEQ + t;
                        vt[0] = (bf16)f2bf(v[0]); vt[SEQ] = (bf16)f2bf(v[1]); vt[2 * SEQ] = (bf16)f2bf(v[2]); vt[3 * SEQ] = (bf16)f2bf(v[3]); }
                } } } }
    }
};

struct CmpOrder {
    int G, c, lo, hi;
    __device__ __forceinline__ bool next(int i, pg8::Unit& u) const { const int L = lo + i * G + c; if (L >= hi) return false; u.pm = L; u.pn = L / (CMP_ROWS / 256); return true; }
    __device__ __forceinline__ void a_ready(const pg8::Unit&) const {}
    __device__ __forceinline__ void done(const pg8::Unit&) const {}
};

__device__ __forceinline__ float rcp_fast(float x) { return __builtin_amdgcn_rcpf(x); }
__device__ __forceinline__ float softplus_neg(float lam) { const float e = __expf(-lam); return e < 0.03f ? e * (1.0f - e * (0.5f - e * ((1.0f / 3.0f) - 0.25f * e))) : (lam < -20.f ? -lam : __logf(1.0f + e)); }
__device__ __forceinline__ float sigmoid_fast(float x) { return rcp_fast(1.0f + __expf(-x)); }
__device__ __forceinline__ int rg2_unit(int bid, int G, int k) {
    constexpr int NU = 257 * 16;
    if (G != 256) { const int un = bid + k * G; return un < NU ? un : -1; }
    if (bid < 16) return k < 14 ? bid + 256 * k : (k == 14 ? 4096 + bid : -1);
    if (bid < 48) return k < 16 ? bid + 256 * k : (k == 16 ? (bid & 15) + 256 * (14 + ((bid >> 4) - 1)) : -1);
    return k < 16 ? bid + 256 * k : -1;
}
__device__ __forceinline__ void rg2_phase(KP P, LAS unsigned char* lds, int L, int tid, int lane, int wave, int G) {
    unsigned char* ws = P->ws;
    const bf16* XR = (const bf16*)(ws + WS_XR); bf16* HL = (bf16*)(ws + WS_HL); bf16* AC = (bf16*)(ws + WS_AC);
    const bf16* WG = (const bf16*)(ws + WS_WGA) + (size_t)L * 2 * 16 * 80 * 96;
    const float* cw = (const float*)P->in[16] + (size_t)L * 4 * DRNN; const float* cb = (const float*)P->in[17] + (size_t)L * DRNN;
    const float* b_a = (const float*)P->in[19] + (size_t)L * DRNN; const float* b_x = (const float*)P->in[21] + (size_t)L * DRNN; const float* lam = (const float*)P->in[22] + (size_t)L * DRNN;
    const float* st_c = (const float*)P->in[7] + (size_t)L * MS * 3 * DRNN; const float* st_h = (const float*)P->in[8] + (size_t)L * MS * DRNN;
    LAS bf16* wab = (LAS bf16*)(lds);
    LAS float* xrt = (LAS float*)(lds + 33280);
    LAS float* xcf = (LAS float*)(lds + 54720);
    LAS bf16* xcb = (LAS bf16*)(lds + 75200);
    LAS float* af = (LAS float*)(lds + 88512);
    LAS float* uf = (LAS float*)(lds + 108992);
    LAS float* agg = (LAS float*)(lds + 129472);
    LAS float* cws = (LAS float*)(lds + 132032);
    const int NU = 257 * 16, bid = launder_s(blockIdx.x);
    int cur_n = -1; bool have_pf = false; u32x2 pf[3];
    for (int uk = 0, un = rg2_unit(bid, G, 0); un >= 0; ++uk, un = rg2_unit(bid, G, uk)) {
        const int tl = un >> 4, n = un & 15, c0 = n * RGB; const bool smp = (tl == 256);
        const int m0 = tl * 64, t0 = m0 & (SEQ - 1), b = m0 >> 12;
        if (n != cur_n) {
            cur_n = n;
            for (int i = tid; i < 2 * 80 * 12; i += 512) { const int ck = i % 12, rw = i / 12; const int ax = rw / 80, j = rw % 80;
                *(LAS u32x4*)(wab + (size_t)rw * 104 + ck * 8) = *(const u32x4*)(WG + ((size_t)(ax * 16 + n) * 80 + j) * 96 + ck * 8); }
            for (int i = tid; i < 8 * 80; i += 512) { const int k = i / 80, c = i % 80, ch = c0 + c;
                cws[i] = (k < 4) ? cw[k * DRNN + ch] : (k == 4) ? cb[ch] : (k == 5) ? b_a[ch] : (k == 6) ? b_x[ch] : softplus_neg(lam[ch]); }
            for (int i = tid; i < 64 * 24; i += 512) xcb[(i / 24) * 104 + 80 + (i % 24)] = 0;
        }
        if (!smp) {
            if (!have_pf) {
#pragma unroll
                for (int k = 0; k < 3; ++k) { const int i = tid + 512 * k, r = i / 20, q = i % 20; pf[k] = (u32x2){0u, 0u};
                    if (i < 67 * 20 && t0 + r - 3 >= 0) pf[k] = *(const u32x2*)(XR + (size_t)(m0 + r - 3) * DRNN + c0 + 4 * q); } }
#pragma unroll
            for (int k = 0; k < 3; ++k) { const int i = tid + 512 * k, r = i / 20, q = i % 20; if (i < 67 * 20) *(LAS f32x4*)(xrt + r * 80 + 4 * q) = unpack4(pf[k]); }
            { const int un2 = rg2_unit(bid, G, uk + 1); have_pf = false;
              if (un2 >= 0 && (un2 >> 4) != 256) { const int m2 = (un2 >> 4) * 64, t2 = m2 & (SEQ - 1), c2 = (un2 & 15) * RGB; have_pf = true;
#pragma unroll
                for (int k = 0; k < 3; ++k) { const int i = tid + 512 * k, r = i / 20, q = i % 20; pf[k] = (u32x2){0u, 0u};
                    if (i < 67 * 20 && t2 + r - 3 >= 0) pf[k] = *(const u32x2*)(XR + (size_t)(m2 + r - 3) * DRNN + c2 + 4 * q); } } }
            __syncthreads();
            for (int rep_ = 0; rep_ < 1 + 4 * ((PROBE_DUP >> 23) & 1); ++rep_)
#pragma unroll
            for (int i = 0; i < 10; ++i) { const int e = tid + 512 * i, r = e / 80, c = e % 80;
                const float xc = cws[320 + c] + cws[c] * xrt[r * 80 + c] + cws[80 + c] * xrt[(r + 1) * 80 + c] + cws[160 + c] * xrt[(r + 2) * 80 + c] + cws[240 + c] * xrt[(r + 3) * 80 + c];
                xcf[e] = xc; xcb[r * 104 + c] = (bf16)f2bf(xc); }
        } else {
            __syncthreads();
            for (int e = tid; e < 64 * 80; e += 512) { const int r = e / 80, c = e % 80, ch = c0 + c; float xc = 0.f;
                if (r < MS) { xc = cws[320 + c] + cws[240 + c] * bf2f(XR[(size_t)(MP + r) * DRNN + ch]);
#pragma unroll
                    for (int k = 0; k < 3; ++k) xc += cws[k * 80 + c] * st_c[((size_t)r * 3 + k) * DRNN + ch]; }
                xcf[e] = xc; xcb[r * 104 + c] = (bf16)f2bf(xc); }
        }
        __syncthreads();
        for (int rep3_ = 0; rep3_ < 1 + 4 * ((PROBE_DUP >> 24) & 1); ++rep3_)
        { const int mt = wave & 3, jt0 = (wave >> 2) ? 3 : 0, jt1 = (wave >> 2) ? 5 : 3, fr = lane & 15, fq = lane >> 4;
            for (int jt = jt0; jt < jt1; ++jt) {
                f32x4 accA = (f32x4){0.f, 0.f, 0.f, 0.f}, accX = accA;
#pragma unroll
                for (int ks = 0; ks < 3; ++ks) {
                    const bf16x8 a = *(const LAS bf16x8*)(xcb + (size_t)(16 * mt + fr) * 104 + 32 * ks + 8 * fq);
                    const bf16x8 ba = *(const LAS bf16x8*)(wab + (size_t)(16 * jt + fr) * 104 + 32 * ks + 8 * fq);
                    const bf16x8 bx = *(const LAS bf16x8*)(wab + (size_t)(80 + 16 * jt + fr) * 104 + 32 * ks + 8 * fq);
                    accA = __builtin_amdgcn_mfma_f32_16x16x32_bf16(a, ba, accA, 0, 0, 0);
                    accX = __builtin_amdgcn_mfma_f32_16x16x32_bf16(a, bx, accX, 0, 0, 0);
                }
                const int c = 16 * jt + fr, ch = c0 + c;
                const float ba_ = cws[400 + c], bx_ = cws[480 + c], sp = cws[560 + c];
#pragma unroll
                for (int e = 0; e < 4; ++e) { const int r = 16 * mt + 4 * fq + e;
                    const float rg = sigmoid_fast(accA[e] + ba_), ig = sigmoid_fast(accX[e] + bx_);
                    const float la = -8.0f * rg * sp, a = __expf(la), x2 = 2.0f * la;
                    const float em = x2 * (1.0f + x2 * 0.5f * (1.0f + x2 * (1.0f / 3.0f) * (1.0f + x2 * 0.25f * (1.0f + x2 * 0.2f))));
                    float mult = __builtin_amdgcn_sqrtf(-em); if (!smp && t0 + r == 0) mult = 1.0f;
                    const float u = mult * (ig * xcf[r * 80 + c]);
                    if (!smp) { af[r * 80 + c] = a; uf[r * 80 + c] = u; }
                    else if (r < MS) { HL[(size_t)(MP + r) * DRNN + ch] = (bf16)f2bf(a * st_h[(size_t)r * DRNN + ch] + u); AC[(size_t)(MP + r) * DRNN + ch] = 0; } }
            } }
        __syncthreads();
        for (int rep4_ = 0; rep4_ < 1 + 4 * ((PROBE_DUP >> 25) & 1); ++rep4_)
        if (!smp) {
            const int ch = tid % 80, seg = tid / 80; float hs[16], ps[16];
            if (tid < 320) { float h = 0.f, p = 1.f;
#pragma unroll
                for (int r = 0; r < 16; ++r) { const float a = af[(seg * 16 + r) * 80 + ch], u = uf[(seg * 16 + r) * 80 + ch]; h = a * h + u; p *= a; hs[r] = h; ps[r] = p; }
                agg[(seg * 80 + ch) * 2] = p; agg[(seg * 80 + ch) * 2 + 1] = h; }
            __syncthreads();
            if (tid < 320) { float cy = 0.f, pc = 1.f;
                for (int s = 0; s < seg; ++s) { const float pp = agg[(s * 80 + ch) * 2], hh = agg[(s * 80 + ch) * 2 + 1]; cy = pp * cy + hh; pc *= pp; }
                bf16* hp = HL + (size_t)(m0 + seg * 16) * DRNN + c0 + ch; bf16* ap = AC + (size_t)(m0 + seg * 16) * DRNN + c0 + ch;
#pragma unroll
                for (int r = 0; r < 16; ++r) { hp[(size_t)r * DRNN] = (bf16)f2bf(hs[r] + ps[r] * cy); ap[(size_t)r * DRNN] = (bf16)f2bf(ps[r] * pc); } }
            else if (t0 == SEQ - 64 && tid >= 320 && tid < 320 + 80) { const int c = tid - 320;
#pragma unroll
                for (int k = 0; k < 3; ++k) P->out[O_RGC_P + ((size_t)(L * NB + b) * 3 + k) * DRNN + c0 + c] = xrt[(64 + k) * 80 + c]; }
        }
        __syncthreads();
    }
}
__device__ __forceinline__ void rg3_phase(KP P, LAS unsigned char* lds, int L, int tid, int G) {
    unsigned char* ws = P->ws;
    const bf16* HL = (const bf16*)(ws + WS_HL); const bf16* AC = (const bf16*)(ws + WS_AC); const bf16* Y = (const bf16*)(ws + WS_Y); bf16* Gb = (bf16*)(ws + WS_G);
    LAS float* cmb = (LAS float*)lds;
    const int oc = tid % 160, grp = tid / 160, c = oc * 8; const bool act = grp < 3;
    const f32x4 one4 = (f32x4){1.f, 1.f, 1.f, 1.f}, zero4 = (f32x4){0.f, 0.f, 0.f, 0.f};
    {
        const float* st_c = (const float*)P->in[7] + (size_t)L * MS * 3 * DRNN; const bf16* XR = (const bf16*)(ws + WS_XR);
        for (int e = launder_s(blockIdx.x) * 512 + tid; e < MS * 3 * DRNN; e += G * 512) { const int sb = e / (3 * DRNN), k = (e / DRNN) % 3, ch = e % DRNN;
            P->out[O_RGC_S + ((size_t)(L * MS + sb) * 3 + k) * DRNN + ch] = (k < 2) ? st_c[((size_t)sb * 3 + k + 1) * DRNN + ch] : bf2f(XR[(size_t)(MP + sb) * DRNN + ch]); }
    }
    for (int tl = launder_s(blockIdx.x); tl < 257; tl += G) {
        const bool smp = (tl == 256); const int m0 = tl * 64, b = m0 >> 12, kc = smp ? 0 : ((m0 & (SEQ - 1)) >> 6);
        if (act) {
            f32x4 cy0 = zero4, cy1 = zero4, ap0 = one4, ap1 = one4;
            const int lo = grp * kc / 3, hi = (grp + 1) * kc / 3;
            for (int kk = lo; kk < hi; kk += 4) {
                u32x4 aw[4], hw[4];
#pragma unroll
                for (int q = 0; q < 4; ++q) { aw[q] = (u32x4){0x3f803f80u, 0x3f803f80u, 0x3f803f80u, 0x3f803f80u}; hw[q] = (u32x4){0u, 0u, 0u, 0u};
                    if (kk + q < hi) { const size_t mr = (size_t)(b * SEQ + (kk + q) * 64 + 63) * DRNN + c; aw[q] = *(const u32x4*)(AC + mr); hw[q] = *(const u32x4*)(HL + mr); } }
#pragma unroll
                for (int q = 0; q < 4; ++q) { f32x4 a0, a1, h0, h1; unpack8(aw[q], a0, a1); unpack8(hw[q], h0, h1); cy0 = a0 * cy0 + h0; cy1 = a1 * cy1 + h1; ap0 *= a0; ap1 *= a1; }
            }
            *(LAS f32x4*)(cmb + (grp * 2 + 0) * 1280 + c) = ap0; *(LAS f32x4*)(cmb + (grp * 2 + 0) * 1280 + c + 4) = ap1;
            *(LAS f32x4*)(cmb + (grp * 2 + 1) * 1280 + c) = cy0; *(LAS f32x4*)(cmb + (grp * 2 + 1) * 1280 + c + 4) = cy1;
        }
        __syncthreads();
        if (act) {
            f32x4 cy0 = zero4, cy1 = zero4;
#pragma unroll
            for (int g2 = 0; g2 < 3; ++g2) {
                const f32x4 A0 = *(const LAS f32x4*)(cmb + (g2 * 2 + 0) * 1280 + c), A1 = *(const LAS f32x4*)(cmb + (g2 * 2 + 0) * 1280 + c + 4);
                const f32x4 H0 = *(const LAS f32x4*)(cmb + (g2 * 2 + 1) * 1280 + c), H1 = *(const LAS f32x4*)(cmb + (g2 * 2 + 1) * 1280 + c + 4);
                cy0 = A0 * cy0 + H0; cy1 = A1 * cy1 + H1; }
            const int nr = smp ? MS : 64;
            for (int r0 = grp; r0 < nr; r0 += 12) {
                u32x4 hlw[4], acw[4], yw[4];
#pragma unroll
                for (int q = 0; q < 4; ++q) { const int r = r0 + 3 * q; hlw[q] = (u32x4){0u, 0u, 0u, 0u}; acw[q] = hlw[q]; yw[q] = hlw[q];
                    if (r < nr) { const size_t mr = (size_t)(m0 + r) * DRNN + c; hlw[q] = *(const u32x4*)(HL + mr); acw[q] = *(const u32x4*)(AC + mr); yw[q] = *(const u32x4*)(Y + mr); } }
#pragma unroll
                for (int q = 0; q < 4; ++q) { const int r = r0 + 3 * q;
                    if (r < nr) { const size_t mr = (size_t)(m0 + r) * DRNN + c;
                        f32x4 hl0, hl1, ac0, ac1; unpack8(hlw[q], hl0, hl1); unpack8(acw[q], ac0, ac1);
                        const f32x4 h0 = hl0 + ac0 * cy0, h1 = hl1 + ac1 * cy1; u32x4 o;
                        o.x = pk2(__builtin_bit_cast(float, yw[q].x << 16) * h0[0], __builtin_bit_cast(float, yw[q].x & 0xffff0000u) * h0[1]);
                        o.y = pk2(__builtin_bit_cast(float, yw[q].y << 16) * h0[2], __builtin_bit_cast(float, yw[q].y & 0xffff0000u) * h0[3]);
                        o.z = pk2(__builtin_bit_cast(float, yw[q].z << 16) * h1[0], __builtin_bit_cast(float, yw[q].z & 0xffff0000u) * h1[1]);
                        o.w = pk2(__builtin_bit_cast(float, yw[q].w << 16) * h1[2], __builtin_bit_cast(float, yw[q].w & 0xffff0000u) * h1[3]);
                        *(u32x4*)(Gb + mr) = o;
                        if (smp) { float* op = P->out + O_RGH_S + (size_t)(L * MS + r) * DRNN + c; *(f32x4*)op = h0; *(f32x4*)(op + 4) = h1; }
                        else if (kc == 63 && r == 63) { float* op = P->out + O_RGH_P + (size_t)(L * NB + b) * DRNN + c; *(f32x4*)op = h0; *(f32x4*)(op + 4) = h1; } } }
            }
        }
        __syncthreads();
    }
}
__device__ __forceinline__ void cmp2_phase(KP P, LAS unsigned char* lds, int tid, int lane, int wave, int G) {
    unsigned char* ws = P->ws;
    const bf16* T = (const bf16*)(ws + WS_T); const float* B1P = (const float*)(ws + WS_B1F); const float* b1 = (const float*)P->in[28]; const float* w2 = (const float*)P->in[29];
    bf16* KC = (bf16*)(ws + WS_KC); bf16* VCT = (bf16*)(ws + WS_VCT); float* KCS = (float*)(ws + WS_KCS); float* VCS = (float*)(ws + WS_VCS);
    LAS bf16* w2b = (LAS bf16*)lds;
    LAS float* b1s = (LAS float*)(lds + 34816);
    LAS bf16* hidb = (LAS bf16*)(lds + 35840);
    for (int i = tid; i < 2 * 128 * 64; i += 512) { const int d = i & 63, e = (i >> 6) & 127, j = i >> 13; w2b[(j * 64 + d) * 136 + e] = (bf16)f2bf(w2[i]); }
    if (tid < 256) { float s = b1[tid];
        for (int l = 0; l < 32; ++l) s += B1P[l * 256 + tid];
        b1s[tid] = s; }
    __syncthreads();
    const int NU = 2 * CMP_ROWS / 64;
    const int mt = wave & 3, nh = wave >> 2, fr = lane & 15, fq = lane >> 4;
    for (int un = launder_s(blockIdx.x); un < NU; un += G) {
        const int slot0 = un * 64, j = slot0 / CMP_ROWS, row0 = slot0 % CMP_ROWS;
#pragma unroll
        for (int q = 0; q < 4; ++q) { const int idx = tid + 512 * q, r = idx >> 5, e4 = (idx & 31) * 4; const int row = row0 + r;
            const bool smp = row >= CMP_ROWS_P; const int cb = smp ? ((row - CMP_ROWS_P) & 511) : (row & 255); const bool valid = cb < (smp ? NCB_S : NCB_P);
            f32x4 h = (f32x4){0.f, 0.f, 0.f, 0.f};
            if (valid) { const f32x4 a = unpack4(*(const u32x2*)(T + (size_t)(slot0 + r) * 256 + e4)), bq = unpack4(*(const u32x2*)(T + (size_t)(slot0 + r + 1) * 256 + 128 + e4)), bb = *(const LAS f32x4*)(b1s + j * 128 + e4);
#pragma unroll
                for (int k = 0; k < 4; ++k) h[k] = gelu_tanh(a[k] + bq[k] + bb[k]); }
            *(LAS u32x2*)(hidb + r * 136 + e4) = (u32x2){pk2(h[0], h[1]), pk2(h[2], h[3])}; }
        __syncthreads();
        f32x4 acc[2];
#pragma unroll
        for (int n = 0; n < 2; ++n) { acc[n] = (f32x4){0.f, 0.f, 0.f, 0.f};
#pragma unroll
            for (int ks = 0; ks < 4; ++ks) { const bf16x8 a = *(const LAS bf16x8*)(hidb + (16 * mt + fr) * 136 + 32 * ks + 8 * fq);
                const bf16x8 b = *(const LAS bf16x8*)(w2b + (j * 64 + 16 * (2 * nh + n) + fr) * 136 + 32 * ks + 8 * fq);
                acc[n] = __builtin_amdgcn_mfma_f32_16x16x32_bf16(a, b, acc[n], 0, 0, 0); } }
#pragma unroll
        for (int n = 0; n < 2; ++n) { const int d = 16 * (2 * nh + n) + fr;
#pragma unroll
            for (int e = 0; e < 4; ++e) { const int row = row0 + 16 * mt + 4 * fq + e; const float o = acc[n][e];
                if (row < CMP_ROWS_P) { const int g = row >> 10, bb = (row >> 8) & 3, cb = row & 255;
                    if (j == 0) KC[((size_t)(bb * NG + g) * 256 + cb) * 64 + 2 * (d & 31) + (d >> 5)] = (bf16)f2bf(o);
                    else VCT[((size_t)(bb * NG + g) * 64 + d) * 256 + cb] = (bf16)f2bf(o); }
                else { const int rr = row - CMP_ROWS_P, g = rr >> 14, sb = (rr >> 9) & 31, cb = rr & 511;
                    (j == 0 ? KCS : VCS)[((size_t)(sb * NG + g) * 512 + cb) * 64 + d] = o; } } }
        __syncthreads();
    }
}
__device__ __forceinline__ void final_phase(KP P, const float* PSScur, const float* SPcur, int lane, int wave, int G) {
    const bf16* X = (const bf16*)(P->ws + xb_off(4)); const float* gf = (const float*)P->in[14];
    f32x4 gg[4];
#pragma unroll
    for (int jj = 0; jj < 4; ++jj) gg[jj] = *(const f32x4*)(gf + 4 * lane + 256 * jj);
    const int NGW = G * 8;
    for (int m0 = launder_s(blockIdx.x) * 8 + wave; m0 < MTOT; m0 += 2 * NGW) {
        float sp[2]; u32x2 xv[2][4];
#pragma unroll
        for (int q = 0; q < 2; ++q) { const int m = m0 + q * NGW; sp[q] = 0.f;
            if (m < MTOT) {
                if (m < MP) { if (lane < 16) sp[q] = PSScur[(size_t)lane * MPAD + m]; } else sp[q] = SPcur[lane * 32 + (m - MP)];
#pragma unroll
                for (int jj = 0; jj < 4; ++jj) xv[q][jj] = *(const u32x2*)(X + (size_t)m * DM + 4 * lane + 256 * jj); } }
#pragma unroll
        for (int q = 0; q < 2; ++q) { const int m = m0 + q * NGW;
            if (m < MTOT) {
                const float rs = rsqrtf(wave_sum(sp[q]) * (1.0f / 1024.0f) + EPS);
                float* o = m < MP ? P->out + O_Y_P + (size_t)m * DM : P->out + O_Y_S + (size_t)(m - MP) * DM;
#pragma unroll
                for (int jj = 0; jj < 4; ++jj) { const int c = 4 * lane + 256 * jj; *(f32x4*)(o + c) = unpack4(xv[q][jj]) * rs * gg[jj]; } } }
    }
}

constexpr int AT_KT = 0, AT_KTB = 18432, AT_VT = 36864, AT_VTB = 17408, AT_QS = 71680, AT_LS = 79872, AT_MASK = 88064, AT_QF = 88320, AT_STASH = 121088;
constexpr int AT_ROWB = 144, AT_VROWB = 272;
__device__ __forceinline__ unsigned cvtpk(float lo, float hi) { return pk2(lo, hi); }

template <int MODE>
__device__ __forceinline__ void attn_pass(LAS unsigned char* lds, const bf16* __restrict__ Kg, const bf16* __restrict__ Vtg, int vstride, int tb, int te, const LAS unsigned char* qfl,
                                          int klo, int khi, unsigned long long selmask, float& m_run, float& l_run, f32x16& o0, f32x16& o1, float inv_l, int tokrow, int tid, int lane) {
    if (te <= tb) return;
    const int r32 = lane & 31, hi = lane >> 5, lrow = tid >> 3, lch = tid & 7;
    const unsigned kofs = (unsigned)(lrow * AT_ROWB + lch * 16), vofs = (unsigned)(lrow * AT_VROWB + lch * 16);
    const bf16* kp = Kg + (size_t)lrow * 64 + lch * 8; const bf16* vp = Vtg + (size_t)lrow * vstride + lch * 8;
    u32x4 kreg0 = *(const u32x4*)(kp + (size_t)tb * 8192), kreg1 = *(const u32x4*)(kp + (size_t)tb * 8192 + 4096);
    u32x4 vreg0 = (u32x4){0u, 0u, 0u, 0u}, vreg1 = vreg0;
    if (MODE != 0) { vreg0 = *(const u32x4*)(vp + tb * 128); vreg1 = *(const u32x4*)(vp + tb * 128 + 64); }
    *(LAS u32x4*)(lds + AT_KT + kofs) = kreg0; *(LAS u32x4*)(lds + AT_KT + 64 * AT_ROWB + kofs) = kreg1;
    if (MODE != 0) { *(LAS u32x4*)(lds + AT_VT + vofs) = vreg0; *(LAS u32x4*)(lds + AT_VT + 128 + vofs) = vreg1; }
    __syncthreads();
    for (int t = tb; t < te; ++t) {
        const int buf = (t - tb) & 1, key0 = t * 128;
        if (t + 1 < te) { kreg0 = *(const u32x4*)(kp + (size_t)(t + 1) * 8192); kreg1 = *(const u32x4*)(kp + (size_t)(t + 1) * 8192 + 4096);
            if (MODE != 0) { vreg0 = *(const u32x4*)(vp + (t + 1) * 128); vreg1 = *(const u32x4*)(vp + (t + 1) * 128 + 64); } }
        const bool selA = (MODE == 2) ? ((selmask >> (2 * t)) & 1ull) != 0ull : true, selB = (MODE == 2) ? ((selmask >> (2 * t + 1)) & 1ull) != 0ull : true;
        const bool anyA = selA && (key0 <= khi) && (key0 + 63 >= klo), anyB = selB && (key0 + 64 <= khi) && (key0 + 127 >= klo);
        if (__builtin_amdgcn_ballot_w64(anyA || anyB) != 0ull) {
            const LAS unsigned char* Kb = lds + AT_KT + buf * AT_KTB; const LAS unsigned char* Vb = lds + AT_VT + buf * AT_VTB;
            const bool fullA = selA && (key0 >= klo) && (key0 + 63 <= khi), fullB = selB && (key0 + 64 >= klo) && (key0 + 127 <= khi);
            const bool partial = __builtin_amdgcn_ballot_w64((anyA && !fullA) || (anyB && !fullB)) != 0ull;
            const float base = (m_run == -INFINITY) ? 0.f : -m_run;
            const float ciA = (MODE >= 2) ? ((fullA || (partial && anyA)) ? base : -INFINITY) : 0.f, ciB = (MODE >= 2) ? ((fullB || (partial && anyB)) ? base : -INFINITY) : 0.f;
            f32x16 p[4];
#pragma unroll
            for (int r = 0; r < 16; ++r) { p[0][r] = ciA; p[1][r] = ciA; p[2][r] = ciB; p[3][r] = ciB; }
            __builtin_amdgcn_s_setprio(1);
#pragma unroll
            for (int c = 0; c < 4; ++c)
#pragma unroll
                for (int i = 0; i < 4; ++i) { const bf16x8 a = *(const LAS bf16x8*)(Kb + (32 * i + r32) * AT_ROWB + c * 32 + hi * 16);
                    p[i] = __builtin_amdgcn_mfma_f32_32x32x16_bf16(a, *(const LAS bf16x8*)(qfl + c * 1024), p[i], 0, 0, 0);
                    if (i == 3 && (c & 1)) __builtin_amdgcn_sched_barrier(0); }
            __builtin_amdgcn_s_setprio(0);
            float mx = -INFINITY;
            if (!partial && MODE >= 2) {
#pragma unroll
                for (int r = 0; r < 16; ++r) mx = fmaxf(fmaxf(mx, fmaxf(p[0][r], p[1][r])), fmaxf(p[2][r], p[3][r]));
            } else {
#pragma unroll
                for (int i = 0; i < 4; ++i) { const bool sl = (i < 2) ? selA : selB; const int kb0 = key0 + 32 * i + 4 * hi;
#pragma unroll
                    for (int r = 0; r < 16; ++r) { const int k = kb0 + (r & 3) + 8 * (r >> 2); p[i][r] = (sl && k >= klo && k <= khi) ? p[i][r] : -INFINITY; mx = fmaxf(mx, p[i][r]); } }
            }
            float ls = 0.f;
            if (MODE >= 2) {
                mx = fmaxf(mx, __shfl_xor(mx, 32));
                const bool moved = (m_run == -INFINITY) ? (mx != -INFINITY) : (mx > 0.f);
                if (__builtin_amdgcn_ballot_w64(moved) != 0ull) {
                    const float delta = moved ? mx : 0.f;
                    const float alpha = (m_run == -INFINITY) ? 1.f : __builtin_amdgcn_exp2f(-delta);
                    m_run = moved ? ((m_run == -INFINITY) ? mx : m_run + mx) : m_run;
                    l_run *= alpha;
#pragma unroll
                    for (int r = 0; r < 16; ++r) { o0[r] *= alpha; o1[r] *= alpha; p[0][r] -= delta; p[1][r] -= delta; p[2][r] -= delta; p[3][r] -= delta; }
                }
#pragma unroll
                for (int i = 0; i < 4; ++i)
#pragma unroll
                    for (int r = 0; r < 16; ++r) { p[i][r] = __builtin_amdgcn_exp2f(p[i][r]); ls += p[i][r]; }
            } else {
                float m_use;
                if (MODE == 1) { m_use = (m_run == -INFINITY) ? 0.f : m_run; }
                else {
                    mx = fmaxf(mx, __shfl_xor(mx, 32));
                    const float m_new = fmaxf(m_run, mx); m_use = (m_new == -INFINITY) ? 0.f : m_new;
                    const float alpha = __builtin_amdgcn_exp2f(m_run - m_use);
                    l_run *= alpha; m_run = m_new;
                }
#pragma unroll
                for (int i = 0; i < 4; ++i)
#pragma unroll
                    for (int r = 0; r < 16; ++r) { p[i][r] = __builtin_amdgcn_exp2f(p[i][r] - m_use); ls += p[i][r]; }
            }
            if (MODE != 1) l_run += ls;
            if (MODE == 1) {
                LAS float* QS = (LAS float*)(lds + AT_QS); LAS float* LS = (LAS float*)(lds + AT_LS);
#pragma unroll
                for (int i = 0; i < 4; ++i) {
#pragma unroll
                    for (int r = 0; r < 16; ++r) p[i][r] *= inv_l;
#pragma unroll
                    for (int jq = 0; jq < 4; ++jq) {
                        float q0 = (p[i][4 * jq] + p[i][4 * jq + 1]) + (p[i][4 * jq + 2] + p[i][4 * jq + 3]), l0 = p[i][4 * jq + 3];
#pragma unroll
                        for (int o = 1; o < 8; o <<= 1) { q0 += __shfl_xor(q0, o); l0 += __shfl_xor(l0, o); }
                        if ((lane & 7) == 0) { const int qd = 32 * t + 8 * i + 2 * jq + hi; QS[tokrow * 64 + qd] = q0; LS[tokrow * 64 + qd] = l0; }
                    }
                }
            }
            if (MODE != 0) {
#pragma unroll
                for (int j = 0; j < 8; ++j) {
                    const int i = j >> 1, rb = 8 * (j & 1);
                    u32x4 pw; pw.x = cvtpk(p[i][rb], p[i][rb + 1]); pw.y = cvtpk(p[i][rb + 2], p[i][rb + 3]); pw.z = cvtpk(p[i][rb + 4], p[i][rb + 5]); pw.w = cvtpk(p[i][rb + 6], p[i][rb + 7]);
                    const bf16x8 pb = __builtin_bit_cast(bf16x8, pw);
                    { const LAS unsigned char* vq = Vb + r32 * AT_VROWB + (16 * j + 4 * hi) * 2;
                      const u32x2 lo = *(const LAS u32x2*)vq, hh = *(const LAS u32x2*)(vq + 16);
                      o0 = __builtin_amdgcn_mfma_f32_32x32x16_bf16(__builtin_bit_cast(bf16x8, (u32x4){lo.x, lo.y, hh.x, hh.y}), pb, o0, 0, 0, 0); }
                    { const LAS unsigned char* vq = Vb + (32 + r32) * AT_VROWB + (16 * j + 4 * hi) * 2;
                      const u32x2 lo = *(const LAS u32x2*)vq, hh = *(const LAS u32x2*)(vq + 16);
                      o1 = __builtin_amdgcn_mfma_f32_32x32x16_bf16(__builtin_bit_cast(bf16x8, (u32x4){lo.x, lo.y, hh.x, hh.y}), pb, o1, 0, 0, 0); }
                    if (j & 1) __builtin_amdgcn_sched_barrier(0);
                }
            }
        }
        if (t + 1 < te) { LAS unsigned char* kd = lds + AT_KT + (buf ^ 1) * AT_KTB; *(LAS u32x4*)(kd + kofs) = kreg0; *(LAS u32x4*)(kd + 64 * AT_ROWB + kofs) = kreg1;
            if (MODE != 0) { LAS unsigned char* vd = lds + AT_VT + (buf ^ 1) * AT_VTB; *(LAS u32x4*)(vd + vofs) = vreg0; *(LAS u32x4*)(vd + 128 + vofs) = vreg1; } }
        __syncthreads();
    }
}

__device__ __forceinline__ void attn_prompt_unit(KP P, LAS unsigned char* lds, int b, int g, int t0, int tid, int lane, int wave) {
    unsigned char* ws = P->ws;
    const bf16* Q = (const bf16*)(ws + WS_Q); const bf16* QR = (const bf16*)(ws + WS_QR); const float* GT = (const float*)(ws + WS_GT); bf16* O = (bf16*)(ws + WS_O);
    const int bg = b * NG + g;
    const bf16* KS = (const bf16*)(ws + WS_KS) + (size_t)bg * SEQ * 64; const bf16* VTS = (const bf16*)(ws + WS_VTS) + (size_t)bg * 64 * SEQ;
    const bf16* KW = (const bf16*)(ws + WS_KW) + (size_t)bg * SEQ * 64; const bf16* VTW = (const bf16*)(ws + WS_VTW) + (size_t)bg * 64 * SEQ;
    const bf16* KC = (const bf16*)(ws + WS_KC) + (size_t)bg * 256 * 64; const bf16* VCT = (const bf16*)(ws + WS_VCT) + (size_t)bg * 64 * 256;
    const int r32 = lane & 31, hi = lane >> 5, tok_l = r32 >> 3, hl = r32 & 7, tokrow = wave * 4 + tok_l;
    const int t = t0 + tokrow, mrow = b * SEQ + t, h = g * HPG + hl;
    LAS float* QSb = (LAS float*)(lds + AT_QS); LAS float* LSb = (LAS float*)(lds + AT_LS); LAS unsigned long long* MK = (LAS unsigned long long*)(lds + AT_MASK);
    for (int i = tid; i < 32 * 64; i += 512) { QSb[i] = 0.f; LSb[i] = 0.f; }
    LAS unsigned char* qfl = lds + AT_QF + wave * 4096 + lane * 16;
#pragma unroll
    for (int c = 0; c < 4; ++c) *(LAS bf16x8*)(qfl + c * 1024) = *(const bf16x8*)(Q + (size_t)mrow * DM + h * 64 + c * 16 + hi * 8);
    __syncthreads();
    f32x16 o0, o1;
#pragma unroll
    for (int r = 0; r < 16; ++r) { o0[r] = 0.f; o1[r] = 0.f; }
    LAS unsigned* stash = (LAS unsigned*)(lds + AT_STASH) + wave * 1024 + lane;
    const int cmax = (t >= 31) ? ((t - 31) >> 4) : -1;
    const int ntc = (t0 >> 11) + 1;
    {
        float mc = -INFINITY, lc = 0.f;
        attn_pass<0>(lds, KC, VCT, 256, 0, ntc, qfl, 0, cmax, 0ull, mc, lc, o0, o1, 0.f, tokrow, tid, lane);
        lc += __shfl_xor(lc, 32);
        const float invl = lc > 0.f ? 1.0f / lc : 0.f;
        attn_pass<1>(lds, KC, VCT, 256, 0, ntc, qfl, 0, cmax, 0ull, mc, lc, o0, o1, invl, tokrow, tid, lane);
        const float g0 = GT[(size_t)mrow * 48 + h * 3 + 0];
#pragma unroll
        for (int r = 0; r < 16; ++r) { stash[r * 64] = pk2(g0 * o0[r], g0 * o1[r]); o0[r] = 0.f; o1[r] = 0.f; }
    }
    asm volatile("s_waitcnt lgkmcnt(0)" ::: "memory");
    unsigned long long mymask = 0ull;
    {
        const int cur_w = (t0 + wave * 4) >> 6;
#pragma unroll
        for (int tk = 0; tk < 4; ++tk) {
            const int tr = wave * 4 + tk, s = lane;
            float v = QSb[tr * 64 + s] + (s > 0 ? LSb[tr * 64 + s - 1] : 0.f);
            if (s == 0 || s == cur_w || s + 1 == cur_w) v = INFINITY;
            if (s > cur_w) v = -INFINITY;
            int rank = 0;
            for (int i = 0; i < 64; ++i) { const float x = __builtin_bit_cast(float, __builtin_amdgcn_readlane(__builtin_bit_cast(int, v), i)); rank += (x > v || (x == v && i < s)) ? 1 : 0; }
            const unsigned long long mk = __builtin_amdgcn_ballot_w64(rank < 16);
            if (tok_l == tk) mymask = mk;
        }
    }
    (void)MK;
#pragma unroll
    for (int c = 0; c < 4; ++c) *(LAS bf16x8*)(qfl + c * 1024) = *(const bf16x8*)(QR + (size_t)mrow * DM + h * 64 + c * 16 + hi * 8);
    const int cur = t0 >> 6;
    {
        float ms = -INFINITY, lsum = 0.f;
        attn_pass<2>(lds, KS, VTS, SEQ, 0, (cur >> 1) + 1, qfl, 0, t, mymask, ms, lsum, o0, o1, 0.f, tokrow, tid, lane);
        lsum += __shfl_xor(lsum, 32);
        const float sc = GT[(size_t)mrow * 48 + h * 3 + 1] / lsum;
#pragma unroll
        for (int r = 0; r < 16; ++r) { const unsigned w = stash[r * 64]; stash[r * 64] = pk2(__builtin_bit_cast(float, w << 16) + sc * o0[r], __builtin_bit_cast(float, w & 0xffff0000u) + sc * o1[r]); o0[r] = 0.f; o1[r] = 0.f; }
    }
    f32x16 out0, out1;
    {
        float mw = -INFINITY, lw = 0.f;
        const int wlo = (t0 - 511) > 0 ? (t0 - 511) >> 7 : 0;
        attn_pass<3>(lds, KW, VTW, SEQ, wlo, (cur >> 1) + 1, qfl, t - 511, t, 0ull, mw, lw, o0, o1, 0.f, tokrow, tid, lane);
        lw += __shfl_xor(lw, 32);
        const float sc = GT[(size_t)mrow * 48 + h * 3 + 2] / lw;
#pragma unroll
        for (int r = 0; r < 16; ++r) { const unsigned w = stash[r * 64]; out0[r] = __builtin_bit_cast(float, w << 16) + sc * o0[r]; out1[r] = __builtin_bit_cast(float, w & 0xffff0000u) + sc * o1[r]; }
    }
    bf16* op = O + (size_t)mrow * DM + h * 64 + 4 * hi;
#pragma unroll
    for (int jq = 0; jq < 4; ++jq) {
        u32x2 w0; w0.x = cvtpk(out0[4 * jq], out0[4 * jq + 1]); w0.y = cvtpk(out0[4 * jq + 2], out0[4 * jq + 3]); *(u32x2*)(op + 8 * jq) = w0;
        u32x2 w1; w1.x = cvtpk(out1[4 * jq], out1[4 * jq + 1]); w1.y = cvtpk(out1[4 * jq + 2], out1[4 * jq + 3]); *(u32x2*)(op + 32 + 8 * jq) = w1;
    }
}

constexpr int SM_QN = 0, SM_QR = 2048, SM_SC = 4096, SM_IMP = 36864, SM_SEL = 37888, SM_PTR = 38144, SM_OP = 46336;
__device__ __forceinline__ void smp_scores(const float* __restrict__ kp, const LAS float* q, LAS float* sc, int col, bool valid) {
    float s[8];
#pragma unroll
    for (int hl = 0; hl < 8; ++hl) s[hl] = 0.f;
    if (valid) {
#pragma unroll 4
        for (int d4 = 0; d4 < 16; ++d4) { const f32x4 kv = *(const f32x4*)(kp + 4 * d4);
#pragma unroll
            for (int hl = 0; hl < 8; ++hl) { const f32x4 qv = *(const LAS f32x4*)(q + hl * 64 + 4 * d4); s[hl] += (kv[0] * qv[0] + kv[1] * qv[1]) + (kv[2] * qv[2] + kv[3] * qv[3]); } }
    }
#pragma unroll
    for (int hl = 0; hl < 8; ++hl) sc[hl * 1024 + col] = valid ? s[hl] : -INFINITY;
}
__device__ __forceinline__ void smp_softmax(LAS float* sc, int n, int lane, int wave) {
    LAS float* row = sc + wave * 1024; float mx = -INFINITY;
    for (int i = lane; i < n; i += 64) mx = fmaxf(mx, row[i]);
#pragma unroll
    for (int o = 1; o < 64; o <<= 1) mx = fmaxf(mx, __shfl_xor(mx, o));
    float sum = 0.f;
    for (int i = lane; i < n; i += 64) { const float e = __builtin_amdgcn_exp2f(row[i] - mx); row[i] = e; sum += e; }
    sum = wave_sum(sum); const float inv = 1.0f / sum;
    for (int i = lane; i < n; i += 64) row[i] *= inv;
}
template <bool PTR> __device__ __forceinline__ void smp_pv(const LAS float* sc, const LAS unsigned long long* rp, const float* __restrict__ vbase, int n, LAS float* opart, int tid) {
    const int sl = tid >> 4, dq = tid & 15;
    f32x4 acc[8];
#pragma unroll
    for (int q = 0; q < 8; ++q) acc[q] = (f32x4){0.f, 0.f, 0.f, 0.f};
#pragma unroll 4
    for (int kk = sl; kk < n; kk += 32) {
        f32x4 v = (f32x4){0.f, 0.f, 0.f, 0.f};
        if (PTR) { const float* kp = (const float*)(uintptr_t)rp[kk]; if (kp) v = *(const f32x4*)(kp + 128 + 4 * dq); }
        else v = *(const f32x4*)(vbase + (size_t)kk * 64 + 4 * dq);
#pragma unroll
        for (int q = 0; q < 8; ++q) acc[q] += sc[q * 1024 + kk] * v;
    }
#pragma unroll
    for (int q = 0; q < 8; ++q) *(LAS f32x4*)(opart + (sl * 8 + q) * 64 + 4 * dq) = acc[q];
}
__device__ __forceinline__ float smp_pv_reduce(const LAS float* opart, int hl, int d) {
    float s = 0.f;
#pragma unroll 8
    for (int k = 0; k < 32; ++k) s += opart[(k * 8 + hl) * 64 + d];
    return s;
}
__device__ __forceinline__ void attn_sample_unit(KP P, LAS unsigned char* lds, int sb, int g, int tid, int lane, int wave) {
    unsigned char* ws = P->ws;
    const bf16* Q = (const bf16*)(ws + WS_Q); const bf16* QR = (const bf16*)(ws + WS_QR); const float* GT = (const float*)(ws + WS_GT); bf16* O = (bf16*)(ws + WS_O);
    const float* KCS = (const float*)(ws + WS_KCS) + (size_t)(sb * NG + g) * 512 * 64; const float* VCS = (const float*)(ws + WS_VCS) + (size_t)(sb * NG + g) * 512 * 64;
    const float* cslc = (const float*)P->in[5]; const float* cwin = (const float*)P->in[6]; const int* pt = (const int*)P->in[10] + sb * NPG;
    LAS float* qn = (LAS float*)(lds + SM_QN); LAS float* qr = (LAS float*)(lds + SM_QR); LAS float* sc = (LAS float*)(lds + SM_SC); LAS float* imp = (LAS float*)(lds + SM_IMP);
    LAS int* sel = (LAS int*)(lds + SM_SEL); LAS unsigned long long* rp = (LAS unsigned long long*)(lds + SM_PTR); LAS float* opart = (LAS float*)(lds + SM_OP);
    const int mrow = MP + sb, hl = tid >> 6, d = tid & 63, h = g * HPG + hl;
    { const int e = 2 * (d & 31) + (d >> 5);
      qn[hl * 64 + d] = bf2f(Q[(size_t)mrow * DM + h * 64 + e]); qr[hl * 64 + d] = bf2f(QR[(size_t)mrow * DM + h * 64 + e]); }
    __syncthreads();
    smp_scores(KCS + (size_t)tid * 64, qn, sc, tid, tid < NCB_S);
    __syncthreads();
    smp_softmax(sc, 512, lane, wave);
    __syncthreads();
    smp_pv<false>(sc, rp, VCS, NCB_S, opart, tid);
    if (tid < NSB_S) { float v = 0.f; const int c0 = tid * 4 - 1;
        for (int c = (c0 < 0 ? 0 : c0); c <= c0 + 4 && c < NCB_S; ++c)
#pragma unroll
            for (int q = 0; q < 8; ++q) v += sc[q * 1024 + c];
        if (tid == 0 || tid == 127 || tid == 128) v = INFINITY;
        imp[tid] = v; }
    __syncthreads();
    const float oc = smp_pv_reduce(opart, hl, d);
    if (tid < NSB_S) { const float v = imp[tid]; int rank = 0;
        for (int i = 0; i < NSB_S; ++i) { const float x = imp[i]; rank += (x > v || (x == v && i < tid)) ? 1 : 0; }
        if (rank < 16) sel[rank] = tid; }
    __syncthreads();
#pragma unroll
    for (int q = 0; q < 2; ++q) { const int kk = tid + 512 * q, blk = sel[kk >> 6], pos = blk * 64 + (kk & 63);
        const float* kp = nullptr;
        if (pos < PAST) kp = cslc + ((size_t)pt[pos >> 7] * PGSZ + (pos & 127)) * 256 + g * 64;
        else if (pos == PAST) kp = P->out + O_SLC_S + (size_t)sb * 256 + g * 64;
        rp[kk] = (unsigned long long)(uintptr_t)kp;
        smp_scores(kp, qr, sc, kk, kp != nullptr); }
    __syncthreads();
    smp_softmax(sc, 1024, lane, wave);
    __syncthreads();
    smp_pv<true>(sc, rp, nullptr, 1024, opart, tid);
    __syncthreads();
    const float os = smp_pv_reduce(opart, hl, d);
    __syncthreads();
    { const float* kp = (tid < 511) ? cwin + ((size_t)sb * 512 + tid + 1) * 256 + g * 64 : P->out + O_WIN_S + ((size_t)sb * 512 + 511) * 256 + g * 64;
      rp[tid] = (unsigned long long)(uintptr_t)kp;
      smp_scores(kp, qr, sc, tid, true); }
    __syncthreads();
    smp_softmax(sc, 512, lane, wave);
    __syncthreads();
    smp_pv<true>(sc, rp, nullptr, 512, opart, tid);
    __syncthreads();
    const float ow = smp_pv_reduce(opart, hl, d);
    const float g0 = GT[(size_t)mrow * 48 + h * 3 + 0], g1 = GT[(size_t)mrow * 48 + h * 3 + 1], g2 = GT[(size_t)mrow * 48 + h * 3 + 2];
    O[(size_t)mrow * DM + h * 64 + d] = (bf16)f2bf(g0 * oc + g1 * os + g2 * ow);
    __syncthreads();
}

__device__ __forceinline__ void attn_phase(KP P, LAS unsigned char* lds, int qidx, int tid, int lane, int wave, int G) {
    unsigned* head = (unsigned*)(P->ws + WS_CTL) + 4096 + 64 * qidx;
    volatile LAS int* slot = (volatile LAS int*)(lds + LDS_MISC + 64);
    for (;;) {
        if (tid == 0) slot[0] = (int)__hip_atomic_fetch_add(head, 1u, __ATOMIC_RELAXED, __HIP_MEMORY_SCOPE_AGENT);
        __syncthreads();
        const int un = slot[0];
        __syncthreads();
        if (un >= 64 + 1024) break;
        if (un < 64) attn_sample_unit(P, lds, un >> 1, un & 1, tid, lane, wave);
        else { const int k = un - 64, bg = k & 7, tb = 127 - (k >> 3);
            attn_prompt_unit(P, lds, bg >> 1, bg & 1, tb * 32, tid, lane, wave); }
        __syncthreads();
    }
}

constexpr int NPHASES = 30;
#define DUPK(k) for (int dup_ = 0; dup_ < 1 + ((PROBE_DUP >> (k)) & 1); ++dup_)
#ifndef MK_MULTI
#define MK_MULTI 0
#endif
__global__ void __launch_bounds__(512, 2) mega(Params Pv) {
    extern __shared__ __attribute__((aligned(16))) unsigned char lds_raw[];
    LAS unsigned char* lds = (LAS unsigned char*)lds_raw;

    const KP Pk = (KP)__builtin_amdgcn_kernarg_segment_ptr();
    LAS float* rsb = (LAS float*)(lds + LDS_RS);
    int ph = 0, cur = 0;
    if (Pk->ph_hi - Pk->ph_lo > 1) {
        if (blockIdx.x == 0) { unsigned* ctl = (unsigned*)(Pk->ws + WS_CTL); for (int i = threadIdx.x; i < 8192; i += 512) ctl[i] = 0u; }
        if (threadIdx.x < 16) ((volatile LAS unsigned*)(lds + LDS_MISC))[threadIdx.x] = 0u;
        __syncthreads();
    }
#define RUN (ph >= Pk->ph_lo && ph < Pk->ph_hi)
#define FRESH const int tid = launder_v(threadIdx.x), lane = tid & 63, wave = __builtin_amdgcn_readfirstlane(tid >> 6), G = launder_s(gridDim.x), bid = launder_s(blockIdx.x); (void)lane; (void)wave; (void)bid
#define GRID_BAR do { if (ph == 0) { seam0_barrier(); (void)xcd_barrier_post((unsigned*)(Pk->ws + WS_CTL), (volatile LAS unsigned*)(lds + LDS_MISC) + 8); } else { XcdBarrier b_; b_.bar = (unsigned*)(launder(Pk)->ws + WS_CTL); b_.x = xb_xcc_id(); b_.st = (volatile LAS unsigned*)(lds + LDS_MISC) + 8; xcd_barrier(b_); } } while (0)
#define END_PHASE do { if (RUN && ph + 1 < Pk->ph_hi) { GRID_BAR; if ((PROBE_DUP >> 20) & 1) { if (ph > 0) GRID_BAR; } } ++ph; } while (0)
#define PSS_OF(ws_, c_) ((float*)((ws_) + WS_PSS) + (size_t)(c_) * 16 * MPAD)
#define GEMM_RS(EpiT_, AOFF, BOFF, N_, NTHIN_, K_, ...) GEMM_RS_B(0, EpiT_, AOFF, BOFF, N_, NTHIN_, K_, __VA_ARGS__)
#define GEMM_RS_B(REV_, EpiT_, AOFF, BOFF, N_, NTHIN_, K_, ...) do { const int tid = launder_v(threadIdx.x), G = launder_s(gridDim.x), bid = (REV_) ? G - 1 - launder_s(blockIdx.x) : launder_s(blockIdx.x); const KP P = launder(Pk); unsigned char* ws = P->ws; \
        pg8::Gemm g_{(const bf16*)(ws + (AOFF)), (const bf16*)(ws + (BOFF)), MP, (N_), (K_)}; pg8::StaticOrder S_; S_.init(MP, (N_), G, bid); \
        const int tcg_ = G - 1 - bid; const bool thin_ = tcg_ < (NTHIN_); \
        rs_prepare(S_, PSS_OF(ws, cur), (const float*)(ws + WS_SPSS) + cur * 2048, rsb, tid, thin_); EpiT_ E_{__VA_ARGS__}; \
          \
          \
        { const int tstr_ = ((NTHIN_) > G / 2 && (NTHIN_) < G && ((N_) / 256) * (MP / 256) % G == G / 2) ? G / 2 : G; \
          if (tcg_ < tstr_) for (int cg_ = tcg_; cg_ < (NTHIN_); cg_ += tstr_) { E_.slot = 7; thin_unit<(K_)>(lds, g_.A, g_.Bt, cg_, E_); } } E_.slot = 0; \
        pg8::gemm_phase<EpiT_, pg8::StaticOrder, true, true>(lds, g_, S_, E_); } while (0)
#define GEMM_RES(KIND, AOFF, BOFF, K_, SOFF) DUPK(KIND) { FRESH; const KP P = launder(Pk); unsigned char* ws = P->ws; \
        pg8::Gemm g_{(const bf16*)(ws + (AOFF)), (const bf16*)(ws + (BOFF)), MP, 1024, (K_)}; pg8::StaticOrder S_; S_.init(MP, 1024, G, bid); \
        EpiRes E_{ws, PSS_OF(ws, cur ^ 1), (SOFF), dup_ ? 0.0f : 1.0f, xb_off(L)}; \
        const int tcg_ = G - 1 - bid; if (tcg_ < 64) thin_unit<(K_)>(lds, g_.A, g_.Bt, tcg_, E_); \
        pg8::gemm_phase<EpiRes, pg8::StaticOrder, false, true>(lds, g_, S_, E_); }

    if (RUN) DUPK(0) { FRESH; phase0(launder(Pk), lds, tid, lane, wave, G); }
    END_PHASE;

#pragma unroll
    for (int L = 0; L < 4; ++L) {
        if (L < 2) {
            if (RUN) { GEMM_RS(EpiRG1, xb_off(L), WS_WIN + (size_t)L * 2560 * 1024 * 2, 2560, 160, 1024, ws, rsb, 0);
                if (L == 0) { FRESH; const KP P = launder(Pk); unsigned char* ws = P->ws; const int Gh = G >> 1;
                  pg8::Gemm g_{(const bf16*)(ws + WS_PB), (const bf16*)(ws + WS_WPI), 4 * MPAD, 4096, 256}; EpiPin E_{ws};
                  { PinOrder S_; S_.Lb = 0; S_.stride = 1;
                    if (G == 256) { if (bid < 128) { S_.start = bid; S_.count = 1; } else { S_.start = 128 + (bid - 128) * 3; S_.count = 3; } }
                    else { const int per = (512 + G - 1) / G; S_.start = bid * per; S_.count = per; }
                    pg8::gemm_phase<EpiPin, PinOrder, false, true>(lds, g_, S_, E_); }
                  if (bid < Gh) for (int q_ = bid; q_ < 128; q_ += Gh) { const int L_ = (q_ >> 6), cg_ = q_ & 63; E_.Lthin = L_; thin_unit<256>(lds, g_.A + (size_t)L_ * MPAD * 256, g_.Bt + (size_t)L_ * 1024 * 256, cg_, E_); } }
                if (L == 1) { FRESH; const KP P = launder(Pk); unsigned char* ws = P->ws;
                  if (G == 256 && bid >= 128) { constexpr int NCU_ = 2 * (CMP_ROWS / 256);
                    pg8::Gemm g_{(const bf16*)(ws + WS_CMPA), (const bf16*)(ws + WS_WC1), 2 * CMP_ROWS, 256, 1024}; CmpOrder S_{G, bid - 128, NCU_ - 128, NCU_}; EpiT E_{(bf16*)(ws + WS_T)};
                    pg8::gemm_phase<EpiT, CmpOrder, false, true>(lds, g_, S_, E_); } } }
            END_PHASE;
            if (RUN) DUPK(2) { FRESH; rg2_phase(launder(Pk), lds, L, tid, lane, wave, G); }
            END_PHASE;
            if (RUN) DUPK(3) { FRESH; rg3_phase(launder(Pk), lds, L, tid, G); }
            END_PHASE;
            if (RUN) GEMM_RES(13, WS_G, WS_WOUT + (size_t)L * 1024 * 1280 * 2, 1280, (size_t)0);
            END_PHASE; cur ^= 1;
        } else {
            const int j = L - 2;
            if (L == 2) {
                if (RUN) { GEMM_RS(EpiKV, xb_off(L), WS_WKV, NKV, 48, 1024, P->out, ws, rsb, 0);
                    GEMM_RS_B(1, EpiQ, xb_off(L), WS_WQG, NQGP, 67, 1024, ws, rsb, 0); }
                END_PHASE;
                if (RUN) DUPK(8) { FRESH; const KP P = launder(Pk); unsigned char* ws = P->ws;
                    constexpr int NCU_ = 2 * (CMP_ROWS / 256), NSV_ = 128;
                    const bool early_ = (G == 256);
                    pg8::Gemm g_{(const bf16*)(ws + WS_CMPA), (const bf16*)(ws + WS_WC1), 2 * CMP_ROWS, 256, 1024}; CmpOrder S_{G, bid, 0, early_ ? NCU_ - NSV_ : NCU_}; EpiT E_{(bf16*)(ws + WS_T)};
                    pg8::gemm_phase<EpiT, CmpOrder, false, true>(lds, g_, S_, E_);
                    { const int nb2 = 2 * (CMP_ROWS / 256) - G, nf = G - (nb2 > 0 ? nb2 : 0);
                      pg8::Gemm gp_{(const bf16*)(ws + WS_PB), (const bf16*)(ws + WS_WPI), 4 * MPAD, 4096, 256}; EpiPin Ep_{ws};
                      if (early_) {
                          PinOrder Sp_; Sp_.Lb = 2; Sp_.start = 0; Sp_.stride = 1; Sp_.count = 0;
                          if (bid >= NCU_ - NSV_) { Sp_.start = bid - (NCU_ - NSV_); Sp_.stride = G - (NCU_ - NSV_); Sp_.count = 4; }
                          else if (bid < 512 - 4 * (G - (NCU_ - NSV_))) { Sp_.start = 4 * (G - (NCU_ - NSV_)) + bid; Sp_.count = 1; }
                          pg8::gemm_phase<EpiPin, PinOrder, false, true>(lds, gp_, Sp_, Ep_); }
                      else if (nf > 0 && bid >= G - nf) { PinOrder Sp_; Sp_.Lb = 2; Sp_.start = bid - (G - nf); Sp_.stride = nf; Sp_.count = (512 + nf - 1) / nf;
                          pg8::gemm_phase<EpiPin, PinOrder, false, true>(lds, gp_, Sp_, Ep_); }
                      else if (nf <= 0) { PinOrder Sp_; Sp_.Lb = 2; Sp_.start = bid; Sp_.stride = G; Sp_.count = (512 + G - 1) / G; pg8::gemm_phase<EpiPin, PinOrder, false, true>(lds, gp_, Sp_, Ep_); }
                      for (int q_ = bid; q_ < 128; q_ += G) { const int L_ = 2 + (q_ >> 6), cg_ = q_ & 63; Ep_.Lthin = L_; thin_unit<256>(lds, gp_.A + (size_t)L_ * MPAD * 256, gp_.Bt + (size_t)L_ * 1024 * 256, cg_, Ep_); } } }
                END_PHASE;
                if (RUN) DUPK(9) { FRESH; cmp2_phase(launder(Pk), lds, tid, lane, wave, G); }
                END_PHASE;
            }
            if (L == 3) { if (RUN) DUPK(10) GEMM_RS(EpiQ, xb_off(L), WS_WQG + (size_t)j * NQGP * 1024 * 2, NQGP, 67, 1024, ws, rsb, 0);
            END_PHASE; }
            if (RUN) DUPK(11) { FRESH; attn_phase(launder(Pk), lds, j + 2 * dup_, tid, lane, wave, G); }
            END_PHASE;
            if (RUN) GEMM_RES(16, WS_O, WS_WO + (size_t)j * 1024 * 1024 * 2, 1024, (size_t)0);
            END_PHASE; cur ^= 1;
        }
        if (RUN) DUPK(4) { FRESH; const KP P = launder(Pk); unsigned char* ws = P->ws;
            pg8::Gemm g_{(const bf16*)(ws + xb_off(L)), (const bf16*)(ws + WS_WUP + (size_t)L * 6144 * 1024 * 2), MP, DFF2, 1024}; pg8::StaticOrder S_; S_.init(MP, DFF2, G, bid);
            const int tpg_ = G - 1 - bid; const bool thin_ = tpg_ < 192;
            rs_prepare(S_, PSS_OF(ws, cur), (const float*)(ws + WS_SPSS) + cur * 2048, rsb, tid, thin_);
            const float* cw_ = (const float*)P->in[33] + (size_t)L * 3 * DFF2; const float* cb_ = (const float*)P->in[34] + (size_t)L * DFF2;
            EpiUp E_{ws, rsb, P->out, cw_, cb_, (LAS float*)(lds + LDS_HALO), L, 0};
            if (thin_) thin_unit_up(lds, g_.A, g_.Bt, tpg_, ws, rsb + 7 * 256, P->out, cw_, cb_, (const float*)P->in[9], L);
            pg8::gemm_phase<EpiUp, pg8::StaticOrder, true, true>(lds, g_, S_, E_); }
        END_PHASE;
        if (RUN) DUPK(14) { FRESH; const KP P = launder(Pk); unsigned char* ws = P->ws;
            pg8::Gemm g_{(const bf16*)(ws + WS_ACT), (const bf16*)(ws + WS_WDN + (size_t)L * 1024 * 3072 * 2), MP, 1024, 3072}; pg8::StaticOrder S_; S_.init(MP, 1024, G, bid);
            { pg8::Unit u_; for (int i_ = 0; S_.next(i_, u_); ++i_) act_fixup(ws, (const float*)P->in[33] + (size_t)L * 3 * DFF2, (const float*)P->in[34] + (size_t)L * DFF2, u_.pm, tid); }
            asm volatile("s_waitcnt vmcnt(0)" ::: "memory"); __syncthreads();
            EpiRes E_{ws, PSS_OF(ws, cur ^ 1), (size_t)0, dup_ ? 0.0f : 1.0f, xb_off(L)};
            const int tcg_ = G - 1 - bid; if (tcg_ < 64) thin_unit<3072>(lds, g_.A, g_.Bt, tcg_, E_);
            pg8::gemm_phase<EpiRes, pg8::StaticOrder, false, true>(lds, g_, S_, E_); }
        END_PHASE; cur ^= 1;
        if (RUN) GEMM_RS(EpiGate, xb_off(L), WS_WPG + (size_t)L * 1024 * 1024 * 2, 1024, 64, 1024, ws, rsb, PSS_OF(ws, cur ^ 1), WS_PIN + (size_t)L * MPAD * DM * 2, xb_off(L), xb_off(L + 1), 0);
        END_PHASE; cur ^= 1;
    }
    if (RUN) DUPK(12) { FRESH; const KP P = launder(Pk); final_phase(P, PSS_OF(P->ws, cur), (const float*)(P->ws + WS_SPSS) + cur * 2048, lane, wave, G); }
    END_PHASE;
}

extern "C" void kernel_launch(void* const* d_in, const int* in_sizes, int n_in, void* d_out, int out_size, void* d_ws, size_t ws_size, hipStream_t stream) {
    static int grid = 0;
    if (grid == 0) {
        if (n_in != 38 || (size_t)out_size != O_END || ws_size < WS_END) { fprintf(stderr, "kernel_launch: unexpected problem: n_in %d out %d ws %zu (need %zu)\n", n_in, out_size, ws_size, (size_t)WS_END); grid = -1; return; }
        int dev = 0, cus = 0, per_cu = 0;
        (void)hipGetDevice(&dev); (void)hipDeviceGetAttribute(&cus, hipDeviceAttributeMultiprocessorCount, dev);
        if (hipFuncSetAttribute((const void*)mega, hipFuncAttributeMaxDynamicSharedMemorySize, LDS_BYTES) != hipSuccess) { fprintf(stderr, "kernel_launch: hipFuncSetAttribute failed\n"); grid = -1; return; }
        if (hipOccupancyMaxActiveBlocksPerMultiprocessor(&per_cu, (const void*)mega, 512, LDS_BYTES) != hipSuccess || per_cu < 1) { fprintf(stderr, "kernel_launch: occupancy query says %d\n", per_cu); per_cu = 1; }
        (void)hipGetLastError();
        grid = cus;
        if (grid > 256) grid = 256;
    }
    if (grid < 0) return;
    Params p{};
    for (int i = 0; i < 38; ++i) p.in[i] = d_in[i];
    p.out = (float*)d_out; p.ws = (unsigned char*)d_ws;
#if MK_MULTI
    for (int ph = 0; ph < NPHASES; ++ph) { p.ph_lo = ph; p.ph_hi = ph + 1; hipLaunchKernelGGL(mega, dim3(grid), dim3(512), LDS_BYTES, stream, p); }
#else
    p.ph_lo = 0; p.ph_hi = NPHASES;
    void* args[] = {&p};
    hipError_t e = hipLaunchCooperativeKernel((const void*)mega, dim3(grid), dim3(512), args, LDS_BYTES, stream);
    if (e != hipSuccess) fprintf(stderr, "kernel_launch: cooperative launch failed: %s (grid %d)\n", hipGetErrorString(e), grid);
#endif
}
```

```cpp
#include <hip/hip_runtime.h>
#include <hip/hip_cooperative_groups.h>
#include <cstdio>
#include <cstdint>
#include <cmath>
namespace cg = cooperative_groups;
#ifndef PROBE_DUP
#define PROBE_DUP 0
#endif


#define LAS __attribute__((address_space(3)))
#define GAS __attribute__((address_space(1)))
typedef unsigned short bf16;
typedef short bf16x8 __attribute__((ext_vector_type(8)));
typedef float f32x4 __attribute__((ext_vector_type(4)));
typedef float f32x2 __attribute__((ext_vector_type(2)));
typedef float f32x16 __attribute__((ext_vector_type(16)));
typedef unsigned u32x4 __attribute__((ext_vector_type(4)));
typedef unsigned u32x2 __attribute__((ext_vector_type(2)));

constexpr int DM = 1024, SEQ = 4096, NB = 4, MP = NB * SEQ, MS = 32, MTOT = MP + MS, MPAD = 16640, NMT = MPAD / 256;
constexpr int DRNN = 1280, DFF = 3072, DFF2 = 6144, DPLE = 256, NRGB = 16, RGB = 80;
constexpr int PAST = 8192, NPG = 64, PGSZ = 128, HD = 64, NH = 16, NG = 2, HPG = 8;
constexpr int NCB_P = 255, NCB_S = 511, NSB_S = 129;
constexpr int NQG = 1072, NQGP = 1280, NKV = 768;
constexpr float EPS = 1e-6f;
constexpr float C2 = 0.125f * 1.4426950408889634f;
constexpr int CMP_ROWS_P = NG * NB * 256, CMP_ROWS_S = NG * MS * 512, CMP_ROWS = CMP_ROWS_P + CMP_ROWS_S;

constexpr size_t O_Y_P = 0;
constexpr size_t O_Y_S = O_Y_P + (size_t)MP * DM;
constexpr size_t O_CMP_P = O_Y_S + (size_t)MS * DM;
constexpr size_t O_CMP_S = O_CMP_P + (size_t)MP * 256;
constexpr size_t O_SLC_P = O_CMP_S + (size_t)MS * 256;
constexpr size_t O_SLC_S = O_SLC_P + (size_t)MP * 256;
constexpr size_t O_WIN_P = O_SLC_S + (size_t)MS * 256;
constexpr size_t O_WIN_S = O_WIN_P + (size_t)NB * 512 * 256;
constexpr size_t O_RGC_P = O_WIN_S + (size_t)MS * 512 * 256;
constexpr size_t O_RGC_S = O_RGC_P + (size_t)2 * NB * 3 * DRNN;
constexpr size_t O_RGH_P = O_RGC_S + (size_t)2 * MS * 3 * DRNN;
constexpr size_t O_RGH_S = O_RGH_P + (size_t)2 * NB * DRNN;
constexpr size_t O_FFC_P = O_RGH_S + (size_t)2 * MS * DRNN;
constexpr size_t O_FFC_S = O_FFC_P + (size_t)4 * NB * 2 * DFF2;
constexpr size_t O_END = O_FFC_S + (size_t)4 * MS * 2 * DFF2;
static_assert(O_END == 32071680, "d_out size");

constexpr size_t al256(size_t x) { return (x + 255) & ~(size_t)255; }
constexpr size_t WS_CTL = 0;
constexpr size_t WS_WIN = WS_CTL + 65536;
constexpr size_t WS_WOUT = WS_WIN + (size_t)2 * 2560 * 1024 * 2;
constexpr size_t WS_WUP = WS_WOUT + (size_t)2 * 1024 * 1280 * 2;
constexpr size_t WS_WDN = WS_WUP + (size_t)4 * 6144 * 1024 * 2;
constexpr size_t WS_WPI = WS_WDN + (size_t)4 * 1024 * 3072 * 2;
constexpr size_t WS_WPG = WS_WPI + (size_t)4 * 1024 * 256 * 2;
constexpr size_t WS_WKV = WS_WPG + (size_t)4 * 1024 * 1024 * 2;
constexpr size_t WS_WQG = WS_WKV + (size_t)768 * 1024 * 2;
constexpr size_t WS_WO = WS_WQG + (size_t)2 * 1280 * 1024 * 2;
constexpr size_t WS_WC1 = WS_WO + (size_t)2 * 1024 * 1024 * 2;
constexpr size_t WS_WGA = WS_WC1 + (size_t)2 * 256 * 1024 * 2;
constexpr size_t WS_B1F = al256(WS_WGA + (size_t)2 * 2 * 16 * 80 * 96 * 2);
constexpr size_t WS_ROPE = al256(WS_B1F + 32 * 2 * 128 * 4);
constexpr size_t WS_PSS = al256(WS_ROPE + (size_t)4097 * 64 * 4);
constexpr size_t WS_X = al256(WS_PSS + (size_t)2 * 16 * MPAD * 4);
constexpr size_t WS_XB = WS_X + (size_t)MPAD * 1024 * 4;
__host__ __device__ constexpr size_t xb_off(int L) { return (L & 1) ? WS_X : WS_XB; }
constexpr size_t WS_PB = WS_XB + (size_t)MPAD * 1024 * 2;
constexpr size_t WS_Y = WS_PB + (size_t)4 * MPAD * 256 * 2;
constexpr size_t WS_G = WS_Y + (size_t)MPAD * 1280 * 2;
constexpr size_t WS_S = WS_G + (size_t)MPAD * 1280 * 2;
constexpr size_t WS_Q = WS_S + (size_t)MPAD * 1024 * 2;
constexpr size_t WS_QR = WS_Q + (size_t)MPAD * 1024 * 2;
constexpr size_t WS_O = WS_QR + (size_t)MPAD * 1024 * 2;
constexpr size_t WS_GT = WS_O + (size_t)MPAD * 1024 * 2;
constexpr size_t WS_KS = al256(WS_GT + (size_t)MPAD * 48 * 4);
constexpr size_t WS_VTS = WS_KS + (size_t)NB * NG * SEQ * 64 * 2;
constexpr size_t WS_KW = WS_VTS + (size_t)NB * NG * SEQ * 64 * 2;
constexpr size_t WS_VTW = WS_KW + (size_t)NB * NG * SEQ * 64 * 2;
constexpr size_t WS_KC = WS_VTW + (size_t)NB * NG * SEQ * 64 * 2;
constexpr size_t WS_VCT = WS_KC + (size_t)NB * NG * 256 * 64 * 2;
constexpr size_t WS_KCS = WS_VCT + (size_t)NB * NG * 256 * 64 * 2;
constexpr size_t WS_VCS = WS_KCS + (size_t)MS * NG * 512 * 64 * 4;
constexpr size_t WS_CMPA = WS_VCS + (size_t)MS * NG * 512 * 64 * 4;
constexpr size_t WS_T = WS_CMPA + (size_t)2 * CMP_ROWS * 1024 * 2;
constexpr size_t WS_BIG = WS_T + (size_t)2 * CMP_ROWS * 256 * 4;
constexpr size_t WS_XR = WS_BIG;
constexpr size_t WS_HL = WS_XR + (size_t)MPAD * 1280 * 4;
constexpr size_t WS_AC = WS_HL + (size_t)MPAD * 1280 * 4;
constexpr size_t WS_UP = WS_BIG;
constexpr size_t WS_ACT = WS_UP + (size_t)MPAD * 6144 * 2;
constexpr size_t WS_UPH = WS_ACT + (size_t)MPAD * 3072 * 2;
constexpr size_t WS_PIN = WS_UPH + (size_t)64 * 4 * 6144 * 4;
constexpr size_t WS_STASH = WS_PIN + (size_t)4 * MPAD * 1024 * 2;
constexpr size_t WS_SPSS = WS_STASH + (size_t)256 * 8 * 2048 * 4;
constexpr size_t WS_END_A = WS_AC + (size_t)MPAD * 1280 * 4, WS_END_B = WS_SPSS + (size_t)2 * 64 * 32 * 4;
constexpr size_t WS_END = WS_END_A > WS_END_B ? WS_END_A : WS_END_B;
static_assert(WS_END < (size_t)1300 * 1024 * 1024, "workspace budget");

constexpr int LDS_RING = 0, LDS_RING_BYTES = 131072;
constexpr int LDS_RS = LDS_RING_BYTES;
constexpr int LDS_MISC = 163840 - 256;
constexpr int LDS_HALO = LDS_RS + 8 * 1024;
constexpr int LDS_BYTES = 163840;

struct Params { const void* in[38]; float* out; unsigned char* ws; int ph_lo, ph_hi; };
typedef const __attribute__((address_space(4))) Params* KP;
__device__ __forceinline__ KP launder(KP p) { asm volatile("" : "+s"(p)); return p; }
__device__ __forceinline__ int launder_v(int x) { asm volatile("" : "+v"(x)); return x; }
__device__ __forceinline__ int launder_s(int x) { asm volatile("" : "+s"(x)); return x; }

__device__ __forceinline__ unsigned f2bf(float f) { unsigned u = __builtin_bit_cast(unsigned, f); return (u + 0x7fffu + ((u >> 16) & 1u)) >> 16; }
typedef __bf16 bf16x2_t __attribute__((ext_vector_type(2)));
__device__ __forceinline__ unsigned pk2(float lo, float hi) { const f32x2 v = {lo, hi}; return __builtin_bit_cast(unsigned, __builtin_convertvector(v, bf16x2_t)); }
__device__ __forceinline__ f32x4 unpack4(u32x2 w);
__device__ __forceinline__ void unpack8(u32x4 w, f32x4& lo, f32x4& hi) { lo = unpack4((u32x2){w.x, w.y}); hi = unpack4((u32x2){w.z, w.w}); }
__device__ __forceinline__ f32x4 unpack4(u32x2 w) { f32x4 v; v[0] = __builtin_bit_cast(float, w.x << 16); v[1] = __builtin_bit_cast(float, w.x & 0xffff0000u); v[2] = __builtin_bit_cast(float, w.y << 16); v[3] = __builtin_bit_cast(float, w.y & 0xffff0000u); return v; }
__device__ __forceinline__ float bf2f(unsigned short b) { return __builtin_bit_cast(float, ((unsigned)b) << 16); }
__device__ __forceinline__ float gelu_tanh(float x) {
    const float u = 0.7978845608028654f * (x + 0.044715f * x * x * x);
    return x * __builtin_amdgcn_rcpf(1.0f + __expf(-2.0f * u));
}
__device__ __forceinline__ float sigmoidf_(float x) { return __builtin_amdgcn_rcpf(1.0f + __expf(-x)); }
__device__ __forceinline__ float wave_sum(float v) {
#pragma unroll
    for (int o = 1; o < 64; o <<= 1) v += __shfl_xor(v, o);
    return v;
}
namespace pg8 {
#define PG8_LAS __attribute__((address_space(3)))
typedef unsigned short bf16_t;
typedef short bf16x8 __attribute__((ext_vector_type(8)));
typedef float f32x4 __attribute__((ext_vector_type(4)));
typedef unsigned u32x4 __attribute__((ext_vector_type(4)));
constexpr int BM = 256, BK = 64, HALF = 128, HTB = HALF * BK * 2  , STAGE_BYTES = 8 * HTB, NXCD = 8, WGM = 8;

__host__ __device__ __forceinline__ int lds_byte(int r, int c) { const int st = (r >> 4) * 2 + (c >> 5), rr = r & 15, cc = c & 31, ob = rr * 64 + cc * 2; return st * 1024 + (ob ^ (((ob >> 9) & 1) << 5)); }
__host__ __device__ __forceinline__ void stage_rc(int b, int& R, int& C) { const int st = b / 1024, sb = b % 1024, swz = sb ^ (((sb >> 9) & 1) << 5); R = (st >> 1) * 16 + swz / 64; C = (st & 1) * 32 + (swz % 64) / 2; }
__host__ __device__ __forceinline__ int perm32(int rho) { const int n = rho >> 4, i = rho & 15; return 8 * (i >> 2) + 4 * n + (i & 3); }

struct Unit { int pm, pn; };
struct Gemm { const bf16_t* A; const bf16_t* Bt; int M, N, K; };

struct StaticOrder {
    int nM, nN, nwg, G, c;
    __host__ __device__ __forceinline__ void init(int M, int N, int G_, int c_) { nM = M / BM; nN = N / BM; nwg = nM * nN; G = G_; c = c_; }
    __host__ __device__ __forceinline__ bool next(int i, Unit& u) const {
        const long L = (long)i * G + c; if (L >= nwg) return false;
        int wgid = (int)L; { const int q = nwg / NXCD, r = nwg % NXCD, xcd = wgid % NXCD, off = wgid / NXCD; wgid = (xcd < r ? xcd * (q + 1) : r * (q + 1) + (xcd - r) * q) + off; }
        const int nig = WGM * nN, gid = wgid / nig, fm = gid * WGM, gsz = (nM - fm) < WGM ? (nM - fm) : WGM;
        u.pm = fm + ((wgid % nig) % gsz); u.pn = (wgid % nig) / gsz; return true;
    }
    __device__ __forceinline__ void a_ready(const Unit&) const {}
    __device__ __forceinline__ void done(const Unit&) const {}
};
__device__ __forceinline__ unsigned cvt_pk_bf16(float lo, float hi) { unsigned r; asm volatile("v_cvt_pk_bf16_f32 %0, %1, %2" : "=v"(r) : "v"(lo), "v"(hi)); return r; }
typedef float f32x2 __attribute__((ext_vector_type(2)));
template <class Epi, class Sched, bool ALIGN_EPI = false, bool SP2 = false>
__device__ __forceinline__ void gemm_phase(PG8_LAS unsigned char* lds, const Gemm g, const Sched& S, const Epi& E) {
    int tid = threadIdx.x; asm volatile("" : "+v"(tid));
    const int wid = __builtin_amdgcn_readfirstlane(tid >> 6), lane = tid & 63, wr = wid >> 2, wc = wid & 3, fr = lane & 15, fq = lane >> 4;
    const int K = g.K, nt = K / BK;
    unsigned voffA[2], voffB[2];
#pragma unroll
    for (int i = 0; i < 2; ++i) { int R, C; stage_rc(tid * 16 + i * 8192, R, C); const int Rb = Epi::PERM ? ((R & ~31) + perm32(R & 31)) : R;
        voffA[i] = (unsigned)(R * K + C) * 2u; voffB[i] = (unsigned)(Rb * K + C) * 2u; }
    const size_t kstep = (size_t)(BK * 2);
    const size_t hstep = (size_t)HALF * K * 2;
    const size_t tstep = 2 * hstep;
    const unsigned ldsw = (unsigned)wid * 1024u;
    const int aoff = lds_byte(wr * 64 + fr, fq * 8), boff = lds_byte(wc * 32 + fr, fq * 8);
#define PG8_SA(b, h) (((b) * 2 + (h)) * HTB)
#define PG8_SB(b, h) ((4 + (b) * 2 + (h)) * HTB)
#define PG8_STAGE(bufoff, gbase, voff) do { _Pragma("unroll") for (int _i = 0; _i < 2; ++_i) \
        __builtin_amdgcn_global_load_lds((const unsigned*)((const char*)(gbase) + (voff)[_i]), (PG8_LAS unsigned*)(lds + (bufoff) + ldsw + _i * 8192), 16, 0, 0); } while (0)
#define PG8_LDA(dst, b, h) do { _Pragma("unroll") for (int m = 0; m < 4; ++m) _Pragma("unroll") for (int k = 0; k < 2; ++k) dst[m][k] = *(const PG8_LAS bf16x8*)(lds + PG8_SA(b, h) + aoff + m * 2048 + k * 1024); } while (0)
#define PG8_LDB(dst, b, h) do { _Pragma("unroll") for (int n = 0; n < 2; ++n) _Pragma("unroll") for (int k = 0; k < 2; ++k) dst[n][k] = *(const PG8_LAS bf16x8*)(lds + PG8_SB(b, h) + boff + n * 2048 + k * 1024); } while (0)
#define PG8_MMA(ai, bj, At, Bt) do { __builtin_amdgcn_s_setprio(1); _Pragma("unroll") for (int m = 0; m < 4; ++m) _Pragma("unroll") for (int n = 0; n < 2; ++n) _Pragma("unroll") for (int k = 0; k < 2; ++k) \
        acc[ai][bj][m][n] = __builtin_amdgcn_mfma_f32_16x16x32_bf16(Bt[n][k], At[m][k], acc[ai][bj][m][n], 0, 0, 0); __builtin_amdgcn_s_setprio(0); } while (0)
#define PG8_WAIT_V(n) asm volatile("s_waitcnt vmcnt(" #n ")" ::: "memory")
#define PG8_WAIT_L(n) asm volatile("s_waitcnt lgkmcnt(" #n ")" ::: "memory")
#define PG8_BAR __builtin_amdgcn_s_barrier()
#define PG8_SCHED __builtin_amdgcn_sched_barrier(0)
    Unit cur, nxt; int ui = 0;
    if (!S.next(0, cur)) return;
    f32x4 acc[2][2][4][2];
#pragma unroll
    for (int a = 0; a < 2; ++a)
#pragma unroll
        for (int b = 0; b < 2; ++b)
#pragma unroll
            for (int m = 0; m < 4; ++m)
#pragma unroll
                for (int n = 0; n < 2; ++n) acc[a][b][m][n] = (f32x4){0.f, 0.f, 0.f, 0.f};
    bf16x8 At[4][2], B0[2][2], B1[2][2];
    const char* cA = (const char*)g.A + (size_t)cur.pm * tstep; const char* cB = (const char*)g.Bt + (size_t)cur.pn * tstep;
    S.a_ready(cur);
    if constexpr (SP2) {
        PG8_STAGE(PG8_SB(0, 0), cB, voffB); PG8_STAGE(PG8_SB(0, 1), cB + hstep, voffB); PG8_STAGE(PG8_SA(0, 0), cA, voffA); PG8_STAGE(PG8_SA(0, 1), cA + hstep, voffA);
        if (wr == 1) PG8_BAR;
        PG8_WAIT_V(2); PG8_BAR;
        PG8_STAGE(PG8_SB(1, 0), cB + kstep, voffB); PG8_STAGE(PG8_SA(1, 0), cA + kstep, voffA); PG8_STAGE(PG8_SB(1, 1), cB + hstep + kstep, voffB);
        PG8_WAIT_V(6); PG8_BAR;
    } else {
        PG8_STAGE(PG8_SB(0, 0), cB, voffB); PG8_STAGE(PG8_SA(0, 0), cA, voffA); PG8_STAGE(PG8_SB(0, 1), cB + hstep, voffB); PG8_STAGE(PG8_SA(0, 1), cA + hstep, voffA);
        if (wr == 1) PG8_BAR;
        PG8_WAIT_V(4); PG8_BAR;
        PG8_STAGE(PG8_SB(1, 0), cB + kstep, voffB); PG8_STAGE(PG8_SA(1, 0), cA + kstep, voffA); PG8_STAGE(PG8_SB(1, 1), cB + hstep + kstep, voffB);
        PG8_WAIT_V(6); PG8_BAR;
    }
    for (;;) {
        const bool has_next = S.next(ui + 1, nxt);
        const char* nA = has_next ? (const char*)g.A + (size_t)nxt.pm * tstep : cA; const char* nB = has_next ? (const char*)g.Bt + (size_t)nxt.pn * tstep : cB;
        for (int t = 0; t < nt; t += 2) {
            const bool last = (t == nt - 2);
            const char* a1 = cA + (size_t)(t + 1) * kstep;
            const char* a2 = last ? nA : cA + (size_t)(t + 2) * kstep; const char* b2 = last ? nB : cB + (size_t)(t + 2) * kstep;
            const char* a3 = a2 + kstep; const char* b3 = b2 + kstep;
            if (last && has_next) S.a_ready(nxt);
            if constexpr (SP2) {
            PG8_LDB(B0, 0, 0); PG8_LDB(B1, 0, 1); PG8_SCHED; PG8_LDA(At, 0, 0); PG8_STAGE(PG8_SA(1, 1), a1 + hstep, voffA);
            PG8_WAIT_V(8); PG8_WAIT_L(0); PG8_BAR; PG8_MMA(0, 0, At, B0); PG8_MMA(0, 1, At, B1); PG8_BAR; PG8_SCHED;
            PG8_LDA(At, 0, 1); PG8_STAGE(PG8_SB(0, 0), b2, voffB); PG8_STAGE(PG8_SB(0, 1), b2 + hstep, voffB); PG8_STAGE(PG8_SA(0, 0), a2, voffA);
            PG8_WAIT_V(8); PG8_WAIT_L(0); PG8_BAR; PG8_MMA(1, 0, At, B0); PG8_MMA(1, 1, At, B1); PG8_BAR; PG8_SCHED;
            PG8_LDB(B0, 1, 0); PG8_LDB(B1, 1, 1); PG8_SCHED; PG8_LDA(At, 1, 0); PG8_STAGE(PG8_SA(0, 1), a2 + hstep, voffA);
            PG8_WAIT_V(8); PG8_WAIT_L(0); PG8_BAR; PG8_MMA(0, 0, At, B0); PG8_MMA(0, 1, At, B1); PG8_BAR; PG8_SCHED;
            PG8_LDA(At, 1, 1); PG8_STAGE(PG8_SB(1, 0), b3, voffB); PG8_STAGE(PG8_SB(1, 1), b3 + hstep, voffB); PG8_STAGE(PG8_SA(1, 0), a3, voffA);
            PG8_WAIT_V(8); PG8_WAIT_L(0); PG8_BAR; PG8_MMA(1, 0, At, B0); PG8_MMA(1, 1, At, B1); PG8_BAR; PG8_SCHED;
            } else {
            PG8_LDB(B0, 0, 0); PG8_SCHED; PG8_LDA(At, 0, 0); PG8_STAGE(PG8_SA(1, 1), a1 + hstep, voffA);
            PG8_WAIT_L(8); PG8_BAR; PG8_WAIT_L(0); PG8_MMA(0, 0, At, B0); PG8_BAR; PG8_SCHED;
            PG8_LDB(B1, 0, 1); PG8_STAGE(PG8_SB(0, 0), b2, voffB);
            PG8_BAR; PG8_WAIT_L(0); PG8_MMA(0, 1, At, B1); PG8_BAR;
            PG8_LDA(At, 0, 1); PG8_STAGE(PG8_SA(0, 0), a2, voffA);
            PG8_BAR; PG8_WAIT_L(0); PG8_MMA(1, 0, At, B0); PG8_BAR; PG8_SCHED;
            PG8_STAGE(PG8_SB(0, 1), b2 + hstep, voffB);
            PG8_WAIT_V(6); PG8_BAR; PG8_MMA(1, 1, At, B1); PG8_BAR;
            PG8_LDB(B0, 1, 0); PG8_SCHED; PG8_LDA(At, 1, 0); PG8_STAGE(PG8_SA(0, 1), a2 + hstep, voffA);
            PG8_WAIT_L(8); PG8_BAR; PG8_WAIT_L(0); PG8_MMA(0, 0, At, B0); PG8_BAR; PG8_SCHED;
            PG8_LDB(B1, 1, 1); PG8_STAGE(PG8_SB(1, 0), b3, voffB);
            PG8_BAR; PG8_WAIT_L(0); PG8_MMA(0, 1, At, B1); PG8_BAR;
            PG8_LDA(At, 1, 1); PG8_STAGE(PG8_SA(1, 0), a3, voffA);
            PG8_BAR; PG8_WAIT_L(0); PG8_MMA(1, 0, At, B0); PG8_BAR; PG8_SCHED;
            PG8_STAGE(PG8_SB(1, 1), b3 + hstep, voffB);
            PG8_WAIT_V(6); PG8_BAR; PG8_MMA(1, 1, At, B1); PG8_BAR;
            }
        }
        if constexpr (ALIGN_EPI) { if (wr == 0) PG8_BAR; }
        if constexpr (!Epi::AFTER_DRAIN) { E(acc, cur, wr, wc, fr, fq); S.done(cur); }
        if (!has_next) break;
#pragma unroll
        for (int a = 0; a < 2; ++a)
#pragma unroll
            for (int b = 0; b < 2; ++b)
#pragma unroll
                for (int m = 0; m < 4; ++m)
#pragma unroll
                    for (int n = 0; n < 2; ++n) acc[a][b][m][n] = (f32x4){0.f, 0.f, 0.f, 0.f};
        cur = nxt; cA = nA; cB = nB; ++ui;
        if constexpr (ALIGN_EPI) { if (wr == 1) PG8_BAR; }
    }
    PG8_WAIT_V(0);
    if constexpr (!ALIGN_EPI) { if (wr == 0) PG8_BAR; }
    PG8_BAR;
    if constexpr (Epi::AFTER_DRAIN) { E.fused(acc, cur, wr, wc, fr, fq, lds, wid, lane); S.done(cur); }
#undef PG8_SA
#undef PG8_SB
#undef PG8_STAGE
#undef PG8_LDA
#undef PG8_LDB
#undef PG8_MMA
#undef PG8_WAIT_V
#undef PG8_WAIT_L
#undef PG8_BAR
#undef PG8_SCHED
}
}
#define XB_TMO      128
#define XB_XCNT(j)  (256  + 64 * (j))
#define XB_XSUB(j)  (1280 + 64 * (j))
#define XB_XGEN(j)  (2304 + 64 * (j))
#define XB_TOP      3328
#define XB_TOPGEN   3392
#define XCD_BAR_WORDS 3456
#define XB_SPIN_CAP (1u << 18)

__device__ __forceinline__ unsigned xb_ld(unsigned* p)              { return __hip_atomic_load(p, __ATOMIC_RELAXED, __HIP_MEMORY_SCOPE_AGENT); }
__device__ __forceinline__ unsigned xb_add(unsigned* p, unsigned v) { return __hip_atomic_fetch_add(p, v, __ATOMIC_RELAXED, __HIP_MEMORY_SCOPE_AGENT); }
__device__ __forceinline__ unsigned xb_xcc_id() { return (unsigned)__builtin_amdgcn_s_getreg((3 << 11) | 20) & 0xFu; }
#define XB_SPIN(cond, bar) do { unsigned _sp = 0; while (cond) { __builtin_amdgcn_s_sleep(1); \
    if ((++_sp & 255u) == 0u) { if (xb_ld(&(bar)[XB_TMO])) break; if (_sp > XB_SPIN_CAP) { atomicAdd(&(bar)[XB_TMO], 1u); break; } } } } while (0)

struct XcdBarrier {
    unsigned* bar; unsigned x;
    volatile LAS unsigned* st;
};

__device__ __forceinline__ XcdBarrier xcd_barrier_post(unsigned* bar, volatile LAS unsigned* st) {
    XcdBarrier b; b.bar = bar; b.x = xb_xcc_id(); b.st = st;
    if (threadIdx.x == 0) (void)xb_add(&bar[XB_XCNT(b.x)], 1u);
    return b;
}
__device__ __forceinline__ void xcd_barrier_complete(unsigned* bar, unsigned x, unsigned& nloc, unsigned& nx) {
    const unsigned G = gridDim.x * gridDim.y * gridDim.z;
    unsigned sum, cnt, mine, sp = 0u;
    for (;;) {
        sum = 0u; cnt = 0u; mine = 0u;
#pragma unroll
        for (unsigned j = 0; j < 16; ++j) { const unsigned c = xb_ld(&bar[XB_XCNT(j)]); sum += c; cnt += (c > 0u) ? 1u : 0u; mine = (j == x) ? c : mine; }
        if (sum == G) break;
        __builtin_amdgcn_s_sleep(1);
        if ((++sp & 255u) == 0u) { if (xb_ld(&bar[XB_TMO])) break; if (sp > XB_SPIN_CAP) { atomicAdd(&bar[XB_TMO], 1u); break; } }
    }
    nloc = mine > 0u ? mine : 1u; nx = cnt > 0u ? cnt : 1u;
}

__device__ __forceinline__ void xcd_barrier(const XcdBarrier& b) {
    asm volatile("s_waitcnt vmcnt(0)" ::: "memory");
    __syncthreads();
    if (threadIdx.x == 0) {
        unsigned* bar = b.bar;
        __builtin_amdgcn_s_waitcnt(0);
        unsigned nloc = b.st[0], nx = b.st[1];
        if (nloc == 0u) { xcd_barrier_complete(bar, b.x, nloc, nx); b.st[0] = nloc; b.st[1] = nx; }
        const unsigned old = xb_add(&bar[XB_XSUB(b.x)], 1u);
        const unsigned gen = old / nloc;
        if (old + 1u == (gen + 1u) * nloc) {
            __builtin_amdgcn_fence(__ATOMIC_RELEASE, "agent");
            asm volatile("s_waitcnt vmcnt(0)" ::: "memory");
            const unsigned og = xb_add(&bar[XB_TOP], 1u);
            const unsigned tg = og / nx;
            if (og + 1u == (tg + 1u) * nx) xb_add(&bar[XB_TOPGEN], 1u);
            else XB_SPIN(xb_ld(&bar[XB_TOPGEN]) == tg, bar);
            __builtin_amdgcn_fence(__ATOMIC_ACQUIRE, "agent");
            xb_add(&bar[XB_XGEN(b.x)], 1u);
            asm volatile("s_waitcnt vmcnt(0)" ::: "memory");
        } else {
            XB_SPIN(xb_ld(&bar[XB_XGEN(b.x)]) == gen, bar);
            __builtin_amdgcn_fence(__ATOMIC_ACQUIRE, "agent");
            asm volatile("s_waitcnt vmcnt(0)" ::: "memory");
        }
    }
    __syncthreads();
}


__device__ unsigned g_seam0[10 * 64];
__device__ __forceinline__ void seam0_barrier() {
    asm volatile("s_waitcnt vmcnt(0)" ::: "memory");
    __syncthreads();
    if (threadIdx.x == 0) {
        __builtin_amdgcn_fence(__ATOMIC_RELEASE, "agent");
        asm volatile("s_waitcnt vmcnt(0)" ::: "memory");
        const unsigned G = gridDim.x, s = blockIdx.x & 7u, ns = (G - s + 7u) >> 3, nsh = G < 8u ? G : 8u;
        const unsigned old = xb_add(&g_seam0[s * 64], 1u);
        const unsigned round = old / ns;
        if (old + 1u == (round + 1u) * ns) {
            const unsigned o2 = xb_add(&g_seam0[8 * 64], 1u);
            if ((o2 + 1u) % nsh == 0u) xb_add(&g_seam0[9 * 64], 1u);
        }
        unsigned sp = 0u;
        while ((int)(xb_ld(&g_seam0[9 * 64]) - (round + 1u)) < 0) { __builtin_amdgcn_s_sleep(2); if (++sp > (1u << 24)) break; }
        __builtin_amdgcn_fence(__ATOMIC_ACQUIRE, "agent");
        asm volatile("s_waitcnt vmcnt(0)" ::: "memory");
    }
    __syncthreads();
}
__device__ __forceinline__ int rowmap(int mode, int nn) {
    const int il = (nn & ~63) + 2 * (nn & 31) + ((nn >> 5) & 1);
    if (mode == 1) return nn < 1024 ? il : nn;
    if (mode == 2) { const int j = nn >> 7; return (j == 2 || j == 4) ? il : nn; }
    if (mode == 3) { const int half = nn >= DFF ? 1 : 0, ka = nn - half * DFF; return (ka >> 7) * 256 + half * 128 + (ka & 127); }
    return nn;
}
__device__ __forceinline__ void tr_item(const float* __restrict__ W, int ldn, int Nsrc, bf16* __restrict__ WT, int dstK, const float* __restrict__ gain, int mode, int item, int nblk,
                                        LAS float* scr, int lane) {
    const int kb = item / nblk, nb = item % nblk, k0 = 64 * kb, n0 = 32 * nb;
    const int n = n0 + (lane & 31);
    float wv[32];
#pragma unroll
    for (int i = 0; i < 32; ++i) { const int kk = 2 * i + (lane >> 5); wv[i] = (n < Nsrc) ? W[(size_t)(k0 + kk) * ldn + n] : 0.f; }
#pragma unroll
    for (int i = 0; i < 32; ++i) { const int kk = 2 * i + (lane >> 5); float v = wv[i]; if (gain) v *= gain[k0 + kk]; scr[kk * 33 + (lane & 31)] = v; }
    asm volatile("s_waitcnt lgkmcnt(0)" ::: "memory");
    const int c = lane & 7;
#pragma unroll
    for (int j = 0; j < 4; ++j) {
        const int nl = (lane >> 3) + 8 * j; const LAS float* s = scr + (8 * c) * 33 + nl;
        u32x4 o; o.x = pk2(s[0 * 33], s[1 * 33]); o.y = pk2(s[2 * 33], s[3 * 33]); o.z = pk2(s[4 * 33], s[5 * 33]); o.w = pk2(s[6 * 33], s[7 * 33]);
        const int row = rowmap(mode, n0 + nl);
        *(u32x4*)(WT + (size_t)row * dstK + k0 + 8 * c) = o;
    }
    asm volatile("s_waitcnt lgkmcnt(0)" ::: "memory");
}

__device__ __forceinline__ void phase0(KP P, LAS unsigned char* lds, int tid, int lane, int wave, int G) {
    unsigned char* ws = P->ws;
    const int gw = launder_s(blockIdx.x) * 8 + wave, NGW = G * 8;
    const size_t gt = (size_t)launder_s(blockIdx.x) * 512 + tid, NGT = (size_t)G * 512;
    LAS float* scr = (LAS float*)(lds + wave * 16384);
    {
        const float* g_mix = (const float*)P->in[11]; const float* g_ffn = (const float*)P->in[12]; const float* g_ple = (const float*)P->in[13];
        constexpr int C_WIN = 16 * 80, C_WOUT = 20 * 32, C_WUP = 16 * 192, C_WDN = 48 * 32, C_WPI = 4 * 32, C_WPG = 16 * 32, C_WKV = 16 * 24, C_WQG = 16 * 40, C_WO = 16 * 32, C_WC1 = 16 * 4;
        constexpr int NITEMS = 2 * C_WIN + 2 * C_WOUT + 4 * C_WUP + 4 * C_WDN + 4 * C_WPI + 4 * C_WPG + C_WKV + 2 * C_WQG + 2 * C_WO + 4 * C_WC1;
        for (int it = gw; it < NITEMS; it += NGW) {
            int r = it;
            if (r < 2 * C_WIN) { const int L = r / C_WIN; r %= C_WIN;
                tr_item((const float*)P->in[15] + (size_t)L * 1024 * 2560, 2560, 2560, (bf16*)(ws + WS_WIN) + (size_t)L * 2560 * 1024, 1024, g_mix + L * 1024, 0, r, 80, scr, lane); continue; }
            r -= 2 * C_WIN;
            if (r < 2 * C_WOUT) { const int L = r / C_WOUT; r %= C_WOUT;
                tr_item((const float*)P->in[23] + (size_t)L * 1280 * 1024, 1024, 1024, (bf16*)(ws + WS_WOUT) + (size_t)L * 1024 * 1280, 1280, nullptr, 0, r, 32, scr, lane); continue; }
            r -= 2 * C_WOUT;
            if (r < 4 * C_WUP) { const int L = r / C_WUP; r %= C_WUP;
                tr_item((const float*)P->in[32] + (size_t)L * 1024 * 6144, 6144, 6144, (bf16*)(ws + WS_WUP) + (size_t)L * 6144 * 1024, 1024, g_ffn + L * 1024, 3, r, 192, scr, lane); continue; }
            r -= 4 * C_WUP;
            if (r < 4 * C_WDN) { const int L = r / C_WDN; r %= C_WDN;
                tr_item((const float*)P->in[35] + (size_t)L * 3072 * 1024, 1024, 1024, (bf16*)(ws + WS_WDN) + (size_t)L * 1024 * 3072, 3072, nullptr, 0, r, 32, scr, lane); continue; }
            r -= 4 * C_WDN;
            if (r < 4 * C_WPI) { const int L = r / C_WPI; r %= C_WPI;
                tr_item((const float*)P->in[36] + (size_t)L * 256 * 1024, 1024, 1024, (bf16*)(ws + WS_WPI) + (size_t)L * 1024 * 256, 256, nullptr, 0, r, 32, scr, lane); continue; }
            r -= 4 * C_WPI;
            if (r < 4 * C_WPG) { const int L = r / C_WPG; r %= C_WPG;
                tr_item((const float*)P->in[37] + (size_t)L * 1024 * 1024, 1024, 1024, (bf16*)(ws + WS_WPG) + (size_t)L * 1024 * 1024, 1024, g_ple + L * 1024, 0, r, 32, scr, lane); continue; }
            r -= 4 * C_WPG;
            if (r < C_WKV) { tr_item((const float*)P->in[25], 768, 768, (bf16*)(ws + WS_WKV), 1024, (const float*)P->in[24], 2, r, 24, scr, lane); continue; }
            r -= C_WKV;
            if (r < 2 * C_WQG) { const int L = r / C_WQG; r %= C_WQG;
                tr_item((const float*)P->in[30] + (size_t)L * 1024 * NQG, NQG, NQG, (bf16*)(ws + WS_WQG) + (size_t)L * NQGP * 1024, 1024, g_mix + (2 + L) * 1024, 1, r, 40, scr, lane); continue; }
            r -= 2 * C_WQG;
            if (r < 2 * C_WO) { const int L = r / C_WO; r %= C_WO;
                tr_item((const float*)P->in[31] + (size_t)L * 1024 * 1024, 1024, 1024, (bf16*)(ws + WS_WO) + (size_t)L * 1024 * 1024, 1024, nullptr, 0, r, 32, scr, lane); continue; }
            r -= 2 * C_WO;
            { const int q = r / C_WC1; r %= C_WC1; const int j = q >> 1, half = q & 1;
                tr_item((const float*)P->in[27] + (size_t)j * 2048 * 128 + (size_t)half * 1024 * 128, 128, 128, (bf16*)(ws + WS_WC1) + (size_t)j * 256 * 1024 + (size_t)half * 128 * 1024, 1024, nullptr, 0, r, 4, scr, lane); }
        }
    }
    {
        bf16* XB = (bf16*)(ws + WS_XB); bf16* XB1 = (bf16*)(ws + WS_X); float* PSS = (float*)(ws + WS_PSS);
        for (int m0 = gw; m0 < MPAD; m0 += 2 * NGW) {
          f32x4 vv[2][4];
#pragma unroll
          for (int q = 0; q < 2; ++q) { const int m = m0 + q * NGW;
            const float* src = m < MP ? (const float*)P->in[0] + (size_t)m * 1024 : (const float*)P->in[1] + (size_t)(m - MP) * 1024;
#pragma unroll
            for (int j = 0; j < 4; ++j) { vv[q][j] = (f32x4){0.f, 0.f, 0.f, 0.f}; if (m < MTOT) vv[q][j] = *(const f32x4*)(src + 4 * lane + 256 * j); } }
#pragma unroll
          for (int q = 0; q < 2; ++q) { const int m = m0 + q * NGW; if (m >= MPAD) break;
            float ss = 0.f;
#pragma unroll
            for (int j = 0; j < 4; ++j) {
                f32x4 v = vv[q][j];
                u32x2 w; w.x = pk2(v[0], v[1]); w.y = pk2(v[2], v[3]);
                *(u32x2*)(XB + (size_t)m * 1024 + 4 * lane + 256 * j) = w;
                if (m >= MTOT) *(u32x2*)(XB1 + (size_t)m * 1024 + 4 * lane + 256 * j) = w;
                v = unpack4(w);
                ss += (v[0] * v[0] + v[1] * v[1]) + (v[2] * v[2] + v[3] * v[3]);
            }
            ss = wave_sum(ss);
            if (lane < 16) PSS[(size_t)lane * MPAD + m] = (lane == 0) ? ss : 0.f;
            if (m >= MP && m < MTOT) ((float*)(ws + WS_SPSS))[lane * 32 + (m - MP)] = (lane == 0) ? ss : 0.f;
          }
        }
    }
    {
        bf16* PB = (bf16*)(ws + WS_PB);
        for (size_t i0 = gt; i0 < (size_t)4 * MPAD * 64; i0 += 8 * NGT) {
            f32x4 v[8];
#pragma unroll
            for (int q = 0; q < 8; ++q) { const size_t i = i0 + q * NGT; v[q] = (f32x4){0.f, 0.f, 0.f, 0.f};
                if (i < (size_t)4 * MPAD * 64) { const int c4 = (int)(i & 63); const size_t rm = i >> 6; const int m = (int)(rm % MPAD), L = (int)(rm / MPAD);
                    if (m < MP) v[q] = *(const f32x4*)((const float*)P->in[2] + ((size_t)L * MP + m) * 256 + 4 * c4);
                    else if (m < MTOT) v[q] = *(const f32x4*)((const float*)P->in[3] + ((size_t)L * MS + (m - MP)) * 256 + 4 * c4); } }
#pragma unroll
            for (int q = 0; q < 8; ++q) { const size_t i = i0 + q * NGT;
                if (i < (size_t)4 * MPAD * 64) { u32x2 w; w.x = pk2(v[q][0], v[q][1]); w.y = pk2(v[q][2], v[q][3]); *(u32x2*)(PB + i * 4) = w; } }
        }
    }
    {
        const float* cache = (const float*)P->in[4]; const int* pt = (const int*)P->in[10]; bf16* CA = (bf16*)(ws + WS_CMPA);
        for (int item = launder_s(blockIdx.x); item < MS * NPG; item += G) {
            const int sb = item / NPG, pg = item % NPG;
            const float* src = cache + (size_t)pt[item] * (PGSZ * 256);
            static_assert(PGSZ * 64 == 16 * 512, "page = 16 float4 per thread");
#pragma unroll
            for (int hb = 0; hb < 2; ++hb) {
                f32x4 v[8];
#pragma unroll
                for (int q = 0; q < 8; ++q) v[q] = __builtin_nontemporal_load((const f32x4*)(src + (size_t)(tid + 512 * (8 * hb + q)) * 4));
#pragma unroll
                for (int q = 0; q < 8; ++q) { const int c = tid + 512 * (8 * hb + q);
                    const int f = c * 4, tl = f >> 8, rem = f & 255, j = rem >> 7, g = (rem >> 6) & 1, d = rem & 63;
                    u32x2 w; w.x = pk2(v[q][0], v[q][1]); w.y = pk2(v[q][2], v[q][3]);
                    const size_t row = (size_t)CMP_ROWS_P + (size_t)(g * MS + sb) * 512 + pg * 8 + (tl >> 4);
                    *(u32x2*)(CA + ((size_t)j * CMP_ROWS + row) * 1024 + (tl & 15) * 64 + d) = w; }
            }
        }
    }
    {
        float* RT = (float*)(ws + WS_ROPE);
        for (size_t i = gt; i < (size_t)4097 * 32; i += NGT) {
            const int fi = (int)(i & 31), pi = (int)(i >> 5); const int pos = pi < 4096 ? pi : PAST;
            double f = 1.0; for (int k = 0; k < fi; ++k) f *= 0.7498942093324559;
            const float ang = (float)pos * (float)f;
            const double x = (double)ang; const double kq = __builtin_rint(x * 0.6366197723675814);
            const double r = (x - kq * 1.5707963267948966) - kq * 6.123233995736766e-17, r2 = r * r;
            const double sn = r * (1.0 + r2 * (-1.0 / 6 + r2 * (1.0 / 120 + r2 * (-1.0 / 5040 + r2 * (1.0 / 362880 + r2 * (-1.0 / 39916800 + r2 * (1.0 / 6227020800.0)))))));
            const double cs = 1.0 + r2 * (-0.5 + r2 * (1.0 / 24 + r2 * (-1.0 / 720 + r2 * (1.0 / 40320 + r2 * (-1.0 / 3628800 + r2 * (1.0 / 479001600.0 + r2 * (-1.0 / 87178291200.0)))))));
            const int q = ((int)kq) & 3;
            const double s_ = (q == 0) ? sn : (q == 1) ? cs : (q == 2) ? -sn : -cs;
            const double c_ = (q == 0) ? cs : (q == 1) ? -sn : (q == 2) ? -cs : sn;
            RT[i * 2] = (float)c_; RT[i * 2 + 1] = (float)s_;
        }
    }
    {
        float* B1P = (float*)(ws + WS_B1F); const float* pos = (const float*)P->in[26]; const float* w1 = (const float*)P->in[27];
        for (size_t i = gt; i < (size_t)32 * 2 * 128; i += NGT) {
            const int e = (int)(i & 127), j = (int)((i >> 7) & 1), l = (int)(i >> 8);
            float s = 0.f;
#pragma unroll 16
            for (int d = 0; d < 64; ++d) s += pos[(l * 2 + j) * 64 + d] * w1[((size_t)j * 2048 + l * 64 + d) * 128 + e];
            B1P[i] = s;
        }
    }
    {
        bf16* WG = (bf16*)(ws + WS_WGA);
        for (size_t i = gt; i < (size_t)2 * 2 * 16 * 80 * 96; i += NGT) {
            const int k = (int)(i % 96); size_t r = i / 96; const int j = (int)(r % 80); r /= 80; const int n = (int)(r % 16); r /= 16; const int ax = (int)(r & 1), L = (int)(r >> 1);
            const float* src = (const float*)P->in[ax ? 20 : 18];
            const float v = k < 80 ? src[(((size_t)L * 16 + n) * 80 + k) * 80 + j] : 0.f;
            WG[i] = (bf16)f2bf(v);
        }
    }
    {
        const float* cw = (const float*)P->in[6]; float* o = P->out + O_WIN_S;
        for (size_t i0 = gt; i0 < (size_t)MS * 511 * 64; i0 += 4 * NGT) {
            f32x4 v[4];
#pragma unroll
            for (int q = 0; q < 4; ++q) { const size_t i = i0 + q * NGT; v[q] = (f32x4){0.f, 0.f, 0.f, 0.f};
                if (i < (size_t)MS * 511 * 64) { const int c4 = (int)(i & 63); const size_t rw = i >> 6; const int w = (int)(rw % 511), sb = (int)(rw / 511);
                    v[q] = *(const f32x4*)(cw + ((size_t)sb * 512 + w + 1) * 256 + 4 * c4); } }
#pragma unroll
            for (int q = 0; q < 4; ++q) { const size_t i = i0 + q * NGT;
                if (i < (size_t)MS * 511 * 64) { const int c4 = (int)(i & 63); const size_t rw = i >> 6; const int w = (int)(rw % 511), sb = (int)(rw / 511);
                    *(f32x4*)(o + ((size_t)sb * 512 + w) * 256 + 4 * c4) = v[q]; } }
        }
    }
}

#define EPI_FOR_ROWS _Pragma("unroll") for (int ai = 0; ai < 2; ++ai) _Pragma("unroll") for (int m = 0; m < 4; ++m)
#define EPI_FOR_COLS _Pragma("unroll") for (int bj = 0; bj < 2; ++bj) _Pragma("unroll") for (int n = 0; n < 2; ++n) if (only < 0 || only == bj * 2 + n)
#define EPI_ROWL (ai * 128 + wr * 64 + m * 16 + fr)
#define EPI_COLL (bj * 128 + wc * 32 + n * 16 + 4 * fq)
typedef const f32x4 (&AccRef)[2][2][4][2];

__device__ __forceinline__ u32x2 pack4(f32x4 v) { u32x2 w; w.x = pk2(v[0], v[1]); w.y = pk2(v[2], v[3]); return w; }

__device__ __forceinline__ void rs_sample(const float* SP, LAS float* dst, int tid) {
    const int row = tid >> 4, part = tid & 15; float s = 0.f;
#pragma unroll
    for (int i = 0; i < 4; ++i) s += SP[(part * 4 + i) * 32 + row];
    s += __shfl_xor(s, 1); s += __shfl_xor(s, 2); s += __shfl_xor(s, 4); s += __shfl_xor(s, 8);
    if (part == 0) dst[row] = rsqrtf(s * (1.0f / 1024.0f) + EPS);
}
template <class Sched> __device__ __forceinline__ void rs_prepare(const Sched& S, const float* PSScur, const float* X, LAS float* rsb, int tid, bool thin) {
    pg8::Unit u;
    for (int i = 0; i < 7 && S.next(i, u); ++i) {
        if (tid < 256) { const int mrow = u.pm * 256 + tid; float s = 0.f;
#pragma unroll
            for (int k = 0; k < 16; ++k) s += PSScur[(size_t)k * MPAD + mrow];
            rsb[i * 256 + tid] = rsqrtf(s * (1.0f / 1024.0f) + EPS); }
    }
    if (thin) rs_sample(X, rsb + 7 * 256, tid);
    __syncthreads();
}
template <class E> __device__ __forceinline__ auto warm_call(const E& e, int fr, int fq, int cg, int) -> decltype(e.warm(fr, fq, cg)) { return e.warm(fr, fq, cg); }
template <class E> __device__ __forceinline__ float warm_call(const E&, int, int, int, long) { return 0.f; }
template <class E> __device__ __forceinline__ auto thin_epi(const E& e, f32x4 s0, f32x4 s1, int cg, int fr, int fq, int) -> decltype(e.thin(s0, s1, cg, fr, fq), true) { e.thin(s0, s1, cg, fr, fq); return true; }
template <class E> __device__ __forceinline__ bool thin_epi(const E&, f32x4, f32x4, int, int, int, long) { return false; }
template <int K, class Epi> __device__ __forceinline__ void thin_unit(LAS unsigned char* lds, const bf16* __restrict__ A, const bf16* __restrict__ Bt, int cg, const Epi& E) {
    int tid = threadIdx.x; asm volatile("" : "+v"(tid));
    const int wid = __builtin_amdgcn_readfirstlane(tid >> 6), lane = tid & 63, fr = lane & 15, fq = lane >> 4;
    f32x4 c0 = (f32x4){0.f, 0.f, 0.f, 0.f}, c1 = c0;
    float warm = 0.f; if (wid == 0) warm = warm_call(E, fr, fq, cg, 0);
    const bf16* ap = A + (size_t)(MP + fr) * K + fq * 8;
    const bf16* bp = Bt + (size_t)(cg * 16 + fr) * K + fq * 8;
    constexpr int NI = (K / 32) / 8;
    static_assert((K / 32) % 8 == 0, "thin unit K");
    bf16x8 bb[NI], aa0[NI], aa1[NI];
#pragma unroll
    for (int i = 0; i < NI; ++i) { const int ks = wid + 8 * i; bb[i] = *(const bf16x8*)(bp + ks * 32); aa0[i] = *(const bf16x8*)(ap + ks * 32); aa1[i] = *(const bf16x8*)(ap + (size_t)16 * K + ks * 32); }
#pragma unroll
    for (int i = 0; i < NI; ++i) { c0 = __builtin_amdgcn_mfma_f32_16x16x32_bf16(bb[i], aa0[i], c0, 0, 0, 0); c1 = __builtin_amdgcn_mfma_f32_16x16x32_bf16(bb[i], aa1[i], c1, 0, 0, 0); }
    LAS f32x4* red = (LAS f32x4*)lds;
    red[(wid * 2 + 0) * 64 + lane] = c0; red[(wid * 2 + 1) * 64 + lane] = c1;
    asm volatile("" :: "v"(warm));
    __syncthreads();
    if (wid == 0) {
        f32x4 s0 = red[lane], s1 = red[64 + lane];
#pragma unroll
        for (int w = 1; w < 8; ++w) { s0 += red[(w * 2) * 64 + lane]; s1 += red[(w * 2 + 1) * 64 + lane]; }
      if (!thin_epi(E, s0, s1, cg, fr, fq, 0)) {
        f32x4 acc[2][2][4][2];
        const float z_ = __builtin_bit_cast(float, launder_v(0));
#pragma unroll
        for (int a = 0; a < 2; ++a)
#pragma unroll
            for (int b = 0; b < 2; ++b)
#pragma unroll
                for (int m = 0; m < 4; ++m)
#pragma unroll
                    for (int n = 0; n < 2; ++n) acc[a][b][m][n] = (f32x4){z_, z_, z_, z_};
        const int bj = (cg >> 3) & 1, n = cg & 1;
#pragma unroll
        for (int b = 0; b < 2; ++b)
#pragma unroll
            for (int nn = 0; nn < 2; ++nn) if (b == bj && nn == n) { acc[0][b][0][nn] = s0; acc[0][b][1][nn] = s1; }
        pg8::Unit u; u.pm = MP / 256; u.pn = cg >> 4;
        E.only = bj * 2 + n;
        E(acc, u, 0, (cg >> 1) & 3, fr, fq);
        E.only = -1;
      }
    }
    __syncthreads();
}

struct EpiRG1 {
    static constexpr bool PERM = false, AFTER_DRAIN = false;
    unsigned char* ws; const LAS float* rs; mutable int slot; mutable int only = -1;
    __device__ __forceinline__ void operator()(AccRef acc, const pg8::Unit& u, int wr, int wc, int fr, int fq) const {
        fr = launder_v(fr); fq = launder_v(fq);
        const LAS float* rsl = rs + slot * 256; ++slot;
        bf16* Y = (bf16*)(ws + WS_Y); bf16* XR = (bf16*)(ws + WS_XR);
        EPI_FOR_ROWS { const int rl = EPI_ROWL, row = u.pm * 256 + rl; const float r = rsl[rl];
            EPI_FOR_COLS { const int col = u.pn * 256 + EPI_COLL; f32x4 v = acc[ai][bj][m][n] * r;
                if (row < MTOT) { if (u.pn < 5) { v[0] = gelu_tanh(v[0]); v[1] = gelu_tanh(v[1]); v[2] = gelu_tanh(v[2]); v[3] = gelu_tanh(v[3]); *(u32x2*)(Y + (size_t)row * DRNN + col) = pack4(v); }
                else *(u32x2*)(XR + (size_t)row * DRNN + (col - DRNN)) = pack4(v); } } }
    }
};
struct EpiRes {
    static constexpr bool PERM = false, AFTER_DRAIN = false;
    unsigned char* ws; float* PSSn; size_t soff; float scale; size_t xoff; mutable int only = -1;
    __device__ __forceinline__ float warm(int fr, int fq, int cg) const {
        const bf16* XB = (const bf16*)(ws + xoff); const size_t o0 = (size_t)(MP + fr) * DM + cg * 16 + 4 * fq, o1 = o0 + (size_t)16 * DM;
        float w = bf2f(XB[o0]) + bf2f(XB[o1]);
        if (soff) { const bf16* S = (const bf16*)(ws + soff); w += bf2f(S[o0]) + bf2f(S[o1]); }
        return w; }
    __device__ __forceinline__ void thin(f32x4 s0, f32x4 s1, int cg, int fr, int fq) const {
        bf16* XB = (bf16*)(ws + xoff); const bf16* S = soff ? (const bf16*)(ws + soff) : nullptr;
        const int nx = (int)((PSSn - (float*)(ws + WS_PSS)) / (16 * MPAD));
#pragma unroll
        for (int m = 0; m < 2; ++m) { const size_t o = (size_t)(MP + 16 * m + fr) * DM + cg * 16 + 4 * fq; f32x4 a = (m ? s1 : s0) * scale;
            if (S) a *= unpack4(*(const u32x2*)(S + o));
            const u32x2 xw = pack4(unpack4(*(const u32x2*)(XB + o)) + a); const f32x4 x = unpack4(xw);
            *(u32x2*)(XB + o) = xw;
            float ssq = (x[0] * x[0] + x[1] * x[1]) + (x[2] * x[2] + x[3] * x[3]);
            ssq += __shfl_xor(ssq, 16); ssq += __shfl_xor(ssq, 32);
            if (fq == 0) ((float*)(ws + WS_SPSS))[nx * 2048 + cg * 32 + 16 * m + fr] = ssq; }
    }
    __device__ __forceinline__ void operator()(AccRef acc, const pg8::Unit& u, int wr, int wc, int fr, int fq) const {
        fr = launder_v(fr); fq = launder_v(fq);
        bf16* XB = (bf16*)(ws + xoff); const bf16* S = soff ? (const bf16*)(ws + soff) : nullptr;
#pragma unroll
        for (int ai = 0; ai < 2; ++ai) {
#pragma unroll
          for (int mh = 0; mh < 2; ++mh) {
            u32x2 xv[4][2][2];
#pragma unroll
            for (int m = 2 * mh; m < 2 * mh + 2; ++m) { const int row = u.pm * 256 + EPI_ROWL;
                EPI_FOR_COLS { const int col = u.pn * 256 + EPI_COLL; if (row < MTOT) xv[m][bj][n] = *(const u32x2*)(XB + (size_t)row * DM + col); } }
#pragma unroll
            for (int m = 2 * mh; m < 2 * mh + 2; ++m) { const int rl = EPI_ROWL, row = u.pm * 256 + rl; float ssq = 0.f;
                EPI_FOR_COLS { const int col = u.pn * 256 + EPI_COLL; f32x4 a = acc[ai][bj][m][n] * scale;
                    if (row < MTOT) {
                    if (S) { const u32x2 sw = *(const u32x2*)(S + (size_t)row * DM + col);
                        a[0] *= __builtin_bit_cast(float, sw.x << 16); a[1] *= __builtin_bit_cast(float, sw.x & 0xffff0000u); a[2] *= __builtin_bit_cast(float, sw.y << 16); a[3] *= __builtin_bit_cast(float, sw.y & 0xffff0000u); }
                    const u32x2 xw = pack4(unpack4(xv[m][bj][n]) + a); const f32x4 x = unpack4(xw);
                    *(u32x2*)(XB + (size_t)row * DM + col) = xw;
                    ssq += (x[0] * x[0] + x[1] * x[1]) + (x[2] * x[2] + x[3] * x[3]); } }
                ssq += __shfl_xor(ssq, 16); ssq += __shfl_xor(ssq, 32);
                if (fq == 0) { if (row < MP) PSSn[(size_t)(u.pn * 4 + wc) * MPAD + row] = ssq;
                    else if (only >= 0 && row < MTOT) { const int nx = (int)((PSSn - (float*)(ws + WS_PSS)) / (16 * MPAD));
                        ((float*)(ws + WS_SPSS))[nx * 2048 + (u.pn * 16 + (only >> 1) * 8 + wc * 2 + (only & 1)) * 32 + (row - MP)] = ssq; } } }
          }
        }
    }
};
template <int CTRL> __device__ __forceinline__ float dppf(float x) { return __builtin_bit_cast(float, __builtin_amdgcn_update_dpp(0, __builtin_bit_cast(int, x), CTRL, 0xf, 0xf, true)); }
#define DPPF(src, ctrl) dppf<ctrl>(src)
template <int CTRL> __device__ __forceinline__ float dppf_old(float old, float x) { return __builtin_bit_cast(float, __builtin_amdgcn_update_dpp(__builtin_bit_cast(int, old), __builtin_bit_cast(int, x), CTRL, 0xf, 0xf, false)); }
struct EpiUp {
    static constexpr bool PERM = false, AFTER_DRAIN = false;
    unsigned char* ws; const LAS float* rs; float* out; const float* cw; const float* cb; LAS float* halo; int L; mutable int slot; mutable int only = -1;
    __device__ __forceinline__ void operator()(AccRef acc, const pg8::Unit& u, int wr, int wc, int fr, int fq) const {
        fr = launder_v(fr); fq = launder_v(fq);
        const LAS float* rsl = rs + slot * 256; ++slot;
        bf16* ACT = (bf16*)(ws + WS_ACT); float* UPH = (float*)(ws + WS_UPH) + (size_t)u.pm * 4 * DFF2 + u.pn * 256;
#pragma unroll
        for (int ai = 0; ai < 2; ++ai) { const int band = ai * 2 + wr; const float r3 = rsl[ai * 128 + wr * 64 + 48 + fr], r0 = rsl[ai * 128 + wr * 64 + fr];
#pragma unroll
            for (int bj = 0; bj < 2; ++bj)
#pragma unroll
                for (int n = 0; n < 2; ++n) { const int ci = bj * 128 + wc * 32 + n * 16 + 4 * fq;
                    if (fr >= 14) { const f32x4 v = acc[ai][bj][3][n] * r3; *(LAS f32x4*)(halo + (band * 2 + (fr - 14)) * 256 + ci) = v;
                        if (band == 3) *(f32x4*)(UPH + (size_t)(2 + fr - 14) * DFF2 + ci) = v; }
                    if (band == 0 && fr < 2) *(f32x4*)(UPH + (size_t)fr * DFF2 + ci) = acc[0][bj][0][n] * r0; } }
        asm volatile("s_waitcnt lgkmcnt(0)" ::: "memory"); __builtin_amdgcn_s_barrier(); asm volatile("" ::: "memory");
        const int b = u.pm >> 4; const bool last_tile = (u.pm & 15) == 15, first_tile = (u.pm & 15) == 0;
#pragma unroll
        for (int n = 0; n < 2; ++n) {
            const int ci = wc * 32 + n * 16 + 4 * fq, lca = u.pn * 128 + ci;
            f32x4 w[2][3], bs[2];
#pragma unroll
            for (int bj = 0; bj < 2; ++bj) { bs[bj] = *(const f32x4*)(cb + bj * DFF + lca);
#pragma unroll
                for (int k = 0; k < 3; ++k) w[bj][k] = *(const f32x4*)(cw + k * DFF2 + bj * DFF + lca); }
#pragma unroll
            for (int ai = 0; ai < 2; ++ai) {
                const int band = ai * 2 + wr;
                f32x4 s[4][2];
#pragma unroll
                for (int m = 0; m < 4; ++m) { const float r = rsl[ai * 128 + wr * 64 + m * 16 + fr]; s[m][0] = acc[ai][0][m][n] * r; s[m][1] = acc[ai][1][m][n] * r; }
#pragma unroll
                for (int m = 0; m < 4; ++m) {
                    const int rl = ai * 128 + wr * 64 + m * 16 + fr, row = u.pm * 256 + rl;
                    f32x4 uc[2];
#pragma unroll
                    for (int bj = 0; bj < 2; ++bj) {
                        f32x4 p1, p2;
                        if (m > 0) {
#pragma unroll
                            for (int e = 0; e < 4; ++e) { const float cur_ = s[m][bj][e], prv_ = s[m - 1][bj][e];
                                p1[e] = dppf_old<0x111>(dppf<0x121>(prv_), cur_); p2[e] = dppf_old<0x112>(dppf<0x122>(prv_), cur_); }
                        } else {
                            f32x4 h0 = (f32x4){0.f, 0.f, 0.f, 0.f}, h1 = h0;
                            if (band > 0) { h0 = *(const LAS f32x4*)(halo + ((band - 1) * 2 + 0) * 256 + bj * 128 + ci); h1 = *(const LAS f32x4*)(halo + ((band - 1) * 2 + 1) * 256 + bj * 128 + ci); }
#pragma unroll
                            for (int e = 0; e < 4; ++e) { const float cur_ = s[0][bj][e], h0_ = h0[e], h1_ = h1[e];
                                p1[e] = dppf_old<0x111>(h1_, cur_); p2[e] = dppf_old<0x112>((fr == 0) ? h0_ : h1_, cur_); }
                        }
                        uc[bj] = bs[bj] + w[bj][0] * p2 + w[bj][1] * p1 + w[bj][2] * s[m][bj];
                    }
                    f32x4 a;
#pragma unroll
                    for (int e = 0; e < 4; ++e) a[e] = gelu_tanh(uc[0][e]) * uc[1][e];
                    if (first_tile || rl >= 2) *(u32x2*)(ACT + (size_t)row * DFF + lca) = pack4(a);
                    if (last_tile && rl >= 254) {
                        float* o = out + O_FFC_P + ((size_t)(L * NB + b) * 2 + (rl - 254)) * DFF2 + lca;
                        *(f32x4*)o = s[m][0]; *(f32x4*)(o + DFF) = s[m][1]; }
                }
            }
        }
    }
};
__device__ __forceinline__ void act_fixup(unsigned char* ws, const float* cw, const float* cb, int pm, int tid) {
    if ((pm & 15) == 0) return;
    const float* own = (const float*)(ws + WS_UPH) + (size_t)pm * 4 * DFF2; const float* prv = own - (size_t)4 * DFF2; bf16* ACT = (bf16*)(ws + WS_ACT) + (size_t)pm * 256 * DFF;
#pragma unroll
    for (int k = tid; k < DFF; k += 512) {
        const int pa = (k >> 7) * 256 + (k & 127);
        float uc0[2], uc1[2];
#pragma unroll
        for (int h = 0; h < 2; ++h) { const int p = pa + h * 128, lc = h * DFF + k;
            const float w0 = cw[lc], w1 = cw[DFF2 + lc], w2 = cw[2 * DFF2 + lc], bb = cb[lc];
            const float q2 = prv[2 * DFF2 + p], q3 = prv[3 * DFF2 + p], o0 = own[p], o1 = own[DFF2 + p];
            uc0[h] = bb + w0 * q2 + w1 * q3 + w2 * o0; uc1[h] = bb + w0 * q3 + w1 * o0 + w2 * o1; }
        ACT[k] = (bf16)f2bf(gelu_tanh(uc0[0]) * uc0[1]); ACT[DFF + k] = (bf16)f2bf(gelu_tanh(uc1[0]) * uc1[1]);
    }
}
__device__ __forceinline__ void thin_unit_up(LAS unsigned char* lds, const bf16* __restrict__ A, const bf16* __restrict__ Bt, int pg, unsigned char* ws, const LAS float* rs32, float* out,
                                             const float* cw, const float* cb, const float* st, int L) {
    int tid = threadIdx.x; asm volatile("" : "+v"(tid));
    const int wid = __builtin_amdgcn_readfirstlane(tid >> 6), lane = tid & 63, fr = lane & 15, fq = lane >> 4, K = 1024;
    const int pn = pg >> 3, cgi = pg & 7;
    f32x4 c[2][2];
#pragma unroll
    for (int i = 0; i < 2; ++i) { c[i][0] = (f32x4){0.f, 0.f, 0.f, 0.f}; c[i][1] = c[i][0]; }
    const bf16* ap = A + (size_t)(MP + fr) * K + fq * 8;
    const bf16* bp = Bt + (size_t)(pn * 256 + cgi * 16 + fr) * K + fq * 8;
#pragma unroll
    for (int ks = wid; ks < 32; ks += 8) {
        const bf16x8 a0 = *(const bf16x8*)(ap + ks * 32), a1 = *(const bf16x8*)(ap + (size_t)16 * K + ks * 32);
        const bf16x8 b0 = *(const bf16x8*)(bp + ks * 32), b1 = *(const bf16x8*)(bp + (size_t)128 * K + ks * 32);
        c[0][0] = __builtin_amdgcn_mfma_f32_16x16x32_bf16(b0, a0, c[0][0], 0, 0, 0); c[0][1] = __builtin_amdgcn_mfma_f32_16x16x32_bf16(b0, a1, c[0][1], 0, 0, 0);
        c[1][0] = __builtin_amdgcn_mfma_f32_16x16x32_bf16(b1, a0, c[1][0], 0, 0, 0); c[1][1] = __builtin_amdgcn_mfma_f32_16x16x32_bf16(b1, a1, c[1][1], 0, 0, 0);
    }
    LAS f32x4* red = (LAS f32x4*)lds;
#pragma unroll
    for (int i = 0; i < 2; ++i)
#pragma unroll
        for (int m = 0; m < 2; ++m) red[(wid * 4 + i * 2 + m) * 64 + lane] = c[i][m];
    __syncthreads();
    if (wid == 0) {
        const int lca = pn * 128 + cgi * 16 + 4 * fq;
#pragma unroll
        for (int m = 0; m < 2; ++m) { const int sb = m * 16 + fr; const float r = rs32[sb];
            f32x4 uc[2];
#pragma unroll
            for (int i = 0; i < 2; ++i) { f32x4 s = red[(i * 2 + m) * 64 + lane];
#pragma unroll
                for (int w = 1; w < 8; ++w) s += red[(w * 4 + i * 2 + m) * 64 + lane];
                s = s * r; const int lc = i * DFF + lca; const size_t so = ((size_t)(L * MS + sb) * 2) * DFF2 + lc;
                const f32x4 s0 = *(const f32x4*)(st + so), s1 = *(const f32x4*)(st + so + DFF2);
                uc[i] = *(const f32x4*)(cb + lc) + *(const f32x4*)(cw + lc) * s0 + *(const f32x4*)(cw + DFF2 + lc) * s1 + *(const f32x4*)(cw + 2 * DFF2 + lc) * s;
                *(f32x4*)(out + O_FFC_S + so) = s1; *(f32x4*)(out + O_FFC_S + so + DFF2) = s; }
            f32x4 a;
#pragma unroll
            for (int e = 0; e < 4; ++e) a[e] = gelu_tanh(uc[0][e]) * uc[1][e];
            *(u32x2*)((bf16*)(ws + WS_ACT) + (size_t)(MP + sb) * DFF + lca) = pack4(a); }
    }
    __syncthreads();
}
struct EpiGate {
    static constexpr bool PERM = false, AFTER_DRAIN = false;
    unsigned char* ws; const LAS float* rs; float* PSSn; size_t pinoff; size_t xin, xout; mutable int slot; mutable int only = -1;
    __device__ __forceinline__ float warm(int fr, int fq, int cg) const {
        const bf16* Xr = (const bf16*)(ws + xin); const bf16* PIN = (const bf16*)(ws + pinoff); const size_t o0 = (size_t)(MP + fr) * DM + cg * 16 + 4 * fq, o1 = o0 + (size_t)16 * DM;
        return (bf2f(Xr[o0]) + bf2f(Xr[o1])) + (bf2f(PIN[o0]) + bf2f(PIN[o1])); }
    __device__ __forceinline__ void thin(f32x4 s0, f32x4 s1, int cg, int fr, int fq) const {
        const LAS float* rsl = rs + 7 * 256;
        const bf16* Xr = (const bf16*)(ws + xin); bf16* XB = (bf16*)(ws + xout); const bf16* PIN = (const bf16*)(ws + pinoff);
        const int nx = (int)((PSSn - (float*)(ws + WS_PSS)) / (16 * MPAD));
#pragma unroll
        for (int m = 0; m < 2; ++m) { const size_t o = (size_t)(MP + 16 * m + fr) * DM + cg * 16 + 4 * fq; f32x4 v = (m ? s1 : s0) * rsl[16 * m + fr];
            const f32x4 pv = unpack4(*(const u32x2*)(PIN + o));
            v[0] = sigmoidf_(v[0]) * pv[0]; v[1] = sigmoidf_(v[1]) * pv[1]; v[2] = sigmoidf_(v[2]) * pv[2]; v[3] = sigmoidf_(v[3]) * pv[3];
            const u32x2 xw = pack4(unpack4(*(const u32x2*)(Xr + o)) + v); const f32x4 x = unpack4(xw);
            *(u32x2*)(XB + o) = xw;
            float ssq = (x[0] * x[0] + x[1] * x[1]) + (x[2] * x[2] + x[3] * x[3]);
            ssq += __shfl_xor(ssq, 16); ssq += __shfl_xor(ssq, 32);
            if (fq == 0) ((float*)(ws + WS_SPSS))[nx * 2048 + cg * 32 + 16 * m + fr] = ssq; }
    }
    __device__ __forceinline__ void operator()(AccRef acc, const pg8::Unit& u, int wr, int wc, int fr, int fq) const {
        fr = launder_v(fr); fq = launder_v(fq);
        const LAS float* rsl = rs + slot * 256; ++slot;
        const bf16* __restrict__ Xr = (const bf16*)(ws + xin); bf16* __restrict__ XB = (bf16*)(ws + xout); const bf16* __restrict__ PIN = (const bf16*)(ws + pinoff);
#pragma unroll
        for (int ai = 0; ai < 2; ++ai) {
#pragma unroll
          for (int mh = 0; mh < 2; ++mh) {
            u32x2 xv[4][2][2]; u32x2 pv[4][2][2];
#pragma unroll
            for (int m = 2 * mh; m < 2 * mh + 2; ++m) { const int row = u.pm * 256 + EPI_ROWL;
                EPI_FOR_COLS { const int col = u.pn * 256 + EPI_COLL; if (row < MTOT) { xv[m][bj][n] = *(const u32x2*)(Xr + (size_t)row * DM + col); pv[m][bj][n] = *(const u32x2*)(PIN + (size_t)row * DM + col); } } }
#pragma unroll
            for (int m = 2 * mh; m < 2 * mh + 2; ++m) { const int rl = EPI_ROWL, row = u.pm * 256 + rl; const float r = rsl[rl]; float ssq = 0.f;
                EPI_FOR_COLS { const int col = u.pn * 256 + EPI_COLL;
                    if (row < MTOT) { f32x4 v = acc[ai][bj][m][n] * r; const u32x2 pw = pv[m][bj][n];
                        v[0] = sigmoidf_(v[0]) * __builtin_bit_cast(float, pw.x << 16); v[1] = sigmoidf_(v[1]) * __builtin_bit_cast(float, pw.x & 0xffff0000u);
                        v[2] = sigmoidf_(v[2]) * __builtin_bit_cast(float, pw.y << 16); v[3] = sigmoidf_(v[3]) * __builtin_bit_cast(float, pw.y & 0xffff0000u);
                        const u32x2 xw = pack4(unpack4(xv[m][bj][n]) + v); const f32x4 x = unpack4(xw);
                        *(u32x2*)(XB + (size_t)row * DM + col) = xw;
                        ssq += (x[0] * x[0] + x[1] * x[1]) + (x[2] * x[2] + x[3] * x[3]); } }
                ssq += __shfl_xor(ssq, 16); ssq += __shfl_xor(ssq, 32);
                if (fq == 0) { if (row < MP) PSSn[(size_t)(u.pn * 4 + wc) * MPAD + row] = ssq;
                    else if (only >= 0 && row < MTOT) { const int nx = (int)((PSSn - (float*)(ws + WS_PSS)) / (16 * MPAD));
                        ((float*)(ws + WS_SPSS))[nx * 2048 + (u.pn * 16 + (only >> 1) * 8 + wc * 2 + (only & 1)) * 32 + (row - MP)] = ssq; } } }
          }
        }
    }
};
struct EpiPin {
    static constexpr bool PERM = false, AFTER_DRAIN = false;
    unsigned char* ws; mutable int Lthin = -1; mutable int only = -1;
    __device__ __forceinline__ void operator()(AccRef acc, const pg8::Unit& u, int wr, int wc, int fr, int fq) const {
        fr = launder_v(fr); fq = launder_v(fq);
        const int L = Lthin >= 0 ? Lthin : u.pn >> 2, pm = Lthin >= 0 ? u.pm : u.pm - L * NMT, pn = Lthin >= 0 ? u.pn : u.pn & 3;
        bf16* PIN = (bf16*)(ws + WS_PIN) + (size_t)L * MPAD * DM;
        EPI_FOR_ROWS { const int rl = EPI_ROWL, row = pm * 256 + rl;
            if (row < MTOT) EPI_FOR_COLS { const int col = pn * 256 + EPI_COLL; *(u32x2*)(PIN + (size_t)row * DM + col) = pack4(acc[ai][bj][m][n]); } }
    }
};
struct PinOrder {
    int start, stride, count, Lb;
    __device__ __forceinline__ bool next(int i, pg8::Unit& u) const { if (i >= count) return false; const int idx = start + i * stride; if (idx >= 512) return false; const int L = Lb + (idx >> 8), w = idx & 255; u.pm = L * NMT + (w >> 2); u.pn = L * 4 + (w & 3); return true; }
    __device__ __forceinline__ void a_ready(const pg8::Unit&) const {}
    __device__ __forceinline__ void done(const pg8::Unit&) const {}
};
struct EpiT {
    static constexpr bool PERM = false, AFTER_DRAIN = false;
    bf16* T; mutable int only = -1;
    __device__ __forceinline__ void operator()(AccRef acc, const pg8::Unit& u, int wr, int wc, int fr, int fq) const {
        fr = launder_v(fr); fq = launder_v(fq);
        bf16* Tt = T + (size_t)u.pm * 65536;
        EPI_FOR_ROWS { const int rl = EPI_ROWL;
            EPI_FOR_COLS { *(u32x2*)(Tt + rl * 256 + EPI_COLL) = pack4(acc[ai][bj][m][n]); } }
    }
};
__device__ __forceinline__ f32x4 rope4(f32x4 v, const float* rt  , int d0) {
    const f32x4 cs = *(const f32x4*)(rt + 2 * d0);
    f32x4 o; o[0] = v[0] * cs[0] - v[1] * cs[1]; o[1] = v[1] * cs[0] + v[0] * cs[1]; o[2] = v[2] * cs[2] - v[3] * cs[3]; o[3] = v[3] * cs[2] + v[2] * cs[3]; return o;
}
struct EpiQ {
    static constexpr bool PERM = false, AFTER_DRAIN = false;
    unsigned char* ws; const LAS float* rs; mutable int slot; mutable int only = -1;
    __device__ __forceinline__ void operator()(AccRef acc, const pg8::Unit& u, int wr, int wc, int fr, int fq) const {
        fr = launder_v(fr); fq = launder_v(fq);
        const LAS float* rsl = rs + slot * 256; ++slot;
        bf16* Q = (bf16*)(ws + WS_Q); bf16* QR = (bf16*)(ws + WS_QR); float* GT = (float*)(ws + WS_GT); const float* RT = (const float*)(ws + WS_ROPE);
        EPI_FOR_ROWS { const int rl = EPI_ROWL, row = u.pm * 256 + rl; const float r = rsl[rl];
            const float* rt = RT + (size_t)(row < MP ? (row & (SEQ - 1)) : SEQ) * 64;
            if (row < MTOT) EPI_FOR_COLS { const int col = u.pn * 256 + EPI_COLL;
                if (u.pn < 4) { const f32x4 v = acc[ai][bj][m][n] * (r * C2);
                    *(u32x2*)(Q + (size_t)row * DM + col) = pack4(v);
                    *(u32x2*)(QR + (size_t)row * DM + col) = pack4(rope4(v, rt, (col & 63) >> 1)); }
                else if (col < NQG) { f32x4 v = acc[ai][bj][m][n] * r;
                    v[0] = sigmoidf_(v[0]); v[1] = sigmoidf_(v[1]); v[2] = sigmoidf_(v[2]); v[3] = sigmoidf_(v[3]);
                    *(f32x4*)(GT + (size_t)row * 48 + (col - 1024)) = v; } } }
    }
};
struct EpiKV {
    static constexpr bool PERM = false, AFTER_DRAIN = false;
    float* out; unsigned char* ws; const LAS float* rs; mutable int slot; mutable int only = -1;
    __device__ __forceinline__ void operator()(AccRef acc, const pg8::Unit& u, int wr, int wc, int fr, int fq) const {
        fr = launder_v(fr); fq = launder_v(fq);
        const LAS float* rsl = rs + slot * 256; ++slot;
        bf16* CA = (bf16*)(ws + WS_CMPA); bf16* KS = (bf16*)(ws + WS_KS); bf16* VTS = (bf16*)(ws + WS_VTS); bf16* KW = (bf16*)(ws + WS_KW); bf16* VTW = (bf16*)(ws + WS_VTW); const float* RT = (const float*)(ws + WS_ROPE);
        EPI_FOR_ROWS { const int rl = EPI_ROWL, row = u.pm * 256 + rl; const float r = rsl[rl];
            if (row < MTOT) {
            const bool smp = row >= MP; const int b = row >> 12, t = row & (SEQ - 1), sb = row - MP;
            const float* rt = RT + (size_t)(smp ? SEQ : t) * 64;
            EPI_FOR_COLS { const int col = u.pn * 256 + EPI_COLL; const int j = col >> 7, g = (col >> 6) & 1, e0 = col & 63;
                f32x4 v = acc[ai][bj][m][n] * r;
                if (j < 2) {
                    if (!smp) { *(f32x4*)(out + O_CMP_P + (size_t)row * 256 + col) = v;
                        *(u32x2*)(CA + ((size_t)j * CMP_ROWS + (size_t)(g * NB + b) * 256 + (t >> 4)) * 1024 + (t & 15) * 64 + e0) = pack4(v); }
                    else *(f32x4*)(out + O_CMP_S + (size_t)sb * 256 + col) = v;
                } else if (j == 2 || j == 4) {
                    const int d0 = e0 >> 1; const f32x4 q = rope4(v, rt, d0);
                    const int lc = (j - 2) * 128 + g * 64;
                    float* orow = nullptr;
                    if (j == 2) orow = smp ? out + O_SLC_S + (size_t)sb * 256 : out + O_SLC_P + (size_t)row * 256;
                    else if (smp) orow = out + O_WIN_S + ((size_t)sb * 512 + 511) * 256;
                    else if (t >= SEQ - 512) orow = out + O_WIN_P + ((size_t)b * 512 + (t - (SEQ - 512))) * 256;
                    if (orow) { float* p = orow + (lc & 255) + d0; *(f32x2*)p = (f32x2){q[0], q[2]}; *(f32x2*)(p + 32) = (f32x2){q[1], q[3]}; }
                    if (!smp) *(u32x2*)((j == 2 ? KS : KW) + ((size_t)(b * NG + g) * SEQ + t) * 64 + e0) = pack4(q);
                } else {
                    const int lc = 128 + g * 64 + e0;
                    float* orow = nullptr;
                    if (j == 3) orow = smp ? out + O_SLC_S + (size_t)sb * 256 : out + O_SLC_P + (size_t)row * 256;
                    else if (smp) orow = out + O_WIN_S + ((size_t)sb * 512 + 511) * 256;
                    else if (t >= SEQ - 512) orow = out + O_WIN_P + ((size_t)b * 512 + (t - (SEQ - 512))) * 256;
                    if (orow) *(f32x4*)(orow + lc) = v;
                    if (!smp) { bf16* vt = (j == 3 ? VTS : VTW) + ((size_t)(b * NG + g) * 64 + e0) * SEQ + t;
                        vt[0] = (bf16)f2bf(v[0]); vt[SEQ] = (bf16)f2bf(v[1]); vt[2 * SEQ] = (bf16)f2bf(v[2]); vt[3 * SEQ] = (bf16)f2bf(v[3]); }
                } } } }
    }
};

struct CmpOrder {
    int G, c, lo, hi;
    __device__ __forceinline__ bool next(int i, pg8::Unit& u) const { const int L = lo + i * G + c; if (L >= hi) return false; u.pm = L; u.pn = L / (CMP_ROWS / 256); return true; }
    __device__ __forceinline__ void a_ready(const pg8::Unit&) const {}
    __device__ __forceinline__ void done(const pg8::Unit&) const {}
};

__device__ __forceinline__ float rcp_fast(float x) { return __builtin_amdgcn_rcpf(x); }
__device__ __forceinline__ float softplus_neg(float lam) { const float e = __expf(-lam); return e < 0.03f ? e * (1.0f - e * (0.5f - e * ((1.0f / 3.0f) - 0.25f * e))) : (lam < -20.f ? -lam : __logf(1.0f + e)); }
__device__ __forceinline__ float sigmoid_fast(float x) { return rcp_fast(1.0f + __expf(-x)); }
__device__ __forceinline__ int rg2_unit(int bid, int G, int k) {
    constexpr int NU = 257 * 16;
    if (G != 256) { const int un = bid + k * G; return un < NU ? un : -1; }
    if (bid < 16) return k < 14 ? bid + 256 * k : (k == 14 ? 4096 + bid : -1);
    if (bid < 48) return k < 16 ? bid + 256 * k : (k == 16 ? (bid & 15) + 256 * (14 + ((bid >> 4) - 1)) : -1);
    return k < 16 ? bid + 256 * k : -1;
}
__device__ __forceinline__ void rg2_phase(KP P, LAS unsigned char* lds, int L, int tid, int lane, int wave, int G) {
    unsigned char* ws = P->ws;
    const bf16* XR = (const bf16*)(ws + WS_XR); bf16* HL = (bf16*)(ws + WS_HL); bf16* AC = (bf16*)(ws + WS_AC);
    const bf16* WG = (const bf16*)(ws + WS_WGA) + (size_t)L * 2 * 16 * 80 * 96;
    const float* cw = (const float*)P->in[16] + (size_t)L * 4 * DRNN; const float* cb = (const float*)P->in[17] + (size_t)L * DRNN;
    const float* b_a = (const float*)P->in[19] + (size_t)L * DRNN; const float* b_x = (const float*)P->in[21] + (size_t)L * DRNN; const float* lam = (const float*)P->in[22] + (size_t)L * DRNN;
    const float* st_c = (const float*)P->in[7] + (size_t)L * MS * 3 * DRNN; const float* st_h = (const float*)P->in[8] + (size_t)L * MS * DRNN;
    LAS bf16* wab = (LAS bf16*)(lds);
    LAS float* xrt = (LAS float*)(lds + 33280);
    LAS float* xcf = (LAS float*)(lds + 54720);
    LAS bf16* xcb = (LAS bf16*)(lds + 75200);
    LAS float* af = (LAS float*)(lds + 88512);
    LAS float* uf = (LAS float*)(lds + 108992);
    LAS float* agg = (LAS float*)(lds + 129472);
    LAS float* cws = (LAS float*)(lds + 132032);
    const int NU = 257 * 16, bid = launder_s(blockIdx.x);
    int cur_n = -1; bool have_pf = false; u32x2 pf[3];
    for (int uk = 0, un = rg2_unit(bid, G, 0); un >= 0; ++uk, un = rg2_unit(bid, G, uk)) {
        const int tl = un >> 4, n = un & 15, c0 = n * RGB; const bool smp = (tl == 256);
        const int m0 = tl * 64, t0 = m0 & (SEQ - 1), b = m0 >> 12;
        if (n != cur_n) {
            cur_n = n;
            for (int i = tid; i < 2 * 80 * 12; i += 512) { const int ck = i % 12, rw = i / 12; const int ax = rw / 80, j = rw % 80;
                *(LAS u32x4*)(wab + (size_t)rw * 104 + ck * 8) = *(const u32x4*)(WG + ((size_t)(ax * 16 + n) * 80 + j) * 96 + ck * 8); }
            for (int i = tid; i < 8 * 80; i += 512) { const int k = i / 80, c = i % 80, ch = c0 + c;
                cws[i] = (k < 4) ? cw[k * DRNN + ch] : (k == 4) ? cb[ch] : (k == 5) ? b_a[ch] : (k == 6) ? b_x[ch] : softplus_neg(lam[ch]); }
            for (int i = tid; i < 64 * 24; i += 512) xcb[(i / 24) * 104 + 80 + (i % 24)] = 0;
        }
        if (!smp) {
            if (!have_pf) {
#pragma unroll
                for (int k = 0; k < 3; ++k) { const int i = tid + 512 * k, r = i / 20, q = i % 20; pf[k] = (u32x2){0u, 0u};
                    if (i < 67 * 20 && t0 + r - 3 >= 0) pf[k] = *(const u32x2*)(XR + (size_t)(m0 + r - 3) * DRNN + c0 + 4 * q); } }
#pragma unroll
            for (int k = 0; k < 3; ++k) { const int i = tid + 512 * k, r = i / 20, q = i % 20; if (i < 67 * 20) *(LAS f32x4*)(xrt + r * 80 + 4 * q) = unpack4(pf[k]); }
            { const int un2 = rg2_unit(bid, G, uk + 1); have_pf = false;
              if (un2 >= 0 && (un2 >> 4) != 256) { const int m2 = (un2 >> 4) * 64, t2 = m2 & (SEQ - 1), c2 = (un2 & 15) * RGB; have_pf = true;
#pragma unroll
                for (int k = 0; k < 3; ++k) { const int i = tid + 512 * k, r = i / 20, q = i % 20; pf[k] = (u32x2){0u, 0u};
                    if (i < 67 * 20 && t2 + r - 3 >= 0) pf[k] = *(const u32x2*)(XR + (size_t)(m2 + r - 3) * DRNN + c2 + 4 * q); } } }
            __syncthreads();
            for (int rep_ = 0; rep_ < 1 + 4 * ((PROBE_DUP >> 23) & 1); ++rep_)
#pragma unroll
            for (int i = 0; i < 10; ++i) { const int e = tid + 512 * i, r = e / 80, c = e % 80;
                const float xc = cws[320 + c] + cws[c] * xrt[r * 80 + c] + cws[80 + c] * xrt[(r + 1) * 80 + c] + cws[160 + c] * xrt[(r + 2) * 80 + c] + cws[240 + c] * xrt[(r + 3) * 80 + c];
                xcf[e] = xc; xcb[r * 104 + c] = (bf16)f2bf(xc); }
        } else {
            __syncthreads();
            for (int e = tid; e < 64 * 80; e += 512) { const int r = e / 80, c = e % 80, ch = c0 + c; float xc = 0.f;
                if (r < MS) { xc = cws[320 + c] + cws[240 + c] * bf2f(XR[(size_t)(MP + r) * DRNN + ch]);
#pragma unroll
                    for (int k = 0; k < 3; ++k) xc += cws[k * 80 + c] * st_c[((size_t)r * 3 + k) * DRNN + ch]; }
                xcf[e] = xc; xcb[r * 104 + c] = (bf16)f2bf(xc); }
        }
        __syncthreads();
        for (int rep3_ = 0; rep3_ < 1 + 4 * ((PROBE_DUP >> 24) & 1); ++rep3_)
        { const int mt = wave & 3, jt0 = (wave >> 2) ? 3 : 0, jt1 = (wave >> 2) ? 5 : 3, fr = lane & 15, fq = lane >> 4;
            for (int jt = jt0; jt < jt1; ++jt) {
                f32x4 accA = (f32x4){0.f, 0.f, 0.f, 0.f}, accX = accA;
#pragma unroll
                for (int ks = 0; ks < 3; ++ks) {
                    const bf16x8 a = *(const LAS bf16x8*)(xcb + (size_t)(16 * mt + fr) * 104 + 32 * ks + 8 * fq);
                    const bf16x8 ba = *(const LAS bf16x8*)(wab + (size_t)(16 * jt + fr) * 104 + 32 * ks + 8 * fq);
                    const bf16x8 bx = *(const LAS bf16x8*)(wab + (size_t)(80 + 16 * jt + fr) * 104 + 32 * ks + 8 * fq);
                    accA = __builtin_amdgcn_mfma_f32_16x16x32_bf16(a, ba, accA, 0, 0, 0);
                    accX = __builtin_amdgcn_mfma_f32_16x16x32_bf16(a, bx, accX, 0, 0, 0);
                }
                const int c = 16 * jt + fr, ch = c0 + c;
                const float ba_ = cws[400 + c], bx_ = cws[480 + c], sp = cws[560 + c];
#pragma unroll
                for (int e = 0; e < 4; ++e) { const int r = 16 * mt + 4 * fq + e;
                    const float rg = sigmoid_fast(accA[e] + ba_), ig = sigmoid_fast(accX[e] + bx_);
                    const float la = -8.0f * rg * sp, a = __expf(la), x2 = 2.0f * la;
                    const float em = x2 * (1.0f + x2 * 0.5f * (1.0f + x2 * (1.0f / 3.0f) * (1.0f + x2 * 0.25f * (1.0f + x2 * 0.2f))));
                    float mult = __builtin_amdgcn_sqrtf(-em); if (!smp && t0 + r == 0) mult = 1.0f;
                    const float u = mult * (ig * xcf[r * 80 + c]);
                    if (!smp) { af[r * 80 + c] = a; uf[r * 80 + c] = u; }
                    else if (r < MS) { HL[(size_t)(MP + r) * DRNN + ch] = (bf16)f2bf(a * st_h[(size_t)r * DRNN + ch] + u); AC[(size_t)(MP + r) * DRNN + ch] = 0; } }
            } }
        __syncthreads();
        for (int rep4_ = 0; rep4_ < 1 + 4 * ((PROBE_DUP >> 25) & 1); ++rep4_)
        if (!smp) {
            const int ch = tid % 80, seg = tid / 80; float hs[16], ps[16];
            if (tid < 320) { float h = 0.f, p = 1.f;
#pragma unroll
                for (int r = 0; r < 16; ++r) { const float a = af[(seg * 16 + r) * 80 + ch], u = uf[(seg * 16 + r) * 80 + ch]; h = a * h + u; p *= a; hs[r] = h; ps[r] = p; }
                agg[(seg * 80 + ch) * 2] = p; agg[(seg * 80 + ch) * 2 + 1] = h; }
            __syncthreads();
            if (tid < 320) { float cy = 0.f, pc = 1.f;
                for (int s = 0; s < seg; ++s) { const float pp = agg[(s * 80 + ch) * 2], hh = agg[(s * 80 + ch) * 2 + 1]; cy = pp * cy + hh; pc *= pp; }
                bf16* hp = HL + (size_t)(m0 + seg * 16) * DRNN + c0 + ch; bf16* ap = AC + (size_t)(m0 + seg * 16) * DRNN + c0 + ch;
#pragma unroll
                for (int r = 0; r < 16; ++r) { hp[(size_t)r * DRNN] = (bf16)f2bf(hs[r] + ps[r] * cy); ap[(size_t)r * DRNN] = (bf16)f2bf(ps[r] * pc); } }
            else if (t0 == SEQ - 64 && tid >= 320 && tid < 320 + 80) { const int c = tid - 320;
#pragma unroll
                for (int k = 0; k < 3; ++k) P->out[O_RGC_P + ((size_t)(L * NB + b) * 3 + k) * DRNN + c0 + c] = xrt[(64 + k) * 80 + c]; }
        }
        __syncthreads();
    }
}
__device__ __forceinline__ void rg3_phase(KP P, LAS unsigned char* lds, int L, int tid, int G) {
    unsigned char* ws = P->ws;
    const bf16* HL = (const bf16*)(ws + WS_HL); const bf16* AC = (const bf16*)(ws + WS_AC); const bf16* Y = (const bf16*)(ws + WS_Y); bf16* Gb = (bf16*)(ws + WS_G);
    LAS float* cmb = (LAS float*)lds;
    const int oc = tid % 160, grp = tid / 160, c = oc * 8; const bool act = grp < 3;
    const f32x4 one4 = (f32x4){1.f, 1.f, 1.f, 1.f}, zero4 = (f32x4){0.f, 0.f, 0.f, 0.f};
    {
        const float* st_c = (const float*)P->in[7] + (size_t)L * MS * 3 * DRNN; const bf16* XR = (const bf16*)(ws + WS_XR);
        for (int e = launder_s(blockIdx.x) * 512 + tid; e < MS * 3 * DRNN; e += G * 512) { const int sb = e / (3 * DRNN), k = (e / DRNN) % 3, ch = e % DRNN;
            P->out[O_RGC_S + ((size_t)(L * MS + sb) * 3 + k) * DRNN + ch] = (k < 2) ? st_c[((size_t)sb * 3 + k + 1) * DRNN + ch] : bf2f(XR[(size_t)(MP + sb) * DRNN + ch]); }
    }
    for (int tl = launder_s(blockIdx.x); tl < 257; tl += G) {
        const bool smp = (tl == 256); const int m0 = tl * 64, b = m0 >> 12, kc = smp ? 0 : ((m0 & (SEQ - 1)) >> 6);
        if (act) {
            f32x4 cy0 = zero4, cy1 = zero4, ap0 = one4, ap1 = one4;
            const int lo = grp * kc / 3, hi = (grp + 1) * kc / 3;
            for (int kk = lo; kk < hi; kk += 4) {
                u32x4 aw[4], hw[4];
#pragma unroll
                for (int q = 0; q < 4; ++q) { aw[q] = (u32x4){0x3f803f80u, 0x3f803f80u, 0x3f803f80u, 0x3f803f80u}; hw[q] = (u32x4){0u, 0u, 0u, 0u};
                    if (kk + q < hi) { const size_t mr = (size_t)(b * SEQ + (kk + q) * 64 + 63) * DRNN + c; aw[q] = *(const u32x4*)(AC + mr); hw[q] = *(const u32x4*)(HL + mr); } }
#pragma unroll
                for (int q = 0; q < 4; ++q) { f32x4 a0, a1, h0, h1; unpack8(aw[q], a0, a1); unpack8(hw[q], h0, h1); cy0 = a0 * cy0 + h0; cy1 = a1 * cy1 + h1; ap0 *= a0; ap1 *= a1; }
            }
            *(LAS f32x4*)(cmb + (grp * 2 + 0) * 1280 + c) = ap0; *(LAS f32x4*)(cmb + (grp * 2 + 0) * 1280 + c + 4) = ap1;
            *(LAS f32x4*)(cmb + (grp * 2 + 1) * 1280 + c) = cy0; *(LAS f32x4*)(cmb + (grp * 2 + 1) * 1280 + c + 4) = cy1;
        }
        __syncthreads();
        if (act) {
            f32x4 cy0 = zero4, cy1 = zero4;
#pragma unroll
            for (int g2 = 0; g2 < 3; ++g2) {
                const f32x4 A0 = *(const LAS f32x4*)(cmb + (g2 * 2 + 0) * 1280 + c), A1 = *(const LAS f32x4*)(cmb + (g2 * 2 + 0) * 1280 + c + 4);
                const f32x4 H0 = *(const LAS f32x4*)(cmb + (g2 * 2 + 1) * 1280 + c), H1 = *(const LAS f32x4*)(cmb + (g2 * 2 + 1) * 1280 + c + 4);
                cy0 = A0 * cy0 + H0; cy1 = A1 * cy1 + H1; }
            const int nr = smp ? MS : 64;
            for (int r0 = grp; r0 < nr; r0 += 12) {
                u32x4 hlw[4], acw[4], yw[4];
#pragma unroll
                for (int q = 0; q < 4; ++q) { const int r = r0 + 3 * q; hlw[q] = (u32x4){0u, 0u, 0u, 0u}; acw[q] = hlw[q]; yw[q] = hlw[q];
                    if (r < nr) { const size_t mr = (size_t)(m0 + r) * DRNN + c; hlw[q] = *(const u32x4*)(HL + mr); acw[q] = *(const u32x4*)(AC + mr); yw[q] = *(const u32x4*)(Y + mr); } }
#pragma unroll
                for (int q = 0; q < 4; ++q) { const int r = r0 + 3 * q;
                    if (r < nr) { const size_t mr = (size_t)(m0 + r) * DRNN + c;
                        f32x4 hl0, hl1, ac0, ac1; unpack8(hlw[q], hl0, hl1); unpack8(acw[q], ac0, ac1);
                        const f32x4 h0 = hl0 + ac0 * cy0, h1 = hl1 + ac1 * cy1; u32x4 o;
                        o.x = pk2(__builtin_bit_cast(float, yw[q].x << 16) * h0[0], __builtin_bit_cast(float, yw[q].x & 0xffff0000u) * h0[1]);
                        o.y = pk2(__builtin_bit_cast(float, yw[q].y << 16) * h0[2], __builtin_bit_cast(float, yw[q].y & 0xffff0000u) * h0[3]);
                        o.z = pk2(__builtin_bit_cast(float, yw[q].z << 16) * h1[0], __builtin_bit_cast(float, yw[q].z & 0xffff0000u) * h1[1]);
                        o.w = pk2(__builtin_bit_cast(float, yw[q].w << 16) * h1[2], __builtin_bit_cast(float, yw[q].w & 0xffff0000u) * h1[3]);
                        *(u32x4*)(Gb + mr) = o;
                        if (smp) { float* op = P->out + O_RGH_S + (size_t)(L * MS + r) * DRNN + c; *(f32x4*)op = h0; *(f32x4*)(op + 4) = h1; }
                        else if (kc == 63 && r == 63) { float* op = P->out + O_RGH_P + (size_t)(L * NB + b) * DRNN + c; *(f32x4*)op = h0; *(f32x4*)(op + 4) = h1; } } }
            }
        }
        __syncthreads();
    }
}
__device__ __forceinline__ void cmp2_phase(KP P, LAS unsigned char* lds, int tid, int lane, int wave, int G) {
    unsigned char* ws = P->ws;
    const bf16* T = (const bf16*)(ws + WS_T); const float* B1P = (const float*)(ws + WS_B1F); const float* b1 = (const float*)P->in[28]; const float* w2 = (const float*)P->in[29];
    bf16* KC = (bf16*)(ws + WS_KC); bf16* VCT = (bf16*)(ws + WS_VCT); float* KCS = (float*)(ws + WS_KCS); float* VCS = (float*)(ws + WS_VCS);
    LAS bf16* w2b = (LAS bf16*)lds;
    LAS float* b1s = (LAS float*)(lds + 34816);
    LAS bf16* hidb = (LAS bf16*)(lds + 35840);
    for (int i = tid; i < 2 * 128 * 64; i += 512) { const int d = i & 63, e = (i >> 6) & 127, j = i >> 13; w2b[(j * 64 + d) * 136 + e] = (bf16)f2bf(w2[i]); }
    if (tid < 256) { float s = b1[tid];
        for (int l = 0; l < 32; ++l) s += B1P[l * 256 + tid];
        b1s[tid] = s; }
    __syncthreads();
    const int NU = 2 * CMP_ROWS / 64;
    const int mt = wave & 3, nh = wave >> 2, fr = lane & 15, fq = lane >> 4;
    for (int un = launder_s(blockIdx.x); un < NU; un += G) {
        const int slot0 = un * 64, j = slot0 / CMP_ROWS, row0 = slot0 % CMP_ROWS;
#pragma unroll
        for (int q = 0; q < 4; ++q) { const int idx = tid + 512 * q, r = idx >> 5, e4 = (idx & 31) * 4; const int row = row0 + r;
            const bool smp = row >= CMP_ROWS_P; const int cb = smp ? ((row - CMP_ROWS_P) & 511) : (row & 255); const bool valid = cb < (smp ? NCB_S : NCB_P);
            f32x4 h = (f32x4){0.f, 0.f, 0.f, 0.f};
            if (valid) { const f32x4 a = unpack4(*(const u32x2*)(T + (size_t)(slot0 + r) * 256 + e4)), bq = unpack4(*(const u32x2*)(T + (size_t)(slot0 + r + 1) * 256 + 128 + e4)), bb = *(const LAS f32x4*)(b1s + j * 128 + e4);
#pragma unroll
                for (int k = 0; k < 4; ++k) h[k] = gelu_tanh(a[k] + bq[k] + bb[k]); }
            *(LAS u32x2*)(hidb + r * 136 + e4) = (u32x2){pk2(h[0], h[1]), pk2(h[2], h[3])}; }
        __syncthreads();
        f32x4 acc[2];
#pragma unroll
        for (int n = 0; n < 2; ++n) { acc[n] = (f32x4){0.f, 0.f, 0.f, 0.f};
#pragma unroll
            for (int ks = 0; ks < 4; ++ks) { const bf16x8 a = *(const LAS bf16x8*)(hidb + (16 * mt + fr) * 136 + 32 * ks + 8 * fq);
                const bf16x8 b = *(const LAS bf16x8*)(w2b + (j * 64 + 16 * (2 * nh + n) + fr) * 136 + 32 * ks + 8 * fq);
                acc[n] = __builtin_amdgcn_mfma_f32_16x16x32_bf16(a, b, acc[n], 0, 0, 0); } }
#pragma unroll
        for (int n = 0; n < 2; ++n) { const int d = 16 * (2 * nh + n) + fr;
#pragma unroll
            for (int e = 0; e < 4; ++e) { const int row = row0 + 16 * mt + 4 * fq + e; const float o = acc[n][e];
                if (row < CMP_ROWS_P) { const int g = row >> 10, bb = (row >> 8) & 3, cb = row & 255;
                    if (j == 0) KC[((size_t)(bb * NG + g) * 256 + cb) * 64 + 2 * (d & 31) + (d >> 5)] = (bf16)f2bf(o);
                    else VCT[((size_t)(bb * NG + g) * 64 + d) * 256 + cb] = (bf16)f2bf(o); }
                else { const int rr = row - CMP_ROWS_P, g = rr >> 14, sb = (rr >> 9) & 31, cb = rr & 511;
                    (j == 0 ? KCS : VCS)[((size_t)(sb * NG + g) * 512 + cb) * 64 + d] = o; } } }
        __syncthreads();
    }
}
__device__ __forceinline__ void final_phase(KP P, const float* PSScur, const float* SPcur, int lane, int wave, int G) {
    const bf16* X = (const bf16*)(P->ws + xb_off(4)); const float* gf = (const float*)P->in[14];
    f32x4 gg[4];
#pragma unroll
    for (int jj = 0; jj < 4; ++jj) gg[jj] = *(const f32x4*)(gf + 4 * lane + 256 * jj);
    const int NGW = G * 8;
    for (int m0 = launder_s(blockIdx.x) * 8 + wave; m0 < MTOT; m0 += 2 * NGW) {
        float sp[2]; u32x2 xv[2][4];
#pragma unroll
        for (int q = 0; q < 2; ++q) { const int m = m0 + q * NGW; sp[q] = 0.f;
            if (m < MTOT) {
                if (m < MP) { if (lane < 16) sp[q] = PSScur[(size_t)lane * MPAD + m]; } else sp[q] = SPcur[lane * 32 + (m - MP)];
#pragma unroll
                for (int jj = 0; jj < 4; ++jj) xv[q][jj] = *(const u32x2*)(X + (size_t)m * DM + 4 * lane + 256 * jj); } }
#pragma unroll
        for (int q = 0; q < 2; ++q) { const int m = m0 + q * NGW;
            if (m < MTOT) {
                const float rs = rsqrtf(wave_sum(sp[q]) * (1.0f / 1024.0f) + EPS);
                float* o = m < MP ? P->out + O_Y_P + (size_t)m * DM : P->out + O_Y_S + (size_t)(m - MP) * DM;
#pragma unroll
                for (int jj = 0; jj < 4; ++jj) { const int c = 4 * lane + 256 * jj; *(f32x4*)(o + c) = unpack4(xv[q][jj]) * rs * gg[jj]; } } }
    }
}

constexpr int AT_KT = 0, AT_KTB = 18432, AT_VT = 36864, AT_VTB = 17408, AT_QS = 71680, AT_LS = 79872, AT_MASK = 88064, AT_QF = 88320, AT_STASH = 121088;
constexpr int AT_ROWB = 144, AT_VROWB = 272;
__device__ __forceinline__ unsigned cvtpk(float lo, float hi) { return pk2(lo, hi); }

template <int MODE>
__device__ __forceinline__ void attn_pass(LAS unsigned char* lds, const bf16* __restrict__ Kg, const bf16* __restrict__ Vtg, int vstride, int tb, int te, const LAS unsigned char* qfl,
                                          int klo, int khi, unsigned long long selmask, float& m_run, float& l_run, f32x16& o0, f32x16& o1, float inv_l, int tokrow, int tid, int lane) {
    if (te <= tb) return;
    const int r32 = lane & 31, hi = lane >> 5, lrow = tid >> 3, lch = tid & 7;
    const unsigned kofs = (unsigned)(lrow * AT_ROWB + lch * 16), vofs = (unsigned)(lrow * AT_VROWB + lch * 16);
    const bf16* kp = Kg + (size_t)lrow * 64 + lch * 8; const bf16* vp = Vtg + (size_t)lrow * vstride + lch * 8;
    u32x4 kreg0 = *(const u32x4*)(kp + (size_t)tb * 8192), kreg1 = *(const u32x4*)(kp + (size_t)tb * 8192 + 4096);
    u32x4 vreg0 = (u32x4){0u, 0u, 0u, 0u}, vreg1 = vreg0;
    if (MODE != 0) { vreg0 = *(const u32x4*)(vp + tb * 128); vreg1 = *(const u32x4*)(vp + tb * 128 + 64); }
    *(LAS u32x4*)(lds + AT_KT + kofs) = kreg0; *(LAS u32x4*)(lds + AT_KT + 64 * AT_ROWB + kofs) = kreg1;
    if (MODE != 0) { *(LAS u32x4*)(lds + AT_VT + vofs) = vreg0; *(LAS u32x4*)(lds + AT_VT + 128 + vofs) = vreg1; }
    __syncthreads();
    for (int t = tb; t < te; ++t) {
        const int buf = (t - tb) & 1, key0 = t * 128;
        if (t + 1 < te) { kreg0 = *(const u32x4*)(kp + (size_t)(t + 1) * 8192); kreg1 = *(const u32x4*)(kp + (size_t)(t + 1) * 8192 + 4096);
            if (MODE != 0) { vreg0 = *(const u32x4*)(vp + (t + 1) * 128); vreg1 = *(const u32x4*)(vp + (t + 1) * 128 + 64); } }
        const bool selA = (MODE == 2) ? ((selmask >> (2 * t)) & 1ull) != 0ull : true, selB = (MODE == 2) ? ((selmask >> (2 * t + 1)) & 1ull) != 0ull : true;
        const bool anyA = selA && (key0 <= khi) && (key0 + 63 >= klo), anyB = selB && (key0 + 64 <= khi) && (key0 + 127 >= klo);
        if (__builtin_amdgcn_ballot_w64(anyA || anyB) != 0ull) {
            const LAS unsigned char* Kb = lds + AT_KT + buf * AT_KTB; const LAS unsigned char* Vb = lds + AT_VT + buf * AT_VTB;
            const bool fullA = selA && (key0 >= klo) && (key0 + 63 <= khi), fullB = selB && (key0 + 64 >= klo) && (key0 + 127 <= khi);
            const bool partial = __builtin_amdgcn_ballot_w64((anyA && !fullA) || (anyB && !fullB)) != 0ull;
            const float base = (m_run == -INFINITY) ? 0.f : -m_run;
            const float ciA = (MODE >= 2) ? ((fullA || (partial && anyA)) ? base : -INFINITY) : 0.f, ciB = (MODE >= 2) ? ((fullB || (partial && anyB)) ? base : -INFINITY) : 0.f;
            f32x16 p[4];
#pragma unroll
            for (int r = 0; r < 16; ++r) { p[0][r] = ciA; p[1][r] = ciA; p[2][r] = ciB; p[3][r] = ciB; }
            __builtin_amdgcn_s_setprio(1);
#pragma unroll
            for (int c = 0; c < 4; ++c)
#pragma unroll
                for (int i = 0; i < 4; ++i) { const bf16x8 a = *(const LAS bf16x8*)(Kb + (32 * i + r32) * AT_ROWB + c * 32 + hi * 16);
                    p[i] = __builtin_amdgcn_mfma_f32_32x32x16_bf16(a, *(const LAS bf16x8*)(qfl + c * 1024), p[i], 0, 0, 0);
                    if (i == 3 && (c & 1)) __builtin_amdgcn_sched_barrier(0); }
            __builtin_amdgcn_s_setprio(0);
            float mx = -INFINITY;
            if (!partial && MODE >= 2) {
#pragma unroll
                for (int r = 0; r < 16; ++r) mx = fmaxf(fmaxf(mx, fmaxf(p[0][r], p[1][r])), fmaxf(p[2][r], p[3][r]));
            } else {
#pragma unroll
                for (int i = 0; i < 4; ++i) { const bool sl = (i < 2) ? selA : selB; const int kb0 = key0 + 32 * i + 4 * hi;
#pragma unroll
                    for (int r = 0; r < 16; ++r) { const int k = kb0 + (r & 3) + 8 * (r >> 2); p[i][r] = (sl && k >= klo && k <= khi) ? p[i][r] : -INFINITY; mx = fmaxf(mx, p[i][r]); } }
            }
            float ls = 0.f;
            if (MODE >= 2) {
                mx = fmaxf(mx, __shfl_xor(mx, 32));
                const bool moved = (m_run == -INFINITY) ? (mx != -INFINITY) : (mx > 0.f);
                if (__builtin_amdgcn_ballot_w64(moved) != 0ull) {
                    const float delta = moved ? mx : 0.f;
                    const float alpha = (m_run == -INFINITY) ? 1.f : __builtin_amdgcn_exp2f(-delta);
                    m_run = moved ? ((m_run == -INFINITY) ? mx : m_run + mx) : m_run;
                    l_run *= alpha;
#pragma unroll
                    for (int r = 0; r < 16; ++r) { o0[r] *= alpha; o1[r] *= alpha; p[0][r] -= delta; p[1][r] -= delta; p[2][r] -= delta; p[3][r] -= delta; }
                }
#pragma unroll
                for (int i = 0; i < 4; ++i)
#pragma unroll
                    for (int r = 0; r < 16; ++r) { p[i][r] = __builtin_amdgcn_exp2f(p[i][r]); ls += p[i][r]; }
            } else {
                float m_use;
                if (MODE == 1) { m_use = (m_run == -INFINITY) ? 0.f : m_run; }
                else {
                    mx = fmaxf(mx, __shfl_xor(mx, 32));
                    const float m_new = fmaxf(m_run, mx); m_use = (m_new == -INFINITY) ? 0.f : m_new;
                    const float alpha = __builtin_amdgcn_exp2f(m_run - m_use);
                    l_run *= alpha; m_run = m_new;
                }
#pragma unroll
                for (int i = 0; i < 4; ++i)
#pragma unroll
                    for (int r = 0; r < 16; ++r) { p[i][r] = __builtin_amdgcn_exp2f(p[i][r] - m_use); ls += p[i][r]; }
            }
            if (MODE != 1) l_run += ls;
            if (MODE == 1) {
                LAS float* QS = (LAS float*)(lds + AT_QS); LAS float* LS = (LAS float*)(lds + AT_LS);
#pragma unroll
                for (int i = 0; i < 4; ++i) {
#pragma unroll
                    for (int r = 0; r < 16; ++r) p[i][r] *= inv_l;
#pragma unroll
                    for (int jq = 0; jq < 4; ++jq) {
                        float q0 = (p[i][4 * jq] + p[i][4 * jq + 1]) + (p[i][4 * jq + 2] + p[i][4 * jq + 3]), l0 = p[i][4 * jq + 3];
#pragma unroll
                        for (int o = 1; o < 8; o <<= 1) { q0 += __shfl_xor(q0, o); l0 += __shfl_xor(l0, o); }
                        if ((lane & 7) == 0) { const int qd = 32 * t + 8 * i + 2 * jq + hi; QS[tokrow * 64 + qd] = q0; LS[tokrow * 64 + qd] = l0; }
                    }
                }
            }
            if (MODE != 0) {
#pragma unroll
                for (int j = 0; j < 8; ++j) {
                    const int i = j >> 1, rb = 8 * (j & 1);
                    u32x4 pw; pw.x = cvtpk(p[i][rb], p[i][rb + 1]); pw.y = cvtpk(p[i][rb + 2], p[i][rb + 3]); pw.z = cvtpk(p[i][rb + 4], p[i][rb + 5]); pw.w = cvtpk(p[i][rb + 6], p[i][rb + 7]);
                    const bf16x8 pb = __builtin_bit_cast(bf16x8, pw);
                    { const LAS unsigned char* vq = Vb + r32 * AT_VROWB + (16 * j + 4 * hi) * 2;
                      const u32x2 lo = *(const LAS u32x2*)vq, hh = *(const LAS u32x2*)(vq + 16);
                      o0 = __builtin_amdgcn_mfma_f32_32x32x16_bf16(__builtin_bit_cast(bf16x8, (u32x4){lo.x, lo.y, hh.x, hh.y}), pb, o0, 0, 0, 0); }
                    { const LAS unsigned char* vq = Vb + (32 + r32) * AT_VROWB + (16 * j + 4 * hi) * 2;
                      const u32x2 lo = *(const LAS u32x2*)vq, hh = *(const LAS u32x2*)(vq + 16);
                      o1 = __builtin_amdgcn_mfma_f32_32x32x16_bf16(__builtin_bit_cast(bf16x8, (u32x4){lo.x, lo.y, hh.x, hh.y}), pb, o1, 0, 0, 0); }
                    if (j & 1) __builtin_amdgcn_sched_barrier(0);
                }
            }
        }
        if (t + 1 < te) { LAS unsigned char* kd = lds + AT_KT + (buf ^ 1) * AT_KTB; *(LAS u32x4*)(kd + kofs) = kreg0; *(LAS u32x4*)(kd + 64 * AT_ROWB + kofs) = kreg1;
            if (MODE != 0) { LAS unsigned char* vd = lds + AT_VT + (buf ^ 1) * AT_VTB; *(LAS u32x4*)(vd + vofs) = vreg0; *(LAS u32x4*)(vd + 128 + vofs) = vreg1; } }
        __syncthreads();
    }
}

__device__ __forceinline__ void attn_prompt_unit(KP P, LAS unsigned char* lds, int b, int g, int t0, int tid, int lane, int wave) {
    unsigned char* ws = P->ws;
    const bf16* Q = (const bf16*)(ws + WS_Q); const bf16* QR = (const bf16*)(ws + WS_QR); const float* GT = (const float*)(ws + WS_GT); bf16* O = (bf16*)(ws + WS_O);
    const int bg = b * NG + g;
    const bf16* KS = (const bf16*)(ws + WS_KS) + (size_t)bg * SEQ * 64; const bf16* VTS = (const bf16*)(ws + WS_VTS) + (size_t)bg * 64 * SEQ;
    const bf16* KW = (const bf16*)(ws + WS_KW) + (size_t)bg * SEQ * 64; const bf16* VTW = (const bf16*)(ws + WS_VTW) + (size_t)bg * 64 * SEQ;
    const bf16* KC = (const bf16*)(ws + WS_KC) + (size_t)bg * 256 * 64; const bf16* VCT = (const bf16*)(ws + WS_VCT) + (size_t)bg * 64 * 256;
    const int r32 = lane & 31, hi = lane >> 5, tok_l = r32 >> 3, hl = r32 & 7, tokrow = wave * 4 + tok_l;
    const int t = t0 + tokrow, mrow = b * SEQ + t, h = g * HPG + hl;
    LAS float* QSb = (LAS float*)(lds + AT_QS); LAS float* LSb = (LAS float*)(lds + AT_LS); LAS unsigned long long* MK = (LAS unsigned long long*)(lds + AT_MASK);
    for (int i = tid; i < 32 * 64; i += 512) { QSb[i] = 0.f; LSb[i] = 0.f; }
    LAS unsigned char* qfl = lds + AT_QF + wave * 4096 + lane * 16;
#pragma unroll
    for (int c = 0; c < 4; ++c) *(LAS bf16x8*)(qfl + c * 1024) = *(const bf16x8*)(Q + (size_t)mrow * DM + h * 64 + c * 16 + hi * 8);
    __syncthreads();
    f32x16 o0, o1;
#pragma unroll
    for (int r = 0; r < 16; ++r) { o0[r] = 0.f; o1[r] = 0.f; }
    LAS unsigned* stash = (LAS unsigned*)(lds + AT_STASH) + wave * 1024 + lane;
    const int cmax = (t >= 31) ? ((t - 31) >> 4) : -1;
    const int ntc = (t0 >> 11) + 1;
    {
        float mc = -INFINITY, lc = 0.f;
        attn_pass<0>(lds, KC, VCT, 256, 0, ntc, qfl, 0, cmax, 0ull, mc, lc, o0, o1, 0.f, tokrow, tid, lane);
        lc += __shfl_xor(lc, 32);
        const float invl = lc > 0.f ? 1.0f / lc : 0.f;
        attn_pass<1>(lds, KC, VCT, 256, 0, ntc, qfl, 0, cmax, 0ull, mc, lc, o0, o1, invl, tokrow, tid, lane);
        const float g0 = GT[(size_t)mrow * 48 + h * 3 + 0];
#pragma unroll
        for (int r = 0; r < 16; ++r) { stash[r * 64] = pk2(g0 * o0[r], g0 * o1[r]); o0[r] = 0.f; o1[r] = 0.f; }
    }
    asm volatile("s_waitcnt lgkmcnt(0)" ::: "memory");
    unsigned long long mymask = 0ull;
    {
        const int cur_w = (t0 + wave * 4) >> 6;
#pragma unroll
        for (int tk = 0; tk < 4; ++tk) {
            const int tr = wave * 4 + tk, s = lane;
            float v = QSb[tr * 64 + s] + (s > 0 ? LSb[tr * 64 + s - 1] : 0.f);
            if (s == 0 || s == cur_w || s + 1 == cur_w) v = INFINITY;
            if (s > cur_w) v = -INFINITY;
            int rank = 0;
            for (int i = 0; i < 64; ++i) { const float x = __builtin_bit_cast(float, __builtin_amdgcn_readlane(__builtin_bit_cast(int, v), i)); rank += (x > v || (x == v && i < s)) ? 1 : 0; }
            const unsigned long long mk = __builtin_amdgcn_ballot_w64(rank < 16);
            if (tok_l == tk) mymask = mk;
        }
    }
    (void)MK;
#pragma unroll
    for (int c = 0; c < 4; ++c) *(LAS bf16x8*)(qfl + c * 1024) = *(const bf16x8*)(QR + (size_t)mrow * DM + h * 64 + c * 16 + hi * 8);
    const int cur = t0 >> 6;
    {
        float ms = -INFINITY, lsum = 0.f;
        attn_pass<2>(lds, KS, VTS, SEQ, 0, (cur >> 1) + 1, qfl, 0, t, mymask, ms, lsum, o0, o1, 0.f, tokrow, tid, lane);
        lsum += __shfl_xor(lsum, 32);
        const float sc = GT[(size_t)mrow * 48 + h * 3 + 1] / lsum;
#pragma unroll
        for (int r = 0; r < 16; ++r) { const unsigned w = stash[r * 64]; stash[r * 64] = pk2(__builtin_bit_cast(float, w << 16) + sc * o0[r], __builtin_bit_cast(float, w & 0xffff0000u) + sc * o1[r]); o0[r] = 0.f; o1[r] = 0.f; }
    }
    f32x16 out0, out1;
    {
        float mw = -INFINITY, lw = 0.f;
        const int wlo = (t0 - 511) > 0 ? (t0 - 511) >> 7 : 0;
        attn_pass<3>(lds, KW, VTW, SEQ, wlo, (cur >> 1) + 1, qfl, t - 511, t, 0ull, mw, lw, o0, o1, 0.f, tokrow, tid, lane);
        lw += __shfl_xor(lw, 32);
        const float sc = GT[(size_t)mrow * 48 + h * 3 + 2] / lw;
#pragma unroll
        for (int r = 0; r < 16; ++r) { const unsigned w = stash[r * 64]; out0[r] = __builtin_bit_cast(float, w << 16) + sc * o0[r]; out1[r] = __builtin_bit_cast(float, w & 0xffff0000u) + sc * o1[r]; }
    }
    bf16* op = O + (size_t)mrow * DM + h * 64 + 4 * hi;
#pragma unroll
    for (int jq = 0; jq < 4; ++jq) {
        u32x2 w0; w0.x = cvtpk(out0[4 * jq], out0[4 * jq + 1]); w0.y = cvtpk(out0[4 * jq + 2], out0[4 * jq + 3]); *(u32x2*)(op + 8 * jq) = w0;
        u32x2 w1; w1.x = cvtpk(out1[4 * jq], out1[4 * jq + 1]); w1.y = cvtpk(out1[4 * jq + 2], out1[4 * jq + 3]); *(u32x2*)(op + 32 + 8 * jq) = w1;
    }
}

constexpr int SM_QN = 0, SM_QR = 2048, SM_SC = 4096, SM_IMP = 36864, SM_SEL = 37888, SM_PTR = 38144, SM_OP = 46336;
__device__ __forceinline__ void smp_scores(const float* __restrict__ kp, const LAS float* q, LAS float* sc, int col, bool valid) {
    float s[8];
#pragma unroll
    for (int hl = 0; hl < 8; ++hl) s[hl] = 0.f;
    if (valid) {
#pragma unroll 4
        for (int d4 = 0; d4 < 16; ++d4) { const f32x4 kv = *(const f32x4*)(kp + 4 * d4);
#pragma unroll
            for (int hl = 0; hl < 8; ++hl) { const f32x4 qv = *(const LAS f32x4*)(q + hl * 64 + 4 * d4); s[hl] += (kv[0] * qv[0] + kv[1] * qv[1]) + (kv[2] * qv[2] + kv[3] * qv[3]); } }
    }
#pragma unroll
    for (int hl = 0; hl < 8; ++hl) sc[hl * 1024 + col] = valid ? s[hl] : -INFINITY;
}
__device__ __forceinline__ void smp_softmax(LAS float* sc, int n, int lane, int wave) {
    LAS float* row = sc + wave * 1024; float mx = -INFINITY;
    for (int i = lane; i < n; i += 64) mx = fmaxf(mx, row[i]);
#pragma unroll
    for (int o = 1; o < 64; o <<= 1) mx = fmaxf(mx, __shfl_xor(mx, o));
    float sum = 0.f;
    for (int i = lane; i < n; i += 64) { const float e = __builtin_amdgcn_exp2f(row[i] - mx); row[i] = e; sum += e; }
    sum = wave_sum(sum); const float inv = 1.0f / sum;
    for (int i = lane; i < n; i += 64) row[i] *= inv;
}
template <bool PTR> __device__ __forceinline__ void smp_pv(const LAS float* sc, const LAS unsigned long long* rp, const float* __restrict__ vbase, int n, LAS float* opart, int tid) {
    const int sl = tid >> 4, dq = tid & 15;
    f32x4 acc[8];
#pragma unroll
    for (int q = 0; q < 8; ++q) acc[q] = (f32x4){0.f, 0.f, 0.f, 0.f};
#pragma unroll 4
    for (int kk = sl; kk < n; kk += 32) {
        f32x4 v = (f32x4){0.f, 0.f, 0.f, 0.f};
        if (PTR) { const float* kp = (const float*)(uintptr_t)rp[kk]; if (kp) v = *(const f32x4*)(kp + 128 + 4 * dq); }
        else v = *(const f32x4*)(vbase + (size_t)kk * 64 + 4 * dq);
#pragma unroll
        for (int q = 0; q < 8; ++q) acc[q] += sc[q * 1024 + kk] * v;
    }
#pragma unroll
    for (int q = 0; q < 8; ++q) *(LAS f32x4*)(opart + (sl * 8 + q) * 64 + 4 * dq) = acc[q];
}
__device__ __forceinline__ float smp_pv_reduce(const LAS float* opart, int hl, int d) {
    float s = 0.f;
#pragma unroll 8
    for (int k = 0; k < 32; ++k) s += opart[(k * 8 + hl) * 64 + d];
    return s;
}
__device__ __forceinline__ void attn_sample_unit(KP P, LAS unsigned char* lds, int sb, int g, int tid, int lane, int wave) {
    unsigned char* ws = P->ws;
    const bf16* Q = (const bf16*)(ws + WS_Q); const bf16* QR = (const bf16*)(ws + WS_QR); const float* GT = (const float*)(ws + WS_GT); bf16* O = (bf16*)(ws + WS_O);
    const float* KCS = (const float*)(ws + WS_KCS) + (size_t)(sb * NG + g) * 512 * 64; const float* VCS = (const float*)(ws + WS_VCS) + (size_t)(sb * NG + g) * 512 * 64;
    const float* cslc = (const float*)P->in[5]; const float* cwin = (const float*)P->in[6]; const int* pt = (const int*)P->in[10] + sb * NPG;
    LAS float* qn = (LAS float*)(lds + SM_QN); LAS float* qr = (LAS float*)(lds + SM_QR); LAS float* sc = (LAS float*)(lds + SM_SC); LAS float* imp = (LAS float*)(lds + SM_IMP);
    LAS int* sel = (LAS int*)(lds + SM_SEL); LAS unsigned long long* rp = (LAS unsigned long long*)(lds + SM_PTR); LAS float* opart = (LAS float*)(lds + SM_OP);
    const int mrow = MP + sb, hl = tid >> 6, d = tid & 63, h = g * HPG + hl;
    { const int e = 2 * (d & 31) + (d >> 5);
      qn[hl * 64 + d] = bf2f(Q[(size_t)mrow * DM + h * 64 + e]); qr[hl * 64 + d] = bf2f(QR[(size_t)mrow * DM + h * 64 + e]); }
    __syncthreads();
    smp_scores(KCS + (size_t)tid * 64, qn, sc, tid, tid < NCB_S);
    __syncthreads();
    smp_softmax(sc, 512, lane, wave);
    __syncthreads();
    smp_pv<false>(sc, rp, VCS, NCB_S, opart, tid);
    if (tid < NSB_S) { float v = 0.f; const int c0 = tid * 4 - 1;
        for (int c = (c0 < 0 ? 0 : c0); c <= c0 + 4 && c < NCB_S; ++c)
#pragma unroll
            for (int q = 0; q < 8; ++q) v += sc[q * 1024 + c];
        if (tid == 0 || tid == 127 || tid == 128) v = INFINITY;
        imp[tid] = v; }
    __syncthreads();
    const float oc = smp_pv_reduce(opart, hl, d);
    if (tid < NSB_S) { const float v = imp[tid]; int rank = 0;
        for (int i = 0; i < NSB_S; ++i) { const float x = imp[i]; rank += (x > v || (x == v && i < tid)) ? 1 : 0; }
        if (rank < 16) sel[rank] = tid; }
    __syncthreads();
#pragma unroll
    for (int q = 0; q < 2; ++q) { const int kk = tid + 512 * q, blk = sel[kk >> 6], pos = blk * 64 + (kk & 63);
        const float* kp = nullptr;
        if (pos < PAST) kp = cslc + ((size_t)pt[pos >> 7] * PGSZ + (pos & 127)) * 256 + g * 64;
        else if (pos == PAST) kp = P->out + O_SLC_S + (size_t)sb * 256 + g * 64;
        rp[kk] = (unsigned long long)(uintptr_t)kp;
        smp_scores(kp, qr, sc, kk, kp != nullptr); }
    __syncthreads();
    smp_softmax(sc, 1024, lane, wave);
    __syncthreads();
    smp_pv<true>(sc, rp, nullptr, 1024, opart, tid);
    __syncthreads();
    const float os = smp_pv_reduce(opart, hl, d);
    __syncthreads();
    { const float* kp = (tid < 511) ? cwin + ((size_t)sb * 512 + tid + 1) * 256 + g * 64 : P->out + O_WIN_S + ((size_t)sb * 512 + 511) * 256 + g * 64;
      rp[tid] = (unsigned long long)(uintptr_t)kp;
      smp_scores(kp, qr, sc, tid, true); }
    __syncthreads();
    smp_softmax(sc, 512, lane, wave);
    __syncthreads();
    smp_pv<true>(sc, rp, nullptr, 512, opart, tid);
    __syncthreads();
    const float ow = smp_pv_reduce(opart, hl, d);
    const float g0 = GT[(size_t)mrow * 48 + h * 3 + 0], g1 = GT[(size_t)mrow * 48 + h * 3 + 1], g2 = GT[(size_t)mrow * 48 + h * 3 + 2];
    O[(size_t)mrow * DM + h * 64 + d] = (bf16)f2bf(g0 * oc + g1 * os + g2 * ow);
    __syncthreads();
}

__device__ __forceinline__ void attn_phase(KP P, LAS unsigned char* lds, int qidx, int tid, int lane, int wave, int G) {
    unsigned* head = (unsigned*)(P->ws + WS_CTL) + 4096 + 64 * qidx;
    volatile LAS int* slot = (volatile LAS int*)(lds + LDS_MISC + 64);
    for (;;) {
        if (tid == 0) slot[0] = (int)__hip_atomic_fetch_add(head, 1u, __ATOMIC_RELAXED, __HIP_MEMORY_SCOPE_AGENT);
        __syncthreads();
        const int un = slot[0];
        __syncthreads();
        if (un >= 64 + 1024) break;
        if (un < 64) attn_sample_unit(P, lds, un >> 1, un & 1, tid, lane, wave);
        else { const int k = un - 64, bg = k & 7, tb = 127 - (k >> 3);
            attn_prompt_unit(P, lds, bg >> 1, bg & 1, tb * 32, tid, lane, wave); }
        __syncthreads();
    }
}

constexpr int NPHASES = 30;
#define DUPK(k) for (int dup_ = 0; dup_ < 1 + ((PROBE_DUP >> (k)) & 1); ++dup_)
#ifndef MK_MULTI
#define MK_MULTI 0
#endif
__global__ void __launch_bounds__(512, 2) mega(Params Pv) {
    extern __shared__ __attribute__((aligned(16))) unsigned char lds_raw[];
    LAS unsigned char* lds = (LAS unsigned char*)lds_raw;

    const KP Pk = (KP)__builtin_amdgcn_kernarg_segment_ptr();
    LAS float* rsb = (LAS float*)(lds + LDS_RS);
    int ph = 0, cur = 0;
    if (Pk->ph_hi - Pk->ph_lo > 1) {
        if (blockIdx.x == 0) { unsigned* ctl = (unsigned*)(Pk->ws + WS_CTL); for (int i = threadIdx.x; i < 8192; i += 512) ctl[i] = 0u; }
        if (threadIdx.x < 16) ((volatile LAS unsigned*)(lds + LDS_MISC))[threadIdx.x] = 0u;
        __syncthreads();
    }
#define RUN (ph >= Pk->ph_lo && ph < Pk->ph_hi)
#define FRESH const int tid = launder_v(threadIdx.x), lane = tid & 63, wave = __builtin_amdgcn_readfirstlane(tid >> 6), G = launder_s(gridDim.x), bid = launder_s(blockIdx.x); (void)lane; (void)wave; (void)bid
#define GRID_BAR do { if (ph == 0) { seam0_barrier(); (void)xcd_barrier_post((unsigned*)(Pk->ws + WS_CTL), (volatile LAS unsigned*)(lds + LDS_MISC) + 8); } else { XcdBarrier b_; b_.bar = (unsigned*)(launder(Pk)->ws + WS_CTL); b_.x = xb_xcc_id(); b_.st = (volatile LAS unsigned*)(lds + LDS_MISC) + 8; xcd_barrier(b_); } } while (0)
#define END_PHASE do { if (RUN && ph + 1 < Pk->ph_hi) { GRID_BAR; if ((PROBE_DUP >> 20) & 1) { if (ph > 0) GRID_BAR; } } ++ph; } while (0)
#define PSS_OF(ws_, c_) ((float*)((ws_) + WS_PSS) + (size_t)(c_) * 16 * MPAD)
#define GEMM_RS(EpiT_, AOFF, BOFF, N_, NTHIN_, K_, ...) GEMM_RS_B(0, EpiT_, AOFF, BOFF, N_, NTHIN_, K_, __VA_ARGS__)
#define GEMM_RS_B(REV_, EpiT_, AOFF, BOFF, N_, NTHIN_, K_, ...) do { const int tid = launder_v(threadIdx.x), G = launder_s(gridDim.x), bid = (REV_) ? G - 1 - launder_s(blockIdx.x) : launder_s(blockIdx.x); const KP P = launder(Pk); unsigned char* ws = P->ws; \
        pg8::Gemm g_{(const bf16*)(ws + (AOFF)), (const bf16*)(ws + (BOFF)), MP, (N_), (K_)}; pg8::StaticOrder S_; S_.init(MP, (N_), G, bid); \
        const int tcg_ = G - 1 - bid; const bool thin_ = tcg_ < (NTHIN_); \
        rs_prepare(S_, PSS_OF(ws, cur), (const float*)(ws + WS_SPSS) + cur * 2048, rsb, tid, thin_); EpiT_ E_{__VA_ARGS__}; \
          \
          \
        { const int tstr_ = ((NTHIN_) > G / 2 && (NTHIN_) < G && ((N_) / 256) * (MP / 256) % G == G / 2) ? G / 2 : G; \
          if (tcg_ < tstr_) for (int cg_ = tcg_; cg_ < (NTHIN_); cg_ += tstr_) { E_.slot = 7; thin_unit<(K_)>(lds, g_.A, g_.Bt, cg_, E_); } } E_.slot = 0; \
        pg8::gemm_phase<EpiT_, pg8::StaticOrder, true, true>(lds, g_, S_, E_); } while (0)
#define GEMM_RES(KIND, AOFF, BOFF, K_, SOFF) DUPK(KIND) { FRESH; const KP P = launder(Pk); unsigned char* ws = P->ws; \
        pg8::Gemm g_{(const bf16*)(ws + (AOFF)), (const bf16*)(ws + (BOFF)), MP, 1024, (K_)}; pg8::StaticOrder S_; S_.init(MP, 1024, G, bid); \
        EpiRes E_{ws, PSS_OF(ws, cur ^ 1), (SOFF), dup_ ? 0.0f : 1.0f, xb_off(L)}; \
        const int tcg_ = G - 1 - bid; if (tcg_ < 64) thin_unit<(K_)>(lds, g_.A, g_.Bt, tcg_, E_); \
        pg8::gemm_phase<EpiRes, pg8::StaticOrder, true, true>(lds, g_, S_, E_); }

    if (RUN) DUPK(0) { FRESH; phase0(launder(Pk), lds, tid, lane, wave, G); }
    END_PHASE;

#pragma unroll
    for (int L = 0; L < 4; ++L) {
        if (L < 2) {
            if (RUN) { GEMM_RS(EpiRG1, xb_off(L), WS_WIN + (size_t)L * 2560 * 1024 * 2, 2560, 160, 1024, ws, rsb, 0);
                if (L == 0) { FRESH; const KP P = launder(Pk); unsigned char* ws = P->ws; const int Gh = G >> 1;
                  pg8::Gemm g_{(const bf16*)(ws + WS_PB), (const bf16*)(ws + WS_WPI), 4 * MPAD, 4096, 256}; EpiPin E_{ws};
                  { PinOrder S_; S_.Lb = 0; S_.stride = 1;
                    if (G == 256) { if (bid < 128) { S_.start = bid; S_.count = 1; } else { S_.start = 128 + (bid - 128) * 3; S_.count = 3; } }
                    else { const int per = (512 + G - 1) / G; S_.start = bid * per; S_.count = per; }
                    pg8::gemm_phase<EpiPin, PinOrder, true, true>(lds, g_, S_, E_); }
                  if (bid < Gh) for (int q_ = bid; q_ < 128; q_ += Gh) { const int L_ = (q_ >> 6), cg_ = q_ & 63; E_.Lthin = L_; thin_unit<256>(lds, g_.A + (size_t)L_ * MPAD * 256, g_.Bt + (size_t)L_ * 1024 * 256, cg_, E_); } }
                if (L == 1) { FRESH; const KP P = launder(Pk); unsigned char* ws = P->ws;
                  if (G == 256 && bid >= 128) { constexpr int NCU_ = 2 * (CMP_ROWS / 256);
                    pg8::Gemm g_{(const bf16*)(ws + WS_CMPA), (const bf16*)(ws + WS_WC1), 2 * CMP_ROWS, 256, 1024}; CmpOrder S_{G, bid - 128, NCU_ - 128, NCU_}; EpiT E_{(bf16*)(ws + WS_T)};
                    pg8::gemm_phase<EpiT, CmpOrder, true, true>(lds, g_, S_, E_); } } }
            END_PHASE;
            if (RUN) DUPK(2) { FRESH; rg2_phase(launder(Pk), lds, L, tid, lane, wave, G); }
            END_PHASE;
            if (RUN) DUPK(3) { FRESH; rg3_phase(launder(Pk), lds, L, tid, G); }
            END_PHASE;
            if (RUN) GEMM_RES(13, WS_G, WS_WOUT + (size_t)L * 1024 * 1280 * 2, 1280, (size_t)0);
            END_PHASE; cur ^= 1;
        } else {
            const int j = L - 2;
            if (L == 2) {
                if (RUN) { GEMM_RS(EpiKV, xb_off(L), WS_WKV, NKV, 48, 1024, P->out, ws, rsb, 0);
                    GEMM_RS_B(1, EpiQ, xb_off(L), WS_WQG, NQGP, 67, 1024, ws, rsb, 0); }
                END_PHASE;
                if (RUN) DUPK(8) { FRESH; const KP P = launder(Pk); unsigned char* ws = P->ws;
                    constexpr int NCU_ = 2 * (CMP_ROWS / 256), NSV_ = 128;
                    const bool early_ = (G == 256);
                    pg8::Gemm g_{(const bf16*)(ws + WS_CMPA), (const bf16*)(ws + WS_WC1), 2 * CMP_ROWS, 256, 1024}; CmpOrder S_{G, bid, 0, early_ ? NCU_ - NSV_ : NCU_}; EpiT E_{(bf16*)(ws + WS_T)};
                    pg8::gemm_phase<EpiT, CmpOrder, true, true>(lds, g_, S_, E_);
                    { const int nb2 = 2 * (CMP_ROWS / 256) - G, nf = G - (nb2 > 0 ? nb2 : 0);
                      pg8::Gemm gp_{(const bf16*)(ws + WS_PB), (const bf16*)(ws + WS_WPI), 4 * MPAD, 4096, 256}; EpiPin Ep_{ws};
                      if (early_) {
                          PinOrder Sp_; Sp_.Lb = 2; Sp_.start = 0; Sp_.stride = 1; Sp_.count = 0;
                          if (bid >= NCU_ - NSV_) { Sp_.start = bid - (NCU_ - NSV_); Sp_.stride = G - (NCU_ - NSV_); Sp_.count = 4; }
                          else if (bid < 512 - 4 * (G - (NCU_ - NSV_))) { Sp_.start = 4 * (G - (NCU_ - NSV_)) + bid; Sp_.count = 1; }
                          pg8::gemm_phase<EpiPin, PinOrder, true, true>(lds, gp_, Sp_, Ep_); }
                      else if (nf > 0 && bid >= G - nf) { PinOrder Sp_; Sp_.Lb = 2; Sp_.start = bid - (G - nf); Sp_.stride = nf; Sp_.count = (512 + nf - 1) / nf;
                          pg8::gemm_phase<EpiPin, PinOrder, true, true>(lds, gp_, Sp_, Ep_); }
                      else if (nf <= 0) { PinOrder Sp_; Sp_.Lb = 2; Sp_.start = bid; Sp_.stride = G; Sp_.count = (512 + G - 1) / G; pg8::gemm_phase<EpiPin, PinOrder, true, true>(lds, gp_, Sp_, Ep_); }
                      for (int q_ = bid; q_ < 128; q_ += G) { const int L_ = 2 + (q_ >> 6), cg_ = q_ & 63; Ep_.Lthin = L_; thin_unit<256>(lds, gp_.A + (size_t)L_ * MPAD * 256, gp_.Bt + (size_t)L_ * 1024 * 256, cg_, Ep_); } } }
                END_PHASE;
                if (RUN) DUPK(9) { FRESH; cmp2_phase(launder(Pk), lds, tid, lane, wave, G); }
                END_PHASE;
            }
            if (L == 3) { if (RUN) DUPK(10) GEMM_RS(EpiQ, xb_off(L), WS_WQG + (size_t)j * NQGP * 1024 * 2, NQGP, 67, 1024, ws, rsb, 0);
            END_PHASE; }
            if (RUN) DUPK(11) { FRESH; attn_phase(launder(Pk), lds, j + 2 * dup_, tid, lane, wave, G); }
            END_PHASE;
            if (RUN) GEMM_RES(16, WS_O, WS_WO + (size_t)j * 1024 * 1024 * 2, 1024, (size_t)0);
            END_PHASE; cur ^= 1;
        }
        if (RUN) DUPK(4) { FRESH; const KP P = launder(Pk); unsigned char* ws = P->ws;
            pg8::Gemm g_{(const bf16*)(ws + xb_off(L)), (const bf16*)(ws + WS_WUP + (size_t)L * 6144 * 1024 * 2), MP, DFF2, 1024}; pg8::StaticOrder S_; S_.init(MP, DFF2, G, bid);
            const int tpg_ = G - 1 - bid; const bool thin_ = tpg_ < 192;
            rs_prepare(S_, PSS_OF(ws, cur), (const float*)(ws + WS_SPSS) + cur * 2048, rsb, tid, thin_);
            const float* cw_ = (const float*)P->in[33] + (size_t)L * 3 * DFF2; const float* cb_ = (const float*)P->in[34] + (size_t)L * DFF2;
            EpiUp E_{ws, rsb, P->out, cw_, cb_, (LAS float*)(lds + LDS_HALO), L, 0};
            if (thin_) thin_unit_up(lds, g_.A, g_.Bt, tpg_, ws, rsb + 7 * 256, P->out, cw_, cb_, (const float*)P->in[9], L);
            pg8::gemm_phase<EpiUp, pg8::StaticOrder, true, true>(lds, g_, S_, E_); }
        END_PHASE;
        if (RUN) DUPK(14) { FRESH; const KP P = launder(Pk); unsigned char* ws = P->ws;
            pg8::Gemm g_{(const bf16*)(ws + WS_ACT), (const bf16*)(ws + WS_WDN + (size_t)L * 1024 * 3072 * 2), MP, 1024, 3072}; pg8::StaticOrder S_; S_.init(MP, 1024, G, bid);
            { pg8::Unit u_; for (int i_ = 0; S_.next(i_, u_); ++i_) act_fixup(ws, (const float*)P->in[33] + (size_t)L * 3 * DFF2, (const float*)P->in[34] + (size_t)L * DFF2, u_.pm, tid); }
            asm volatile("s_waitcnt vmcnt(0)" ::: "memory"); __syncthreads();
            EpiRes E_{ws, PSS_OF(ws, cur ^ 1), (size_t)0, dup_ ? 0.0f : 1.0f, xb_off(L)};
            const int tcg_ = G - 1 - bid; if (tcg_ < 64) thin_unit<3072>(lds, g_.A, g_.Bt, tcg_, E_);
            pg8::gemm_phase<EpiRes, pg8::StaticOrder, true, true>(lds, g_, S_, E_); }
        END_PHASE; cur ^= 1;
        if (RUN) GEMM_RS(EpiGate, xb_off(L), WS_WPG + (size_t)L * 1024 * 1024 * 2, 1024, 64, 1024, ws, rsb, PSS_OF(ws, cur ^ 1), WS_PIN + (size_t)L * MPAD * DM * 2, xb_off(L), xb_off(L + 1), 0);
        END_PHASE; cur ^= 1;
    }
    if (RUN) DUPK(12) { FRESH; const KP P = launder(Pk); final_phase(P, PSS_OF(P->ws, cur), (const float*)(P->ws + WS_SPSS) + cur * 2048, lane, wave, G); }
    END_PHASE;
}

extern "C" void kernel_launch(void* const* d_in, const int* in_sizes, int n_in, void* d_out, int out_size, void* d_ws, size_t ws_size, hipStream_t stream) {
    static int grid = 0;
    if (grid == 0) {
        if (n_in != 38 || (size_t)out_size != O_END || ws_size < WS_END) { fprintf(stderr, "kernel_launch: unexpected problem: n_in %d out %d ws %zu (need %zu)\n", n_in, out_size, ws_size, (size_t)WS_END); grid = -1; return; }
        int dev = 0, cus = 0, per_cu = 0;
        (void)hipGetDevice(&dev); (void)hipDeviceGetAttribute(&cus, hipDeviceAttributeMultiprocessorCount, dev);
        if (hipFuncSetAttribute((const void*)mega, hipFuncAttributeMaxDynamicSharedMemorySize, LDS_BYTES) != hipSuccess) { fprintf(stderr, "kernel_launch: hipFuncSetAttribute failed\n"); grid = -1; return; }
        if (hipOccupancyMaxActiveBlocksPerMultiprocessor(&per_cu, (const void*)mega, 512, LDS_BYTES) != hipSuccess || per_cu < 1) { fprintf(stderr, "kernel_launch: occupancy query says %d\n", per_cu); per_cu = 1; }
        (void)hipGetLastError();
        grid = cus;
        if (grid > 256) grid = 256;
    }
    if (grid < 0) return;
    Params p{};
    for (int i = 0; i < 38; ++i) p.in[i] = d_in[i];
    p.out = (float*)d_out; p.ws = (unsigned char*)d_ws;
#if MK_MULTI
    for (int ph = 0; ph < NPHASES; ++ph) { p.ph_lo = ph; p.ph_hi = ph + 1; hipLaunchKernelGGL(mega, dim3(grid), dim3(512), LDS_BYTES, stream, p); }
#else
    p.ph_lo = 0; p.ph_hi = NPHASES;
    void* args[] = {&p};
    hipError_t e = hipLaunchCooperativeKernel((const void*)mega, dim3(grid), dim3(512), args, LDS_BYTES, stream);
    if (e != hipSuccess) fprintf(stderr, "kernel_launch: cooperative launch failed: %s (grid %d)\n", hipGetErrorString(e), grid);
#endif
}
```

```cpp
#include <hip/hip_runtime.h>
#include <hip/hip_cooperative_groups.h>
#include <cstdio>
#include <cstdint>
#include <cmath>
namespace cg = cooperative_groups;
#ifndef PROBE_DUP
#define PROBE_DUP 0
#endif


#define LAS __attribute__((address_space(3)))
#define GAS __attribute__((address_space(1)))
typedef unsigned short bf16;
typedef short bf16x8 __attribute__((ext_vector_type(8)));
typedef float f32x4 __attribute__((ext_vector_type(4)));
typedef float f32x2 __attribute__((ext_vector_type(2)));
typedef float f32x16 __attribute__((ext_vector_type(16)));
typedef unsigned u32x4 __attribute__((ext_vector_type(4)));
typedef unsigned u32x2 __attribute__((ext_vector_type(2)));

constexpr int DM = 1024, SEQ = 4096, NB = 4, MP = NB * SEQ, MS = 32, MTOT = MP + MS, MPAD = 16640, NMT = MPAD / 256;
constexpr int DRNN = 1280, DFF = 3072, DFF2 = 6144, DPLE = 256, NRGB = 16, RGB = 80;
constexpr int PAST = 8192, NPG = 64, PGSZ = 128, HD = 64, NH = 16, NG = 2, HPG = 8;
constexpr int NCB_P = 255, NCB_S = 511, NSB_S = 129;
constexpr int NQG = 1072, NQGP = 1280, NKV = 768;
constexpr float EPS = 1e-6f;
constexpr float C2 = 0.125f * 1.4426950408889634f;
constexpr int CMP_ROWS_P = NG * NB * 256, CMP_ROWS_S = NG * MS * 512, CMP_ROWS = CMP_ROWS_P + CMP_ROWS_S;

constexpr size_t O_Y_P = 0;
constexpr size_t O_Y_S = O_Y_P + (size_t)MP * DM;
constexpr size_t O_CMP_P = O_Y_S + (size_t)MS * DM;
constexpr size_t O_CMP_S = O_CMP_P + (size_t)MP * 256;
constexpr size_t O_SLC_P = O_CMP_S + (size_t)MS * 256;
constexpr size_t O_SLC_S = O_SLC_P + (size_t)MP * 256;
constexpr size_t O_WIN_P = O_SLC_S + (size_t)MS * 256;
constexpr size_t O_WIN_S = O_WIN_P + (size_t)NB * 512 * 256;
constexpr size_t O_RGC_P = O_WIN_S + (size_t)MS * 512 * 256;
constexpr size_t O_RGC_S = O_RGC_P + (size_t)2 * NB * 3 * DRNN;
constexpr size_t O_RGH_P = O_RGC_S + (size_t)2 * MS * 3 * DRNN;
constexpr size_t O_RGH_S = O_RGH_P + (size_t)2 * NB * DRNN;
constexpr size_t O_FFC_P = O_RGH_S + (size_t)2 * MS * DRNN;
constexpr size_t O_FFC_S = O_FFC_P + (size_t)4 * NB * 2 * DFF2;
constexpr size_t O_END = O_FFC_S + (size_t)4 * MS * 2 * DFF2;
static_assert(O_END == 32071680, "d_out size");

constexpr size_t al256(size_t x) { return (x + 255) & ~(size_t)255; }
constexpr size_t WS_CTL = 0;
constexpr size_t WS_WIN = WS_CTL + 65536;
constexpr size_t WS_WOUT = WS_WIN + (size_t)2 * 2560 * 1024 * 2;
constexpr size_t WS_WUP = WS_WOUT + (size_t)2 * 1024 * 1280 * 2;
constexpr size_t WS_WDN = WS_WUP + (size_t)4 * 6144 * 1024 * 2;
constexpr size_t WS_WPI = WS_WDN + (size_t)4 * 1024 * 3072 * 2;
constexpr size_t WS_WPG = WS_WPI + (size_t)4 * 1024 * 256 * 2;
constexpr size_t WS_WKV = WS_WPG + (size_t)4 * 1024 * 1024 * 2;
constexpr size_t WS_WQG = WS_WKV + (size_t)768 * 1024 * 2;
constexpr size_t WS_WO = WS_WQG + (size_t)2 * 1280 * 1024 * 2;
constexpr size_t WS_WC1 = WS_WO + (size_t)2 * 1024 * 1024 * 2;
constexpr size_t WS_WGA = WS_WC1 + (size_t)2 * 256 * 1024 * 2;
constexpr size_t WS_B1F = al256(WS_WGA + (size_t)2 * 2 * 16 * 80 * 96 * 2);
constexpr size_t WS_ROPE = al256(WS_B1F + 32 * 2 * 128 * 4);
constexpr size_t WS_PSS = al256(WS_ROPE + (size_t)4097 * 64 * 4);
constexpr size_t WS_X = al256(WS_PSS + (size_t)2 * 16 * MPAD * 4);
constexpr size_t WS_XB = WS_X + (size_t)MPAD * 1024 * 4;
__host__ __device__ constexpr size_t xb_off(int L) { return (L & 1) ? WS_X : WS_XB; }
constexpr size_t WS_PB = WS_XB + (size_t)MPAD * 1024 * 2;
constexpr size_t WS_Y = WS_PB + (size_t)4 * MPAD * 256 * 2;
constexpr size_t WS_G = WS_Y + (size_t)MPAD * 1280 * 2;
constexpr size_t WS_S = WS_G + (size_t)MPAD * 1280 * 2;
constexpr size_t WS_Q = WS_S + (size_t)MPAD * 1024 * 2;
constexpr size_t WS_QR = WS_Q + (size_t)MPAD * 1024 * 2;
constexpr size_t WS_O = WS_QR + (size_t)MPAD * 1024 * 2;
constexpr size_t WS_GT = WS_O + (size_t)MPAD * 1024 * 2;
constexpr size_t WS_KS = al256(WS_GT + (size_t)MPAD * 48 * 4);
constexpr size_t WS_VTS = WS_KS + (size_t)NB * NG * SEQ * 64 * 2;
constexpr size_t WS_KW = WS_VTS + (size_t)NB * NG * SEQ * 64 * 2;
constexpr size_t WS_VTW = WS_KW + (size_t)NB * NG * SEQ * 64 * 2;
constexpr size_t WS_KC = WS_VTW + (size_t)NB * NG * SEQ * 64 * 2;
constexpr size_t WS_VCT = WS_KC + (size_t)NB * NG * 256 * 64 * 2;
constexpr size_t WS_KCS = WS_VCT + (size_t)NB * NG * 256 * 64 * 2;
constexpr size_t WS_VCS = WS_KCS + (size_t)MS * NG * 512 * 64 * 4;
constexpr size_t WS_CMPA = WS_VCS + (size_t)MS * NG * 512 * 64 * 4;
constexpr size_t WS_T = WS_CMPA + (size_t)2 * CMP_ROWS * 1024 * 2;
constexpr size_t WS_BIG = WS_T + (size_t)2 * CMP_ROWS * 256 * 4;
constexpr size_t WS_XR = WS_BIG;
constexpr size_t WS_HL = WS_XR + (size_t)MPAD * 1280 * 4;
constexpr size_t WS_AC = WS_HL + (size_t)MPAD * 1280 * 4;
constexpr size_t WS_UP = WS_BIG;
constexpr size_t WS_ACT = WS_UP + (size_t)MPAD * 6144 * 2;
constexpr size_t WS_UPH = WS_ACT + (size_t)MPAD * 3072 * 2;
constexpr size_t WS_PIN = WS_UPH + (size_t)64 * 4 * 6144 * 4;
constexpr size_t WS_STASH = WS_PIN + (size_t)4 * MPAD * 1024 * 2;
constexpr size_t WS_SPSS = WS_STASH + (size_t)256 * 8 * 2048 * 4;
constexpr size_t WS_END_A = WS_AC + (size_t)MPAD * 1280 * 4, WS_END_B = WS_SPSS + (size_t)2 * 64 * 32 * 4;
constexpr size_t WS_END = WS_END_A > WS_END_B ? WS_END_A : WS_END_B;
static_assert(WS_END < (size_t)1300 * 1024 * 1024, "workspace budget");

constexpr int LDS_RING = 0, LDS_RING_BYTES = 131072;
constexpr int LDS_RS = LDS_RING_BYTES;
constexpr int LDS_MISC = 163840 - 256;
constexpr int LDS_HALO = LDS_RS + 8 * 1024;
constexpr int LDS_BYTES = 163840;

struct Params { const void* in[38]; float* out; unsigned char* ws; int ph_lo, ph_hi; };
typedef const __attribute__((address_space(4))) Params* KP;
__device__ __forceinline__ KP launder(KP p) { asm volatile("" : "+s"(p)); return p; }
__device__ __forceinline__ int launder_v(int x) { asm volatile("" : "+v"(x)); return x; }
__device__ __forceinline__ int launder_s(int x) { asm volatile("" : "+s"(x)); return x; }

__device__ __forceinline__ unsigned f2bf(float f) { unsigned u = __builtin_bit_cast(unsigned, f); return (u + 0x7fffu + ((u >> 16) & 1u)) >> 16; }
typedef __bf16 bf16x2_t __attribute__((ext_vector_type(2)));
__device__ __forceinline__ unsigned pk2(float lo, float hi) { const f32x2 v = {lo, hi}; return __builtin_bit_cast(unsigned, __builtin_convertvector(v, bf16x2_t)); }
__device__ __forceinline__ f32x4 unpack4(u32x2 w);
__device__ __forceinline__ void unpack8(u32x4 w, f32x4& lo, f32x4& hi) { lo = unpack4((u32x2){w.x, w.y}); hi = unpack4((u32x2){w.z, w.w}); }
__device__ __forceinline__ f32x4 unpack4(u32x2 w) { f32x4 v; v[0] = __builtin_bit_cast(float, w.x << 16); v[1] = __builtin_bit_cast(float, w.x & 0xffff0000u); v[2] = __builtin_bit_cast(float, w.y << 16); v[3] = __builtin_bit_cast(float, w.y & 0xffff0000u); return v; }
__device__ __forceinline__ float bf2f(unsigned short b) { return __builtin_bit_cast(float, ((unsigned)b) << 16); }
__device__ __forceinline__ float gelu_tanh(float x) {
    const float u = 0.7978845608028654f * (x + 0.044715f * x * x * x);
    return x * __builtin_amdgcn_rcpf(1.0f + __expf(-2.0f * u));
}
__device__ __forceinline__ float sigmoidf_(float x) { return __builtin_amdgcn_rcpf(1.0f + __expf(-x)); }
__device__ __forceinline__ float wave_sum(float v) {
#pragma unroll
    for (int o = 1; o < 64; o <<= 1) v += __shfl_xor(v, o);
    return v;
}
namespace pg8 {
#define PG8_LAS __attribute__((address_space(3)))
typedef unsigned short bf16_t;
typedef short bf16x8 __attribute__((ext_vector_type(8)));
typedef float f32x4 __attribute__((ext_vector_type(4)));
typedef unsigned u32x4 __attribute__((ext_vector_type(4)));
constexpr int BM = 256, BK = 64, HALF = 128, HTB = HALF * BK * 2  , STAGE_BYTES = 8 * HTB, NXCD = 8, WGM = 8;

__host__ __device__ __forceinline__ int lds_byte(int r, int c) { const int st = (r >> 4) * 2 + (c >> 5), rr = r & 15, cc = c & 31, ob = rr * 64 + cc * 2; return st * 1024 + (ob ^ (((ob >> 9) & 1) << 5)); }
__host__ __device__ __forceinline__ void stage_rc(int b, int& R, int& C) { const int st = b / 1024, sb = b % 1024, swz = sb ^ (((sb >> 9) & 1) << 5); R = (st >> 1) * 16 + swz / 64; C = (st & 1) * 32 + (swz % 64) / 2; }
__host__ __device__ __forceinline__ int perm32(int rho) { const int n = rho >> 4, i = rho & 15; return 8 * (i >> 2) + 4 * n + (i & 3); }

struct Unit { int pm, pn; };
struct Gemm { const bf16_t* A; const bf16_t* Bt; int M, N, K; };

struct StaticOrder {
    int nM, nN, nwg, G, c;
    __host__ __device__ __forceinline__ void init(int M, int N, int G_, int c_) { nM = M / BM; nN = N / BM; nwg = nM * nN; G = G_; c = c_; }
    __host__ __device__ __forceinline__ bool next(int i, Unit& u) const {
        const long L = (long)i * G + c; if (L >= nwg) return false;
        int wgid = (int)L; { const int q = nwg / NXCD, r = nwg % NXCD, xcd = wgid % NXCD, off = wgid / NXCD; wgid = (xcd < r ? xcd * (q + 1) : r * (q + 1) + (xcd - r) * q) + off; }
        const int nig = WGM * nN, gid = wgid / nig, fm = gid * WGM, gsz = (nM - fm) < WGM ? (nM - fm) : WGM;
        u.pm = fm + ((wgid % nig) % gsz); u.pn = (wgid % nig) / gsz; return true;
    }
    __device__ __forceinline__ void a_ready(const Unit&) const {}
    __device__ __forceinline__ void done(const Unit&) const {}
};
__device__ __forceinline__ unsigned cvt_pk_bf16(float lo, float hi) { unsigned r; asm volatile("v_cvt_pk_bf16_f32 %0, %1, %2" : "=v"(r) : "v"(lo), "v"(hi)); return r; }
typedef float f32x2 __attribute__((ext_vector_type(2)));
template <class Epi, class Sched, bool ALIGN_EPI = false, bool SP2 = false>
__device__ __forceinline__ void gemm_phase(PG8_LAS unsigned char* lds, const Gemm g, const Sched& S, const Epi& E) {
    int tid = threadIdx.x; asm volatile("" : "+v"(tid));
    const int wid = __builtin_amdgcn_readfirstlane(tid >> 6), lane = tid & 63, wr = wid >> 2, wc = wid & 3, fr = lane & 15, fq = lane >> 4;
    const int K = g.K, nt = K / BK;
    unsigned voffA[2], voffB[2];
#pragma unroll
    for (int i = 0; i < 2; ++i) { int R, C; stage_rc(tid * 16 + i * 8192, R, C); const int Rb = Epi::PERM ? ((R & ~31) + perm32(R & 31)) : R;
        voffA[i] = (unsigned)(R * K + C) * 2u; voffB[i] = (unsigned)(Rb * K + C) * 2u; }
    const size_t kstep = (size_t)(BK * 2);
    const size_t hstep = (size_t)HALF * K * 2;
    const size_t tstep = 2 * hstep;
    const unsigned ldsw = (unsigned)wid * 1024u;
    const int aoff = lds_byte(wr * 64 + fr, fq * 8), boff = lds_byte(wc * 32 + fr, fq * 8);
#define PG8_SA(b, h) (((b) * 2 + (h)) * HTB)
#define PG8_SB(b, h) ((4 + (b) * 2 + (h)) * HTB)
#define PG8_STAGE(bufoff, gbase, voff) do { _Pragma("unroll") for (int _i = 0; _i < 2; ++_i) \
        __builtin_amdgcn_global_load_lds((const unsigned*)((const char*)(gbase) + (voff)[_i]), (PG8_LAS unsigned*)(lds + (bufoff) + ldsw + _i * 8192), 16, 0, 0); } while (0)
#define PG8_LDA(dst, b, h) do { _Pragma("unroll") for (int m = 0; m < 4; ++m) _Pragma("unroll") for (int k = 0; k < 2; ++k) dst[m][k] = *(const PG8_LAS bf16x8*)(lds + PG8_SA(b, h) + aoff + m * 2048 + k * 1024); } while (0)
#define PG8_LDB(dst, b, h) do { _Pragma("unroll") for (int n = 0; n < 2; ++n) _Pragma("unroll") for (int k = 0; k < 2; ++k) dst[n][k] = *(const PG8_LAS bf16x8*)(lds + PG8_SB(b, h) + boff + n * 2048 + k * 1024); } while (0)
#define PG8_MMA(ai, bj, At, Bt) do { __builtin_amdgcn_s_setprio(1); _Pragma("unroll") for (int m = 0; m < 4; ++m) _Pragma("unroll") for (int n = 0; n < 2; ++n) _Pragma("unroll") for (int k = 0; k < 2; ++k) \
        acc[ai][bj][m][n] = __builtin_amdgcn_mfma_f32_16x16x32_bf16(Bt[n][k], At[m][k], acc[ai][bj][m][n], 0, 0, 0); __builtin_amdgcn_s_setprio(0); } while (0)
#define PG8_WAIT_V(n) asm volatile("s_waitcnt vmcnt(" #n ")" ::: "memory")
#define PG8_WAIT_L(n) asm volatile("s_waitcnt lgkmcnt(" #n ")" ::: "memory")
#define PG8_BAR __builtin_amdgcn_s_barrier()
#define PG8_SCHED __builtin_amdgcn_sched_barrier(0)
    Unit cur, nxt; int ui = 0;
    if (!S.next(0, cur)) return;
    f32x4 acc[2][2][4][2];
#pragma unroll
    for (int a = 0; a < 2; ++a)
#pragma unroll
        for (int b = 0; b < 2; ++b)
#pragma unroll
            for (int m = 0; m < 4; ++m)
#pragma unroll
                for (int n = 0; n < 2; ++n) acc[a][b][m][n] = (f32x4){0.f, 0.f, 0.f, 0.f};
    bf16x8 At[4][2], B0[2][2], B1[2][2];
    const char* cA = (const char*)g.A + (size_t)cur.pm * tstep; const char* cB = (const char*)g.Bt + (size_t)cur.pn * tstep;
    S.a_ready(cur);
    if constexpr (SP2) {
        PG8_STAGE(PG8_SB(0, 0), cB, voffB); PG8_STAGE(PG8_SB(0, 1), cB + hstep, voffB); PG8_STAGE(PG8_SA(0, 0), cA, voffA); PG8_STAGE(PG8_SA(0, 1), cA + hstep, voffA);
        if (wr == 1) PG8_BAR;
        PG8_WAIT_V(2); PG8_BAR;
        PG8_STAGE(PG8_SB(1, 0), cB + kstep, voffB); PG8_STAGE(PG8_SA(1, 0), cA + kstep, voffA); PG8_STAGE(PG8_SB(1, 1), cB + hstep + kstep, voffB);
        PG8_WAIT_V(6); PG8_BAR;
    } else {
        PG8_STAGE(PG8_SB(0, 0), cB, voffB); PG8_STAGE(PG8_SA(0, 0), cA, voffA); PG8_STAGE(PG8_SB(0, 1), cB + hstep, voffB); PG8_STAGE(PG8_SA(0, 1), cA + hstep, voffA);
        if (wr == 1) PG8_BAR;
        PG8_WAIT_V(4); PG8_BAR;
        PG8_STAGE(PG8_SB(1, 0), cB + kstep, voffB); PG8_STAGE(PG8_SA(1, 0), cA + kstep, voffA); PG8_STAGE(PG8_SB(1, 1), cB + hstep + kstep, voffB);
        PG8_WAIT_V(6); PG8_BAR;
    }
    for (;;) {
        const bool has_next = S.next(ui + 1, nxt);
        const char* nA = has_next ? (const char*)g.A + (size_t)nxt.pm * tstep : cA; const char* nB = has_next ? (const char*)g.Bt + (size_t)nxt.pn * tstep : cB;
        for (int t = 0; t < nt; t += 2) {
            const bool last = (t == nt - 2);
            const char* a1 = cA + (size_t)(t + 1) * kstep;
            const char* a2 = last ? nA : cA + (size_t)(t + 2) * kstep; const char* b2 = last ? nB : cB + (size_t)(t + 2) * kstep;
            const char* a3 = a2 + kstep; const char* b3 = b2 + kstep;
            if (last && has_next) S.a_ready(nxt);
            if constexpr (SP2) {
            PG8_LDB(B0, 0, 0); PG8_LDB(B1, 0, 1); PG8_SCHED; PG8_LDA(At, 0, 0); PG8_STAGE(PG8_SA(1, 1), a1 + hstep, voffA);
            PG8_WAIT_V(8); PG8_WAIT_L(0); PG8_BAR; PG8_MMA(0, 0, At, B0); PG8_MMA(0, 1, At, B1); PG8_BAR; PG8_SCHED;
            PG8_LDA(At, 0, 1); PG8_STAGE(PG8_SB(0, 0), b2, voffB); PG8_STAGE(PG8_SB(0, 1), b2 + hstep, voffB); PG8_STAGE(PG8_SA(0, 0), a2, voffA);
            PG8_WAIT_V(8); PG8_WAIT_L(0); PG8_BAR; PG8_MMA(1, 0, At, B0); PG8_MMA(1, 1, At, B1); PG8_BAR; PG8_SCHED;
            PG8_LDB(B0, 1, 0); PG8_LDB(B1, 1, 1); PG8_SCHED; PG8_LDA(At, 1, 0); PG8_STAGE(PG8_SA(0, 1), a2 + hstep, voffA);
            PG8_WAIT_V(8); PG8_WAIT_L(0); PG8_BAR; PG8_MMA(0, 0, At, B0); PG8_MMA(0, 1, At, B1); PG8_BAR; PG8_SCHED;
            PG8_LDA(At, 1, 1); PG8_STAGE(PG8_SB(1, 0), b3, voffB); PG8_STAGE(PG8_SB(1, 1), b3 + hstep, voffB); PG8_STAGE(PG8_SA(1, 0), a3, voffA);
            PG8_WAIT_V(8); PG8_WAIT_L(0); PG8_BAR; PG8_MMA(1, 0, At, B0); PG8_MMA(1, 1, At, B1); PG8_BAR; PG8_SCHED;
            } else {
            PG8_LDB(B0, 0, 0); PG8_SCHED; PG8_LDA(At, 0, 0); PG8_STAGE(PG8_SA(1, 1), a1 + hstep, voffA);
            PG8_WAIT_L(8); PG8_BAR; PG8_WAIT_L(0); PG8_MMA(0, 0, At, B0); PG8_BAR; PG8_SCHED;
            PG8_LDB(B1, 0, 1); PG8_STAGE(PG8_SB(0, 0), b2, voffB);
            PG8_BAR; PG8_WAIT_L(0); PG8_MMA(0, 1, At, B1); PG8_BAR;
            PG8_LDA(At, 0, 1); PG8_STAGE(PG8_SA(0, 0), a2, voffA);
            PG8_BAR; PG8_WAIT_L(0); PG8_MMA(1, 0, At, B0); PG8_BAR; PG8_SCHED;
            PG8_STAGE(PG8_SB(0, 1), b2 + hstep, voffB);
            PG8_WAIT_V(6); PG8_BAR; PG8_MMA(1, 1, At, B1); PG8_BAR;
            PG8_LDB(B0, 1, 0); PG8_SCHED; PG8_LDA(At, 1, 0); PG8_STAGE(PG8_SA(0, 1), a2 + hstep, voffA);
            PG8_WAIT_L(8); PG8_BAR; PG8_WAIT_L(0); PG8_MMA(0, 0, At, B0); PG8_BAR; PG8_SCHED;
            PG8_LDB(B1, 1, 1); PG8_STAGE(PG8_SB(1, 0), b3, voffB);
            PG8_BAR; PG8_WAIT_L(0); PG8_MMA(0, 1, At, B1); PG8_BAR;
            PG8_LDA(At, 1, 1); PG8_STAGE(PG8_SA(1, 0), a3, voffA);
            PG8_BAR; PG8_WAIT_L(0); PG8_MMA(1, 0, At, B0); PG8_BAR; PG8_SCHED;
            PG8_STAGE(PG8_SB(1, 1), b3 + hstep, voffB);
            PG8_WAIT_V(6); PG8_BAR; PG8_MMA(1, 1, At, B1); PG8_BAR;
            }
        }
        if constexpr (ALIGN_EPI) { if (wr == 0) PG8_BAR; }
        if constexpr (!Epi::AFTER_DRAIN) { E(acc, cur, wr, wc, fr, fq); S.done(cur); }
        if (!has_next) break;
#pragma unroll
        for (int a = 0; a < 2; ++a)
#pragma unroll
            for (int b = 0; b < 2; ++b)
#pragma unroll
                for (int m = 0; m < 4; ++m)
#pragma unroll
                    for (int n = 0; n < 2; ++n) acc[a][b][m][n] = (f32x4){0.f, 0.f, 0.f, 0.f};
        cur = nxt; cA = nA; cB = nB; ++ui;
        if constexpr (ALIGN_EPI) { if (wr == 1) PG8_BAR; }
    }
    PG8_WAIT_V(0);
    if constexpr (!ALIGN_EPI) { if (wr == 0) PG8_BAR; }
    PG8_BAR;
    if constexpr (Epi::AFTER_DRAIN) { E.fused(acc, cur, wr, wc, fr, fq, lds, wid, lane); S.done(cur); }
#undef PG8_SA
#undef PG8_SB
#undef PG8_STAGE
#undef PG8_LDA
#undef PG8_LDB
#undef PG8_MMA
#undef PG8_WAIT_V
#undef PG8_WAIT_L
#undef PG8_BAR
#undef PG8_SCHED
}
}
#define XB_TMO      128
#define XB_XCNT(j)  (256  + 64 * (j))
#define XB_XSUB(j)  (1280 + 64 * (j))
#define XB_XGEN(j)  (2304 + 64 * (j))
#define XB_TOP      3328
#define XB_TOPGEN   3392
#define XCD_BAR_WORDS 3456
#define XB_SPIN_CAP (1u << 18)

__device__ __forceinline__ unsigned xb_ld(unsigned* p)              { return __hip_atomic_load(p, __ATOMIC_RELAXED, __HIP_MEMORY_SCOPE_AGENT); }
__device__ __forceinline__ unsigned xb_add(unsigned* p, unsigned v) { return __hip_atomic_fetch_add(p, v, __ATOMIC_RELAXED, __HIP_MEMORY_SCOPE_AGENT); }
__device__ __forceinline__ unsigned xb_xcc_id() { return (unsigned)__builtin_amdgcn_s_getreg((3 << 11) | 20) & 0xFu; }
#define XB_SPIN(cond, bar) do { unsigned _sp = 0; while (cond) { __builtin_amdgcn_s_sleep(1); \
    if ((++_sp & 255u) == 0u) { if (xb_ld(&(bar)[XB_TMO])) break; if (_sp > XB_SPIN_CAP) { atomicAdd(&(bar)[XB_TMO], 1u); break; } } } } while (0)

struct XcdBarrier {
    unsigned* bar; unsigned x;
    volatile LAS unsigned* st;
};

__device__ __forceinline__ XcdBarrier xcd_barrier_post(unsigned* bar, volatile LAS unsigned* st) {
    XcdBarrier b; b.bar = bar; b.x = xb_xcc_id(); b.st = st;
    if (threadIdx.x == 0) (void)xb_add(&bar[XB_XCNT(b.x)], 1u);
    return b;
}
__device__ __forceinline__ void xcd_barrier_complete(unsigned* bar, unsigned x, unsigned& nloc, unsigned& nx) {
    const unsigned G = gridDim.x * gridDim.y * gridDim.z;
    unsigned sum, cnt, mine, sp = 0u;
    for (;;) {
        sum = 0u; cnt = 0u; mine = 0u;
#pragma unroll
        for (unsigned j = 0; j < 16; ++j) { const unsigned c = xb_ld(&bar[XB_XCNT(j)]); sum += c; cnt += (c > 0u) ? 1u : 0u; mine = (j == x) ? c : mine; }
        if (sum == G) break;
        __builtin_amdgcn_s_sleep(1);
        if ((++sp & 255u) == 0u) { if (xb_ld(&bar[XB_TMO])) break; if (sp > XB_SPIN_CAP) { atomicAdd(&bar[XB_TMO], 1u); break; } }
    }
    nloc = mine > 0u ? mine : 1u; nx = cnt > 0u ? cnt : 1u;
}

__device__ __forceinline__ void xcd_barrier(const XcdBarrier& b) {
    asm volatile("s_waitcnt vmcnt(0)" ::: "memory");
    __syncthreads();
    if (threadIdx.x == 0) {
        unsigned* bar = b.bar;
        __builtin_amdgcn_s_waitcnt(0);
        unsigned nloc = b.st[0], nx = b.st[1];
        if (nloc == 0u) { xcd_barrier_complete(bar, b.x, nloc, nx); b.st[0] = nloc; b.st[1] = nx; }
        const unsigned old = xb_add(&bar[XB_XSUB(b.x)], 1u);
        const unsigned gen = old / nloc;
        if (old + 1u == (gen + 1u) * nloc) {
            __builtin_amdgcn_fence(__ATOMIC_RELEASE, "agent");
            asm volatile("s_waitcnt vmcnt(0)" ::: "memory");
            const unsigned og = xb_add(&bar[XB_TOP], 1u);
            const unsigned tg = og / nx;
            if (og + 1u == (tg + 1u) * nx) xb_add(&bar[XB_TOPGEN], 1u);
            else XB_SPIN(xb_ld(&bar[XB_TOPGEN]) == tg, bar);
            __builtin_amdgcn_fence(__ATOMIC_ACQUIRE, "agent");
            xb_add(&bar[XB_XGEN(b.x)], 1u);
            asm volatile("s_waitcnt vmcnt(0)" ::: "memory");
        } else {
            XB_SPIN(xb_ld(&bar[XB_XGEN(b.x)]) == gen, bar);
            __builtin_amdgcn_fence(__ATOMIC_ACQUIRE, "agent");
            asm volatile("s_waitcnt vmcnt(0)" ::: "memory");
        }
    }
    __syncthreads();
}


__device__ unsigned g_seam0[10 * 64];
__device__ __forceinline__ void seam0_barrier() {
    asm volatile("s_waitcnt vmcnt(0)" ::: "memory");
    __syncthreads();
    if (threadIdx.x == 0) {
        __builtin_amdgcn_fence(__ATOMIC_RELEASE, "agent");
        asm volatile("s_waitcnt vmcnt(0)" ::: "memory");
        const unsigned G = gridDim.x, s = blockIdx.x & 7u, ns = (G - s + 7u) >> 3, nsh = G < 8u ? G : 8u;
        const unsigned old = xb_add(&g_seam0[s * 64], 1u);
        const unsigned round = old / ns;
        if (old + 1u == (round + 1u) * ns) {
            const unsigned o2 = xb_add(&g_seam0[8 * 64], 1u);
            if ((o2 + 1u) % nsh == 0u) xb_add(&g_seam0[9 * 64], 1u);
        }
        unsigned sp = 0u;
        while ((int)(xb_ld(&g_seam0[9 * 64]) - (round + 1u)) < 0) { __builtin_amdgcn_s_sleep(2); if (++sp > (1u << 24)) break; }
        __builtin_amdgcn_fence(__ATOMIC_ACQUIRE, "agent");
        asm volatile("s_waitcnt vmcnt(0)" ::: "memory");
    }
    __syncthreads();
}
__device__ __forceinline__ int rowmap(int mode, int nn) {
    const int il = (nn & ~63) + 2 * (nn & 31) + ((nn >> 5) & 1);
    if (mode == 1) return nn < 1024 ? il : nn;
    if (mode == 2) { const int j = nn >> 7; return (j == 2 || j == 4) ? il : nn; }
    if (mode == 3) { const int half = nn >= DFF ? 1 : 0, ka = nn - half * DFF; return (ka >> 7) * 256 + half * 128 + (ka & 127); }
    return nn;
}
__device__ __forceinline__ void tr_item(const float* __restrict__ W, int ldn, int Nsrc, bf16* __restrict__ WT, int dstK, const float* __restrict__ gain, int mode, int item, int nblk,
                                        LAS float* scr, int lane) {
    const int kb = item / nblk, nb = item % nblk, k0 = 64 * kb, n0 = 32 * nb;
    const int n = n0 + (lane & 31);
    float wv[32];
#pragma unroll
    for (int i = 0; i < 32; ++i) { const int kk = 2 * i + (lane >> 5); wv[i] = (n < Nsrc) ? __builtin_nontemporal_load(W + (size_t)(k0 + kk) * ldn + n) : 0.f; }
#pragma unroll
    for (int i = 0; i < 32; ++i) { const int kk = 2 * i + (lane >> 5); float v = wv[i]; if (gain) v *= gain[k0 + kk]; scr[kk * 33 + (lane & 31)] = v; }
    asm volatile("s_waitcnt lgkmcnt(0)" ::: "memory");
    const int c = lane & 7;
#pragma unroll
    for (int j = 0; j < 4; ++j) {
        const int nl = (lane >> 3) + 8 * j; const LAS float* s = scr + (8 * c) * 33 + nl;
        u32x4 o; o.x = pk2(s[0 * 33], s[1 * 33]); o.y = pk2(s[2 * 33], s[3 * 33]); o.z = pk2(s[4 * 33], s[5 * 33]); o.w = pk2(s[6 * 33], s[7 * 33]);
        const int row = rowmap(mode, n0 + nl);
        *(u32x4*)(WT + (size_t)row * dstK + k0 + 8 * c) = o;
    }
    asm volatile("s_waitcnt lgkmcnt(0)" ::: "memory");
}

__device__ __forceinline__ void phase0(KP P, LAS unsigned char* lds, int tid, int lane, int wave, int G) {
    unsigned char* ws = P->ws;
    const int gw = launder_s(blockIdx.x) * 8 + wave, NGW = G * 8;
    const size_t gt = (size_t)launder_s(blockIdx.x) * 512 + tid, NGT = (size_t)G * 512;
    LAS float* scr = (LAS float*)(lds + wave * 16384);
    {
        const float* g_mix = (const float*)P->in[11]; const float* g_ffn = (const float*)P->in[12]; const float* g_ple = (const float*)P->in[13];
        constexpr int C_WIN = 16 * 80, C_WOUT = 20 * 32, C_WUP = 16 * 192, C_WDN = 48 * 32, C_WPI = 4 * 32, C_WPG = 16 * 32, C_WKV = 16 * 24, C_WQG = 16 * 40, C_WO = 16 * 32, C_WC1 = 16 * 4;
        constexpr int NITEMS = 2 * C_WIN + 2 * C_WOUT + 4 * C_WUP + 4 * C_WDN + 4 * C_WPI + 4 * C_WPG + C_WKV + 2 * C_WQG + 2 * C_WO + 4 * C_WC1;
        for (int it = gw; it < NITEMS; it += NGW) {
            int r = it;
            if (r < 2 * C_WIN) { const int L = r / C_WIN; r %= C_WIN;
                tr_item((const float*)P->in[15] + (size_t)L * 1024 * 2560, 2560, 2560, (bf16*)(ws + WS_WIN) + (size_t)L * 2560 * 1024, 1024, g_mix + L * 1024, 0, r, 80, scr, lane); continue; }
            r -= 2 * C_WIN;
            if (r < 2 * C_WOUT) { const int L = r / C_WOUT; r %= C_WOUT;
                tr_item((const float*)P->in[23] + (size_t)L * 1280 * 1024, 1024, 1024, (bf16*)(ws + WS_WOUT) + (size_t)L * 1024 * 1280, 1280, nullptr, 0, r, 32, scr, lane); continue; }
            r -= 2 * C_WOUT;
            if (r < 4 * C_WUP) { const int L = r / C_WUP; r %= C_WUP;
                tr_item((const float*)P->in[32] + (size_t)L * 1024 * 6144, 6144, 6144, (bf16*)(ws + WS_WUP) + (size_t)L * 6144 * 1024, 1024, g_ffn + L * 1024, 3, r, 192, scr, lane); continue; }
            r -= 4 * C_WUP;
            if (r < 4 * C_WDN) { const int L = r / C_WDN; r %= C_WDN;
                tr_item((const float*)P->in[35] + (size_t)L * 3072 * 1024, 1024, 1024, (bf16*)(ws + WS_WDN) + (size_t)L * 1024 * 3072, 3072, nullptr, 0, r, 32, scr, lane); continue; }
            r -= 4 * C_WDN;
            if (r < 4 * C_WPI) { const int L = r / C_WPI; r %= C_WPI;
                tr_item((const float*)P->in[36] + (size_t)L * 256 * 1024, 1024, 1024, (bf16*)(ws + WS_WPI) + (size_t)L * 1024 * 256, 256, nullptr, 0, r, 32, scr, lane); continue; }
            r -= 4 * C_WPI;
            if (r < 4 * C_WPG) { const int L = r / C_WPG; r %= C_WPG;
                tr_item((const float*)P->in[37] + (size_t)L * 1024 * 1024, 1024, 1024, (bf16*)(ws + WS_WPG) + (size_t)L * 1024 * 1024, 1024, g_ple + L * 1024, 0, r, 32, scr, lane); continue; }
            r -= 4 * C_WPG;
            if (r < C_WKV) { tr_item((const float*)P->in[25], 768, 768, (bf16*)(ws + WS_WKV), 1024, (const float*)P->in[24], 2, r, 24, scr, lane); continue; }
            r -= C_WKV;
            if (r < 2 * C_WQG) { const int L = r / C_WQG; r %= C_WQG;
                tr_item((const float*)P->in[30] + (size_t)L * 1024 * NQG, NQG, NQG, (bf16*)(ws + WS_WQG) + (size_t)L * NQGP * 1024, 1024, g_mix + (2 + L) * 1024, 1, r, 40, scr, lane); continue; }
            r -= 2 * C_WQG;
            if (r < 2 * C_WO) { const int L = r / C_WO; r %= C_WO;
                tr_item((const float*)P->in[31] + (size_t)L * 1024 * 1024, 1024, 1024, (bf16*)(ws + WS_WO) + (size_t)L * 1024 * 1024, 1024, nullptr, 0, r, 32, scr, lane); continue; }
            r -= 2 * C_WO;
            { const int q = r / C_WC1; r %= C_WC1; const int j = q >> 1, half = q & 1;
                tr_item((const float*)P->in[27] + (size_t)j * 2048 * 128 + (size_t)half * 1024 * 128, 128, 128, (bf16*)(ws + WS_WC1) + (size_t)j * 256 * 1024 + (size_t)half * 128 * 1024, 1024, nullptr, 0, r, 4, scr, lane); }
        }
    }
    {
        bf16* XB = (bf16*)(ws + WS_XB); bf16* XB1 = (bf16*)(ws + WS_X); float* PSS = (float*)(ws + WS_PSS);
        for (int m0 = gw; m0 < MPAD; m0 += 2 * NGW) {
          f32x4 vv[2][4];
#pragma unroll
          for (int q = 0; q < 2; ++q) { const int m = m0 + q * NGW;
            const float* src = m < MP ? (const float*)P->in[0] + (size_t)m * 1024 : (const float*)P->in[1] + (size_t)(m - MP) * 1024;
#pragma unroll
            for (int j = 0; j < 4; ++j) { vv[q][j] = (f32x4){0.f, 0.f, 0.f, 0.f}; if (m < MTOT) vv[q][j] = __builtin_nontemporal_load((const f32x4*)(src + 4 * lane + 256 * j)); } }
#pragma unroll
          for (int q = 0; q < 2; ++q) { const int m = m0 + q * NGW; if (m >= MPAD) break;
            float ss = 0.f;
#pragma unroll
            for (int j = 0; j < 4; ++j) {
                f32x4 v = vv[q][j];
                u32x2 w; w.x = pk2(v[0], v[1]); w.y = pk2(v[2], v[3]);
                *(u32x2*)(XB + (size_t)m * 1024 + 4 * lane + 256 * j) = w;
                if (m >= MTOT) *(u32x2*)(XB1 + (size_t)m * 1024 + 4 * lane + 256 * j) = w;
                v = unpack4(w);
                ss += (v[0] * v[0] + v[1] * v[1]) + (v[2] * v[2] + v[3] * v[3]);
            }
            ss = wave_sum(ss);
            if (lane < 16) PSS[(size_t)lane * MPAD + m] = (lane == 0) ? ss : 0.f;
            if (m >= MP && m < MTOT) ((float*)(ws + WS_SPSS))[lane * 32 + (m - MP)] = (lane == 0) ? ss : 0.f;
          }
        }
    }
    {
        bf16* PB = (bf16*)(ws + WS_PB);
        for (size_t i0 = gt; i0 < (size_t)4 * MPAD * 64; i0 += 8 * NGT) {
            f32x4 v[8];
#pragma unroll
            for (int q = 0; q < 8; ++q) { const size_t i = i0 + q * NGT; v[q] = (f32x4){0.f, 0.f, 0.f, 0.f};
                if (i < (size_t)4 * MPAD * 64) { const int c4 = (int)(i & 63); const size_t rm = i >> 6; const int m = (int)(rm % MPAD), L = (int)(rm / MPAD);
                    if (m < MP) v[q] = __builtin_nontemporal_load((const f32x4*)((const float*)P->in[2] + ((size_t)L * MP + m) * 256 + 4 * c4));
                    else if (m < MTOT) v[q] = *(const f32x4*)((const float*)P->in[3] + ((size_t)L * MS + (m - MP)) * 256 + 4 * c4); } }
#pragma unroll
            for (int q = 0; q < 8; ++q) { const size_t i = i0 + q * NGT;
                if (i < (size_t)4 * MPAD * 64) { u32x2 w; w.x = pk2(v[q][0], v[q][1]); w.y = pk2(v[q][2], v[q][3]); *(u32x2*)(PB + i * 4) = w; } }
        }
    }
    {
        const float* cache = (const float*)P->in[4]; const int* pt = (const int*)P->in[10]; bf16* CA = (bf16*)(ws + WS_CMPA);
        for (int item = launder_s(blockIdx.x); item < MS * NPG; item += G) {
            const int sb = item / NPG, pg = item % NPG;
            const float* src = cache + (size_t)pt[item] * (PGSZ * 256);
            static_assert(PGSZ * 64 == 16 * 512, "page = 16 float4 per thread");
#pragma unroll
            for (int hb = 0; hb < 2; ++hb) {
                f32x4 v[8];
#pragma unroll
                for (int q = 0; q < 8; ++q) v[q] = __builtin_nontemporal_load((const f32x4*)(src + (size_t)(tid + 512 * (8 * hb + q)) * 4));
#pragma unroll
                for (int q = 0; q < 8; ++q) { const int c = tid + 512 * (8 * hb + q);
                    const int f = c * 4, tl = f >> 8, rem = f & 255, j = rem >> 7, g = (rem >> 6) & 1, d = rem & 63;
                    u32x2 w; w.x = pk2(v[q][0], v[q][1]); w.y = pk2(v[q][2], v[q][3]);
                    const size_t row = (size_t)CMP_ROWS_P + (size_t)(g * MS + sb) * 512 + pg * 8 + (tl >> 4);
                    *(u32x2*)(CA + ((size_t)j * CMP_ROWS + row) * 1024 + (tl & 15) * 64 + d) = w; }
            }
        }
    }
    {
        float* RT = (float*)(ws + WS_ROPE);
        for (size_t i = gt; i < (size_t)4097 * 32; i += NGT) {
            const int fi = (int)(i & 31), pi = (int)(i >> 5); const int pos = pi < 4096 ? pi : PAST;
            double f = 1.0; for (int k = 0; k < fi; ++k) f *= 0.7498942093324559;
            const float ang = (float)pos * (float)f;
            const double x = (double)ang; const double kq = __builtin_rint(x * 0.6366197723675814);
            const double r = (x - kq * 1.5707963267948966) - kq * 6.123233995736766e-17, r2 = r * r;
            const double sn = r * (1.0 + r2 * (-1.0 / 6 + r2 * (1.0 / 120 + r2 * (-1.0 / 5040 + r2 * (1.0 / 362880 + r2 * (-1.0 / 39916800 + r2 * (1.0 / 6227020800.0)))))));
            const double cs = 1.0 + r2 * (-0.5 + r2 * (1.0 / 24 + r2 * (-1.0 / 720 + r2 * (1.0 / 40320 + r2 * (-1.0 / 3628800 + r2 * (1.0 / 479001600.0 + r2 * (-1.0 / 87178291200.0)))))));
            const int q = ((int)kq) & 3;
            const double s_ = (q == 0) ? sn : (q == 1) ? cs : (q == 2) ? -sn : -cs;
            const double c_ = (q == 0) ? cs : (q == 1) ? -sn : (q == 2) ? -cs : sn;
            RT[i * 2] = (float)c_; RT[i * 2 + 1] = (float)s_;
        }
    }
    {
        float* B1P = (float*)(ws + WS_B1F); const float* pos = (const float*)P->in[26]; const float* w1 = (const float*)P->in[27];
        for (size_t i = gt; i < (size_t)32 * 2 * 128; i += NGT) {
            const int e = (int)(i & 127), j = (int)((i >> 7) & 1), l = (int)(i >> 8);
            float s = 0.f;
#pragma unroll 16
            for (int d = 0; d < 64; ++d) s += pos[(l * 2 + j) * 64 + d] * w1[((size_t)j * 2048 + l * 64 + d) * 128 + e];
            B1P[i] = s;
        }
    }
    {
        bf16* WG = (bf16*)(ws + WS_WGA);
        for (size_t i = gt; i < (size_t)2 * 2 * 16 * 80 * 96; i += NGT) {
            const int k = (int)(i % 96); size_t r = i / 96; const int j = (int)(r % 80); r /= 80; const int n = (int)(r % 16); r /= 16; const int ax = (int)(r & 1), L = (int)(r >> 1);
            const float* src = (const float*)P->in[ax ? 20 : 18];
            const float v = k < 80 ? src[(((size_t)L * 16 + n) * 80 + k) * 80 + j] : 0.f;
            WG[i] = (bf16)f2bf(v);
        }
    }
    {
        const float* cw = (const float*)P->in[6]; float* o = P->out + O_WIN_S;
        for (size_t i0 = gt; i0 < (size_t)MS * 511 * 64; i0 += 4 * NGT) {
            f32x4 v[4];
#pragma unroll
            for (int q = 0; q < 4; ++q) { const size_t i = i0 + q * NGT; v[q] = (f32x4){0.f, 0.f, 0.f, 0.f};
                if (i < (size_t)MS * 511 * 64) { const int c4 = (int)(i & 63); const size_t rw = i >> 6; const int w = (int)(rw % 511), sb = (int)(rw / 511);
                    v[q] = __builtin_nontemporal_load((const f32x4*)(cw + ((size_t)sb * 512 + w + 1) * 256 + 4 * c4)); } }
#pragma unroll
            for (int q = 0; q < 4; ++q) { const size_t i = i0 + q * NGT;
                if (i < (size_t)MS * 511 * 64) { const int c4 = (int)(i & 63); const size_t rw = i >> 6; const int w = (int)(rw % 511), sb = (int)(rw / 511);
                    __builtin_nontemporal_store(v[q], (f32x4*)(o + ((size_t)sb * 512 + w) * 256 + 4 * c4)); } }
        }
    }
}

#define EPI_FOR_ROWS _Pragma("unroll") for (int ai = 0; ai < 2; ++ai) _Pragma("unroll") for (int m = 0; m < 4; ++m)
#define EPI_FOR_COLS _Pragma("unroll") for (int bj = 0; bj < 2; ++bj) _Pragma("unroll") for (int n = 0; n < 2; ++n) if (only < 0 || only == bj * 2 + n)
#define EPI_ROWL (ai * 128 + wr * 64 + m * 16 + fr)
#define EPI_COLL (bj * 128 + wc * 32 + n * 16 + 4 * fq)
typedef const f32x4 (&AccRef)[2][2][4][2];

__device__ __forceinline__ u32x2 pack4(f32x4 v) { u32x2 w; w.x = pk2(v[0], v[1]); w.y = pk2(v[2], v[3]); return w; }

__device__ __forceinline__ void rs_sample(const float* SP, LAS float* dst, int tid) {
    const int row = tid >> 4, part = tid & 15; float s = 0.f;
#pragma unroll
    for (int i = 0; i < 4; ++i) s += SP[(part * 4 + i) * 32 + row];
    s += __shfl_xor(s, 1); s += __shfl_xor(s, 2); s += __shfl_xor(s, 4); s += __shfl_xor(s, 8);
    if (part == 0) dst[row] = rsqrtf(s * (1.0f / 1024.0f) + EPS);
}
template <class Sched> __device__ __forceinline__ void rs_prepare(const Sched& S, const float* PSScur, const float* X, LAS float* rsb, int tid, bool thin) {
    pg8::Unit u;
    for (int i = 0; i < 7 && S.next(i, u); ++i) {
        if (tid < 256) { const int mrow = u.pm * 256 + tid; float s = 0.f;
#pragma unroll
            for (int k = 0; k < 16; ++k) s += PSScur[(size_t)k * MPAD + mrow];
            rsb[i * 256 + tid] = rsqrtf(s * (1.0f / 1024.0f) + EPS); }
    }
    if (thin) rs_sample(X, rsb + 7 * 256, tid);
    __syncthreads();
}
template <class E> __device__ __forceinline__ auto warm_call(const E& e, int fr, int fq, int cg, int) -> decltype(e.warm(fr, fq, cg)) { return e.warm(fr, fq, cg); }
template <class E> __device__ __forceinline__ float warm_call(const E&, int, int, int, long) { return 0.f; }
template <class E> __device__ __forceinline__ auto thin_epi(const E& e, f32x4 s0, f32x4 s1, int cg, int fr, int fq, int) -> decltype(e.thin(s0, s1, cg, fr, fq), true) { e.thin(s0, s1, cg, fr, fq); return true; }
template <class E> __device__ __forceinline__ bool thin_epi(const E&, f32x4, f32x4, int, int, int, long) { return false; }
template <int K, class Epi> __device__ __forceinline__ void thin_unit(LAS unsigned char* lds, const bf16* __restrict__ A, const bf16* __restrict__ Bt, int cg, const Epi& E) {
    int tid = threadIdx.x; asm volatile("" : "+v"(tid));
    const int wid = __builtin_amdgcn_readfirstlane(tid >> 6), lane = tid & 63, fr = lane & 15, fq = lane >> 4;
    f32x4 c0 = (f32x4){0.f, 0.f, 0.f, 0.f}, c1 = c0;
    float warm = 0.f; if (wid == 0) warm = warm_call(E, fr, fq, cg, 0);
    const bf16* ap = A + (size_t)(MP + fr) * K + fq * 8;
    const bf16* bp = Bt + (size_t)(cg * 16 + fr) * K + fq * 8;
    constexpr int NI = (K / 32) / 8;
    static_assert((K / 32) % 8 == 0, "thin unit K");
    bf16x8 bb[NI], aa0[NI], aa1[NI];
#pragma unroll
    for (int i = 0; i < NI; ++i) { const int ks = wid + 8 * i; bb[i] = *(const bf16x8*)(bp + ks * 32); aa0[i] = *(const bf16x8*)(ap + ks * 32); aa1[i] = *(const bf16x8*)(ap + (size_t)16 * K + ks * 32); }
#pragma unroll
    for (int i = 0; i < NI; ++i) { c0 = __builtin_amdgcn_mfma_f32_16x16x32_bf16(bb[i], aa0[i], c0, 0, 0, 0); c1 = __builtin_amdgcn_mfma_f32_16x16x32_bf16(bb[i], aa1[i], c1, 0, 0, 0); }
    LAS f32x4* red = (LAS f32x4*)lds;
    red[(wid * 2 + 0) * 64 + lane] = c0; red[(wid * 2 + 1) * 64 + lane] = c1;
    asm volatile("" :: "v"(warm));
    __syncthreads();
    if (wid == 0) {
        f32x4 s0 = red[lane], s1 = red[64 + lane];
#pragma unroll
        for (int w = 1; w < 8; ++w) { s0 += red[(w * 2) * 64 + lane]; s1 += red[(w * 2 + 1) * 64 + lane]; }
      if (!thin_epi(E, s0, s1, cg, fr, fq, 0)) {
        f32x4 acc[2][2][4][2];
        const float z_ = __builtin_bit_cast(float, launder_v(0));
#pragma unroll
        for (int a = 0; a < 2; ++a)
#pragma unroll
            for (int b = 0; b < 2; ++b)
#pragma unroll
                for (int m = 0; m < 4; ++m)
#pragma unroll
                    for (int n = 0; n < 2; ++n) acc[a][b][m][n] = (f32x4){z_, z_, z_, z_};
        const int bj = (cg >> 3) & 1, n = cg & 1;
#pragma unroll
        for (int b = 0; b < 2; ++b)
#pragma unroll
            for (int nn = 0; nn < 2; ++nn) if (b == bj && nn == n) { acc[0][b][0][nn] = s0; acc[0][b][1][nn] = s1; }
        pg8::Unit u; u.pm = MP / 256; u.pn = cg >> 4;
        E.only = bj * 2 + n;
        E(acc, u, 0, (cg >> 1) & 3, fr, fq);
        E.only = -1;
      }
    }
    __syncthreads();
}

struct EpiRG1 {
    static constexpr bool PERM = false, AFTER_DRAIN = false;
    unsigned char* ws; const LAS float* rs; mutable int slot; mutable int only = -1;
    __device__ __forceinline__ void operator()(AccRef acc, const pg8::Unit& u, int wr, int wc, int fr, int fq) const {
        fr = launder_v(fr); fq = launder_v(fq);
        const LAS float* rsl = rs + slot * 256; ++slot;
        bf16* Y = (bf16*)(ws + WS_Y); bf16* XR = (bf16*)(ws + WS_XR);
        EPI_FOR_ROWS { const int rl = EPI_ROWL, row = u.pm * 256 + rl; const float r = rsl[rl];
            EPI_FOR_COLS { const int col = u.pn * 256 + EPI_COLL; f32x4 v = acc[ai][bj][m][n] * r;
                if (row < MTOT) { if (u.pn < 5) { v[0] = gelu_tanh(v[0]); v[1] = gelu_tanh(v[1]); v[2] = gelu_tanh(v[2]); v[3] = gelu_tanh(v[3]); *(u32x2*)(Y + (size_t)row * DRNN + col) = pack4(v); }
                else *(u32x2*)(XR + (size_t)row * DRNN + (col - DRNN)) = pack4(v); } } }
    }
};
struct EpiRes {
    static constexpr bool PERM = false, AFTER_DRAIN = false;
    unsigned char* ws; float* PSSn; size_t soff; float scale; size_t xoff; mutable int only = -1;
    __device__ __forceinline__ float warm(int fr, int fq, int cg) const {
        const bf16* XB = (const bf16*)(ws + xoff); const size_t o0 = (size_t)(MP + fr) * DM + cg * 16 + 4 * fq, o1 = o0 + (size_t)16 * DM;
        float w = bf2f(XB[o0]) + bf2f(XB[o1]);
        if (soff) { const bf16* S = (const bf16*)(ws + soff); w += bf2f(S[o0]) + bf2f(S[o1]); }
        return w; }
    __device__ __forceinline__ void thin(f32x4 s0, f32x4 s1, int cg, int fr, int fq) const {
        bf16* XB = (bf16*)(ws + xoff); const bf16* S = soff ? (const bf16*)(ws + soff) : nullptr;
        const int nx = (int)((PSSn - (float*)(ws + WS_PSS)) / (16 * MPAD));
#pragma unroll
        for (int m = 0; m < 2; ++m) { const size_t o = (size_t)(MP + 16 * m + fr) * DM + cg * 16 + 4 * fq; f32x4 a = (m ? s1 : s0) * scale;
            if (S) a *= unpack4(*(const u32x2*)(S + o));
            const u32x2 xw = pack4(unpack4(*(const u32x2*)(XB + o)) + a); const f32x4 x = unpack4(xw);
            *(u32x2*)(XB + o) = xw;
            float ssq = (x[0] * x[0] + x[1] * x[1]) + (x[2] * x[2] + x[3] * x[3]);
            ssq += __shfl_xor(ssq, 16); ssq += __shfl_xor(ssq, 32);
            if (fq == 0) ((float*)(ws + WS_SPSS))[nx * 2048 + cg * 32 + 16 * m + fr] = ssq; }
    }
    __device__ __forceinline__ void operator()(AccRef acc, const pg8::Unit& u, int wr, int wc, int fr, int fq) const {
        fr = launder_v(fr); fq = launder_v(fq);
        bf16* XB = (bf16*)(ws + xoff); const bf16* S = soff ? (const bf16*)(ws + soff) : nullptr;
#pragma unroll
        for (int ai = 0; ai < 2; ++ai) {
#pragma unroll
          for (int mh = 0; mh < 2; ++mh) {
            u32x2 xv[4][2][2];
#pragma unroll
            for (int m = 2 * mh; m < 2 * mh + 2; ++m) { const int row = u.pm * 256 + EPI_ROWL;
                EPI_FOR_COLS { const int col = u.pn * 256 + EPI_COLL; if (row < MTOT) xv[m][bj][n] = *(const u32x2*)(XB + (size_t)row * DM + col); } }
#pragma unroll
            for (int m = 2 * mh; m < 2 * mh + 2; ++m) { const int rl = EPI_ROWL, row = u.pm * 256 + rl; float ssq = 0.f;
                EPI_FOR_COLS { const int col = u.pn * 256 + EPI_COLL; f32x4 a = acc[ai][bj][m][n] * scale;
                    if (row < MTOT) {
                    if (S) { const u32x2 sw = *(const u32x2*)(S + (size_t)row * DM + col);
                        a[0] *= __builtin_bit_cast(float, sw.x << 16); a[1] *= __builtin_bit_cast(float, sw.x & 0xffff0000u); a[2] *= __builtin_bit_cast(float, sw.y << 16); a[3] *= __builtin_bit_cast(float, sw.y & 0xffff0000u); }
                    const u32x2 xw = pack4(unpack4(xv[m][bj][n]) + a); const f32x4 x = unpack4(xw);
                    *(u32x2*)(XB + (size_t)row * DM + col) = xw;
                    ssq += (x[0] * x[0] + x[1] * x[1]) + (x[2] * x[2] + x[3] * x[3]); } }
                ssq += __shfl_xor(ssq, 16); ssq += __shfl_xor(ssq, 32);
                if (fq == 0) { if (row < MP) PSSn[(size_t)(u.pn * 4 + wc) * MPAD + row] = ssq;
                    else if (only >= 0 && row < MTOT) { const int nx = (int)((PSSn - (float*)(ws + WS_PSS)) / (16 * MPAD));
                        ((float*)(ws + WS_SPSS))[nx * 2048 + (u.pn * 16 + (only >> 1) * 8 + wc * 2 + (only & 1)) * 32 + (row - MP)] = ssq; } } }
          }
        }
    }
};
template <int CTRL> __device__ __forceinline__ float dppf(float x) { return __builtin_bit_cast(float, __builtin_amdgcn_update_dpp(0, __builtin_bit_cast(int, x), CTRL, 0xf, 0xf, true)); }
#define DPPF(src, ctrl) dppf<ctrl>(src)
template <int CTRL> __device__ __forceinline__ float dppf_old(float old, float x) { return __builtin_bit_cast(float, __builtin_amdgcn_update_dpp(__builtin_bit_cast(int, old), __builtin_bit_cast(int, x), CTRL, 0xf, 0xf, false)); }
struct EpiUp {
    static constexpr bool PERM = false, AFTER_DRAIN = false;
    unsigned char* ws; const LAS float* rs; float* out; const float* cw; const float* cb; LAS float* halo; int L; mutable int slot; mutable int only = -1;
    __device__ __forceinline__ void operator()(AccRef acc, const pg8::Unit& u, int wr, int wc, int fr, int fq) const {
        fr = launder_v(fr); fq = launder_v(fq);
        const LAS float* rsl = rs + slot * 256; ++slot;
        bf16* ACT = (bf16*)(ws + WS_ACT); float* UPH = (float*)(ws + WS_UPH) + (size_t)u.pm * 4 * DFF2 + u.pn * 256;
#pragma unroll
        for (int ai = 0; ai < 2; ++ai) { const int band = ai * 2 + wr; const float r3 = rsl[ai * 128 + wr * 64 + 48 + fr], r0 = rsl[ai * 128 + wr * 64 + fr];
#pragma unroll
            for (int bj = 0; bj < 2; ++bj)
#pragma unroll
                for (int n = 0; n < 2; ++n) { const int ci = bj * 128 + wc * 32 + n * 16 + 4 * fq;
                    if (fr >= 14) { const f32x4 v = acc[ai][bj][3][n] * r3; *(LAS f32x4*)(halo + (band * 2 + (fr - 14)) * 256 + ci) = v;
                        if (band == 3) *(f32x4*)(UPH + (size_t)(2 + fr - 14) * DFF2 + ci) = v; }
                    if (band == 0 && fr < 2) *(f32x4*)(UPH + (size_t)fr * DFF2 + ci) = acc[0][bj][0][n] * r0; } }
        asm volatile("s_waitcnt lgkmcnt(0)" ::: "memory"); __builtin_amdgcn_s_barrier(); asm volatile("" ::: "memory");
        const int b = u.pm >> 4; const bool last_tile = (u.pm & 15) == 15, first_tile = (u.pm & 15) == 0;
#pragma unroll
        for (int n = 0; n < 2; ++n) {
            const int ci = wc * 32 + n * 16 + 4 * fq, lca = u.pn * 128 + ci;
            f32x4 w[2][3], bs[2];
#pragma unroll
            for (int bj = 0; bj < 2; ++bj) { bs[bj] = *(const f32x4*)(cb + bj * DFF + lca);
#pragma unroll
                for (int k = 0; k < 3; ++k) w[bj][k] = *(const f32x4*)(cw + k * DFF2 + bj * DFF + lca); }
#pragma unroll
            for (int ai = 0; ai < 2; ++ai) {
                const int band = ai * 2 + wr;
                f32x4 s[4][2];
#pragma unroll
                for (int m = 0; m < 4; ++m) { const float r = rsl[ai * 128 + wr * 64 + m * 16 + fr]; s[m][0] = acc[ai][0][m][n] * r; s[m][1] = acc[ai][1][m][n] * r; }
#pragma unroll
                for (int m = 0; m < 4; ++m) {
                    const int rl = ai * 128 + wr * 64 + m * 16 + fr, row = u.pm * 256 + rl;
                    f32x4 uc[2];
#pragma unroll
                    for (int bj = 0; bj < 2; ++bj) {
                        f32x4 p1, p2;
                        if (m > 0) {
#pragma unroll
                            for (int e = 0; e < 4; ++e) { const float cur_ = s[m][bj][e], prv_ = s[m - 1][bj][e];
                                p1[e] = dppf_old<0x111>(dppf<0x121>(prv_), cur_); p2[e] = dppf_old<0x112>(dppf<0x122>(prv_), cur_); }
                        } else {
                            f32x4 h0 = (f32x4){0.f, 0.f, 0.f, 0.f}, h1 = h0;
                            if (band > 0) { h0 = *(const LAS f32x4*)(halo + ((band - 1) * 2 + 0) * 256 + bj * 128 + ci); h1 = *(const LAS f32x4*)(halo + ((band - 1) * 2 + 1) * 256 + bj * 128 + ci); }
#pragma unroll
                            for (int e = 0; e < 4; ++e) { const float cur_ = s[0][bj][e], h0_ = h0[e], h1_ = h1[e];
                                p1[e] = dppf_old<0x111>(h1_, cur_); p2[e] = dppf_old<0x112>((fr == 0) ? h0_ : h1_, cur_); }
                        }
                        uc[bj] = bs[bj] + w[bj][0] * p2 + w[bj][1] * p1 + w[bj][2] * s[m][bj];
                    }
                    f32x4 a;
#pragma unroll
                    for (int e = 0; e < 4; ++e) a[e] = gelu_tanh(uc[0][e]) * uc[1][e];
                    if (first_tile || rl >= 2) *(u32x2*)(ACT + (size_t)row * DFF + lca) = pack4(a);
                    if (last_tile && rl >= 254) {
                        float* o = out + O_FFC_P + ((size_t)(L * NB + b) * 2 + (rl - 254)) * DFF2 + lca;
                        *(f32x4*)o = s[m][0]; *(f32x4*)(o + DFF) = s[m][1]; }
                }
            }
        }
    }
};
__device__ __forceinline__ void act_fixup(unsigned char* ws, const float* cw, const float* cb, int pm, int tid) {
    if ((pm & 15) == 0) return;
    const float* own = (const float*)(ws + WS_UPH) + (size_t)pm * 4 * DFF2; const float* prv = own - (size_t)4 * DFF2; bf16* ACT = (bf16*)(ws + WS_ACT) + (size_t)pm * 256 * DFF;
#pragma unroll
    for (int k = tid; k < DFF; k += 512) {
        const int pa = (k >> 7) * 256 + (k & 127);
        float uc0[2], uc1[2];
#pragma unroll
        for (int h = 0; h < 2; ++h) { const int p = pa + h * 128, lc = h * DFF + k;
            const float w0 = cw[lc], w1 = cw[DFF2 + lc], w2 = cw[2 * DFF2 + lc], bb = cb[lc];
            const float q2 = prv[2 * DFF2 + p], q3 = prv[3 * DFF2 + p], o0 = own[p], o1 = own[DFF2 + p];
            uc0[h] = bb + w0 * q2 + w1 * q3 + w2 * o0; uc1[h] = bb + w0 * q3 + w1 * o0 + w2 * o1; }
        ACT[k] = (bf16)f2bf(gelu_tanh(uc0[0]) * uc0[1]); ACT[DFF + k] = (bf16)f2bf(gelu_tanh(uc1[0]) * uc1[1]);
    }
}
__device__ __forceinline__ void thin_unit_up(LAS unsigned char* lds, const bf16* __restrict__ A, const bf16* __restrict__ Bt, int pg, unsigned char* ws, const LAS float* rs32, float* out,
                                             const float* cw, const float* cb, const float* st, int L) {
    int tid = threadIdx.x; asm volatile("" : "+v"(tid));
    const int wid = __builtin_amdgcn_readfirstlane(tid >> 6), lane = tid & 63, fr = lane & 15, fq = lane >> 4, K = 1024;
    const int pn = pg >> 3, cgi = pg & 7;
    f32x4 c[2][2];
#pragma unroll
    for (int i = 0; i < 2; ++i) { c[i][0] = (f32x4){0.f, 0.f, 0.f, 0.f}; c[i][1] = c[i][0]; }
    const bf16* ap = A + (size_t)(MP + fr) * K + fq * 8;
    const bf16* bp = Bt + (size_t)(pn * 256 + cgi * 16 + fr) * K + fq * 8;
#pragma unroll
    for (int ks = wid; ks < 32; ks += 8) {
        const bf16x8 a0 = *(const bf16x8*)(ap + ks * 32), a1 = *(const bf16x8*)(ap + (size_t)16 * K + ks * 32);
        const bf16x8 b0 = *(const bf16x8*)(bp + ks * 32), b1 = *(const bf16x8*)(bp + (size_t)128 * K + ks * 32);
        c[0][0] = __builtin_amdgcn_mfma_f32_16x16x32_bf16(b0, a0, c[0][0], 0, 0, 0); c[0][1] = __builtin_amdgcn_mfma_f32_16x16x32_bf16(b0, a1, c[0][1], 0, 0, 0);
        c[1][0] = __builtin_amdgcn_mfma_f32_16x16x32_bf16(b1, a0, c[1][0], 0, 0, 0); c[1][1] = __builtin_amdgcn_mfma_f32_16x16x32_bf16(b1, a1, c[1][1], 0, 0, 0);
    }
    LAS f32x4* red = (LAS f32x4*)lds;
#pragma unroll
    for (int i = 0; i < 2; ++i)
#pragma unroll
        for (int m = 0; m < 2; ++m) red[(wid * 4 + i * 2 + m) * 64 + lane] = c[i][m];
    __syncthreads();
    if (wid == 0) {
        const int lca = pn * 128 + cgi * 16 + 4 * fq;
#pragma unroll
        for (int m = 0; m < 2; ++m) { const int sb = m * 16 + fr; const float r = rs32[sb];
            f32x4 uc[2];
#pragma unroll
            for (int i = 0; i < 2; ++i) { f32x4 s = red[(i * 2 + m) * 64 + lane];
#pragma unroll
                for (int w = 1; w < 8; ++w) s += red[(w * 4 + i * 2 + m) * 64 + lane];
                s = s * r; const int lc = i * DFF + lca; const size_t so = ((size_t)(L * MS + sb) * 2) * DFF2 + lc;
                const f32x4 s0 = *(const f32x4*)(st + so), s1 = *(const f32x4*)(st + so + DFF2);
                uc[i] = *(const f32x4*)(cb + lc) + *(const f32x4*)(cw + lc) * s0 + *(const f32x4*)(cw + DFF2 + lc) * s1 + *(const f32x4*)(cw + 2 * DFF2 + lc) * s;
                *(f32x4*)(out + O_FFC_S + so) = s1; *(f32x4*)(out + O_FFC_S + so + DFF2) = s; }
            f32x4 a;
#pragma unroll
            for (int e = 0; e < 4; ++e) a[e] = gelu_tanh(uc[0][e]) * uc[1][e];
            *(u32x2*)((bf16*)(ws + WS_ACT) + (size_t)(MP + sb) * DFF + lca) = pack4(a); }
    }
    __syncthreads();
}
struct EpiGate {
    static constexpr bool PERM = false, AFTER_DRAIN = false;
    unsigned char* ws; const LAS float* rs; float* PSSn; size_t pinoff; size_t xin, xout; mutable int slot; mutable int only = -1;
    __device__ __forceinline__ float warm(int fr, int fq, int cg) const {
        const bf16* Xr = (const bf16*)(ws + xin); const bf16* PIN = (const bf16*)(ws + pinoff); const size_t o0 = (size_t)(MP + fr) * DM + cg * 16 + 4 * fq, o1 = o0 + (size_t)16 * DM;
        return (bf2f(Xr[o0]) + bf2f(Xr[o1])) + (bf2f(PIN[o0]) + bf2f(PIN[o1])); }
    __device__ __forceinline__ void thin(f32x4 s0, f32x4 s1, int cg, int fr, int fq) const {
        const LAS float* rsl = rs + 7 * 256;
        const bf16* Xr = (const bf16*)(ws + xin); bf16* XB = (bf16*)(ws + xout); const bf16* PIN = (const bf16*)(ws + pinoff);
        const int nx = (int)((PSSn - (float*)(ws + WS_PSS)) / (16 * MPAD));
#pragma unroll
        for (int m = 0; m < 2; ++m) { const size_t o = (size_t)(MP + 16 * m + fr) * DM + cg * 16 + 4 * fq; f32x4 v = (m ? s1 : s0) * rsl[16 * m + fr];
            const f32x4 pv = unpack4(*(const u32x2*)(PIN + o));
            v[0] = sigmoidf_(v[0]) * pv[0]; v[1] = sigmoidf_(v[1]) * pv[1]; v[2] = sigmoidf_(v[2]) * pv[2]; v[3] = sigmoidf_(v[3]) * pv[3];
            const u32x2 xw = pack4(unpack4(*(const u32x2*)(Xr + o)) + v); const f32x4 x = unpack4(xw);
            *(u32x2*)(XB + o) = xw;
            float ssq = (x[0] * x[0] + x[1] * x[1]) + (x[2] * x[2] + x[3] * x[3]);
            ssq += __shfl_xor(ssq, 16); ssq += __shfl_xor(ssq, 32);
            if (fq == 0) ((float*)(ws + WS_SPSS))[nx * 2048 + cg * 32 + 16 * m + fr] = ssq; }
    }
    __device__ __forceinline__ void operator()(AccRef acc, const pg8::Unit& u, int wr, int wc, int fr, int fq) const {
        fr = launder_v(fr); fq = launder_v(fq);
        const LAS float* rsl = rs + slot * 256; ++slot;
        const bf16* __restrict__ Xr = (const bf16*)(ws + xin); bf16* __restrict__ XB = (bf16*)(ws + xout); const bf16* __restrict__ PIN = (const bf16*)(ws + pinoff);
#pragma unroll
        for (int ai = 0; ai < 2; ++ai) {
#pragma unroll
          for (int mh = 0; mh < 2; ++mh) {
            u32x2 xv[4][2][2]; u32x2 pv[4][2][2];
#pragma unroll
            for (int m = 2 * mh; m < 2 * mh + 2; ++m) { const int row = u.pm * 256 + EPI_ROWL;
                EPI_FOR_COLS { const int col = u.pn * 256 + EPI_COLL; if (row < MTOT) { xv[m][bj][n] = *(const u32x2*)(Xr + (size_t)row * DM + col); pv[m][bj][n] = *(const u32x2*)(PIN + (size_t)row * DM + col); } } }
#pragma unroll
            for (int m = 2 * mh; m < 2 * mh + 2; ++m) { const int rl = EPI_ROWL, row = u.pm * 256 + rl; const float r = rsl[rl]; float ssq = 0.f;
                EPI_FOR_COLS { const int col = u.pn * 256 + EPI_COLL;
                    if (row < MTOT) { f32x4 v = acc[ai][bj][m][n] * r; const u32x2 pw = pv[m][bj][n];
                        v[0] = sigmoidf_(v[0]) * __builtin_bit_cast(float, pw.x << 16); v[1] = sigmoidf_(v[1]) * __builtin_bit_cast(float, pw.x & 0xffff0000u);
                        v[2] = sigmoidf_(v[2]) * __builtin_bit_cast(float, pw.y << 16); v[3] = sigmoidf_(v[3]) * __builtin_bit_cast(float, pw.y & 0xffff0000u);
                        const u32x2 xw = pack4(unpack4(xv[m][bj][n]) + v); const f32x4 x = unpack4(xw);
                        *(u32x2*)(XB + (size_t)row * DM + col) = xw;
                        ssq += (x[0] * x[0] + x[1] * x[1]) + (x[2] * x[2] + x[3] * x[3]); } }
                ssq += __shfl_xor(ssq, 16); ssq += __shfl_xor(ssq, 32);
                if (fq == 0) { if (row < MP) PSSn[(size_t)(u.pn * 4 + wc) * MPAD + row] = ssq;
                    else if (only >= 0 && row < MTOT) { const int nx = (int)((PSSn - (float*)(ws + WS_PSS)) / (16 * MPAD));
                        ((float*)(ws + WS_SPSS))[nx * 2048 + (u.pn * 16 + (only >> 1) * 8 + wc * 2 + (only & 1)) * 32 + (row - MP)] = ssq; } } }
          }
        }
    }
};
struct EpiPin {
    static constexpr bool PERM = false, AFTER_DRAIN = false;
    unsigned char* ws; mutable int Lthin = -1; mutable int only = -1;
    __device__ __forceinline__ void operator()(AccRef acc, const pg8::Unit& u, int wr, int wc, int fr, int fq) const {
        fr = launder_v(fr); fq = launder_v(fq);
        const int L = Lthin >= 0 ? Lthin : u.pn >> 2, pm = Lthin >= 0 ? u.pm : u.pm - L * NMT, pn = Lthin >= 0 ? u.pn : u.pn & 3;
        bf16* PIN = (bf16*)(ws + WS_PIN) + (size_t)L * MPAD * DM;
        EPI_FOR_ROWS { const int rl = EPI_ROWL, row = pm * 256 + rl;
            if (row < MTOT) EPI_FOR_COLS { const int col = pn * 256 + EPI_COLL; *(u32x2*)(PIN + (size_t)row * DM + col) = pack4(acc[ai][bj][m][n]); } }
    }
};
struct PinOrder {
    int start, stride, count, Lb;
    __device__ __forceinline__ bool next(int i, pg8::Unit& u) const { if (i >= count) return false; const int idx = start + i * stride; if (idx >= 512) return false; const int L = Lb + (idx >> 8), w = idx & 255; u.pm = L * NMT + (w >> 2); u.pn = L * 4 + (w & 3); return true; }
    __device__ __forceinline__ void a_ready(const pg8::Unit&) const {}
    __device__ __forceinline__ void done(const pg8::Unit&) const {}
};
struct EpiT {
    static constexpr bool PERM = false, AFTER_DRAIN = false;
    bf16* T; mutable int only = -1;
    __device__ __forceinline__ void operator()(AccRef acc, const pg8::Unit& u, int wr, int wc, int fr, int fq) const {
        fr = launder_v(fr); fq = launder_v(fq);
        bf16* Tt = T + (size_t)u.pm * 65536;
        EPI_FOR_ROWS { const int rl = EPI_ROWL;
            EPI_FOR_COLS { *(u32x2*)(Tt + rl * 256 + EPI_COLL) = pack4(acc[ai][bj][m][n]); } }
    }
};
__device__ __forceinline__ f32x4 rope4(f32x4 v, const float* rt  , int d0) {
    const f32x4 cs = *(const f32x4*)(rt + 2 * d0);
    f32x4 o; o[0] = v[0] * cs[0] - v[1] * cs[1]; o[1] = v[1] * cs[0] + v[0] * cs[1]; o[2] = v[2] * cs[2] - v[3] * cs[3]; o[3] = v[3] * cs[2] + v[2] * cs[3]; return o;
}
struct EpiQ {
    static constexpr bool PERM = false, AFTER_DRAIN = false;
    unsigned char* ws; const LAS float* rs; mutable int slot; mutable int only = -1;
    __device__ __forceinline__ void operator()(AccRef acc, const pg8::Unit& u, int wr, int wc, int fr, int fq) const {
        fr = launder_v(fr); fq = launder_v(fq);
        const LAS float* rsl = rs + slot * 256; ++slot;
        bf16* Q = (bf16*)(ws + WS_Q); bf16* QR = (bf16*)(ws + WS_QR); float* GT = (float*)(ws + WS_GT); const float* RT = (const float*)(ws + WS_ROPE);
        EPI_FOR_ROWS { const int rl = EPI_ROWL, row = u.pm * 256 + rl; const float r = rsl[rl];
            const float* rt = RT + (size_t)(row < MP ? (row & (SEQ - 1)) : SEQ) * 64;
            if (row < MTOT) EPI_FOR_COLS { const int col = u.pn * 256 + EPI_COLL;
                if (u.pn < 4) { const f32x4 v = acc[ai][bj][m][n] * (r * C2);
                    *(u32x2*)(Q + (size_t)row * DM + col) = pack4(v);
                    *(u32x2*)(QR + (size_t)row * DM + col) = pack4(rope4(v, rt, (col & 63) >> 1)); }
                else if (col < NQG) { f32x4 v = acc[ai][bj][m][n] * r;
                    v[0] = sigmoidf_(v[0]); v[1] = sigmoidf_(v[1]); v[2] = sigmoidf_(v[2]); v[3] = sigmoidf_(v[3]);
                    *(f32x4*)(GT + (size_t)row * 48 + (col - 1024)) = v; } } }
    }
};
struct EpiKV {
    static constexpr bool PERM = false, AFTER_DRAIN = false;
    float* out; unsigned char* ws; const LAS float* rs; mutable int slot; mutable int only = -1;
    __device__ __forceinline__ void operator()(AccRef acc, const pg8::Unit& u, int wr, int wc, int fr, int fq) const {
        fr = launder_v(fr); fq = launder_v(fq);
        const LAS float* rsl = rs + slot * 256; ++slot;
        bf16* CA = (bf16*)(ws + WS_CMPA); bf16* KS = (bf16*)(ws + WS_KS); bf16* VTS = (bf16*)(ws + WS_VTS); bf16* KW = (bf16*)(ws + WS_KW); bf16* VTW = (bf16*)(ws + WS_VTW); const float* RT = (const float*)(ws + WS_ROPE);
        EPI_FOR_ROWS { const int rl = EPI_ROWL, row = u.pm * 256 + rl; const float r = rsl[rl];
            if (row < MTOT) {
            const bool smp = row >= MP; const int b = row >> 12, t = row & (SEQ - 1), sb = row - MP;
            const float* rt = RT + (size_t)(smp ? SEQ : t) * 64;
            EPI_FOR_COLS { const int col = u.pn * 256 + EPI_COLL; const int j = col >> 7, g = (col >> 6) & 1, e0 = col & 63;
                f32x4 v = acc[ai][bj][m][n] * r;
                if (j < 2) {
                    if (!smp) { *(f32x4*)(out + O_CMP_P + (size_t)row * 256 + col) = v;
                        *(u32x2*)(CA + ((size_t)j * CMP_ROWS + (size_t)(g * NB + b) * 256 + (t >> 4)) * 1024 + (t & 15) * 64 + e0) = pack4(v); }
                    else *(f32x4*)(out + O_CMP_S + (size_t)sb * 256 + col) = v;
                } else if (j == 2 || j == 4) {
                    const int d0 = e0 >> 1; const f32x4 q = rope4(v, rt, d0);
                    const int lc = (j - 2) * 128 + g * 64;
                    float* orow = nullptr;
                    if (j == 2) orow = smp ? out + O_SLC_S + (size_t)sb * 256 : out + O_SLC_P + (size_t)row * 256;
                    else if (smp) orow = out + O_WIN_S + ((size_t)sb * 512 + 511) * 256;
                    else if (t >= SEQ - 512) orow = out + O_WIN_P + ((size_t)b * 512 + (t - (SEQ - 512))) * 256;
                    if (orow) { float* p = orow + (lc & 255) + d0; *(f32x2*)p = (f32x2){q[0], q[2]}; *(f32x2*)(p + 32) = (f32x2){q[1], q[3]}; }
                    if (!smp) *(u32x2*)((j == 2 ? KS : KW) + ((size_t)(b * NG + g) * SEQ + t) * 64 + e0) = pack4(q);
                } else {
                    const int lc = 128 + g * 64 + e0;
                    float* orow = nullptr;
                    if (j == 3) orow = smp ? out + O_SLC_S + (size_t)sb * 256 : out + O_SLC_P + (size_t)row * 256;
                    else if (smp) orow = out + O_WIN_S + ((size_t)sb * 512 + 511) * 256;
                    else if (t >= SEQ - 512) orow = out + O_WIN_P + ((size_t)b * 512 + (t - (SEQ - 512))) * 256;
                    if (orow) *(f32x4*)(orow + lc) = v;
                    if (!smp) { bf16* vt = (j == 3 ? VTS : VTW) + ((size_t)(b * NG + g) * 64 + e0) * SEQ + t;
                        vt[0] = (bf16)f2bf(v[0]); vt[SEQ] = (bf16)f2bf(v[1]); vt[2 * SEQ] = (bf16)f2bf(v[2]); vt[3 * SEQ] = (bf16)f2bf(v[3]); }
                } } } }
    }
};

struct CmpOrder {
    int G, c, lo, hi;
    __device__ __forceinline__ bool next(int i, pg8::Unit& u) const { const int L = lo + i * G + c; if (L >= hi) return false; u.pm = L; u.pn = L / (CMP_ROWS / 256); return true; }
    __device__ __forceinline__ void a_ready(const pg8::Unit&) const {}
    __device__ __forceinline__ void done(const pg8::Unit&) const {}
};

__device__ __forceinline__ float rcp_fast(float x) { return __builtin_amdgcn_rcpf(x); }
__device__ __forceinline__ float softplus_neg(float lam) { const float e = __expf(-lam); return e < 0.03f ? e * (1.0f - e * (0.5f - e * ((1.0f / 3.0f) - 0.25f * e))) : (lam < -20.f ? -lam : __logf(1.0f + e)); }
__device__ __forceinline__ float sigmoid_fast(float x) { return rcp_fast(1.0f + __expf(-x)); }
__device__ __forceinline__ int rg2_unit(int bid, int G, int k) {
    constexpr int NU = 257 * 16;
    if (G != 256) { const int un = bid + k * G; return un < NU ? un : -1; }
    if (bid < 16) return k < 14 ? bid + 256 * k : (k == 14 ? 4096 + bid : -1);
    if (bid < 48) return k < 16 ? bid + 256 * k : (k == 16 ? (bid & 15) + 256 * (14 + ((bid >> 4) - 1)) : -1);
    return k < 16 ? bid + 256 * k : -1;
}
__device__ __forceinline__ void rg2_phase(KP P, LAS unsigned char* lds, int L, int tid, int lane, int wave, int G) {
    unsigned char* ws = P->ws;
    const bf16* XR = (const bf16*)(ws + WS_XR); bf16* HL = (bf16*)(ws + WS_HL); bf16* AC = (bf16*)(ws + WS_AC);
    const bf16* WG = (const bf16*)(ws + WS_WGA) + (size_t)L * 2 * 16 * 80 * 96;
    const float* cw = (const float*)P->in[16] + (size_t)L * 4 * DRNN; const float* cb = (const float*)P->in[17] + (size_t)L * DRNN;
    const float* b_a = (const float*)P->in[19] + (size_t)L * DRNN; const float* b_x = (const float*)P->in[21] + (size_t)L * DRNN; const float* lam = (const float*)P->in[22] + (size_t)L * DRNN;
    const float* st_c = (const float*)P->in[7] + (size_t)L * MS * 3 * DRNN; const float* st_h = (const float*)P->in[8] + (size_t)L * MS * DRNN;
    LAS bf16* wab = (LAS bf16*)(lds);
    LAS float* xrt = (LAS float*)(lds + 33280);
    LAS float* xcf = (LAS float*)(lds + 54720);
    LAS bf16* xcb = (LAS bf16*)(lds + 75200);
    LAS float* af = (LAS float*)(lds + 88512);
    LAS float* uf = (LAS float*)(lds + 108992);
    LAS float* agg = (LAS float*)(lds + 129472);
    LAS float* cws = (LAS float*)(lds + 132032);
    const int NU = 257 * 16, bid = launder_s(blockIdx.x);
    int cur_n = -1; bool have_pf = false; u32x2 pf[3];
    for (int uk = 0, un = rg2_unit(bid, G, 0); un >= 0; ++uk, un = rg2_unit(bid, G, uk)) {
        const int tl = un >> 4, n = un & 15, c0 = n * RGB; const bool smp = (tl == 256);
        const int m0 = tl * 64, t0 = m0 & (SEQ - 1), b = m0 >> 12;
        if (n != cur_n) {
            cur_n = n;
            for (int i = tid; i < 2 * 80 * 12; i += 512) { const int ck = i % 12, rw = i / 12; const int ax = rw / 80, j = rw % 80;
                *(LAS u32x4*)(wab + (size_t)rw * 104 + ck * 8) = *(const u32x4*)(WG + ((size_t)(ax * 16 + n) * 80 + j) * 96 + ck * 8); }
            for (int i = tid; i < 8 * 80; i += 512) { const int k = i / 80, c = i % 80, ch = c0 + c;
                cws[i] = (k < 4) ? cw[k * DRNN + ch] : (k == 4) ? cb[ch] : (k == 5) ? b_a[ch] : (k == 6) ? b_x[ch] : softplus_neg(lam[ch]); }
            for (int i = tid; i < 64 * 24; i += 512) xcb[(i / 24) * 104 + 80 + (i % 24)] = 0;
        }
        if (!smp) {
            if (!have_pf) {
#pragma unroll
                for (int k = 0; k < 3; ++k) { const int i = tid + 512 * k, r = i / 20, q = i % 20; pf[k] = (u32x2){0u, 0u};
                    if (i < 67 * 20 && t0 + r - 3 >= 0) pf[k] = *(const u32x2*)(XR + (size_t)(m0 + r - 3) * DRNN + c0 + 4 * q); } }
#pragma unroll
            for (int k = 0; k < 3; ++k) { const int i = tid + 512 * k, r = i / 20, q = i % 20; if (i < 67 * 20) *(LAS f32x4*)(xrt + r * 80 + 4 * q) = unpack4(pf[k]); }
            { const int un2 = rg2_unit(bid, G, uk + 1); have_pf = false;
              if (un2 >= 0 && (un2 >> 4) != 256) { const int m2 = (un2 >> 4) * 64, t2 = m2 & (SEQ - 1), c2 = (un2 & 15) * RGB; have_pf = true;
#pragma unroll
                for (int k = 0; k < 3; ++k) { const int i = tid + 512 * k, r = i / 20, q = i % 20; pf[k] = (u32x2){0u, 0u};
                    if (i < 67 * 20 && t2 + r - 3 >= 0) pf[k] = *(const u32x2*)(XR + (size_t)(m2 + r - 3) * DRNN + c2 + 4 * q); } } }
            __syncthreads();
            for (int rep_ = 0; rep_ < 1 + 4 * ((PROBE_DUP >> 23) & 1); ++rep_)
#pragma unroll
            for (int i = 0; i < 10; ++i) { const int e = tid + 512 * i, r = e / 80, c = e % 80;
                const float xc = cws[320 + c] + cws[c] * xrt[r * 80 + c] + cws[80 + c] * xrt[(r + 1) * 80 + c] + cws[160 + c] * xrt[(r + 2) * 80 + c] + cws[240 + c] * xrt[(r + 3) * 80 + c];
                xcf[e] = xc; xcb[r * 104 + c] = (bf16)f2bf(xc); }
        } else {
            __syncthreads();
            for (int e = tid; e < 64 * 80; e += 512) { const int r = e / 80, c = e % 80, ch = c0 + c; float xc = 0.f;
                if (r < MS) { xc = cws[320 + c] + cws[240 + c] * bf2f(XR[(size_t)(MP + r) * DRNN + ch]);
#pragma unroll
                    for (int k = 0; k < 3; ++k) xc += cws[k * 80 + c] * st_c[((size_t)r * 3 + k) * DRNN + ch]; }
                xcf[e] = xc; xcb[r * 104 + c] = (bf16)f2bf(xc); }
        }
        __syncthreads();
        for (int rep3_ = 0; rep3_ < 1 + 4 * ((PROBE_DUP >> 24) & 1); ++rep3_)
        { const int mt = wave & 3, jt0 = (wave >> 2) ? 3 : 0, jt1 = (wave >> 2) ? 5 : 3, fr = lane & 15, fq = lane >> 4;
            for (int jt = jt0; jt < jt1; ++jt) {
                f32x4 accA = (f32x4){0.f, 0.f, 0.f, 0.f}, accX = accA;
#pragma unroll
                for (int ks = 0; ks < 3; ++ks) {
                    const bf16x8 a = *(const LAS bf16x8*)(xcb + (size_t)(16 * mt + fr) * 104 + 32 * ks + 8 * fq);
                    const bf16x8 ba = *(const LAS bf16x8*)(wab + (size_t)(16 * jt + fr) * 104 + 32 * ks + 8 * fq);
                    const bf16x8 bx = *(const LAS bf16x8*)(wab + (size_t)(80 + 16 * jt + fr) * 104 + 32 * ks + 8 * fq);
                    accA = __builtin_amdgcn_mfma_f32_16x16x32_bf16(a, ba, accA, 0, 0, 0);
                    accX = __builtin_amdgcn_mfma_f32_16x16x32_bf16(a, bx, accX, 0, 0, 0);
                }
                const int c = 16 * jt + fr, ch = c0 + c;
                const float ba_ = cws[400 + c], bx_ = cws[480 + c], sp = cws[560 + c];
#pragma unroll
                for (int e = 0; e < 4; ++e) { const int r = 16 * mt + 4 * fq + e;
                    const float rg = sigmoid_fast(accA[e] + ba_), ig = sigmoid_fast(accX[e] + bx_);
                    const float la = -8.0f * rg * sp, a = __expf(la), x2 = 2.0f * la;
                    const float em = x2 * (1.0f + x2 * 0.5f * (1.0f + x2 * (1.0f / 3.0f) * (1.0f + x2 * 0.25f * (1.0f + x2 * 0.2f))));
                    float mult = __builtin_amdgcn_sqrtf(-em); if (!smp && t0 + r == 0) mult = 1.0f;
                    const float u = mult * (ig * xcf[r * 80 + c]);
                    if (!smp) { af[r * 80 + c] = a; uf[r * 80 + c] = u; }
                    else if (r < MS) { HL[(size_t)(MP + r) * DRNN + ch] = (bf16)f2bf(a * st_h[(size_t)r * DRNN + ch] + u); AC[(size_t)(MP + r) * DRNN + ch] = 0; } }
            } }
        __syncthreads();
        for (int rep4_ = 0; rep4_ < 1 + 4 * ((PROBE_DUP >> 25) & 1); ++rep4_)
        if (!smp) {
            const int ch = tid % 80, seg = tid / 80; float hs[16], ps[16];
            if (tid < 320) { float h = 0.f, p = 1.f;
#pragma unroll
                for (int r = 0; r < 16; ++r) { const float a = af[(seg * 16 + r) * 80 + ch], u = uf[(seg * 16 + r) * 80 + ch]; h = a * h + u; p *= a; hs[r] = h; ps[r] = p; }
                agg[(seg * 80 + ch) * 2] = p; agg[(seg * 80 + ch) * 2 + 1] = h; }
            __syncthreads();
            if (tid < 320) { float cy = 0.f, pc = 1.f;
                for (int s = 0; s < seg; ++s) { const float pp = agg[(s * 80 + ch) * 2], hh = agg[(s * 80 + ch) * 2 + 1]; cy = pp * cy + hh; pc *= pp; }
                bf16* hp = HL + (size_t)(m0 + seg * 16) * DRNN + c0 + ch; bf16* ap = AC + (size_t)(m0 + seg * 16) * DRNN + c0 + ch;
#pragma unroll
                for (int r = 0; r < 16; ++r) { hp[(size_t)r * DRNN] = (bf16)f2bf(hs[r] + ps[r] * cy); ap[(size_t)r * DRNN] = (bf16)f2bf(ps[r] * pc); } }
            else if (t0 == SEQ - 64 && tid >= 320 && tid < 320 + 80) { const int c = tid - 320;
#pragma unroll
                for (int k = 0; k < 3; ++k) P->out[O_RGC_P + ((size_t)(L * NB + b) * 3 + k) * DRNN + c0 + c] = xrt[(64 + k) * 80 + c]; }
        }
        __syncthreads();
    }
}
__device__ __forceinline__ void rg3_phase(KP P, LAS unsigned char* lds, int L, int tid, int G) {
    unsigned char* ws = P->ws;
    const bf16* HL = (const bf16*)(ws + WS_HL); const bf16* AC = (const bf16*)(ws + WS_AC); const bf16* Y = (const bf16*)(ws + WS_Y); bf16* Gb = (bf16*)(ws + WS_G);
    LAS float* cmb = (LAS float*)lds;
    const int oc = tid % 160, grp = tid / 160, c = oc * 8; const bool act = grp < 3;
    const f32x4 one4 = (f32x4){1.f, 1.f, 1.f, 1.f}, zero4 = (f32x4){0.f, 0.f, 0.f, 0.f};
    {
        const float* st_c = (const float*)P->in[7] + (size_t)L * MS * 3 * DRNN; const bf16* XR = (const bf16*)(ws + WS_XR);
        for (int e = launder_s(blockIdx.x) * 512 + tid; e < MS * 3 * DRNN; e += G * 512) { const int sb = e / (3 * DRNN), k = (e / DRNN) % 3, ch = e % DRNN;
            P->out[O_RGC_S + ((size_t)(L * MS + sb) * 3 + k) * DRNN + ch] = (k < 2) ? st_c[((size_t)sb * 3 + k + 1) * DRNN + ch] : bf2f(XR[(size_t)(MP + sb) * DRNN + ch]); }
    }
    for (int tl = launder_s(blockIdx.x); tl < 257; tl += G) {
        const bool smp = (tl == 256); const int m0 = tl * 64, b = m0 >> 12, kc = smp ? 0 : ((m0 & (SEQ - 1)) >> 6);
        if (act) {
            f32x4 cy0 = zero4, cy1 = zero4, ap0 = one4, ap1 = one4;
            const int lo = grp * kc / 3, hi = (grp + 1) * kc / 3;
            for (int kk = lo; kk < hi; kk += 4) {
                u32x4 aw[4], hw[4];
#pragma unroll
                for (int q = 0; q < 4; ++q) { aw[q] = (u32x4){0x3f803f80u, 0x3f803f80u, 0x3f803f80u, 0x3f803f80u}; hw[q] = (u32x4){0u, 0u, 0u, 0u};
                    if (kk + q < hi) { const size_t mr = (size_t)(b * SEQ + (kk + q) * 64 + 63) * DRNN + c; aw[q] = *(const u32x4*)(AC + mr); hw[q] = *(const u32x4*)(HL + mr); } }
#pragma unroll
                for (int q = 0; q < 4; ++q) { f32x4 a0, a1, h0, h1; unpack8(aw[q], a0, a1); unpack8(hw[q], h0, h1); cy0 = a0 * cy0 + h0; cy1 = a1 * cy1 + h1; ap0 *= a0; ap1 *= a1; }
            }
            *(LAS f32x4*)(cmb + (grp * 2 + 0) * 1280 + c) = ap0; *(LAS f32x4*)(cmb + (grp * 2 + 0) * 1280 + c + 4) = ap1;
            *(LAS f32x4*)(cmb + (grp * 2 + 1) * 1280 + c) = cy0; *(LAS f32x4*)(cmb + (grp * 2 + 1) * 1280 + c + 4) = cy1;
        }
        __syncthreads();
        if (act) {
            f32x4 cy0 = zero4, cy1 = zero4;
#pragma unroll
            for (int g2 = 0; g2 < 3; ++g2) {
                const f32x4 A0 = *(const LAS f32x4*)(cmb + (g2 * 2 + 0) * 1280 + c), A1 = *(const LAS f32x4*)(cmb + (g2 * 2 + 0) * 1280 + c + 4);
                const f32x4 H0 = *(const LAS f32x4*)(cmb + (g2 * 2 + 1) * 1280 + c), H1 = *(const LAS f32x4*)(cmb + (g2 * 2 + 1) * 1280 + c + 4);
                cy0 = A0 * cy0 + H0; cy1 = A1 * cy1 + H1; }
            const int nr = smp ? MS : 64;
            for (int r0 = grp; r0 < nr; r0 += 12) {
                u32x4 hlw[4], acw[4], yw[4];
#pragma unroll
                for (int q = 0; q < 4; ++q) { const int r = r0 + 3 * q; hlw[q] = (u32x4){0u, 0u, 0u, 0u}; acw[q] = hlw[q]; yw[q] = hlw[q];
                    if (r < nr) { const size_t mr = (size_t)(m0 + r) * DRNN + c; hlw[q] = *(const u32x4*)(HL + mr); acw[q] = *(const u32x4*)(AC + mr); yw[q] = *(const u32x4*)(Y + mr); } }
#pragma unroll
                for (int q = 0; q < 4; ++q) { const int r = r0 + 3 * q;
                    if (r < nr) { const size_t mr = (size_t)(m0 + r) * DRNN + c;
                        f32x4 hl0, hl1, ac0, ac1; unpack8(hlw[q], hl0, hl1); unpack8(acw[q], ac0, ac1);
                        const f32x4 h0 = hl0 + ac0 * cy0, h1 = hl1 + ac1 * cy1; u32x4 o;
                        o.x = pk2(__builtin_bit_cast(float, yw[q].x << 16) * h0[0], __builtin_bit_cast(float, yw[q].x & 0xffff0000u) * h0[1]);
                        o.y = pk2(__builtin_bit_cast(float, yw[q].y << 16) * h0[2], __builtin_bit_cast(float, yw[q].y & 0xffff0000u) * h0[3]);
                        o.z = pk2(__builtin_bit_cast(float, yw[q].z << 16) * h1[0], __builtin_bit_cast(float, yw[q].z & 0xffff0000u) * h1[1]);
                        o.w = pk2(__builtin_bit_cast(float, yw[q].w << 16) * h1[2], __builtin_bit_cast(float, yw[q].w & 0xffff0000u) * h1[3]);
                        *(u32x4*)(Gb + mr) = o;
                        if (smp) { float* op = P->out + O_RGH_S + (size_t)(L * MS + r) * DRNN + c; *(f32x4*)op = h0; *(f32x4*)(op + 4) = h1; }
                        else if (kc == 63 && r == 63) { float* op = P->out + O_RGH_P + (size_t)(L * NB + b) * DRNN + c; *(f32x4*)op = h0; *(f32x4*)(op + 4) = h1; } } }
            }
        }
        __syncthreads();
    }
}
__device__ __forceinline__ void cmp2_phase(KP P, LAS unsigned char* lds, int tid, int lane, int wave, int G) {
    unsigned char* ws = P->ws;
    const bf16* T = (const bf16*)(ws + WS_T); const float* B1P = (const float*)(ws + WS_B1F); const float* b1 = (const float*)P->in[28]; const float* w2 = (const float*)P->in[29];
    bf16* KC = (bf16*)(ws + WS_KC); bf16* VCT = (bf16*)(ws + WS_VCT); float* KCS = (float*)(ws + WS_KCS); float* VCS = (float*)(ws + WS_VCS);
    LAS bf16* w2b = (LAS bf16*)lds;
    LAS float* b1s = (LAS float*)(lds + 34816);
    LAS bf16* hidb = (LAS bf16*)(lds + 35840);
    for (int i = tid; i < 2 * 128 * 64; i += 512) { const int d = i & 63, e = (i >> 6) & 127, j = i >> 13; w2b[(j * 64 + d) * 136 + e] = (bf16)f2bf(w2[i]); }
    if (tid < 256) { float s = b1[tid];
        for (int l = 0; l < 32; ++l) s += B1P[l * 256 + tid];
        b1s[tid] = s; }
    __syncthreads();
    const int NU = 2 * CMP_ROWS / 64;
    const int mt = wave & 3, nh = wave >> 2, fr = lane & 15, fq = lane >> 4;
    for (int un = launder_s(blockIdx.x); un < NU; un += G) {
        const int slot0 = un * 64, j = slot0 / CMP_ROWS, row0 = slot0 % CMP_ROWS;
#pragma unroll
        for (int q = 0; q < 4; ++q) { const int idx = tid + 512 * q, r = idx >> 5, e4 = (idx & 31) * 4; const int row = row0 + r;
            const bool smp = row >= CMP_ROWS_P; const int cb = smp ? ((row - CMP_ROWS_P) & 511) : (row & 255); const bool valid = cb < (smp ? NCB_S : NCB_P);
            f32x4 h = (f32x4){0.f, 0.f, 0.f, 0.f};
            if (valid) { const f32x4 a = unpack4(*(const u32x2*)(T + (size_t)(slot0 + r) * 256 + e4)), bq = unpack4(*(const u32x2*)(T + (size_t)(slot0 + r + 1) * 256 + 128 + e4)), bb = *(const LAS f32x4*)(b1s + j * 128 + e4);
#pragma unroll
                for (int k = 0; k < 4; ++k) h[k] = gelu_tanh(a[k] + bq[k] + bb[k]); }
            *(LAS u32x2*)(hidb + r * 136 + e4) = (u32x2){pk2(h[0], h[1]), pk2(h[2], h[3])}; }
        __syncthreads();
        f32x4 acc[2];
#pragma unroll
        for (int n = 0; n < 2; ++n) { acc[n] = (f32x4){0.f, 0.f, 0.f, 0.f};
#pragma unroll
            for (int ks = 0; ks < 4; ++ks) { const bf16x8 a = *(const LAS bf16x8*)(hidb + (16 * mt + fr) * 136 + 32 * ks + 8 * fq);
                const bf16x8 b = *(const LAS bf16x8*)(w2b + (j * 64 + 16 * (2 * nh + n) + fr) * 136 + 32 * ks + 8 * fq);
                acc[n] = __builtin_amdgcn_mfma_f32_16x16x32_bf16(a, b, acc[n], 0, 0, 0); } }
#pragma unroll
        for (int n = 0; n < 2; ++n) { const int d = 16 * (2 * nh + n) + fr;
#pragma unroll
            for (int e = 0; e < 4; ++e) { const int row = row0 + 16 * mt + 4 * fq + e; const float o = acc[n][e];
                if (row < CMP_ROWS_P) { const int g = row >> 10, bb = (row >> 8) & 3, cb = row & 255;
                    if (j == 0) KC[((size_t)(bb * NG + g) * 256 + cb) * 64 + 2 * (d & 31) + (d >> 5)] = (bf16)f2bf(o);
                    else VCT[((size_t)(bb * NG + g) * 64 + d) * 256 + cb] = (bf16)f2bf(o); }
                else { const int rr = row - CMP_ROWS_P, g = rr >> 14, sb = (rr >> 9) & 31, cb = rr & 511;
                    (j == 0 ? KCS : VCS)[((size_t)(sb * NG + g) * 512 + cb) * 64 + d] = o; } } }
        __syncthreads();
    }
}
__device__ __forceinline__ void final_phase(KP P, const float* PSScur, const float* SPcur, int lane, int wave, int G) {
    const bf16* X = (const bf16*)(P->ws + xb_off(4)); const float* gf = (const float*)P->in[14];
    f32x4 gg[4];
#pragma unroll
    for (int jj = 0; jj < 4; ++jj) gg[jj] = *(const f32x4*)(gf + 4 * lane + 256 * jj);
    const int NGW = G * 8;
    for (int m0 = launder_s(blockIdx.x) * 8 + wave; m0 < MTOT; m0 += 2 * NGW) {
        float sp[2]; u32x2 xv[2][4];
#pragma unroll
        for (int q = 0; q < 2; ++q) { const int m = m0 + q * NGW; sp[q] = 0.f;
            if (m < MTOT) {
                if (m < MP) { if (lane < 16) sp[q] = PSScur[(size_t)lane * MPAD + m]; } else sp[q] = SPcur[lane * 32 + (m - MP)];
#pragma unroll
                for (int jj = 0; jj < 4; ++jj) xv[q][jj] = *(const u32x2*)(X + (size_t)m * DM + 4 * lane + 256 * jj); } }
#pragma unroll
        for (int q = 0; q < 2; ++q) { const int m = m0 + q * NGW;
            if (m < MTOT) {
                const float rs = rsqrtf(wave_sum(sp[q]) * (1.0f / 1024.0f) + EPS);
                float* o = m < MP ? P->out + O_Y_P + (size_t)m * DM : P->out + O_Y_S + (size_t)(m - MP) * DM;
#pragma unroll
                for (int jj = 0; jj < 4; ++jj) { const int c = 4 * lane + 256 * jj; __builtin_nontemporal_store(unpack4(xv[q][jj]) * rs * gg[jj], (f32x4*)(o + c)); } } }
    }
}

constexpr int AT_KT = 0, AT_KTB = 18432, AT_VT = 36864, AT_VTB = 17408, AT_QS = 71680, AT_LS = 79872, AT_MASK = 88064, AT_QF = 88320, AT_STASH = 121088;
constexpr int AT_ROWB = 144, AT_VROWB = 272;
__device__ __forceinline__ unsigned cvtpk(float lo, float hi) { return pk2(lo, hi); }

template <int MODE>
__device__ __forceinline__ void attn_pass(LAS unsigned char* lds, const bf16* __restrict__ Kg, const bf16* __restrict__ Vtg, int vstride, int tb, int te, const LAS unsigned char* qfl,
                                          int klo, int khi, unsigned long long selmask, float& m_run, float& l_run, f32x16& o0, f32x16& o1, float inv_l, int tokrow, int tid, int lane) {
    if (te <= tb) return;
    const int r32 = lane & 31, hi = lane >> 5, lrow = tid >> 3, lch = tid & 7;
    const unsigned kofs = (unsigned)(lrow * AT_ROWB + lch * 16), vofs = (unsigned)(lrow * AT_VROWB + lch * 16);
    const bf16* kp = Kg + (size_t)lrow * 64 + lch * 8; const bf16* vp = Vtg + (size_t)lrow * vstride + lch * 8;
    u32x4 kreg0 = *(const u32x4*)(kp + (size_t)tb * 8192), kreg1 = *(const u32x4*)(kp + (size_t)tb * 8192 + 4096);
    u32x4 vreg0 = (u32x4){0u, 0u, 0u, 0u}, vreg1 = vreg0;
    if (MODE != 0) { vreg0 = *(const u32x4*)(vp + tb * 128); vreg1 = *(const u32x4*)(vp + tb * 128 + 64); }
    *(LAS u32x4*)(lds + AT_KT + kofs) = kreg0; *(LAS u32x4*)(lds + AT_KT + 64 * AT_ROWB + kofs) = kreg1;
    if (MODE != 0) { *(LAS u32x4*)(lds + AT_VT + vofs) = vreg0; *(LAS u32x4*)(lds + AT_VT + 128 + vofs) = vreg1; }
    __syncthreads();
    for (int t = tb; t < te; ++t) {
        const int buf = (t - tb) & 1, key0 = t * 128;
        if (t + 1 < te) { kreg0 = *(const u32x4*)(kp + (size_t)(t + 1) * 8192); kreg1 = *(const u32x4*)(kp + (size_t)(t + 1) * 8192 + 4096);
            if (MODE != 0) { vreg0 = *(const u32x4*)(vp + (t + 1) * 128); vreg1 = *(const u32x4*)(vp + (t + 1) * 128 + 64); } }
        const bool selA = (MODE == 2) ? ((selmask >> (2 * t)) & 1ull) != 0ull : true, selB = (MODE == 2) ? ((selmask >> (2 * t + 1)) & 1ull) != 0ull : true;
        const bool anyA = selA && (key0 <= khi) && (key0 + 63 >= klo), anyB = selB && (key0 + 64 <= khi) && (key0 + 127 >= klo);
        if (__builtin_amdgcn_ballot_w64(anyA || anyB) != 0ull) {
            const LAS unsigned char* Kb = lds + AT_KT + buf * AT_KTB; const LAS unsigned char* Vb = lds + AT_VT + buf * AT_VTB;
            const bool fullA = selA && (key0 >= klo) && (key0 + 63 <= khi), fullB = selB && (key0 + 64 >= klo) && (key0 + 127 <= khi);
            const bool partial = __builtin_amdgcn_ballot_w64((anyA && !fullA) || (anyB && !fullB)) != 0ull;
            const float base = (m_run == -INFINITY) ? 0.f : -m_run;
            const float ciA = (MODE >= 2) ? ((fullA || (partial && anyA)) ? base : -INFINITY) : 0.f, ciB = (MODE >= 2) ? ((fullB || (partial && anyB)) ? base : -INFINITY) : 0.f;
            f32x16 p[4];
#pragma unroll
            for (int r = 0; r < 16; ++r) { p[0][r] = ciA; p[1][r] = ciA; p[2][r] = ciB; p[3][r] = ciB; }
            __builtin_amdgcn_s_setprio(1);
#pragma unroll
            for (int c = 0; c < 4; ++c)
#pragma unroll
                for (int i = 0; i < 4; ++i) { const bf16x8 a = *(const LAS bf16x8*)(Kb + (32 * i + r32) * AT_ROWB + c * 32 + hi * 16);
                    p[i] = __builtin_amdgcn_mfma_f32_32x32x16_bf16(a, *(const LAS bf16x8*)(qfl + c * 1024), p[i], 0, 0, 0);
                    if (i == 3 && (c & 1)) __builtin_amdgcn_sched_barrier(0); }
            __builtin_amdgcn_s_setprio(0);
            float mx = -INFINITY;
            if (!partial && MODE >= 2) {
#pragma unroll
                for (int r = 0; r < 16; ++r) mx = fmaxf(fmaxf(mx, fmaxf(p[0][r], p[1][r])), fmaxf(p[2][r], p[3][r]));
            } else {
#pragma unroll
                for (int i = 0; i < 4; ++i) { const bool sl = (i < 2) ? selA : selB; const int kb0 = key0 + 32 * i + 4 * hi;
#pragma unroll
                    for (int r = 0; r < 16; ++r) { const int k = kb0 + (r & 3) + 8 * (r >> 2); p[i][r] = (sl && k >= klo && k <= khi) ? p[i][r] : -INFINITY; mx = fmaxf(mx, p[i][r]); } }
            }
            float ls = 0.f;
            if (MODE >= 2) {
                mx = fmaxf(mx, __shfl_xor(mx, 32));
                const bool moved = (m_run == -INFINITY) ? (mx != -INFINITY) : (mx > 0.f);
                if (__builtin_amdgcn_ballot_w64(moved) != 0ull) {
                    const float delta = moved ? mx : 0.f;
                    const float alpha = (m_run == -INFINITY) ? 1.f : __builtin_amdgcn_exp2f(-delta);
                    m_run = moved ? ((m_run == -INFINITY) ? mx : m_run + mx) : m_run;
                    l_run *= alpha;
#pragma unroll
                    for (int r = 0; r < 16; ++r) { o0[r] *= alpha; o1[r] *= alpha; p[0][r] -= delta; p[1][r] -= delta; p[2][r] -= delta; p[3][r] -= delta; }
                }
#pragma unroll
                for (int i = 0; i < 4; ++i)
#pragma unroll
                    for (int r = 0; r < 16; ++r) { p[i][r] = __builtin_amdgcn_exp2f(p[i][r]); ls += p[i][r]; }
            } else {
                float m_use;
                if (MODE == 1) { m_use = (m_run == -INFINITY) ? 0.f : m_run; }
                else {
                    mx = fmaxf(mx, __shfl_xor(mx, 32));
                    const float m_new = fmaxf(m_run, mx); m_use = (m_new == -INFINITY) ? 0.f : m_new;
                    const float alpha = __builtin_amdgcn_exp2f(m_run - m_use);
                    l_run *= alpha; m_run = m_new;
                }
#pragma unroll
                for (int i = 0; i < 4; ++i)
#pragma unroll
                    for (int r = 0; r < 16; ++r) { p[i][r] = __builtin_amdgcn_exp2f(p[i][r] - m_use); ls += p[i][r]; }
            }
            if (MODE != 1) l_run += ls;
            if (MODE == 1) {
                LAS float* QS = (LAS float*)(lds + AT_QS); LAS float* LS = (LAS float*)(lds + AT_LS);
#pragma unroll
                for (int i = 0; i < 4; ++i) {
#pragma unroll
                    for (int r = 0; r < 16; ++r) p[i][r] *= inv_l;
#pragma unroll
                    for (int jq = 0; jq < 4; ++jq) {
                        float q0 = (p[i][4 * jq] + p[i][4 * jq + 1]) + (p[i][4 * jq + 2] + p[i][4 * jq + 3]), l0 = p[i][4 * jq + 3];
#pragma unroll
                        for (int o = 1; o < 8; o <<= 1) { q0 += __shfl_xor(q0, o); l0 += __shfl_xor(l0, o); }
                        if ((lane & 7) == 0) { const int qd = 32 * t + 8 * i + 2 * jq + hi; QS[tokrow * 64 + qd] = q0; LS[tokrow * 64 + qd] = l0; }
                    }
                }
            }
            if (MODE != 0) {
#pragma unroll
                for (int j = 0; j < 8; ++j) {
                    const int i = j >> 1, rb = 8 * (j & 1);
                    u32x4 pw; pw.x = cvtpk(p[i][rb], p[i][rb + 1]); pw.y = cvtpk(p[i][rb + 2], p[i][rb + 3]); pw.z = cvtpk(p[i][rb + 4], p[i][rb + 5]); pw.w = cvtpk(p[i][rb + 6], p[i][rb + 7]);
                    const bf16x8 pb = __builtin_bit_cast(bf16x8, pw);
                    { const LAS unsigned char* vq = Vb + r32 * AT_VROWB + (16 * j + 4 * hi) * 2;
                      const u32x2 lo = *(const LAS u32x2*)vq, hh = *(const LAS u32x2*)(vq + 16);
                      o0 = __builtin_amdgcn_mfma_f32_32x32x16_bf16(__builtin_bit_cast(bf16x8, (u32x4){lo.x, lo.y, hh.x, hh.y}), pb, o0, 0, 0, 0); }
                    { const LAS unsigned char* vq = Vb + (32 + r32) * AT_VROWB + (16 * j + 4 * hi) * 2;
                      const u32x2 lo = *(const LAS u32x2*)vq, hh = *(const LAS u32x2*)(vq + 16);
                      o1 = __builtin_amdgcn_mfma_f32_32x32x16_bf16(__builtin_bit_cast(bf16x8, (u32x4){lo.x, lo.y, hh.x, hh.y}), pb, o1, 0, 0, 0); }
                    if (j & 1) __builtin_amdgcn_sched_barrier(0);
                }
            }
        }
        if (t + 1 < te) { LAS unsigned char* kd = lds + AT_KT + (buf ^ 1) * AT_KTB; *(LAS u32x4*)(kd + kofs) = kreg0; *(LAS u32x4*)(kd + 64 * AT_ROWB + kofs) = kreg1;
            if (MODE != 0) { LAS unsigned char* vd = lds + AT_VT + (buf ^ 1) * AT_VTB; *(LAS u32x4*)(vd + vofs) = vreg0; *(LAS u32x4*)(vd + 128 + vofs) = vreg1; } }
        __syncthreads();
    }
}

__device__ __forceinline__ void attn_prompt_unit(KP P, LAS unsigned char* lds, int b, int g, int t0, int tid, int lane, int wave) {
    unsigned char* ws = P->ws;
    const bf16* Q = (const bf16*)(ws + WS_Q); const bf16* QR = (const bf16*)(ws + WS_QR); const float* GT = (const float*)(ws + WS_GT); bf16* O = (bf16*)(ws + WS_O);
    const int bg = b * NG + g;
    const bf16* KS = (const bf16*)(ws + WS_KS) + (size_t)bg * SEQ * 64; const bf16* VTS = (const bf16*)(ws + WS_VTS) + (size_t)bg * 64 * SEQ;
    const bf16* KW = (const bf16*)(ws + WS_KW) + (size_t)bg * SEQ * 64; const bf16* VTW = (const bf16*)(ws + WS_VTW) + (size_t)bg * 64 * SEQ;
    const bf16* KC = (const bf16*)(ws + WS_KC) + (size_t)bg * 256 * 64; const bf16* VCT = (const bf16*)(ws + WS_VCT) + (size_t)bg * 64 * 256;
    const int r32 = lane & 31, hi = lane >> 5, tok_l = r32 >> 3, hl = r32 & 7, tokrow = wave * 4 + tok_l;
    const int t = t0 + tokrow, mrow = b * SEQ + t, h = g * HPG + hl;
    LAS float* QSb = (LAS float*)(lds + AT_QS); LAS float* LSb = (LAS float*)(lds + AT_LS); LAS unsigned long long* MK = (LAS unsigned long long*)(lds + AT_MASK);
    for (int i = tid; i < 32 * 64; i += 512) { QSb[i] = 0.f; LSb[i] = 0.f; }
    LAS unsigned char* qfl = lds + AT_QF + wave * 4096 + lane * 16;
#pragma unroll
    for (int c = 0; c < 4; ++c) *(LAS bf16x8*)(qfl + c * 1024) = *(const bf16x8*)(Q + (size_t)mrow * DM + h * 64 + c * 16 + hi * 8);
    __syncthreads();
    f32x16 o0, o1;
#pragma unroll
    for (int r = 0; r < 16; ++r) { o0[r] = 0.f; o1[r] = 0.f; }
    LAS unsigned* stash = (LAS unsigned*)(lds + AT_STASH) + wave * 1024 + lane;
    const int cmax = (t >= 31) ? ((t - 31) >> 4) : -1;
    const int ntc = (t0 >> 11) + 1;
    {
        float mc = -INFINITY, lc = 0.f;
        attn_pass<0>(lds, KC, VCT, 256, 0, ntc, qfl, 0, cmax, 0ull, mc, lc, o0, o1, 0.f, tokrow, tid, lane);
        lc += __shfl_xor(lc, 32);
        const float invl = lc > 0.f ? 1.0f / lc : 0.f;
        attn_pass<1>(lds, KC, VCT, 256, 0, ntc, qfl, 0, cmax, 0ull, mc, lc, o0, o1, invl, tokrow, tid, lane);
        const float g0 = GT[(size_t)mrow * 48 + h * 3 + 0];
#pragma unroll
        for (int r = 0; r < 16; ++r) { stash[r * 64] = pk2(g0 * o0[r], g0 * o1[r]); o0[r] = 0.f; o1[r] = 0.f; }
    }
    asm volatile("s_waitcnt lgkmcnt(0)" ::: "memory");
    unsigned long long mymask = 0ull;
    {
        const int cur_w = (t0 + wave * 4) >> 6;
#pragma unroll
        for (int tk = 0; tk < 4; ++tk) {
            const int tr = wave * 4 + tk, s = lane;
            float v = QSb[tr * 64 + s] + (s > 0 ? LSb[tr * 64 + s - 1] : 0.f);
            if (s == 0 || s == cur_w || s + 1 == cur_w) v = INFINITY;
            if (s > cur_w) v = -INFINITY;
            int rank = 0;
            for (int i = 0; i < 64; ++i) { const float x = __builtin_bit_cast(float, __builtin_amdgcn_readlane(__builtin_bit_cast(int, v), i)); rank += (x > v || (x == v && i < s)) ? 1 : 0; }
            const unsigned long long mk = __builtin_amdgcn_ballot_w64(rank < 16);
            if (tok_l == tk) mymask = mk;
        }
    }
    (void)MK;
#pragma unroll
    for (int c = 0; c < 4; ++c) *(LAS bf16x8*)(qfl + c * 1024) = *(const bf16x8*)(QR + (size_t)mrow * DM + h * 64 + c * 16 + hi * 8);
    const int cur = t0 >> 6;
    {
        float ms = -INFINITY, lsum = 0.f;
        attn_pass<2>(lds, KS, VTS, SEQ, 0, (cur >> 1) + 1, qfl, 0, t, mymask, ms, lsum, o0, o1, 0.f, tokrow, tid, lane);
        lsum += __shfl_xor(lsum, 32);
        const float sc = GT[(size_t)mrow * 48 + h * 3 + 1] / lsum;
#pragma unroll
        for (int r = 0; r < 16; ++r) { const unsigned w = stash[r * 64]; stash[r * 64] = pk2(__builtin_bit_cast(float, w << 16) + sc * o0[r], __builtin_bit_cast(float, w & 0xffff0000u) + sc * o1[r]); o0[r] = 0.f; o1[r] = 0.f; }
    }
    f32x16 out0, out1;
    {
        float mw = -INFINITY, lw = 0.f;
        const int wlo = (t0 - 511) > 0 ? (t0 - 511) >> 7 : 0;
        attn_pass<3>(lds, KW, VTW, SEQ, wlo, (cur >> 1) + 1, qfl, t - 511, t, 0ull, mw, lw, o0, o1, 0.f, tokrow, tid, lane);
        lw += __shfl_xor(lw, 32);
        const float sc = GT[(size_t)mrow * 48 + h * 3 + 2] / lw;
#pragma unroll
        for (int r = 0; r < 16; ++r) { const unsigned w = stash[r * 64]; out0[r] = __builtin_bit_cast(float, w << 16) + sc * o0[r]; out1[r] = __builtin_bit_cast(float, w & 0xffff0000u) + sc * o1[r]; }
    }
    bf16* op = O + (size_t)mrow * DM + h * 64 + 4 * hi;
#pragma unroll
    for (int jq = 0; jq < 4; ++jq) {
        u32x2 w0; w0.x = cvtpk(out0[4 * jq], out0[4 * jq + 1]); w0.y = cvtpk(out0[4 * jq + 2], out0[4 * jq + 3]); *(u32x2*)(op + 8 * jq) = w0;
        u32x2 w1; w1.x = cvtpk(out1[4 * jq], out1[4 * jq + 1]); w1.y = cvtpk(out1[4 * jq + 2], out1[4 * jq + 3]); *(u32x2*)(op + 32 + 8 * jq) = w1;
    }
}

constexpr int SM_QN = 0, SM_QR = 2048, SM_SC = 4096, SM_IMP = 36864, SM_SEL = 37888, SM_PTR = 38144, SM_OP = 46336;
__device__ __forceinline__ void smp_scores(const float* __restrict__ kp, const LAS float* q, LAS float* sc, int col, bool valid) {
    float s[8];
#pragma unroll
    for (int hl = 0; hl < 8; ++hl) s[hl] = 0.f;
    if (valid) {
#pragma unroll 4
        for (int d4 = 0; d4 < 16; ++d4) { const f32x4 kv = *(const f32x4*)(kp + 4 * d4);
#pragma unroll
            for (int hl = 0; hl < 8; ++hl) { const f32x4 qv = *(const LAS f32x4*)(q + hl * 64 + 4 * d4); s[hl] += (kv[0] * qv[0] + kv[1] * qv[1]) + (kv[2] * qv[2] + kv[3] * qv[3]); } }
    }
#pragma unroll
    for (int hl = 0; hl < 8; ++hl) sc[hl * 1024 + col] = valid ? s[hl] : -INFINITY;
}
__device__ __forceinline__ void smp_softmax(LAS float* sc, int n, int lane, int wave) {
    LAS float* row = sc + wave * 1024; float mx = -INFINITY;
    for (int i = lane; i < n; i += 64) mx = fmaxf(mx, row[i]);
#pragma unroll
    for (int o = 1; o < 64; o <<= 1) mx = fmaxf(mx, __shfl_xor(mx, o));
    float sum = 0.f;
    for (int i = lane; i < n; i += 64) { const float e = __builtin_amdgcn_exp2f(row[i] - mx); row[i] = e; sum += e; }
    sum = wave_sum(sum); const float inv = 1.0f / sum;
    for (int i = lane; i < n; i += 64) row[i] *= inv;
}
template <bool PTR> __device__ __forceinline__ void smp_pv(const LAS float* sc, const LAS unsigned long long* rp, const float* __restrict__ vbase, int n, LAS float* opart, int tid) {
    const int sl = tid >> 4, dq = tid & 15;
    f32x4 acc[8];
#pragma unroll
    for (int q = 0; q < 8; ++q) acc[q] = (f32x4){0.f, 0.f, 0.f, 0.f};
#pragma unroll 4
    for (int kk = sl; kk < n; kk += 32) {
        f32x4 v = (f32x4){0.f, 0.f, 0.f, 0.f};
        if (PTR) { const float* kp = (const float*)(uintptr_t)rp[kk]; if (kp) v = *(const f32x4*)(kp + 128 + 4 * dq); }
        else v = *(const f32x4*)(vbase + (size_t)kk * 64 + 4 * dq);
#pragma unroll
        for (int q = 0; q < 8; ++q) acc[q] += sc[q * 1024 + kk] * v;
    }
#pragma unroll
    for (int q = 0; q < 8; ++q) *(LAS f32x4*)(opart + (sl * 8 + q) * 64 + 4 * dq) = acc[q];
}
__device__ __forceinline__ float smp_pv_reduce(const LAS float* opart, int hl, int d) {
    float s = 0.f;
#pragma unroll 8
    for (int k = 0; k < 32; ++k) s += opart[(k * 8 + hl) * 64 + d];
    return s;
}
__device__ __forceinline__ void attn_sample_unit(KP P, LAS unsigned char* lds, int sb, int g, int tid, int lane, int wave) {
    unsigned char* ws = P->ws;
    const bf16* Q = (const bf16*)(ws + WS_Q); const bf16* QR = (const bf16*)(ws + WS_QR); const float* GT = (const float*)(ws + WS_GT); bf16* O = (bf16*)(ws + WS_O);
    const float* KCS = (const float*)(ws + WS_KCS) + (size_t)(sb * NG + g) * 512 * 64; const float* VCS = (const float*)(ws + WS_VCS) + (size_t)(sb * NG + g) * 512 * 64;
    const float* cslc = (const float*)P->in[5]; const float* cwin = (const float*)P->in[6]; const int* pt = (const int*)P->in[10] + sb * NPG;
    LAS float* qn = (LAS float*)(lds + SM_QN); LAS float* qr = (LAS float*)(lds + SM_QR); LAS float* sc = (LAS float*)(lds + SM_SC); LAS float* imp = (LAS float*)(lds + SM_IMP);
    LAS int* sel = (LAS int*)(lds + SM_SEL); LAS unsigned long long* rp = (LAS unsigned long long*)(lds + SM_PTR); LAS float* opart = (LAS float*)(lds + SM_OP);
    const int mrow = MP + sb, hl = tid >> 6, d = tid & 63, h = g * HPG + hl;
    { const int e = 2 * (d & 31) + (d >> 5);
      qn[hl * 64 + d] = bf2f(Q[(size_t)mrow * DM + h * 64 + e]); qr[hl * 64 + d] = bf2f(QR[(size_t)mrow * DM + h * 64 + e]); }
    __syncthreads();
    smp_scores(KCS + (size_t)tid * 64, qn, sc, tid, tid < NCB_S);
    __syncthreads();
    smp_softmax(sc, 512, lane, wave);
    __syncthreads();
    smp_pv<false>(sc, rp, VCS, NCB_S, opart, tid);
    if (tid < NSB_S) { float v = 0.f; const int c0 = tid * 4 - 1;
        for (int c = (c0 < 0 ? 0 : c0); c <= c0 + 4 && c < NCB_S; ++c)
#pragma unroll
            for (int q = 0; q < 8; ++q) v += sc[q * 1024 + c];
        if (tid == 0 || tid == 127 || tid == 128) v = INFINITY;
        imp[tid] = v; }
    __syncthreads();
    const float oc = smp_pv_reduce(opart, hl, d);
    if (tid < NSB_S) { const float v = imp[tid]; int rank = 0;
        for (int i = 0; i < NSB_S; ++i) { const float x = imp[i]; rank += (x > v || (x == v && i < tid)) ? 1 : 0; }
        if (rank < 16) sel[rank] = tid; }
    __syncthreads();
#pragma unroll
    for (int q = 0; q < 2; ++q) { const int kk = tid + 512 * q, blk = sel[kk >> 6], pos = blk * 64 + (kk & 63);
        const float* kp = nullptr;
        if (pos < PAST) kp = cslc + ((size_t)pt[pos >> 7] * PGSZ + (pos & 127)) * 256 + g * 64;
        else if (pos == PAST) kp = P->out + O_SLC_S + (size_t)sb * 256 + g * 64;
        rp[kk] = (unsigned long long)(uintptr_t)kp;
        smp_scores(kp, qr, sc, kk, kp != nullptr); }
    __syncthreads();
    smp_softmax(sc, 1024, lane, wave);
    __syncthreads();
    smp_pv<true>(sc, rp, nullptr, 1024, opart, tid);
    __syncthreads();
    const float os = smp_pv_reduce(opart, hl, d);
    __syncthreads();
    { const float* kp = (tid < 511) ? cwin + ((size_t)sb * 512 + tid + 1) * 256 + g * 64 : P->out + O_WIN_S + ((size_t)sb * 512 + 511) * 256 + g * 64;
      rp[tid] = (unsigned long long)(uintptr_t)kp;
      smp_scores(kp, qr, sc, tid, true); }
    __syncthreads();
    smp_softmax(sc, 512, lane, wave);
    __syncthreads();
    smp_pv<true>(sc, rp, nullptr, 512, opart, tid);
    __syncthreads();
    const float ow = smp_pv_reduce(opart, hl, d);
    const float g0 = GT[(size_t)mrow * 48 + h * 3 + 0], g1 = GT[(size_t)mrow * 48 + h * 3 + 1], g2 = GT[(size_t)mrow * 48 + h * 3 + 2];
    O[(size_t)mrow * DM + h * 64 + d] = (bf16)f2bf(g0 * oc + g1 * os + g2 * ow);
    __syncthreads();
}

__device__ __forceinline__ void attn_phase(KP P, LAS unsigned char* lds, int qidx, int tid, int lane, int wave, int G) {
    unsigned* head = (unsigned*)(P->ws + WS_CTL) + 4096 + 64 * qidx;
    volatile LAS int* slot = (volatile LAS int*)(lds + LDS_MISC + 64);
    for (;;) {
        if (tid == 0) slot[0] = (int)__hip_atomic_fetch_add(head, 1u, __ATOMIC_RELAXED, __HIP_MEMORY_SCOPE_AGENT);
        __syncthreads();
        const int un = slot[0];
        __syncthreads();
        if (un >= 64 + 1024) break;
        if (un < 64) attn_sample_unit(P, lds, un >> 1, un & 1, tid, lane, wave);
        else { const int k = un - 64, bg = k & 7, tb = 127 - (k >> 3);
            attn_prompt_unit(P, lds, bg >> 1, bg & 1, tb * 32, tid, lane, wave); }
        __syncthreads();
    }
}

constexpr int NPHASES = 30;
#define DUPK(k) for (int dup_ = 0; dup_ < 1 + ((PROBE_DUP >> (k)) & 1); ++dup_)
#ifndef MK_MULTI
#define MK_MULTI 0
#endif
__global__ void __launch_bounds__(512, 2) mega(Params Pv) {
    extern __shared__ __attribute__((aligned(16))) unsigned char lds_raw[];
    LAS unsigned char* lds = (LAS unsigned char*)lds_raw;

    const KP Pk = (KP)__builtin_amdgcn_kernarg_segment_ptr();
    LAS float* rsb = (LAS float*)(lds + LDS_RS);
    int ph = 0, cur = 0;
    if (Pk->ph_hi - Pk->ph_lo > 1) {
        if (blockIdx.x == 0) { unsigned* ctl = (unsigned*)(Pk->ws + WS_CTL); for (int i = threadIdx.x; i < 8192; i += 512) ctl[i] = 0u; }
        if (threadIdx.x < 16) ((volatile LAS unsigned*)(lds + LDS_MISC))[threadIdx.x] = 0u;
        __syncthreads();
    }
#define RUN (ph >= Pk->ph_lo && ph < Pk->ph_hi)
#define FRESH const int tid = launder_v(threadIdx.x), lane = tid & 63, wave = __builtin_amdgcn_readfirstlane(tid >> 6), G = launder_s(gridDim.x), bid = launder_s(blockIdx.x); (void)lane; (void)wave; (void)bid
#define GRID_BAR do { if (ph == 0) { seam0_barrier(); (void)xcd_barrier_post((unsigned*)(Pk->ws + WS_CTL), (volatile LAS unsigned*)(lds + LDS_MISC) + 8); } else { XcdBarrier b_; b_.bar = (unsigned*)(launder(Pk)->ws + WS_CTL); b_.x = xb_xcc_id(); b_.st = (volatile LAS unsigned*)(lds + LDS_MISC) + 8; xcd_barrier(b_); } } while (0)
#define END_PHASE do { if (RUN && ph + 1 < Pk->ph_hi) { GRID_BAR; if ((PROBE_DUP >> 20) & 1) { if (ph > 0) GRID_BAR; } } ++ph; } while (0)
#define PSS_OF(ws_, c_) ((float*)((ws_) + WS_PSS) + (size_t)(c_) * 16 * MPAD)
#define GEMM_RS(EpiT_, AOFF, BOFF, N_, NTHIN_, K_, ...) GEMM_RS_B(0, EpiT_, AOFF, BOFF, N_, NTHIN_, K_, __VA_ARGS__)
#define GEMM_RS_B(REV_, EpiT_, AOFF, BOFF, N_, NTHIN_, K_, ...) do { const int tid = launder_v(threadIdx.x), G = launder_s(gridDim.x), bid = (REV_) ? G - 1 - launder_s(blockIdx.x) : launder_s(blockIdx.x); const KP P = launder(Pk); unsigned char* ws = P->ws; \
        pg8::Gemm g_{(const bf16*)(ws + (AOFF)), (const bf16*)(ws + (BOFF)), MP, (N_), (K_)}; pg8::StaticOrder S_; S_.init(MP, (N_), G, bid); \
        const int tcg_ = G - 1 - bid; const bool thin_ = tcg_ < (NTHIN_); \
        rs_prepare(S_, PSS_OF(ws, cur), (const float*)(ws + WS_SPSS) + cur * 2048, rsb, tid, thin_); EpiT_ E_{__VA_ARGS__}; \
          \
          \
        { const int tstr_ = ((NTHIN_) > G / 2 && (NTHIN_) < G && ((N_) / 256) * (MP / 256) % G == G / 2) ? G / 2 : G; \
          if (tcg_ < tstr_) for (int cg_ = tcg_; cg_ < (NTHIN_); cg_ += tstr_) { E_.slot = 7; thin_unit<(K_)>(lds, g_.A, g_.Bt, cg_, E_); } } E_.slot = 0; \
        pg8::gemm_phase<EpiT_, pg8::StaticOrder, true, true>(lds, g_, S_, E_); } while (0)
#define GEMM_RES(KIND, AOFF, BOFF, K_, SOFF) DUPK(KIND) { FRESH; const KP P = launder(Pk); unsigned char* ws = P->ws; \
        pg8::Gemm g_{(const bf16*)(ws + (AOFF)), (const bf16*)(ws + (BOFF)), MP, 1024, (K_)}; pg8::StaticOrder S_; S_.init(MP, 1024, G, bid); \
        EpiRes E_{ws, PSS_OF(ws, cur ^ 1), (SOFF), dup_ ? 0.0f : 1.0f, xb_off(L)}; \
        const int tcg_ = G - 1 - bid; if (tcg_ < 64) thin_unit<(K_)>(lds, g_.A, g_.Bt, tcg_, E_); \
        pg8::gemm_phase<EpiRes, pg8::StaticOrder, true, true>(lds, g_, S_, E_); }

    if (RUN) DUPK(0) { FRESH; phase0(launder(Pk), lds, tid, lane, wave, G); }
    END_PHASE;

#pragma unroll
    for (int L = 0; L < 4; ++L) {
        if (L < 2) {
            if (RUN) { GEMM_RS(EpiRG1, xb_off(L), WS_WIN + (size_t)L * 2560 * 1024 * 2, 2560, 160, 1024, ws, rsb, 0);
                if (L == 0) { FRESH; const KP P = launder(Pk); unsigned char* ws = P->ws; const int Gh = G >> 1;
                  pg8::Gemm g_{(const bf16*)(ws + WS_PB), (const bf16*)(ws + WS_WPI), 4 * MPAD, 4096, 256}; EpiPin E_{ws};
                  { PinOrder S_; S_.Lb = 0; S_.stride = 1;
                    if (G == 256) { if (bid < 128) { S_.start = bid; S_.count = 1; } else { S_.start = 128 + (bid - 128) * 3; S_.count = 3; } }
                    else { const int per = (512 + G - 1) / G; S_.start = bid * per; S_.count = per; }
                    pg8::gemm_phase<EpiPin, PinOrder, true, true>(lds, g_, S_, E_); }
                  if (bid < Gh) for (int q_ = bid; q_ < 128; q_ += Gh) { const int L_ = (q_ >> 6), cg_ = q_ & 63; E_.Lthin = L_; thin_unit<256>(lds, g_.A + (size_t)L_ * MPAD * 256, g_.Bt + (size_t)L_ * 1024 * 256, cg_, E_); } }
                if (L == 1) { FRESH; const KP P = launder(Pk); unsigned char* ws = P->ws;
                  if (G == 256 && bid >= 128) { constexpr int NCU_ = 2 * (CMP_ROWS / 256);
                    pg8::Gemm g_{(const bf16*)(ws + WS_CMPA), (const bf16*)(ws + WS_WC1), 2 * CMP_ROWS, 256, 1024}; CmpOrder S_{G, bid - 128, NCU_ - 128, NCU_}; EpiT E_{(bf16*)(ws + WS_T)};
                    pg8::gemm_phase<EpiT, CmpOrder, true, true>(lds, g_, S_, E_); } } }
            END_PHASE;
            if (RUN) DUPK(2) { FRESH; rg2_phase(launder(Pk), lds, L, tid, lane, wave, G); }
            END_PHASE;
            if (RUN) DUPK(3) { FRESH; rg3_phase(launder(Pk), lds, L, tid, G); }
            END_PHASE;
            if (RUN) GEMM_RES(13, WS_G, WS_WOUT + (size_t)L * 1024 * 1280 * 2, 1280, (size_t)0);
            END_PHASE; cur ^= 1;
        } else {
            const int j = L - 2;
            if (L == 2) {
                if (RUN) { GEMM_RS(EpiKV, xb_off(L), WS_WKV, NKV, 48, 1024, P->out, ws, rsb, 0);
                    GEMM_RS_B(1, EpiQ, xb_off(L), WS_WQG, NQGP, 67, 1024, ws, rsb, 0); }
                END_PHASE;
                if (RUN) DUPK(8) { FRESH; const KP P = launder(Pk); unsigned char* ws = P->ws;
                    constexpr int NCU_ = 2 * (CMP_ROWS / 256), NSV_ = 128;
                    const bool early_ = (G == 256);
                    pg8::Gemm g_{(const bf16*)(ws + WS_CMPA), (const bf16*)(ws + WS_WC1), 2 * CMP_ROWS, 256, 1024}; CmpOrder S_{G, bid, 0, early_ ? NCU_ - NSV_ : NCU_}; EpiT E_{(bf16*)(ws + WS_T)};
                    pg8::gemm_phase<EpiT, CmpOrder, true, true>(lds, g_, S_, E_);
                    { const int nb2 = 2 * (CMP_ROWS / 256) - G, nf = G - (nb2 > 0 ? nb2 : 0);
                      pg8::Gemm gp_{(const bf16*)(ws + WS_PB), (const bf16*)(ws + WS_WPI), 4 * MPAD, 4096, 256}; EpiPin Ep_{ws};
                      if (early_) {
                          PinOrder Sp_; Sp_.Lb = 2; Sp_.start = 0; Sp_.stride = 1; Sp_.count = 0;
                          if (bid >= NCU_ - NSV_) { Sp_.start = bid - (NCU_ - NSV_); Sp_.stride = G - (NCU_ - NSV_); Sp_.count = 4; }
                          else if (bid < 512 - 4 * (G - (NCU_ - NSV_))) { Sp_.start = 4 * (G - (NCU_ - NSV_)) + bid; Sp_.count = 1; }
                          pg8::gemm_phase<EpiPin, PinOrder, true, true>(lds, gp_, Sp_, Ep_); }
                      else if (nf > 0 && bid >= G - nf) { PinOrder Sp_; Sp_.Lb = 2; Sp_.start = bid - (G - nf); Sp_.stride = nf; Sp_.count = (512 + nf - 1) / nf;
                          pg8::gemm_phase<EpiPin, PinOrder, true, true>(lds, gp_, Sp_, Ep_); }
                      else if (nf <= 0) { PinOrder Sp_; Sp_.Lb = 2; Sp_.start = bid; Sp_.stride = G; Sp_.count = (512 + G - 1) / G; pg8::gemm_phase<EpiPin, PinOrder, true, true>(lds, gp_, Sp_, Ep_); }
                      for (int q_ = bid; q_ < 128; q_ += G) { const int L_ = 2 + (q_ >> 6), cg_ = q_ & 63; Ep_.Lthin = L_; thin_unit<256>(lds, gp_.A + (size_t)L_ * MPAD * 256, gp_.Bt + (size_t)L_ * 1024 * 256, cg_, Ep_); } } }
                END_PHASE;
                if (RUN) DUPK(9) { FRESH; cmp2_phase(launder(Pk), lds, tid, lane, wave, G); }
                END_PHASE;
            }
            if (L == 3) { if (RUN) DUPK(10) GEMM_RS(EpiQ, xb_off(L), WS_WQG + (size_t)j * NQGP * 1024 * 2, NQGP, 67, 1024, ws, rsb, 0);
            END_PHASE; }
            if (RUN) DUPK(11) { FRESH; attn_phase(launder(Pk), lds, j + 2 * dup_, tid, lane, wave, G); }
            END_PHASE;
            if (RUN) GEMM_RES(16, WS_O, WS_WO + (size_t)j * 1024 * 1024 * 2, 1024, (size_t)0);
            END_PHASE; cur ^= 1;
        }
        if (RUN) DUPK(4) { FRESH; const KP P = launder(Pk); unsigned char* ws = P->ws;
            pg8::Gemm g_{(const bf16*)(ws + xb_off(L)), (const bf16*)(ws + WS_WUP + (size_t)L * 6144 * 1024 * 2), MP, DFF2, 1024}; pg8::StaticOrder S_; S_.init(MP, DFF2, G, bid);
            const int tpg_ = G - 1 - bid; const bool thin_ = tpg_ < 192;
            rs_prepare(S_, PSS_OF(ws, cur), (const float*)(ws + WS_SPSS) + cur * 2048, rsb, tid, thin_);
            const float* cw_ = (const float*)P->in[33] + (size_t)L * 3 * DFF2; const float* cb_ = (const float*)P->in[34] + (size_t)L * DFF2;
            EpiUp E_{ws, rsb, P->out, cw_, cb_, (LAS float*)(lds + LDS_HALO), L, 0};
            if (thin_) thin_unit_up(lds, g_.A, g_.Bt, tpg_, ws, rsb + 7 * 256, P->out, cw_, cb_, (const float*)P->in[9], L);
            pg8::gemm_phase<EpiUp, pg8::StaticOrder, true, true>(lds, g_, S_, E_); }
        END_PHASE;
        if (RUN) DUPK(14) { FRESH; const KP P = launder(Pk); unsigned char* ws = P->ws;
            pg8::Gemm g_{(const bf16*)(ws + WS_ACT), (const bf16*)(ws + WS_WDN + (size_t)L * 1024 * 3072 * 2), MP, 1024, 3072}; pg8::StaticOrder S_; S_.init(MP, 1024, G, bid);
            { pg8::Unit u_; for (int i_ = 0; S_.next(i_, u_); ++i_) act_fixup(ws, (const float*)P->in[33] + (size_t)L * 3 * DFF2, (const float*)P->in[34] + (size_t)L * DFF2, u_.pm, tid); }
            asm volatile("s_waitcnt vmcnt(0)" ::: "memory"); __syncthreads();
            EpiRes E_{ws, PSS_OF(ws, cur ^ 1), (size_t)0, dup_ ? 0.0f : 1.0f, xb_off(L)};
            const int tcg_ = G - 1 - bid; if (tcg_ < 64) thin_unit<3072>(lds, g_.A, g_.Bt, tcg_, E_);
            pg8::gemm_phase<EpiRes, pg8::StaticOrder, true, true>(lds, g_, S_, E_); }
        END_PHASE; cur ^= 1;
        if (RUN) GEMM_RS(EpiGate, xb_off(L), WS_WPG + (size_t)L * 1024 * 1024 * 2, 1024, 64, 1024, ws, rsb, PSS_OF(ws, cur ^ 1), WS_PIN + (size_t)L * MPAD * DM * 2, xb_off(L), xb_off(L + 1), 0);
        END_PHASE; cur ^= 1;
    }
    if (RUN) DUPK(12) { FRESH; const KP P = launder(Pk); final_phase(P, PSS_OF(P->ws, cur), (const float*)(P->ws + WS_SPSS) + cur * 2048, lane, wave, G); }
    END_PHASE;
}

extern "C" void kernel_launch(void* const* d_in, const int* in_sizes, int n_in, void* d_out, int out_size, void* d_ws, size_t ws_size, hipStream_t stream) {
    static int grid = 0;
    if (grid == 0) {
        if (n_in != 38 || (size_t)out_size != O_END || ws_size < WS_END) { fprintf(stderr, "kernel_launch: unexpected problem: n_in %d out %d ws %zu (need %zu)\n", n_in, out_size, ws_size, (size_t)WS_END); grid = -1; return; }
        int dev = 0, cus = 0, per_cu = 0;
        (void)hipGetDevice(&dev); (void)hipDeviceGetAttribute(&cus, hipDeviceAttributeMultiprocessorCount, dev);
        if (hipFuncSetAttribute((const void*)mega, hipFuncAttributeMaxDynamicSharedMemorySize, LDS_BYTES) != hipSuccess) { fprintf(stderr, "kernel_launch: hipFuncSetAttribute failed\n"); grid = -1; return; }
        if (hipOccupancyMaxActiveBlocksPerMultiprocessor(&per_cu, (const void*)mega, 512, LDS_BYTES) != hipSuccess || per_cu < 1) { fprintf(stderr, "kernel_launch: occupancy query says %d\n", per_cu); per_cu = 1; }
        (void)hipGetLastError();
        grid = cus;
        if (grid > 256) grid = 256;
    }
    if (grid < 0) return;
    Params p{};
    for (int i = 0; i < 38; ++i) p.in[i] = d_in[i];
    p.out = (float*)d_out; p.ws = (unsigned char*)d_ws;
#if MK_MULTI
    for (int ph = 0; ph < NPHASES; ++ph) { p.ph_lo = ph; p.ph_hi = ph + 1; hipLaunchKernelGGL(mega, dim3(grid), dim3(512), LDS_BYTES, stream, p); }
#else
    p.ph_lo = 0; p.ph_hi = NPHASES;
    void* args[] = {&p};
    hipError_t e = hipLaunchCooperativeKernel((const void*)mega, dim3(grid), dim3(512), args, LDS_BYTES, stream);
    if (e != hipSuccess) fprintf(stderr, "kernel_launch: cooperative launch failed: %s (grid %d)\n", hipGetErrorString(e), grid);
#endif
}
```

```cpp
#include <hip/hip_runtime.h>
#include <hip/hip_cooperative_groups.h>
#include <cstdio>
#include <cstdint>
#include <cmath>
namespace cg = cooperative_groups;
#ifndef PROBE_DUP
#define PROBE_DUP 0
#endif


#define LAS __attribute__((address_space(3)))
#define GAS __attribute__((address_space(1)))
typedef unsigned short bf16;
typedef short bf16x8 __attribute__((ext_vector_type(8)));
typedef float f32x4 __attribute__((ext_vector_type(4)));
typedef float f32x2 __attribute__((ext_vector_type(2)));
typedef float f32x16 __attribute__((ext_vector_type(16)));
typedef unsigned u32x4 __attribute__((ext_vector_type(4)));
typedef unsigned u32x2 __attribute__((ext_vector_type(2)));

constexpr int DM = 1024, SEQ = 4096, NB = 4, MP = NB * SEQ, MS = 32, MTOT = MP + MS, MPAD = 16640, NMT = MPAD / 256;
constexpr int DRNN = 1280, DFF = 3072, DFF2 = 6144, DPLE = 256, NRGB = 16, RGB = 80;
constexpr int PAST = 8192, NPG = 64, PGSZ = 128, HD = 64, NH = 16, NG = 2, HPG = 8;
constexpr int NCB_P = 255, NCB_S = 511, NSB_S = 129;
constexpr int NQG = 1072, NQGP = 1280, NKV = 768;
constexpr float EPS = 1e-6f;
constexpr float C2 = 0.125f * 1.4426950408889634f;
constexpr int CMP_ROWS_P = NG * NB * 256, CMP_ROWS_S = NG * MS * 512, CMP_ROWS = CMP_ROWS_P + CMP_ROWS_S;

constexpr size_t O_Y_P = 0;
constexpr size_t O_Y_S = O_Y_P + (size_t)MP * DM;
constexpr size_t O_CMP_P = O_Y_S + (size_t)MS * DM;
constexpr size_t O_CMP_S = O_CMP_P + (size_t)MP * 256;
constexpr size_t O_SLC_P = O_CMP_S + (size_t)MS * 256;
constexpr size_t O_SLC_S = O_SLC_P + (size_t)MP * 256;
constexpr size_t O_WIN_P = O_SLC_S + (size_t)MS * 256;
constexpr size_t O_WIN_S = O_WIN_P + (size_t)NB * 512 * 256;
constexpr size_t O_RGC_P = O_WIN_S + (size_t)MS * 512 * 256;
constexpr size_t O_RGC_S = O_RGC_P + (size_t)2 * NB * 3 * DRNN;
constexpr size_t O_RGH_P = O_RGC_S + (size_t)2 * MS * 3 * DRNN;
constexpr size_t O_RGH_S = O_RGH_P + (size_t)2 * NB * DRNN;
constexpr size_t O_FFC_P = O_RGH_S + (size_t)2 * MS * DRNN;
constexpr size_t O_FFC_S = O_FFC_P + (size_t)4 * NB * 2 * DFF2;
constexpr size_t O_END = O_FFC_S + (size_t)4 * MS * 2 * DFF2;
static_assert(O_END == 32071680, "d_out size");

constexpr size_t al256(size_t x) { return (x + 255) & ~(size_t)255; }
constexpr size_t WS_CTL = 0;
constexpr size_t WS_WIN = WS_CTL + 65536;
constexpr size_t WS_WOUT = WS_WIN + (size_t)2 * 2560 * 1024 * 2;
constexpr size_t WS_WUP = WS_WOUT + (size_t)2 * 1024 * 1280 * 2;
constexpr size_t WS_WDN = WS_WUP + (size_t)4 * 6144 * 1024 * 2;
constexpr size_t WS_WPI = WS_WDN + (size_t)4 * 1024 * 3072 * 2;
constexpr size_t WS_WPG = WS_WPI + (size_t)4 * 1024 * 256 * 2;
constexpr size_t WS_WKV = WS_WPG + (size_t)4 * 1024 * 1024 * 2;
constexpr size_t WS_WQG = WS_WKV + (size_t)768 * 1024 * 2;
constexpr size_t WS_WO = WS_WQG + (size_t)2 * 1280 * 1024 * 2;
constexpr size_t WS_WC1 = WS_WO + (size_t)2 * 1024 * 1024 * 2;
constexpr size_t WS_WGA = WS_WC1 + (size_t)2 * 256 * 1024 * 2;
constexpr size_t WS_B1F = al256(WS_WGA + (size_t)2 * 2 * 16 * 80 * 96 * 2);
constexpr size_t WS_ROPE = al256(WS_B1F + 32 * 2 * 128 * 4);
constexpr size_t WS_PSS = al256(WS_ROPE + (size_t)4097 * 64 * 4);
constexpr size_t WS_X = al256(WS_PSS + (size_t)2 * 16 * MPAD * 4);
constexpr size_t WS_XB = WS_X + (size_t)MPAD * 1024 * 4;
__host__ __device__ constexpr size_t xb_off(int L) { return (L & 1) ? WS_X : WS_XB; }
constexpr size_t WS_PB = WS_XB + (size_t)MPAD * 1024 * 2;
constexpr size_t WS_Y = WS_PB + (size_t)4 * MPAD * 256 * 2;
constexpr size_t WS_G = WS_Y + (size_t)MPAD * 1280 * 2;
constexpr size_t WS_S = WS_G + (size_t)MPAD * 1280 * 2;
constexpr size_t WS_Q = WS_S + (size_t)MPAD * 1024 * 2;
constexpr size_t WS_QR = WS_Q + (size_t)MPAD * 1024 * 2;
constexpr size_t WS_O = WS_QR + (size_t)MPAD * 1024 * 2;
constexpr size_t WS_GT = WS_O + (size_t)MPAD * 1024 * 2;
constexpr size_t WS_KS = al256(WS_GT + (size_t)MPAD * 48 * 4);
constexpr size_t WS_VTS = WS_KS + (size_t)NB * NG * SEQ * 64 * 2;
constexpr size_t WS_KW = WS_VTS + (size_t)NB * NG * SEQ * 64 * 2;
constexpr size_t WS_VTW = WS_KW + (size_t)NB * NG * SEQ * 64 * 2;
constexpr size_t WS_KC = WS_VTW + (size_t)NB * NG * SEQ * 64 * 2;
constexpr size_t WS_VCT = WS_KC + (size_t)NB * NG * 256 * 64 * 2;
constexpr size_t WS_KCS = WS_VCT + (size_t)NB * NG * 256 * 64 * 2;
constexpr size_t WS_VCS = WS_KCS + (size_t)MS * NG * 512 * 64 * 4;
constexpr size_t WS_CMPA = WS_VCS + (size_t)MS * NG * 512 * 64 * 4;
constexpr size_t WS_T = WS_CMPA + (size_t)2 * CMP_ROWS * 1024 * 2;
constexpr size_t WS_BIG = WS_T + (size_t)2 * CMP_ROWS * 256 * 4;
constexpr size_t WS_XR = WS_BIG;
constexpr size_t WS_HL = WS_XR + (size_t)MPAD * 1280 * 4;
constexpr size_t WS_AC = WS_HL + (size_t)MPAD * 1280 * 4;
constexpr size_t WS_UP = WS_BIG;
constexpr size_t WS_ACT = WS_UP + (size_t)MPAD * 6144 * 2;
constexpr size_t WS_UPH = WS_ACT + (size_t)MPAD * 3072 * 2;
constexpr size_t WS_PIN = WS_UPH + (size_t)64 * 4 * 6144 * 4;
constexpr size_t WS_STASH = WS_PIN + (size_t)4 * MPAD * 1024 * 2;
constexpr size_t WS_SPSS = WS_STASH + (size_t)256 * 8 * 2048 * 4;
constexpr size_t WS_END_A = WS_AC + (size_t)MPAD * 1280 * 4, WS_END_B = WS_SPSS + (size_t)2 * 64 * 32 * 4;
constexpr size_t WS_END = WS_END_A > WS_END_B ? WS_END_A : WS_END_B;
static_assert(WS_END < (size_t)1300 * 1024 * 1024, "workspace budget");

constexpr int LDS_RING = 0, LDS_RING_BYTES = 131072;
constexpr int LDS_RS = LDS_RING_BYTES;
constexpr int LDS_MISC = 163840 - 256;
constexpr int LDS_HALO = LDS_RS + 8 * 1024;
constexpr int LDS_BYTES = 163840;

struct Params { const void* in[38]; float* out; unsigned char* ws; int ph_lo, ph_hi; };
typedef const __attribute__((address_space(4))) Params* KP;
__device__ __forceinline__ KP launder(KP p) { asm volatile("" : "+s"(p)); return p; }
__device__ __forceinline__ int launder_v(int x) { asm volatile("" : "+v"(x)); return x; }
__device__ __forceinline__ int launder_s(int x) { asm volatile("" : "+s"(x)); return x; }

__device__ __forceinline__ unsigned f2bf(float f) { unsigned u = __builtin_bit_cast(unsigned, f); return (u + 0x7fffu + ((u >> 16) & 1u)) >> 16; }
typedef __bf16 bf16x2_t __attribute__((ext_vector_type(2)));
__device__ __forceinline__ unsigned pk2(float lo, float hi) { const f32x2 v = {lo, hi}; return __builtin_bit_cast(unsigned, __builtin_convertvector(v, bf16x2_t)); }
__device__ __forceinline__ f32x4 unpack4(u32x2 w);
__device__ __forceinline__ void unpack8(u32x4 w, f32x4& lo, f32x4& hi) { lo = unpack4((u32x2){w.x, w.y}); hi = unpack4((u32x2){w.z, w.w}); }
__device__ __forceinline__ f32x4 unpack4(u32x2 w) { f32x4 v; v[0] = __builtin_bit_cast(float, w.x << 16); v[1] = __builtin_bit_cast(float, w.x & 0xffff0000u); v[2] = __builtin_bit_cast(float, w.y << 16); v[3] = __builtin_bit_cast(float, w.y & 0xffff0000u); return v; }
__device__ __forceinline__ float bf2f(unsigned short b) { return __builtin_bit_cast(float, ((unsigned)b) << 16); }
__device__ __forceinline__ float gelu_tanh(float x) {
    const float u = 0.7978845608028654f * (x + 0.044715f * x * x * x);
    return x * __builtin_amdgcn_rcpf(1.0f + __expf(-2.0f * u));
}
__device__ __forceinline__ float sigmoidf_(float x) { return __builtin_amdgcn_rcpf(1.0f + __expf(-x)); }
__device__ __forceinline__ float wave_sum(float v) {
#pragma unroll
    for (int o = 1; o < 64; o <<= 1) v += __shfl_xor(v, o);
    return v;
}
namespace pg8 {
#define PG8_LAS __attribute__((address_space(3)))
typedef unsigned short bf16_t;
typedef short bf16x8 __attribute__((ext_vector_type(8)));
typedef float f32x4 __attribute__((ext_vector_type(4)));
typedef unsigned u32x4 __attribute__((ext_vector_type(4)));
constexpr int BM = 256, BK = 64, HALF = 128, HTB = HALF * BK * 2  , STAGE_BYTES = 8 * HTB, NXCD = 8, WGM = 8;

__host__ __device__ __forceinline__ int lds_byte(int r, int c) { const int st = (r >> 4) * 2 + (c >> 5), rr = r & 15, cc = c & 31, ob = rr * 64 + cc * 2; return st * 1024 + (ob ^ (((ob >> 9) & 1) << 5)); }
__host__ __device__ __forceinline__ void stage_rc(int b, int& R, int& C) { const int st = b / 1024, sb = b % 1024, swz = sb ^ (((sb >> 9) & 1) << 5); R = (st >> 1) * 16 + swz / 64; C = (st & 1) * 32 + (swz % 64) / 2; }
__host__ __device__ __forceinline__ int perm32(int rho) { const int n = rho >> 4, i = rho & 15; return 8 * (i >> 2) + 4 * n + (i & 3); }

struct Unit { int pm, pn; };
struct Gemm { const bf16_t* A; const bf16_t* Bt; int M, N, K; };

struct StaticOrder {
    int nM, nN, nwg, G, c;
    __host__ __device__ __forceinline__ void init(int M, int N, int G_, int c_) { nM = M / BM; nN = N / BM; nwg = nM * nN; G = G_; c = c_; }
    __host__ __device__ __forceinline__ bool next(int i, Unit& u) const {
        const long L = (long)i * G + c; if (L >= nwg) return false;
        int wgid = (int)L; { const int q = nwg / NXCD, r = nwg % NXCD, xcd = wgid % NXCD, off = wgid / NXCD; wgid = (xcd < r ? xcd * (q + 1) : r * (q + 1) + (xcd - r) * q) + off; }
        const int nig = WGM * nN, gid = wgid / nig, fm = gid * WGM, gsz = (nM - fm) < WGM ? (nM - fm) : WGM;
        u.pm = fm + ((wgid % nig) % gsz); u.pn = (wgid % nig) / gsz; return true;
    }
    __device__ __forceinline__ void a_ready(const Unit&) const {}
    __device__ __forceinline__ void done(const Unit&) const {}
};
__device__ __forceinline__ unsigned cvt_pk_bf16(float lo, float hi) { unsigned r; asm volatile("v_cvt_pk_bf16_f32 %0, %1, %2" : "=v"(r) : "v"(lo), "v"(hi)); return r; }
typedef float f32x2 __attribute__((ext_vector_type(2)));
template <class Epi, class Sched, bool ALIGN_EPI = false, bool SP2 = false>
__device__ __forceinline__ void gemm_phase(PG8_LAS unsigned char* lds, const Gemm g, const Sched& S, const Epi& E) {
    int tid = threadIdx.x; asm volatile("" : "+v"(tid));
    const int wid = __builtin_amdgcn_readfirstlane(tid >> 6), lane = tid & 63, wr = wid >> 2, wc = wid & 3, fr = lane & 15, fq = lane >> 4;
    const int K = g.K, nt = K / BK;
    unsigned voffA[2], voffB[2];
#pragma unroll
    for (int i = 0; i < 2; ++i) { int R, C; stage_rc(tid * 16 + i * 8192, R, C); const int Rb = Epi::PERM ? ((R & ~31) + perm32(R & 31)) : R;
        voffA[i] = (unsigned)(R * K + C) * 2u; voffB[i] = (unsigned)(Rb * K + C) * 2u; }
    const size_t kstep = (size_t)(BK * 2);
    const size_t hstep = (size_t)HALF * K * 2;
    const size_t tstep = 2 * hstep;
    const unsigned ldsw = (unsigned)wid * 1024u;
    const int aoff = lds_byte(wr * 64 + fr, fq * 8), boff = lds_byte(wc * 32 + fr, fq * 8);
#define PG8_SA(b, h) (((b) * 2 + (h)) * HTB)
#define PG8_SB(b, h) ((4 + (b) * 2 + (h)) * HTB)
#define PG8_STAGE(bufoff, gbase, voff) do { _Pragma("unroll") for (int _i = 0; _i < 2; ++_i) \
        __builtin_amdgcn_global_load_lds((const unsigned*)((const char*)(gbase) + (voff)[_i]), (PG8_LAS unsigned*)(lds + (bufoff) + ldsw + _i * 8192), 16, 0, 0); } while (0)
#define PG8_LDA(dst, b, h) do { _Pragma("unroll") for (int m = 0; m < 4; ++m) _Pragma("unroll") for (int k = 0; k < 2; ++k) dst[m][k] = *(const PG8_LAS bf16x8*)(lds + PG8_SA(b, h) + aoff + m * 2048 + k * 1024); } while (0)
#define PG8_LDB(dst, b, h) do { _Pragma("unroll") for (int n = 0; n < 2; ++n) _Pragma("unroll") for (int k = 0; k < 2; ++k) dst[n][k] = *(const PG8_LAS bf16x8*)(lds + PG8_SB(b, h) + boff + n * 2048 + k * 1024); } while (0)
#define PG8_MMA(ai, bj, At, Bt) do { __builtin_amdgcn_s_setprio(1); _Pragma("unroll") for (int m = 0; m < 4; ++m) _Pragma("unroll") for (int n = 0; n < 2; ++n) _Pragma("unroll") for (int k = 0; k < 2; ++k) \
        acc[ai][bj][m][n] = __builtin_amdgcn_mfma_f32_16x16x32_bf16(Bt[n][k], At[m][k], acc[ai][bj][m][n], 0, 0, 0); __builtin_amdgcn_s_setprio(0); } while (0)
#define PG8_WAIT_V(n) asm volatile("s_waitcnt vmcnt(" #n ")" ::: "memory")
#define PG8_WAIT_L(n) asm volatile("s_waitcnt lgkmcnt(" #n ")" ::: "memory")
#define PG8_BAR __builtin_amdgcn_s_barrier()
#define PG8_SCHED __builtin_amdgcn_sched_barrier(0)
    Unit cur, nxt; int ui = 0;
    if (!S.next(0, cur)) return;
    f32x4 acc[2][2][4][2];
#pragma unroll
    for (int a = 0; a < 2; ++a)
#pragma unroll
        for (int b = 0; b < 2; ++b)
#pragma unroll
            for (int m = 0; m < 4; ++m)
#pragma unroll
                for (int n = 0; n < 2; ++n) acc[a][b][m][n] = (f32x4){0.f, 0.f, 0.f, 0.f};
    bf16x8 At[4][2], B0[2][2], B1[2][2];
    const char* cA = (const char*)g.A + (size_t)cur.pm * tstep; const char* cB = (const char*)g.Bt + (size_t)cur.pn * tstep;
    S.a_ready(cur);
    if constexpr (SP2) {
        PG8_STAGE(PG8_SB(0, 0), cB, voffB); PG8_STAGE(PG8_SB(0, 1), cB + hstep, voffB); PG8_STAGE(PG8_SA(0, 0), cA, voffA); PG8_STAGE(PG8_SA(0, 1), cA + hstep, voffA);
        if (wr == 1) PG8_BAR;
        PG8_WAIT_V(2); PG8_BAR;
        PG8_STAGE(PG8_SB(1, 0), cB + kstep, voffB); PG8_STAGE(PG8_SA(1, 0), cA + kstep, voffA); PG8_STAGE(PG8_SB(1, 1), cB + hstep + kstep, voffB);
        PG8_WAIT_V(6); PG8_BAR;
    } else {
        PG8_STAGE(PG8_SB(0, 0), cB, voffB); PG8_STAGE(PG8_SA(0, 0), cA, voffA); PG8_STAGE(PG8_SB(0, 1), cB + hstep, voffB); PG8_STAGE(PG8_SA(0, 1), cA + hstep, voffA);
        if (wr == 1) PG8_BAR;
        PG8_WAIT_V(4); PG8_BAR;
        PG8_STAGE(PG8_SB(1, 0), cB + kstep, voffB); PG8_STAGE(PG8_SA(1, 0), cA + kstep, voffA); PG8_STAGE(PG8_SB(1, 1), cB + hstep + kstep, voffB);
        PG8_WAIT_V(6); PG8_BAR;
    }
    for (;;) {
        const bool has_next = S.next(ui + 1, nxt);
        const char* nA = has_next ? (const char*)g.A + (size_t)nxt.pm * tstep : cA; const char* nB = has_next ? (const char*)g.Bt + (size_t)nxt.pn * tstep : cB;
        for (int t = 0; t < nt; t += 2) {
            const bool last = (t == nt - 2);
            const char* a1 = cA + (size_t)(t + 1) * kstep;
            const char* a2 = last ? nA : cA + (size_t)(t + 2) * kstep; const char* b2 = last ? nB : cB + (size_t)(t + 2) * kstep;
            const char* a3 = a2 + kstep; const char* b3 = b2 + kstep;
            if (last && has_next) S.a_ready(nxt);
            if constexpr (SP2) {
            PG8_LDB(B0, 0, 0); PG8_LDB(B1, 0, 1); PG8_SCHED; PG8_LDA(At, 0, 0); PG8_STAGE(PG8_SA(1, 1), a1 + hstep, voffA);
            PG8_WAIT_V(8); PG8_WAIT_L(0); PG8_BAR; PG8_MMA(0, 0, At, B0); PG8_MMA(0, 1, At, B1); PG8_BAR; PG8_SCHED;
            PG8_LDA(At, 0, 1); PG8_STAGE(PG8_SB(0, 0), b2, voffB); PG8_STAGE(PG8_SB(0, 1), b2 + hstep, voffB); PG8_STAGE(PG8_SA(0, 0), a2, voffA);
            PG8_WAIT_V(8); PG8_WAIT_L(0); PG8_BAR; PG8_MMA(1, 0, At, B0); PG8_MMA(1, 1, At, B1); PG8_BAR; PG8_SCHED;
            PG8_LDB(B0, 1, 0); PG8_LDB(B1, 1, 1); PG8_SCHED; PG8_LDA(At, 1, 0); PG8_STAGE(PG8_SA(0, 1), a2 + hstep, voffA);
            PG8_WAIT_V(8); PG8_WAIT_L(0); PG8_BAR; PG8_MMA(0, 0, At, B0); PG8_MMA(0, 1, At, B1); PG8_BAR; PG8_SCHED;
            PG8_LDA(At, 1, 1); PG8_STAGE(PG8_SB(1, 0), b3, voffB); PG8_STAGE(PG8_SB(1, 1), b3 + hstep, voffB); PG8_STAGE(PG8_SA(1, 0), a3, voffA);
            PG8_WAIT_V(8); PG8_WAIT_L(0); PG8_BAR; PG8_MMA(1, 0, At, B0); PG8_MMA(1, 1, At, B1); PG8_BAR; PG8_SCHED;
            } else {
            PG8_LDB(B0, 0, 0); PG8_SCHED; PG8_LDA(At, 0, 0); PG8_STAGE(PG8_SA(1, 1), a1 + hstep, voffA);
            PG8_WAIT_L(8); PG8_BAR; PG8_WAIT_L(0); PG8_MMA(0, 0, At, B0); PG8_BAR; PG8_SCHED;
            PG8_LDB(B1, 0, 1); PG8_STAGE(PG8_SB(0, 0), b2, voffB);
            PG8_BAR; PG8_WAIT_L(0); PG8_MMA(0, 1, At, B1); PG8_BAR;
            PG8_LDA(At, 0, 1); PG8_STAGE(PG8_SA(0, 0), a2, voffA);
            PG8_BAR; PG8_WAIT_L(0); PG8_MMA(1, 0, At, B0); PG8_BAR; PG8_SCHED;
            PG8_STAGE(PG8_SB(0, 1), b2 + hstep, voffB);
            PG8_WAIT_V(6); PG8_BAR; PG8_MMA(1, 1, At, B1); PG8_BAR;
            PG8_LDB(B0, 1, 0); PG8_SCHED; PG8_LDA(At, 1, 0); PG8_STAGE(PG8_SA(0, 1), a2 + hstep, voffA);
            PG8_WAIT_L(8); PG8_BAR; PG8_WAIT_L(0); PG8_MMA(0, 0, At, B0); PG8_BAR; PG8_SCHED;
            PG8_LDB(B1, 1, 1); PG8_STAGE(PG8_SB(1, 0), b3, voffB);
            PG8_BAR; PG8_WAIT_L(0); PG8_MMA(0, 1, At, B1); PG8_BAR;
            PG8_LDA(At, 1, 1); PG8_STAGE(PG8_SA(1, 0), a3, voffA);
            PG8_BAR; PG8_WAIT_L(0); PG8_MMA(1, 0, At, B0); PG8_BAR; PG8_SCHED;
            PG8_STAGE(PG8_SB(1, 1), b3 + hstep, voffB);
            PG8_WAIT_V(6); PG8_BAR; PG8_MMA(1, 1, At, B1); PG8_BAR;
            }
        }
        if constexpr (ALIGN_EPI) { if (wr == 0) PG8_BAR; }
        if constexpr (!Epi::AFTER_DRAIN) { E(acc, cur, wr, wc, fr, fq); S.done(cur); }
        if (!has_next) break;
#pragma unroll
        for (int a = 0; a < 2; ++a)
#pragma unroll
            for (int b = 0; b < 2; ++b)
#pragma unroll
                for (int m = 0; m < 4; ++m)
#pragma unroll
                    for (int n = 0; n < 2; ++n) acc[a][b][m][n] = (f32x4){0.f, 0.f, 0.f, 0.f};
        cur = nxt; cA = nA; cB = nB; ++ui;
        if constexpr (ALIGN_EPI) { if (wr == 1) PG8_BAR; }
    }
    PG8_WAIT_V(0);
    if constexpr (!ALIGN_EPI) { if (wr == 0) PG8_BAR; }
    PG8_BAR;
    if constexpr (Epi::AFTER_DRAIN) { E.fused(acc, cur, wr, wc, fr, fq, lds, wid, lane); S.done(cur); }
#undef PG8_SA
#undef PG8_SB
#undef PG8_STAGE
#undef PG8_LDA
#undef PG8_LDB
#undef PG8_MMA
#undef PG8_WAIT_V
#undef PG8_WAIT_L
#undef PG8_BAR
#undef PG8_SCHED
}
}
#define XB_TMO      128
#define XB_XCNT(j)  (256  + 64 * (j))
#define XB_XSUB(j)  (1280 + 64 * (j))
#define XB_XGEN(j)  (2304 + 64 * (j))
#define XB_TOP      3328
#define XB_TOPGEN   3392
#define XCD_BAR_WORDS 3456
#define XB_SPIN_CAP (1u << 18)

__device__ __forceinline__ unsigned xb_ld(unsigned* p)              { return __hip_atomic_load(p, __ATOMIC_RELAXED, __HIP_MEMORY_SCOPE_AGENT); }
__device__ __forceinline__ unsigned xb_add(unsigned* p, unsigned v) { return __hip_atomic_fetch_add(p, v, __ATOMIC_RELAXED, __HIP_MEMORY_SCOPE_AGENT); }
__device__ __forceinline__ unsigned xb_xcc_id() { return (unsigned)__builtin_amdgcn_s_getreg((3 << 11) | 20) & 0xFu; }
#define XB_SPIN(cond, bar) do { unsigned _sp = 0; while (cond) { __builtin_amdgcn_s_sleep(1); \
    if ((++_sp & 255u) == 0u) { if (xb_ld(&(bar)[XB_TMO])) break; if (_sp > XB_SPIN_CAP) { atomicAdd(&(bar)[XB_TMO], 1u); break; } } } } while (0)

struct XcdBarrier {
    unsigned* bar; unsigned x;
    volatile LAS unsigned* st;
};

__device__ __forceinline__ XcdBarrier xcd_barrier_post(unsigned* bar, volatile LAS unsigned* st) {
    XcdBarrier b; b.bar = bar; b.x = xb_xcc_id(); b.st = st;
    if (threadIdx.x == 0) (void)xb_add(&bar[XB_XCNT(b.x)], 1u);
    return b;
}
__device__ __forceinline__ void xcd_barrier_complete(unsigned* bar, unsigned x, unsigned& nloc, unsigned& nx) {
    const unsigned G = gridDim.x * gridDim.y * gridDim.z;
    unsigned sum, cnt, mine, sp = 0u;
    for (;;) {
        sum = 0u; cnt = 0u; mine = 0u;
#pragma unroll
        for (unsigned j = 0; j < 16; ++j) { const unsigned c = xb_ld(&bar[XB_XCNT(j)]); sum += c; cnt += (c > 0u) ? 1u : 0u; mine = (j == x) ? c : mine; }
        if (sum == G) break;
        __builtin_amdgcn_s_sleep(1);
        if ((++sp & 255u) == 0u) { if (xb_ld(&bar[XB_TMO])) break; if (sp > XB_SPIN_CAP) { atomicAdd(&bar[XB_TMO], 1u); break; } }
    }
    nloc = mine > 0u ? mine : 1u; nx = cnt > 0u ? cnt : 1u;
}

__device__ __forceinline__ void xcd_barrier(const XcdBarrier& b) {
    asm volatile("s_waitcnt vmcnt(0)" ::: "memory");
    __syncthreads();
    if (threadIdx.x == 0) {
        unsigned* bar = b.bar;
        __builtin_amdgcn_s_waitcnt(0);
        unsigned nloc = b.st[0], nx = b.st[1];
        if (nloc == 0u) { xcd_barrier_complete(bar, b.x, nloc, nx); b.st[0] = nloc; b.st[1] = nx; }
        const unsigned old = xb_add(&bar[XB_XSUB(b.x)], 1u);
        const unsigned gen = old / nloc;
        if (old + 1u == (gen + 1u) * nloc) {
            __builtin_amdgcn_fence(__ATOMIC_RELEASE, "agent");
            asm volatile("s_waitcnt vmcnt(0)" ::: "memory");
            const unsigned og = xb_add(&bar[XB_TOP], 1u);
            const unsigned tg = og / nx;
            if (og + 1u == (tg + 1u) * nx) xb_add(&bar[XB_TOPGEN], 1u);
            else XB_SPIN(xb_ld(&bar[XB_TOPGEN]) == tg, bar);
            __builtin_amdgcn_fence(__ATOMIC_ACQUIRE, "agent");
            xb_add(&bar[XB_XGEN(b.x)], 1u);
            asm volatile("s_waitcnt vmcnt(0)" ::: "memory");
        } else {
            XB_SPIN(xb_ld(&bar[XB_XGEN(b.x)]) == gen, bar);
            __builtin_amdgcn_fence(__ATOMIC_ACQUIRE, "agent");
            asm volatile("s_waitcnt vmcnt(0)" ::: "memory");
        }
    }
    __syncthreads();
}


__device__ unsigned g_seam0[10 * 64];
__device__ __forceinline__ void seam0_barrier() {
    asm volatile("s_waitcnt vmcnt(0)" ::: "memory");
    __syncthreads();
    if (threadIdx.x == 0) {
        __builtin_amdgcn_fence(__ATOMIC_RELEASE, "agent");
        asm volatile("s_waitcnt vmcnt(0)" ::: "memory");
        const unsigned G = gridDim.x, s = blockIdx.x & 7u, ns = (G - s + 7u) >> 3, nsh = G < 8u ? G : 8u;
        const unsigned old = xb_add(&g_seam0[s * 64], 1u);
        const unsigned round = old / ns;
        if (old + 1u == (round + 1u) * ns) {
            const unsigned o2 = xb_add(&g_seam0[8 * 64], 1u);
            if ((o2 + 1u) % nsh == 0u) xb_add(&g_seam0[9 * 64], 1u);
        }
        unsigned sp = 0u;
        while ((int)(xb_ld(&g_seam0[9 * 64]) - (round + 1u)) < 0) { __builtin_amdgcn_s_sleep(2); if (++sp > (1u << 24)) break; }
        __builtin_amdgcn_fence(__ATOMIC_ACQUIRE, "agent");
        asm volatile("s_waitcnt vmcnt(0)" ::: "memory");
    }
    __syncthreads();
}
__device__ __forceinline__ int rowmap(int mode, int nn) {
    const int il = (nn & ~63) + 2 * (nn & 31) + ((nn >> 5) & 1);
    if (mode == 1) return nn < 1024 ? il : nn;
    if (mode == 2) { const int j = nn >> 7; return (j == 2 || j == 4) ? il : nn; }
    if (mode == 3) { const int half = nn >= DFF ? 1 : 0, ka = nn - half * DFF; return (ka >> 7) * 256 + half * 128 + (ka & 127); }
    return nn;
}
__device__ __forceinline__ void tr_item(const float* __restrict__ W, int ldn, int Nsrc, bf16* __restrict__ WT, int dstK, const float* __restrict__ gain, int mode, int item, int nblk,
                                        LAS float* scr, int lane) {
    const int kb = item / nblk, nb = item % nblk, k0 = 64 * kb, n0 = 32 * nb;
    const int n = n0 + (lane & 31);
    float wv[32];
#pragma unroll
    for (int i = 0; i < 32; ++i) { const int kk = 2 * i + (lane >> 5); wv[i] = (n < Nsrc) ? __builtin_nontemporal_load(W + (size_t)(k0 + kk) * ldn + n) : 0.f; }
#pragma unroll
    for (int i = 0; i < 32; ++i) { const int kk = 2 * i + (lane >> 5); float v = wv[i]; if (gain) v *= gain[k0 + kk]; scr[kk * 33 + (lane & 31)] = v; }
    asm volatile("s_waitcnt lgkmcnt(0)" ::: "memory");
    const int c = lane & 7;
#pragma unroll
    for (int j = 0; j < 4; ++j) {
        const int nl = (lane >> 3) + 8 * j; const LAS float* s = scr + (8 * c) * 33 + nl;
        u32x4 o; o.x = pk2(s[0 * 33], s[1 * 33]); o.y = pk2(s[2 * 33], s[3 * 33]); o.z = pk2(s[4 * 33], s[5 * 33]); o.w = pk2(s[6 * 33], s[7 * 33]);
        const int row = rowmap(mode, n0 + nl);
        *(u32x4*)(WT + (size_t)row * dstK + k0 + 8 * c) = o;
    }
    asm volatile("s_waitcnt lgkmcnt(0)" ::: "memory");
}

__device__ __forceinline__ void phase0(KP P, LAS unsigned char* lds, int tid, int lane, int wave, int G) {
    unsigned char* ws = P->ws;
    const int gw = launder_s(blockIdx.x) * 8 + wave, NGW = G * 8;
    const size_t gt = (size_t)launder_s(blockIdx.x) * 512 + tid, NGT = (size_t)G * 512;
    LAS float* scr = (LAS float*)(lds + wave * 16384);
    {
        const float* g_mix = (const float*)P->in[11]; const float* g_ffn = (const float*)P->in[12]; const float* g_ple = (const float*)P->in[13];
        constexpr int C_WIN = 16 * 80, C_WOUT = 20 * 32, C_WUP = 16 * 192, C_WDN = 48 * 32, C_WPI = 4 * 32, C_WPG = 16 * 32, C_WKV = 16 * 24, C_WQG = 16 * 40, C_WO = 16 * 32, C_WC1 = 16 * 4;
        constexpr int NITEMS = 2 * C_WIN + 2 * C_WOUT + 4 * C_WUP + 4 * C_WDN + 4 * C_WPI + 4 * C_WPG + C_WKV + 2 * C_WQG + 2 * C_WO + 4 * C_WC1;
        for (int it = gw; it < NITEMS; it += NGW) {
            int r = it;
            if (r < 2 * C_WIN) { const int L = r / C_WIN; r %= C_WIN;
                tr_item((const float*)P->in[15] + (size_t)L * 1024 * 2560, 2560, 2560, (bf16*)(ws + WS_WIN) + (size_t)L * 2560 * 1024, 1024, g_mix + L * 1024, 0, r, 80, scr, lane); continue; }
            r -= 2 * C_WIN;
            if (r < 2 * C_WOUT) { const int L = r / C_WOUT; r %= C_WOUT;
                tr_item((const float*)P->in[23] + (size_t)L * 1280 * 1024, 1024, 1024, (bf16*)(ws + WS_WOUT) + (size_t)L * 1024 * 1280, 1280, nullptr, 0, r, 32, scr, lane); continue; }
            r -= 2 * C_WOUT;
            if (r < 4 * C_WUP) { const int L = r / C_WUP; r %= C_WUP;
                tr_item((const float*)P->in[32] + (size_t)L * 1024 * 6144, 6144, 6144, (bf16*)(ws + WS_WUP) + (size_t)L * 6144 * 1024, 1024, g_ffn + L * 1024, 3, r, 192, scr, lane); continue; }
            r -= 4 * C_WUP;
            if (r < 4 * C_WDN) { const int L = r / C_WDN; r %= C_WDN;
                tr_item((const float*)P->in[35] + (size_t)L * 3072 * 1024, 1024, 1024, (bf16*)(ws + WS_WDN) + (size_t)L * 1024 * 3072, 3072, nullptr, 0, r, 32, scr, lane); continue; }
            r -= 4 * C_WDN;
            if (r < 4 * C_WPI) { const int L = r / C_WPI; r %= C_WPI;
                tr_item((const float*)P->in[36] + (size_t)L * 256 * 1024, 1024, 1024, (bf16*)(ws + WS_WPI) + (size_t)L * 1024 * 256, 256, nullptr, 0, r, 32, scr, lane); continue; }
            r -= 4 * C_WPI;
            if (r < 4 * C_WPG) { const int L = r / C_WPG; r %= C_WPG;
                tr_item((const float*)P->in[37] + (size_t)L * 1024 * 1024, 1024, 1024, (bf16*)(ws + WS_WPG) + (size_t)L * 1024 * 1024, 1024, g_ple + L * 1024, 0, r, 32, scr, lane); continue; }
            r -= 4 * C_WPG;
            if (r < C_WKV) { tr_item((const float*)P->in[25], 768, 768, (bf16*)(ws + WS_WKV), 1024, (const float*)P->in[24], 2, r, 24, scr, lane); continue; }
            r -= C_WKV;
            if (r < 2 * C_WQG) { const int L = r / C_WQG; r %= C_WQG;
                tr_item((const float*)P->in[30] + (size_t)L * 1024 * NQG, NQG, NQG, (bf16*)(ws + WS_WQG) + (size_t)L * NQGP * 1024, 1024, g_mix + (2 + L) * 1024, 1, r, 40, scr, lane); continue; }
            r -= 2 * C_WQG;
            if (r < 2 * C_WO) { const int L = r / C_WO; r %= C_WO;
                tr_item((const float*)P->in[31] + (size_t)L * 1024 * 1024, 1024, 1024, (bf16*)(ws + WS_WO) + (size_t)L * 1024 * 1024, 1024, nullptr, 0, r, 32, scr, lane); continue; }
            r -= 2 * C_WO;
            { const int q = r / C_WC1; r %= C_WC1; const int j = q >> 1, half = q & 1;
                tr_item((const float*)P->in[27] + (size_t)j * 2048 * 128 + (size_t)half * 1024 * 128, 128, 128, (bf16*)(ws + WS_WC1) + (size_t)j * 256 * 1024 + (size_t)half * 128 * 1024, 1024, nullptr, 0, r, 4, scr, lane); }
        }
    }
    {
        bf16* XB = (bf16*)(ws + WS_XB); bf16* XB1 = (bf16*)(ws + WS_X); float* PSS = (float*)(ws + WS_PSS);
        for (int m0 = gw; m0 < MPAD; m0 += 2 * NGW) {
          f32x4 vv[2][4];
#pragma unroll
          for (int q = 0; q < 2; ++q) { const int m = m0 + q * NGW;
            const float* src = m < MP ? (const float*)P->in[0] + (size_t)m * 1024 : (const float*)P->in[1] + (size_t)(m - MP) * 1024;
#pragma unroll
            for (int j = 0; j < 4; ++j) { vv[q][j] = (f32x4){0.f, 0.f, 0.f, 0.f}; if (m < MTOT) vv[q][j] = __builtin_nontemporal_load((const f32x4*)(src + 4 * lane + 256 * j)); } }
#pragma unroll
          for (int q = 0; q < 2; ++q) { const int m = m0 + q * NGW; if (m >= MPAD) break;
            float ss = 0.f;
#pragma unroll
            for (int j = 0; j < 4; ++j) {
                f32x4 v = vv[q][j];
                u32x2 w; w.x = pk2(v[0], v[1]); w.y = pk2(v[2], v[3]);
                *(u32x2*)(XB + (size_t)m * 1024 + 4 * lane + 256 * j) = w;
                if (m >= MTOT) *(u32x2*)(XB1 + (size_t)m * 1024 + 4 * lane + 256 * j) = w;
                v = unpack4(w);
                ss += (v[0] * v[0] + v[1] * v[1]) + (v[2] * v[2] + v[3] * v[3]);
            }
            ss = wave_sum(ss);
            if (lane < 16) PSS[(size_t)lane * MPAD + m] = (lane == 0) ? ss : 0.f;
            if (m >= MP && m < MTOT) ((float*)(ws + WS_SPSS))[lane * 32 + (m - MP)] = (lane == 0) ? ss : 0.f;
          }
        }
    }
    {
        bf16* PB = (bf16*)(ws + WS_PB);
        for (size_t i0 = gt; i0 < (size_t)4 * MPAD * 64; i0 += 8 * NGT) {
            f32x4 v[8];
#pragma unroll
            for (int q = 0; q < 8; ++q) { const size_t i = i0 + q * NGT; v[q] = (f32x4){0.f, 0.f, 0.f, 0.f};
                if (i < (size_t)4 * MPAD * 64) { const int c4 = (int)(i & 63); const size_t rm = i >> 6; const int m = (int)(rm % MPAD), L = (int)(rm / MPAD);
                    if (m < MP) v[q] = __builtin_nontemporal_load((const f32x4*)((const float*)P->in[2] + ((size_t)L * MP + m) * 256 + 4 * c4));
                    else if (m < MTOT) v[q] = *(const f32x4*)((const float*)P->in[3] + ((size_t)L * MS + (m - MP)) * 256 + 4 * c4); } }
#pragma unroll
            for (int q = 0; q < 8; ++q) { const size_t i = i0 + q * NGT;
                if (i < (size_t)4 * MPAD * 64) { u32x2 w; w.x = pk2(v[q][0], v[q][1]); w.y = pk2(v[q][2], v[q][3]); *(u32x2*)(PB + i * 4) = w; } }
        }
    }
    {
        const float* cache = (const float*)P->in[4]; const int* pt = (const int*)P->in[10]; bf16* CA = (bf16*)(ws + WS_CMPA);
        for (int item = launder_s(blockIdx.x); item < MS * NPG; item += G) {
            const int sb = item / NPG, pg = item % NPG;
            const float* src = cache + (size_t)pt[item] * (PGSZ * 256);
            static_assert(PGSZ * 64 == 16 * 512, "page = 16 float4 per thread");
#pragma unroll
            for (int hb = 0; hb < 2; ++hb) {
                f32x4 v[8];
#pragma unroll
                for (int q = 0; q < 8; ++q) v[q] = __builtin_nontemporal_load((const f32x4*)(src + (size_t)(tid + 512 * (8 * hb + q)) * 4));
#pragma unroll
                for (int q = 0; q < 8; ++q) { const int c = tid + 512 * (8 * hb + q);
                    const int f = c * 4, tl = f >> 8, rem = f & 255, j = rem >> 7, g = (rem >> 6) & 1, d = rem & 63;
                    u32x2 w; w.x = pk2(v[q][0], v[q][1]); w.y = pk2(v[q][2], v[q][3]);
                    const size_t row = (size_t)CMP_ROWS_P + (size_t)(g * MS + sb) * 512 + pg * 8 + (tl >> 4);
                    *(u32x2*)(CA + ((size_t)j * CMP_ROWS + row) * 1024 + (tl & 15) * 64 + d) = w; }
            }
        }
    }
    {
        float* RT = (float*)(ws + WS_ROPE);
        for (size_t i = gt; i < (size_t)4097 * 32; i += NGT) {
            const int fi = (int)(i & 31), pi = (int)(i >> 5); const int pos = pi < 4096 ? pi : PAST;
            double f = 1.0; for (int k = 0; k < fi; ++k) f *= 0.7498942093324559;
            const float ang = (float)pos * (float)f;
            const double x = (double)ang; const double kq = __builtin_rint(x * 0.6366197723675814);
            const double r = (x - kq * 1.5707963267948966) - kq * 6.123233995736766e-17, r2 = r * r;
            const double sn = r * (1.0 + r2 * (-1.0 / 6 + r2 * (1.0 / 120 + r2 * (-1.0 / 5040 + r2 * (1.0 / 362880 + r2 * (-1.0 / 39916800 + r2 * (1.0 / 6227020800.0)))))));
            const double cs = 1.0 + r2 * (-0.5 + r2 * (1.0 / 24 + r2 * (-1.0 / 720 + r2 * (1.0 / 40320 + r2 * (-1.0 / 3628800 + r2 * (1.0 / 479001600.0 + r2 * (-1.0 / 87178291200.0)))))));
            const int q = ((int)kq) & 3;
            const double s_ = (q == 0) ? sn : (q == 1) ? cs : (q == 2) ? -sn : -cs;
            const double c_ = (q == 0) ? cs : (q == 1) ? -sn : (q == 2) ? -cs : sn;
            RT[i * 2] = (float)c_; RT[i * 2 + 1] = (float)s_;
        }
    }
    {
        float* B1P = (float*)(ws + WS_B1F); const float* pos = (const float*)P->in[26]; const float* w1 = (const float*)P->in[27];
        for (size_t i = gt; i < (size_t)32 * 2 * 128; i += NGT) {
            const int e = (int)(i & 127), j = (int)((i >> 7) & 1), l = (int)(i >> 8);
            float s = 0.f;
#pragma unroll 16
            for (int d = 0; d < 64; ++d) s += pos[(l * 2 + j) * 64 + d] * w1[((size_t)j * 2048 + l * 64 + d) * 128 + e];
            B1P[i] = s;
        }
    }
    {
        bf16* WG = (bf16*)(ws + WS_WGA);
        for (size_t i = gt; i < (size_t)2 * 2 * 16 * 80 * 96; i += NGT) {
            const int k = (int)(i % 96); size_t r = i / 96; const int j = (int)(r % 80); r /= 80; const int n = (int)(r % 16); r /= 16; const int ax = (int)(r & 1), L = (int)(r >> 1);
            const float* src = (const float*)P->in[ax ? 20 : 18];
            const float v = k < 80 ? src[(((size_t)L * 16 + n) * 80 + k) * 80 + j] : 0.f;
            WG[i] = (bf16)f2bf(v);
        }
    }
    {
        const float* cw = (const float*)P->in[6]; float* o = P->out + O_WIN_S;
        for (size_t i0 = gt; i0 < (size_t)MS * 511 * 64; i0 += 4 * NGT) {
            f32x4 v[4];
#pragma unroll
            for (int q = 0; q < 4; ++q) { const size_t i = i0 + q * NGT; v[q] = (f32x4){0.f, 0.f, 0.f, 0.f};
                if (i < (size_t)MS * 511 * 64) { const int c4 = (int)(i & 63); const size_t rw = i >> 6; const int w = (int)(rw % 511), sb = (int)(rw / 511);
                    v[q] = __builtin_nontemporal_load((const f32x4*)(cw + ((size_t)sb * 512 + w + 1) * 256 + 4 * c4)); } }
#pragma unroll
            for (int q = 0; q < 4; ++q) { const size_t i = i0 + q * NGT;
                if (i < (size_t)MS * 511 * 64) { const int c4 = (int)(i & 63); const size_t rw = i >> 6; const int w = (int)(rw % 511), sb = (int)(rw / 511);
                    __builtin_nontemporal_store(v[q], (f32x4*)(o + ((size_t)sb * 512 + w) * 256 + 4 * c4)); } }
        }
    }
}

#define EPI_FOR_ROWS _Pragma("unroll") for (int ai = 0; ai < 2; ++ai) _Pragma("unroll") for (int m = 0; m < 4; ++m)
#define EPI_FOR_COLS _Pragma("unroll") for (int bj = 0; bj < 2; ++bj) _Pragma("unroll") for (int n = 0; n < 2; ++n) if (only < 0 || only == bj * 2 + n)
#define EPI_ROWL (ai * 128 + wr * 64 + m * 16 + fr)
#define EPI_COLL (bj * 128 + wc * 32 + n * 16 + 4 * fq)
typedef const f32x4 (&AccRef)[2][2][4][2];

__device__ __forceinline__ u32x2 pack4(f32x4 v) { u32x2 w; w.x = pk2(v[0], v[1]); w.y = pk2(v[2], v[3]); return w; }

__device__ __forceinline__ void rs_sample(const float* SP, LAS float* dst, int tid) {
    const int row = tid >> 4, part = tid & 15; float s = 0.f;
#pragma unroll
    for (int i = 0; i < 4; ++i) s += SP[(part * 4 + i) * 32 + row];
    s += __shfl_xor(s, 1); s += __shfl_xor(s, 2); s += __shfl_xor(s, 4); s += __shfl_xor(s, 8);
    if (part == 0) dst[row] = rsqrtf(s * (1.0f / 1024.0f) + EPS);
}
template <class Sched> __device__ __forceinline__ void rs_prepare(const Sched& S, const float* PSScur, const float* X, LAS float* rsb, int tid, bool thin) {
    pg8::Unit u;
    for (int i = 0; i < 7 && S.next(i, u); ++i) {
        if (tid < 256) { const int mrow = u.pm * 256 + tid; float s = 0.f;
#pragma unroll
            for (int k = 0; k < 16; ++k) s += PSScur[(size_t)k * MPAD + mrow];
            rsb[i * 256 + tid] = rsqrtf(s * (1.0f / 1024.0f) + EPS); }
    }
    if (thin) rs_sample(X, rsb + 7 * 256, tid);
    __syncthreads();
}
template <class E> __device__ __forceinline__ auto warm_call(const E& e, int fr, int fq, int cg, int) -> decltype(e.warm(fr, fq, cg)) { return e.warm(fr, fq, cg); }
template <class E> __device__ __forceinline__ float warm_call(const E&, int, int, int, long) { return 0.f; }
template <class E> __device__ __forceinline__ auto thin_epi(const E& e, f32x4 s0, f32x4 s1, int cg, int fr, int fq, int) -> decltype(e.thin(s0, s1, cg, fr, fq), true) { e.thin(s0, s1, cg, fr, fq); return true; }
template <class E> __device__ __forceinline__ bool thin_epi(const E&, f32x4, f32x4, int, int, int, long) { return false; }
template <int K, class Epi> __device__ __forceinline__ void thin_unit(LAS unsigned char* lds, const bf16* __restrict__ A, const bf16* __restrict__ Bt, int cg, const Epi& E) {
    int tid = threadIdx.x; asm volatile("" : "+v"(tid));
    const int wid = __builtin_amdgcn_readfirstlane(tid >> 6), lane = tid & 63, fr = lane & 15, fq = lane >> 4;
    f32x4 c0 = (f32x4){0.f, 0.f, 0.f, 0.f}, c1 = c0;
    float warm = 0.f; if (wid == 0) warm = warm_call(E, fr, fq, cg, 0);
    const bf16* ap = A + (size_t)(MP + fr) * K + fq * 8;
    const bf16* bp = Bt + (size_t)(cg * 16 + fr) * K + fq * 8;
    constexpr int NI = (K / 32) / 8;
    static_assert((K / 32) % 8 == 0, "thin unit K");
    bf16x8 bb[NI], aa0[NI], aa1[NI];
#pragma unroll
    for (int i = 0; i < NI; ++i) { const int ks = wid + 8 * i; bb[i] = *(const bf16x8*)(bp + ks * 32); aa0[i] = *(const bf16x8*)(ap + ks * 32); aa1[i] = *(const bf16x8*)(ap + (size_t)16 * K + ks * 32); }
#pragma unroll
    for (int i = 0; i < NI; ++i) { c0 = __builtin_amdgcn_mfma_f32_16x16x32_bf16(bb[i], aa0[i], c0, 0, 0, 0); c1 = __builtin_amdgcn_mfma_f32_16x16x32_bf16(bb[i], aa1[i], c1, 0, 0, 0); }
    LAS f32x4* red = (LAS f32x4*)lds;
    red[(wid * 2 + 0) * 64 + lane] = c0; red[(wid * 2 + 1) * 64 + lane] = c1;
    asm volatile("" :: "v"(warm));
    __syncthreads();
    if (wid == 0) {
        f32x4 s0 = red[lane], s1 = red[64 + lane];
#pragma unroll
        for (int w = 1; w < 8; ++w) { s0 += red[(w * 2) * 64 + lane]; s1 += red[(w * 2 + 1) * 64 + lane]; }
      if (!thin_epi(E, s0, s1, cg, fr, fq, 0)) {
        f32x4 acc[2][2][4][2];
        const float z_ = __builtin_bit_cast(float, launder_v(0));
#pragma unroll
        for (int a = 0; a < 2; ++a)
#pragma unroll
            for (int b = 0; b < 2; ++b)
#pragma unroll
                for (int m = 0; m < 4; ++m)
#pragma unroll
                    for (int n = 0; n < 2; ++n) acc[a][b][m][n] = (f32x4){z_, z_, z_, z_};
        const int bj = (cg >> 3) & 1, n = cg & 1;
#pragma unroll
        for (int b = 0; b < 2; ++b)
#pragma unroll
            for (int nn = 0; nn < 2; ++nn) if (b == bj && nn == n) { acc[0][b][0][nn] = s0; acc[0][b][1][nn] = s1; }
        pg8::Unit u; u.pm = MP / 256; u.pn = cg >> 4;
        E.only = bj * 2 + n;
        E(acc, u, 0, (cg >> 1) & 3, fr, fq);
        E.only = -1;
      }
    }
    __syncthreads();
}

struct EpiRG1 {
    static constexpr bool PERM = false, AFTER_DRAIN = false;
    unsigned char* ws; const LAS float* rs; mutable int slot; mutable int only = -1;
    __device__ __forceinline__ void operator()(AccRef acc, const pg8::Unit& u, int wr, int wc, int fr, int fq) const {
        fr = launder_v(fr); fq = launder_v(fq);
        const LAS float* rsl = rs + slot * 256; ++slot;
        bf16* Y = (bf16*)(ws + WS_Y); bf16* XR = (bf16*)(ws + WS_XR);
        EPI_FOR_ROWS { const int rl = EPI_ROWL, row = u.pm * 256 + rl; const float r = rsl[rl];
            EPI_FOR_COLS { const int col = u.pn * 256 + EPI_COLL; f32x4 v = acc[ai][bj][m][n] * r;
                if (row < MTOT) { if (u.pn < 5) { v[0] = gelu_tanh(v[0]); v[1] = gelu_tanh(v[1]); v[2] = gelu_tanh(v[2]); v[3] = gelu_tanh(v[3]); *(u32x2*)(Y + (size_t)row * DRNN + col) = pack4(v); }
                else *(u32x2*)(XR + (size_t)row * DRNN + (col - DRNN)) = pack4(v); } } }
    }
};
struct EpiRes {
    static constexpr bool PERM = false, AFTER_DRAIN = false;
    unsigned char* ws; float* PSSn; size_t soff; float scale; size_t xoff; mutable int only = -1;
    __device__ __forceinline__ float warm(int fr, int fq, int cg) const {
        const bf16* XB = (const bf16*)(ws + xoff); const size_t o0 = (size_t)(MP + fr) * DM + cg * 16 + 4 * fq, o1 = o0 + (size_t)16 * DM;
        float w = bf2f(XB[o0]) + bf2f(XB[o1]);
        if (soff) { const bf16* S = (const bf16*)(ws + soff); w += bf2f(S[o0]) + bf2f(S[o1]); }
        return w; }
    __device__ __forceinline__ void thin(f32x4 s0, f32x4 s1, int cg, int fr, int fq) const {
        bf16* XB = (bf16*)(ws + xoff); const bf16* S = soff ? (const bf16*)(ws + soff) : nullptr;
        const int nx = (int)((PSSn - (float*)(ws + WS_PSS)) / (16 * MPAD));
#pragma unroll
        for (int m = 0; m < 2; ++m) { const size_t o = (size_t)(MP + 16 * m + fr) * DM + cg * 16 + 4 * fq; f32x4 a = (m ? s1 : s0) * scale;
            if (S) a *= unpack4(*(const u32x2*)(S + o));
            const u32x2 xw = pack4(unpack4(*(const u32x2*)(XB + o)) + a); const f32x4 x = unpack4(xw);
            *(u32x2*)(XB + o) = xw;
            float ssq = (x[0] * x[0] + x[1] * x[1]) + (x[2] * x[2] + x[3] * x[3]);
            ssq += __shfl_xor(ssq, 16); ssq += __shfl_xor(ssq, 32);
            if (fq == 0) ((float*)(ws + WS_SPSS))[nx * 2048 + cg * 32 + 16 * m + fr] = ssq; }
    }
    __device__ __forceinline__ void operator()(AccRef acc, const pg8::Unit& u, int wr, int wc, int fr, int fq) const {
        fr = launder_v(fr); fq = launder_v(fq);
        bf16* XB = (bf16*)(ws + xoff); const bf16* S = soff ? (const bf16*)(ws + soff) : nullptr;
#pragma unroll
        for (int ai = 0; ai < 2; ++ai) {
#pragma unroll
          for (int mh = 0; mh < 2; ++mh) {
            u32x2 xv[4][2][2];
#pragma unroll
            for (int m = 2 * mh; m < 2 * mh + 2; ++m) { const int row = u.pm * 256 + EPI_ROWL;
                EPI_FOR_COLS { const int col = u.pn * 256 + EPI_COLL; if (row < MTOT) xv[m][bj][n] = *(const u32x2*)(XB + (size_t)row * DM + col); } }
#pragma unroll
            for (int m = 2 * mh; m < 2 * mh + 2; ++m) { const int rl = EPI_ROWL, row = u.pm * 256 + rl; float ssq = 0.f;
                EPI_FOR_COLS { const int col = u.pn * 256 + EPI_COLL; f32x4 a = acc[ai][bj][m][n] * scale;
                    if (row < MTOT) {
                    if (S) { const u32x2 sw = *(const u32x2*)(S + (size_t)row * DM + col);
                        a[0] *= __builtin_bit_cast(float, sw.x << 16); a[1] *= __builtin_bit_cast(float, sw.x & 0xffff0000u); a[2] *= __builtin_bit_cast(float, sw.y << 16); a[3] *= __builtin_bit_cast(float, sw.y & 0xffff0000u); }
                    const u32x2 xw = pack4(unpack4(xv[m][bj][n]) + a); const f32x4 x = unpack4(xw);
                    *(u32x2*)(XB + (size_t)row * DM + col) = xw;
                    ssq += (x[0] * x[0] + x[1] * x[1]) + (x[2] * x[2] + x[3] * x[3]); } }
                ssq += __shfl_xor(ssq, 16); ssq += __shfl_xor(ssq, 32);
                if (fq == 0) { if (row < MP) PSSn[(size_t)(u.pn * 4 + wc) * MPAD + row] = ssq;
                    else if (only >= 0 && row < MTOT) { const int nx = (int)((PSSn - (float*)(ws + WS_PSS)) / (16 * MPAD));
                        ((float*)(ws + WS_SPSS))[nx * 2048 + (u.pn * 16 + (only >> 1) * 8 + wc * 2 + (only & 1)) * 32 + (row - MP)] = ssq; } } }
          }
        }
    }
};
template <int CTRL> __device__ __forceinline__ float dppf(float x) { return __builtin_bit_cast(float, __builtin_amdgcn_update_dpp(0, __builtin_bit_cast(int, x), CTRL, 0xf, 0xf, true)); }
#define DPPF(src, ctrl) dppf<ctrl>(src)
template <int CTRL> __device__ __forceinline__ float dppf_old(float old, float x) { return __builtin_bit_cast(float, __builtin_amdgcn_update_dpp(__builtin_bit_cast(int, old), __builtin_bit_cast(int, x), CTRL, 0xf, 0xf, false)); }
struct EpiUp {
    static constexpr bool PERM = false, AFTER_DRAIN = false;
    unsigned char* ws; const LAS float* rs; float* out; const float* cw; const float* cb; LAS float* halo; int L; mutable int slot; mutable int only = -1;
    __device__ __forceinline__ void operator()(AccRef acc, const pg8::Unit& u, int wr, int wc, int fr, int fq) const {
        fr = launder_v(fr); fq = launder_v(fq);
        const LAS float* rsl = rs + slot * 256; ++slot;
        bf16* ACT = (bf16*)(ws + WS_ACT); float* UPH = (float*)(ws + WS_UPH) + (size_t)u.pm * 4 * DFF2 + u.pn * 256;
#pragma unroll
        for (int ai = 0; ai < 2; ++ai) { const int band = ai * 2 + wr; const float r3 = rsl[ai * 128 + wr * 64 + 48 + fr], r0 = rsl[ai * 128 + wr * 64 + fr];
#pragma unroll
            for (int bj = 0; bj < 2; ++bj)
#pragma unroll
                for (int n = 0; n < 2; ++n) { const int ci = bj * 128 + wc * 32 + n * 16 + 4 * fq;
                    if (fr >= 14) { const f32x4 v = acc[ai][bj][3][n] * r3; *(LAS f32x4*)(halo + (band * 2 + (fr - 14)) * 256 + ci) = v;
                        if (band == 3) *(f32x4*)(UPH + (size_t)(2 + fr - 14) * DFF2 + ci) = v; }
                    if (band == 0 && fr < 2) *(f32x4*)(UPH + (size_t)fr * DFF2 + ci) = acc[0][bj][0][n] * r0; } }
        asm volatile("s_waitcnt lgkmcnt(0)" ::: "memory"); __builtin_amdgcn_s_barrier(); asm volatile("" ::: "memory");
        const int b = u.pm >> 4; const bool last_tile = (u.pm & 15) == 15, first_tile = (u.pm & 15) == 0;
#pragma unroll
        for (int n = 0; n < 2; ++n) {
            const int ci = wc * 32 + n * 16 + 4 * fq, lca = u.pn * 128 + ci;
            f32x4 w[2][3], bs[2];
#pragma unroll
            for (int bj = 0; bj < 2; ++bj) { bs[bj] = *(const f32x4*)(cb + bj * DFF + lca);
#pragma unroll
                for (int k = 0; k < 3; ++k) w[bj][k] = *(const f32x4*)(cw + k * DFF2 + bj * DFF + lca); }
#pragma unroll
            for (int ai = 0; ai < 2; ++ai) {
                const int band = ai * 2 + wr;
                f32x4 s[4][2];
#pragma unroll
                for (int m = 0; m < 4; ++m) { const float r = rsl[ai * 128 + wr * 64 + m * 16 + fr]; s[m][0] = acc[ai][0][m][n] * r; s[m][1] = acc[ai][1][m][n] * r; }
#pragma unroll
                for (int m = 0; m < 4; ++m) {
                    const int rl = ai * 128 + wr * 64 + m * 16 + fr, row = u.pm * 256 + rl;
                    f32x4 uc[2];
#pragma unroll
                    for (int bj = 0; bj < 2; ++bj) {
                        f32x4 p1, p2;
                        if (m > 0) {
#pragma unroll
                            for (int e = 0; e < 4; ++e) { const float cur_ = s[m][bj][e], prv_ = s[m - 1][bj][e];
                                p1[e] = dppf_old<0x111>(dppf<0x121>(prv_), cur_); p2[e] = dppf_old<0x112>(dppf<0x122>(prv_), cur_); }
                        } else {
                            f32x4 h0 = (f32x4){0.f, 0.f, 0.f, 0.f}, h1 = h0;
                            if (band > 0) { h0 = *(const LAS f32x4*)(halo + ((band - 1) * 2 + 0) * 256 + bj * 128 + ci); h1 = *(const LAS f32x4*)(halo + ((band - 1) * 2 + 1) * 256 + bj * 128 + ci); }
#pragma unroll
                            for (int e = 0; e < 4; ++e) { const float cur_ = s[0][bj][e], h0_ = h0[e], h1_ = h1[e];
                                p1[e] = dppf_old<0x111>(h1_, cur_); p2[e] = dppf_old<0x112>((fr == 0) ? h0_ : h1_, cur_); }
                        }
                        uc[bj] = bs[bj] + w[bj][0] * p2 + w[bj][1] * p1 + w[bj][2] * s[m][bj];
                    }
                    f32x4 a;
#pragma unroll
                    for (int e = 0; e < 4; ++e) a[e] = gelu_tanh(uc[0][e]) * uc[1][e];
                    if (first_tile || rl >= 2) *(u32x2*)(ACT + (size_t)row * DFF + lca) = pack4(a);
                    if (last_tile && rl >= 254) {
                        float* o = out + O_FFC_P + ((size_t)(L * NB + b) * 2 + (rl - 254)) * DFF2 + lca;
                        *(f32x4*)o = s[m][0]; *(f32x4*)(o + DFF) = s[m][1]; }
                }
            }
        }
    }
};
__device__ __forceinline__ void act_fixup(unsigned char* ws, const float* cw, const float* cb, int pm, int tid) {
    if ((pm & 15) == 0) return;
    const float* own = (const float*)(ws + WS_UPH) + (size_t)pm * 4 * DFF2; const float* prv = own - (size_t)4 * DFF2; bf16* ACT = (bf16*)(ws + WS_ACT) + (size_t)pm * 256 * DFF;
#pragma unroll
    for (int k = tid; k < DFF; k += 512) {
        const int pa = (k >> 7) * 256 + (k & 127);
        float uc0[2], uc1[2];
#pragma unroll
        for (int h = 0; h < 2; ++h) { const int p = pa + h * 128, lc = h * DFF + k;
            const float w0 = cw[lc], w1 = cw[DFF2 + lc], w2 = cw[2 * DFF2 + lc], bb = cb[lc];
            const float q2 = prv[2 * DFF2 + p], q3 = prv[3 * DFF2 + p], o0 = own[p], o1 = own[DFF2 + p];
            uc0[h] = bb + w0 * q2 + w1 * q3 + w2 * o0; uc1[h] = bb + w0 * q3 + w1 * o0 + w2 * o1; }
        ACT[k] = (bf16)f2bf(gelu_tanh(uc0[0]) * uc0[1]); ACT[DFF + k] = (bf16)f2bf(gelu_tanh(uc1[0]) * uc1[1]);
    }
}
__device__ __forceinline__ void thin_unit_up(LAS unsigned char* lds, const bf16* __restrict__ A, const bf16* __restrict__ Bt, int pg, unsigned char* ws, const LAS float* rs32, float* out,
                                             const float* cw, const float* cb, const float* st, int L) {
    int tid = threadIdx.x; asm volatile("" : "+v"(tid));
    const int wid = __builtin_amdgcn_readfirstlane(tid >> 6), lane = tid & 63, fr = lane & 15, fq = lane >> 4, K = 1024;
    const int pn = pg >> 3, cgi = pg & 7;
    f32x4 c[2][2];
#pragma unroll
    for (int i = 0; i < 2; ++i) { c[i][0] = (f32x4){0.f, 0.f, 0.f, 0.f}; c[i][1] = c[i][0]; }
    const bf16* ap = A + (size_t)(MP + fr) * K + fq * 8;
    const bf16* bp = Bt + (size_t)(pn * 256 + cgi * 16 + fr) * K + fq * 8;
#pragma unroll
    for (int ks = wid; ks < 32; ks += 8) {
        const bf16x8 a0 = *(const bf16x8*)(ap + ks * 32), a1 = *(const bf16x8*)(ap + (size_t)16 * K + ks * 32);
        const bf16x8 b0 = *(const bf16x8*)(bp + ks * 32), b1 = *(const bf16x8*)(bp + (size_t)128 * K + ks * 32);
        c[0][0] = __builtin_amdgcn_mfma_f32_16x16x32_bf16(b0, a0, c[0][0], 0, 0, 0); c[0][1] = __builtin_amdgcn_mfma_f32_16x16x32_bf16(b0, a1, c[0][1], 0, 0, 0);
        c[1][0] = __builtin_amdgcn_mfma_f32_16x16x32_bf16(b1, a0, c[1][0], 0, 0, 0); c[1][1] = __builtin_amdgcn_mfma_f32_16x16x32_bf16(b1, a1, c[1][1], 0, 0, 0);
    }
    LAS f32x4* red = (LAS f32x4*)lds;
#pragma unroll
    for (int i = 0; i < 2; ++i)
#pragma unroll
        for (int m = 0; m < 2; ++m) red[(wid * 4 + i * 2 + m) * 64 + lane] = c[i][m];
    __syncthreads();
    if (wid == 0) {
        const int lca = pn * 128 + cgi * 16 + 4 * fq;
#pragma unroll
        for (int m = 0; m < 2; ++m) { const int sb = m * 16 + fr; const float r = rs32[sb];
            f32x4 uc[2];
#pragma unroll
            for (int i = 0; i < 2; ++i) { f32x4 s = red[(i * 2 + m) * 64 + lane];
#pragma unroll
                for (int w = 1; w < 8; ++w) s += red[(w * 4 + i * 2 + m) * 64 + lane];
                s = s * r; const int lc = i * DFF + lca; const size_t so = ((size_t)(L * MS + sb) * 2) * DFF2 + lc;
                const f32x4 s0 = *(const f32x4*)(st + so), s1 = *(const f32x4*)(st + so + DFF2);
                uc[i] = *(const f32x4*)(cb + lc) + *(const f32x4*)(cw + lc) * s0 + *(const f32x4*)(cw + DFF2 + lc) * s1 + *(const f32x4*)(cw + 2 * DFF2 + lc) * s;
                *(f32x4*)(out + O_FFC_S + so) = s1; *(f32x4*)(out + O_FFC_S + so + DFF2) = s; }
            f32x4 a;
#pragma unroll
            for (int e = 0; e < 4; ++e) a[e] = gelu_tanh(uc[0][e]) * uc[1][e];
            *(u32x2*)((bf16*)(ws + WS_ACT) + (size_t)(MP + sb) * DFF + lca) = pack4(a); }
    }
    __syncthreads();
}
struct EpiGate {
    static constexpr bool PERM = false, AFTER_DRAIN = false;
    unsigned char* ws; const LAS float* rs; float* PSSn; size_t pinoff; size_t xin, xout; mutable int slot; mutable int only = -1;
    __device__ __forceinline__ float warm(int fr, int fq, int cg) const {
        const bf16* Xr = (const bf16*)(ws + xin); const bf16* PIN = (const bf16*)(ws + pinoff); const size_t o0 = (size_t)(MP + fr) * DM + cg * 16 + 4 * fq, o1 = o0 + (size_t)16 * DM;
        return (bf2f(Xr[o0]) + bf2f(Xr[o1])) + (bf2f(PIN[o0]) + bf2f(PIN[o1])); }
    __device__ __forceinline__ void thin(f32x4 s0, f32x4 s1, int cg, int fr, int fq) const {
        const LAS float* rsl = rs + 7 * 256;
        const bf16* Xr = (const bf16*)(ws + xin); bf16* XB = (bf16*)(ws + xout); const bf16* PIN = (const bf16*)(ws + pinoff);
        const int nx = (int)((PSSn - (float*)(ws + WS_PSS)) / (16 * MPAD));
#pragma unroll
        for (int m = 0; m < 2; ++m) { const size_t o = (size_t)(MP + 16 * m + fr) * DM + cg * 16 + 4 * fq; f32x4 v = (m ? s1 : s0) * rsl[16 * m + fr];
            const f32x4 pv = unpack4(*(const u32x2*)(PIN + o));
            v[0] = sigmoidf_(v[0]) * pv[0]; v[1] = sigmoidf_(v[1]) * pv[1]; v[2] = sigmoidf_(v[2]) * pv[2]; v[3] = sigmoidf_(v[3]) * pv[3];
            const u32x2 xw = pack4(unpack4(*(const u32x2*)(Xr + o)) + v); const f32x4 x = unpack4(xw);
            *(u32x2*)(XB + o) = xw;
            float ssq = (x[0] * x[0] + x[1] * x[1]) + (x[2] * x[2] + x[3] * x[3]);
            ssq += __shfl_xor(ssq, 16); ssq += __shfl_xor(ssq, 32);
            if (fq == 0) ((float*)(ws + WS_SPSS))[nx * 2048 + cg * 32 + 16 * m + fr] = ssq; }
    }
    __device__ __forceinline__ void operator()(AccRef acc, const pg8::Unit& u, int wr, int wc, int fr, int fq) const {
        fr = launder_v(fr); fq = launder_v(fq);
        const LAS float* rsl = rs + slot * 256; ++slot;
        const bf16* __restrict__ Xr = (const bf16*)(ws + xin); bf16* __restrict__ XB = (bf16*)(ws + xout); const bf16* __restrict__ PIN = (const bf16*)(ws + pinoff);
#pragma unroll
        for (int ai = 0; ai < 2; ++ai) {
#pragma unroll
          for (int mh = 0; mh < 2; ++mh) {
            u32x2 xv[4][2][2]; u32x2 pv[4][2][2];
#pragma unroll
            for (int m = 2 * mh; m < 2 * mh + 2; ++m) { const int row = u.pm * 256 + EPI_ROWL;
                EPI_FOR_COLS { const int col = u.pn * 256 + EPI_COLL; if (row < MTOT) { xv[m][bj][n] = *(const u32x2*)(Xr + (size_t)row * DM + col); pv[m][bj][n] = *(const u32x2*)(PIN + (size_t)row * DM + col); } } }
#pragma unroll
            for (int m = 2 * mh; m < 2 * mh + 2; ++m) { const int rl = EPI_ROWL, row = u.pm * 256 + rl; const float r = rsl[rl]; float ssq = 0.f;
                EPI_FOR_COLS { const int col = u.pn * 256 + EPI_COLL;
                    if (row < MTOT) { f32x4 v = acc[ai][bj][m][n] * r; const u32x2 pw = pv[m][bj][n];
                        v[0] = sigmoidf_(v[0]) * __builtin_bit_cast(float, pw.x << 16); v[1] = sigmoidf_(v[1]) * __builtin_bit_cast(float, pw.x & 0xffff0000u);
                        v[2] = sigmoidf_(v[2]) * __builtin_bit_cast(float, pw.y << 16); v[3] = sigmoidf_(v[3]) * __builtin_bit_cast(float, pw.y & 0xffff0000u);
                        const u32x2 xw = pack4(unpack4(xv[m][bj][n]) + v); const f32x4 x = unpack4(xw);
                        *(u32x2*)(XB + (size_t)row * DM + col) = xw;
                        ssq += (x[0] * x[0] + x[1] * x[1]) + (x[2] * x[2] + x[3] * x[3]); } }
                ssq += __shfl_xor(ssq, 16); ssq += __shfl_xor(ssq, 32);
                if (fq == 0) { if (row < MP) PSSn[(size_t)(u.pn * 4 + wc) * MPAD + row] = ssq;
                    else if (only >= 0 && row < MTOT) { const int nx = (int)((PSSn - (float*)(ws + WS_PSS)) / (16 * MPAD));
                        ((float*)(ws + WS_SPSS))[nx * 2048 + (u.pn * 16 + (only >> 1) * 8 + wc * 2 + (only & 1)) * 32 + (row - MP)] = ssq; } } }
          }
        }
    }
};
struct EpiPin {
    static constexpr bool PERM = false, AFTER_DRAIN = false;
    unsigned char* ws; mutable int Lthin = -1; mutable int only = -1;
    __device__ __forceinline__ void operator()(AccRef acc, const pg8::Unit& u, int wr, int wc, int fr, int fq) const {
        fr = launder_v(fr); fq = launder_v(fq);
        const int L = Lthin >= 0 ? Lthin : u.pn >> 2, pm = Lthin >= 0 ? u.pm : u.pm - L * NMT, pn = Lthin >= 0 ? u.pn : u.pn & 3;
        bf16* PIN = (bf16*)(ws + WS_PIN) + (size_t)L * MPAD * DM;
        EPI_FOR_ROWS { const int rl = EPI_ROWL, row = pm * 256 + rl;
            if (row < MTOT) EPI_FOR_COLS { const int col = pn * 256 + EPI_COLL; *(u32x2*)(PIN + (size_t)row * DM + col) = pack4(acc[ai][bj][m][n]); } }
    }
};
struct PinOrder {
    int start, stride, count, Lb;
    __device__ __forceinline__ bool next(int i, pg8::Unit& u) const { if (i >= count) return false; const int idx = start + i * stride; if (idx >= 512) return false; const int L = Lb + (idx >> 8), w = idx & 255; u.pm = L * NMT + (w >> 2); u.pn = L * 4 + (w & 3); return true; }
    __device__ __forceinline__ void a_ready(const pg8::Unit&) const {}
    __device__ __forceinline__ void done(const pg8::Unit&) const {}
};
struct EpiT {
    static constexpr bool PERM = false, AFTER_DRAIN = false;
    bf16* T; mutable int only = -1;
    __device__ __forceinline__ void operator()(AccRef acc, const pg8::Unit& u, int wr, int wc, int fr, int fq) const {
        fr = launder_v(fr); fq = launder_v(fq);
        bf16* Tt = T + (size_t)u.pm * 65536;
        EPI_FOR_ROWS { const int rl = EPI_ROWL;
            EPI_FOR_COLS { *(u32x2*)(Tt + rl * 256 + EPI_COLL) = pack4(acc[ai][bj][m][n]); } }
    }
};
__device__ __forceinline__ f32x4 rope4(f32x4 v, const float* rt  , int d0) {
    const f32x4 cs = *(const f32x4*)(rt + 2 * d0);
    f32x4 o; o[0] = v[0] * cs[0] - v[1] * cs[1]; o[1] = v[1] * cs[0] + v[0] * cs[1]; o[2] = v[2] * cs[2] - v[3] * cs[3]; o[3] = v[3] * cs[2] + v[2] * cs[3]; return o;
}
struct EpiQ {
    static constexpr bool PERM = false, AFTER_DRAIN = false;
    unsigned char* ws; const LAS float* rs; mutable int slot; mutable int only = -1;
    __device__ __forceinline__ void operator()(AccRef acc, const pg8::Unit& u, int wr, int wc, int fr, int fq) const {
        fr = launder_v(fr); fq = launder_v(fq);
        const LAS float* rsl = rs + slot * 256; ++slot;
        bf16* Q = (bf16*)(ws + WS_Q); bf16* QR = (bf16*)(ws + WS_QR); float* GT = (float*)(ws + WS_GT); const float* RT = (const float*)(ws + WS_ROPE);
        EPI_FOR_ROWS { const int rl = EPI_ROWL, row = u.pm * 256 + rl; const float r = rsl[rl];
            const float* rt = RT + (size_t)(row < MP ? (row & (SEQ - 1)) : SEQ) * 64;
            if (row < MTOT) EPI_FOR_COLS { const int col = u.pn * 256 + EPI_COLL;
                if (u.pn < 4) { const f32x4 v = acc[ai][bj][m][n] * (r * C2);
                    *(u32x2*)(Q + (size_t)row * DM + col) = pack4(v);
                    *(u32x2*)(QR + (size_t)row * DM + col) = pack4(rope4(v, rt, (col & 63) >> 1)); }
                else if (col < NQG) { f32x4 v = acc[ai][bj][m][n] * r;
                    v[0] = sigmoidf_(v[0]); v[1] = sigmoidf_(v[1]); v[2] = sigmoidf_(v[2]); v[3] = sigmoidf_(v[3]);
                    *(f32x4*)(GT + (size_t)row * 48 + (col - 1024)) = v; } } }
    }
};
struct EpiKV {
    static constexpr bool PERM = false, AFTER_DRAIN = false;
    float* out; unsigned char* ws; const LAS float* rs; mutable int slot; mutable int only = -1;
    __device__ __forceinline__ void operator()(AccRef acc, const pg8::Unit& u, int wr, int wc, int fr, int fq) const {
        fr = launder_v(fr); fq = launder_v(fq);
        const LAS float* rsl = rs + slot * 256; ++slot;
        bf16* CA = (bf16*)(ws + WS_CMPA); bf16* KS = (bf16*)(ws + WS_KS); bf16* VTS = (bf16*)(ws + WS_VTS); bf16* KW = (bf16*)(ws + WS_KW); bf16* VTW = (bf16*)(ws + WS_VTW); const float* RT = (const float*)(ws + WS_ROPE);
        EPI_FOR_ROWS { const int rl = EPI_ROWL, row = u.pm * 256 + rl; const float r = rsl[rl];
            if (row < MTOT) {
            const bool smp = row >= MP; const int b = row >> 12, t = row & (SEQ - 1), sb = row - MP;
            const float* rt = RT + (size_t)(smp ? SEQ : t) * 64;
            EPI_FOR_COLS { const int col = u.pn * 256 + EPI_COLL; const int j = col >> 7, g = (col >> 6) & 1, e0 = col & 63;
                f32x4 v = acc[ai][bj][m][n] * r;
                if (j < 2) {
                    if (!smp) { *(f32x4*)(out + O_CMP_P + (size_t)row * 256 + col) = v;
                        *(u32x2*)(CA + ((size_t)j * CMP_ROWS + (size_t)(g * NB + b) * 256 + (t >> 4)) * 1024 + (t & 15) * 64 + e0) = pack4(v); }
                    else *(f32x4*)(out + O_CMP_S + (size_t)sb * 256 + col) = v;
                } else if (j == 2 || j == 4) {
                    const int d0 = e0 >> 1; const f32x4 q = rope4(v, rt, d0);
                    const int lc = (j - 2) * 128 + g * 64;
                    float* orow = nullptr;
                    if (j == 2) orow = smp ? out + O_SLC_S + (size_t)sb * 256 : out + O_SLC_P + (size_t)row * 256;
                    else if (smp) orow = out + O_WIN_S + ((size_t)sb * 512 + 511) * 256;
                    else if (t >= SEQ - 512) orow = out + O_WIN_P + ((size_t)b * 512 + (t - (SEQ - 512))) * 256;
                    if (orow) { float* p = orow + (lc & 255) + d0; *(f32x2*)p = (f32x2){q[0], q[2]}; *(f32x2*)(p + 32) = (f32x2){q[1], q[3]}; }
                    if (!smp) *(u32x2*)((j == 2 ? KS : KW) + ((size_t)(b * NG + g) * SEQ + t) * 64 + e0) = pack4(q);
                } else {
                    const int lc = 128 + g * 64 + e0;
                    float* orow = nullptr;
                    if (j == 3) orow = smp ? out + O_SLC_S + (size_t)sb * 256 : out + O_SLC_P + (size_t)row * 256;
                    else if (smp) orow = out + O_WIN_S + ((size_t)sb * 512 + 511) * 256;
                    else if (t >= SEQ - 512) orow = out + O_WIN_P + ((size_t)b * 512 + (t - (SEQ - 512))) * 256;
                    if (orow) *(f32x4*)(orow + lc) = v;
                    if (!smp) { bf16* vt = (j == 3 ? VTS : VTW) + ((size_t)(b * NG + g) * 64 + e0) * SEQ + t;
                        vt[0] = (bf16)f2bf(v[0]); vt[SEQ] = (bf16)f2bf(v[1]); vt[2 * SEQ] = (bf16)f2bf(v[2]); vt[3 * SEQ] = (bf16)f2bf(v[3]); }
                } } } }
    }
};

struct CmpOrder {
    int G, c, lo, hi;
    __device__ __forceinline__ bool next(int i, pg8::Unit& u) const { const int L = lo + i * G + c; if (L >= hi) return false; u.pm = L; u.pn = L / (CMP_ROWS / 256); return true; }
    __device__ __forceinline__ void a_ready(const pg8::Unit&) const {}
    __device__ __forceinline__ void done(const pg8::Unit&) const {}
};

__device__ __forceinline__ float rcp_fast(float x) { return __builtin_amdgcn_rcpf(x); }
__device__ __forceinline__ float softplus_neg(float lam) { const float e = __expf(-lam); return e < 0.03f ? e * (1.0f - e * (0.5f - e * ((1.0f / 3.0f) - 0.25f * e))) : (lam < -20.f ? -lam : __logf(1.0f + e)); }
__device__ __forceinline__ float sigmoid_fast(float x) { return rcp_fast(1.0f + __expf(-x)); }
__device__ __forceinline__ int rg2_unit(int bid, int G, int k) {
    constexpr int NU = 257 * 16;
    if (G != 256) { const int un = bid + k * G; return un < NU ? un : -1; }
    if (bid < 16) return k < 14 ? bid + 256 * k : (k == 14 ? 4096 + bid : -1);
    if (bid < 48) return k < 16 ? bid + 256 * k : (k == 16 ? (bid & 15) + 256 * (14 + ((bid >> 4) - 1)) : -1);
    return k < 16 ? bid + 256 * k : -1;
}
__device__ __forceinline__ void rg2_phase(KP P, LAS unsigned char* lds, int L, int tid, int lane, int wave, int G) {
    unsigned char* ws = P->ws;
    const bf16* XR = (const bf16*)(ws + WS_XR); bf16* HL = (bf16*)(ws + WS_HL); bf16* AC = (bf16*)(ws + WS_AC);
    const bf16* WG = (const bf16*)(ws + WS_WGA) + (size_t)L * 2 * 16 * 80 * 96;
    const float* cw = (const float*)P->in[16] + (size_t)L * 4 * DRNN; const float* cb = (const float*)P->in[17] + (size_t)L * DRNN;
    const float* b_a = (const float*)P->in[19] + (size_t)L * DRNN; const float* b_x = (const float*)P->in[21] + (size_t)L * DRNN; const float* lam = (const float*)P->in[22] + (size_t)L * DRNN;
    const float* st_c = (const float*)P->in[7] + (size_t)L * MS * 3 * DRNN; const float* st_h = (const float*)P->in[8] + (size_t)L * MS * DRNN;
    LAS bf16* wab = (LAS bf16*)(lds);
    LAS float* xrt = (LAS float*)(lds + 33280);
    LAS float* xcf = (LAS float*)(lds + 54720);
    LAS bf16* xcb = (LAS bf16*)(lds + 75200);
    LAS float* af = (LAS float*)(lds + 88512);
    LAS float* uf = (LAS float*)(lds + 108992);
    LAS float* agg = (LAS float*)(lds + 129472);
    LAS float* cws = (LAS float*)(lds + 132032);
    const int NU = 257 * 16, bid = launder_s(blockIdx.x);
    int cur_n = -1; bool have_pf = false; u32x2 pf[3];
    for (int uk = 0, un = rg2_unit(bid, G, 0); un >= 0; ++uk, un = rg2_unit(bid, G, uk)) {
        const int tl = un >> 4, n = un & 15, c0 = n * RGB; const bool smp = (tl == 256);
        const int m0 = tl * 64, t0 = m0 & (SEQ - 1), b = m0 >> 12;
        if (n != cur_n) {
            cur_n = n;
            for (int i = tid; i < 2 * 80 * 12; i += 512) { const int ck = i % 12, rw = i / 12; const int ax = rw / 80, j = rw % 80;
                *(LAS u32x4*)(wab + (size_t)rw * 104 + ck * 8) = *(const u32x4*)(WG + ((size_t)(ax * 16 + n) * 80 + j) * 96 + ck * 8); }
            for (int i = tid; i < 8 * 80; i += 512) { const int k = i / 80, c = i % 80, ch = c0 + c;
                cws[i] = (k < 4) ? cw[k * DRNN + ch] : (k == 4) ? cb[ch] : (k == 5) ? b_a[ch] : (k == 6) ? b_x[ch] : softplus_neg(lam[ch]); }
            for (int i = tid; i < 64 * 24; i += 512) xcb[(i / 24) * 104 + 80 + (i % 24)] = 0;
        }
        if (!smp) {
            if (!have_pf) {
#pragma unroll
                for (int k = 0; k < 3; ++k) { const int i = tid + 512 * k, r = i / 20, q = i % 20; pf[k] = (u32x2){0u, 0u};
                    if (i < 67 * 20 && t0 + r - 3 >= 0) pf[k] = *(const u32x2*)(XR + (size_t)(m0 + r - 3) * DRNN + c0 + 4 * q); } }
#pragma unroll
            for (int k = 0; k < 3; ++k) { const int i = tid + 512 * k, r = i / 20, q = i % 20; if (i < 67 * 20) *(LAS f32x4*)(xrt + r * 80 + 4 * q) = unpack4(pf[k]); }
            { const int un2 = rg2_unit(bid, G, uk + 1); have_pf = false;
              if (un2 >= 0 && (un2 >> 4) != 256) { const int m2 = (un2 >> 4) * 64, t2 = m2 & (SEQ - 1), c2 = (un2 & 15) * RGB; have_pf = true;
#pragma unroll
                for (int k = 0; k < 3; ++k) { const int i = tid + 512 * k, r = i / 20, q = i % 20; pf[k] = (u32x2){0u, 0u};
                    if (i < 67 * 20 && t2 + r - 3 >= 0) pf[k] = *(const u32x2*)(XR + (size_t)(m2 + r - 3) * DRNN + c2 + 4 * q); } } }
            __syncthreads();
            for (int rep_ = 0; rep_ < 1 + 4 * ((PROBE_DUP >> 23) & 1); ++rep_)
#pragma unroll
            for (int i = 0; i < 10; ++i) { const int e = tid + 512 * i, r = e / 80, c = e % 80;
                const float xc = cws[320 + c] + cws[c] * xrt[r * 80 + c] + cws[80 + c] * xrt[(r + 1) * 80 + c] + cws[160 + c] * xrt[(r + 2) * 80 + c] + cws[240 + c] * xrt[(r + 3) * 80 + c];
                xcf[e] = xc; xcb[r * 104 + c] = (bf16)f2bf(xc); }
        } else {
            __syncthreads();
            for (int e = tid; e < 64 * 80; e += 512) { const int r = e / 80, c = e % 80, ch = c0 + c; float xc = 0.f;
                if (r < MS) { xc = cws[320 + c] + cws[240 + c] * bf2f(XR[(size_t)(MP + r) * DRNN + ch]);
#pragma unroll
                    for (int k = 0; k < 3; ++k) xc += cws[k * 80 + c] * st_c[((size_t)r * 3 + k) * DRNN + ch]; }
                xcf[e] = xc; xcb[r * 104 + c] = (bf16)f2bf(xc); }
        }
        __syncthreads();
        for (int rep3_ = 0; rep3_ < 1 + 4 * ((PROBE_DUP >> 24) & 1); ++rep3_)
        { const int mt = wave & 3, jt0 = (wave >> 2) ? 3 : 0, jt1 = (wave >> 2) ? 5 : 3, fr = lane & 15, fq = lane >> 4;
            for (int jt = jt0; jt < jt1; ++jt) {
                f32x4 accA = (f32x4){0.f, 0.f, 0.f, 0.f}, accX = accA;
#pragma unroll
                for (int ks = 0; ks < 3; ++ks) {
                    const bf16x8 a = *(const LAS bf16x8*)(xcb + (size_t)(16 * mt + fr) * 104 + 32 * ks + 8 * fq);
                    const bf16x8 ba = *(const LAS bf16x8*)(wab + (size_t)(16 * jt + fr) * 104 + 32 * ks + 8 * fq);
                    const bf16x8 bx = *(const LAS bf16x8*)(wab + (size_t)(80 + 16 * jt + fr) * 104 + 32 * ks + 8 * fq);
                    accA = __builtin_amdgcn_mfma_f32_16x16x32_bf16(a, ba, accA, 0, 0, 0);
                    accX = __builtin_amdgcn_mfma_f32_16x16x32_bf16(a, bx, accX, 0, 0, 0);
                }
                const int c = 16 * jt + fr, ch = c0 + c;
                const float ba_ = cws[400 + c], bx_ = cws[480 + c], sp = cws[560 + c];
#pragma unroll
                for (int e = 0; e < 4; ++e) { const int r = 16 * mt + 4 * fq + e;
                    const float rg = sigmoid_fast(accA[e] + ba_), ig = sigmoid_fast(accX[e] + bx_);
                    const float la = -8.0f * rg * sp, a = __expf(la), x2 = 2.0f * la;
                    const float em = x2 * (1.0f + x2 * 0.5f * (1.0f + x2 * (1.0f / 3.0f) * (1.0f + x2 * 0.25f * (1.0f + x2 * 0.2f))));
                    float mult = __builtin_amdgcn_sqrtf(-em); if (!smp && t0 + r == 0) mult = 1.0f;
                    const float u = mult * (ig * xcf[r * 80 + c]);
                    if (!smp) { af[r * 80 + c] = a; uf[r * 80 + c] = u; }
                    else if (r < MS) { HL[(size_t)(MP + r) * DRNN + ch] = (bf16)f2bf(a * st_h[(size_t)r * DRNN + ch] + u); AC[(size_t)(MP + r) * DRNN + ch] = 0; } }
            } }
        __syncthreads();
        for (int rep4_ = 0; rep4_ < 1 + 4 * ((PROBE_DUP >> 25) & 1); ++rep4_)
        if (!smp) {
            const int ch = tid % 80, seg = tid / 80; float hs[16], ps[16];
            if (tid < 320) { float h = 0.f, p = 1.f;
#pragma unroll
                for (int r = 0; r < 16; ++r) { const float a = af[(seg * 16 + r) * 80 + ch], u = uf[(seg * 16 + r) * 80 + ch]; h = a * h + u; p *= a; hs[r] = h; ps[r] = p; }
                agg[(seg * 80 + ch) * 2] = p; agg[(seg * 80 + ch) * 2 + 1] = h; }
            __syncthreads();
            if (tid < 320) { float cy = 0.f, pc = 1.f;
                for (int s = 0; s < seg; ++s) { const float pp = agg[(s * 80 + ch) * 2], hh = agg[(s * 80 + ch) * 2 + 1]; cy = pp * cy + hh; pc *= pp; }
                bf16* hp = HL + (size_t)(m0 + seg * 16) * DRNN + c0 + ch; bf16* ap = AC + (size_t)(m0 + seg * 16) * DRNN + c0 + ch;
#pragma unroll
                for (int r = 0; r < 16; ++r) { hp[(size_t)r * DRNN] = (bf16)f2bf(hs[r] + ps[r] * cy); ap[(size_t)r * DRNN] = (bf16)f2bf(ps[r] * pc); } }
            else if (t0 == SEQ - 64 && tid >= 320 && tid < 320 + 80) { const int c = tid - 320;
#pragma unroll
                for (int k = 0; k < 3; ++k) P->out[O_RGC_P + ((size_t)(L * NB + b) * 3 + k) * DRNN + c0 + c] = xrt[(64 + k) * 80 + c]; }
        }
        __syncthreads();
    }
}
__device__ __forceinline__ void rg3_phase(KP P, LAS unsigned char* lds, int L, int tid, int G) {
    unsigned char* ws = P->ws;
    const bf16* HL = (const bf16*)(ws + WS_HL); const bf16* AC = (const bf16*)(ws + WS_AC); const bf16* Y = (const bf16*)(ws + WS_Y); bf16* Gb = (bf16*)(ws + WS_G);
    LAS float* cmb = (LAS float*)lds;
    const int oc = tid % 160, grp = tid / 160, c = oc * 8; const bool act = grp < 3;
    const f32x4 one4 = (f32x4){1.f, 1.f, 1.f, 1.f}, zero4 = (f32x4){0.f, 0.f, 0.f, 0.f};
    {
        const float* st_c = (const float*)P->in[7] + (size_t)L * MS * 3 * DRNN; const bf16* XR = (const bf16*)(ws + WS_XR);
        for (int e = launder_s(blockIdx.x) * 512 + tid; e < MS * 3 * DRNN; e += G * 512) { const int sb = e / (3 * DRNN), k = (e / DRNN) % 3, ch = e % DRNN;
            P->out[O_RGC_S + ((size_t)(L * MS + sb) * 3 + k) * DRNN + ch] = (k < 2) ? st_c[((size_t)sb * 3 + k + 1) * DRNN + ch] : bf2f(XR[(size_t)(MP + sb) * DRNN + ch]); }
    }
    for (int tl = launder_s(blockIdx.x); tl < 257; tl += G) {
        const bool smp = (tl == 256); const int m0 = tl * 64, b = m0 >> 12, kc = smp ? 0 : ((m0 & (SEQ - 1)) >> 6);
        if (act) {
            f32x4 cy0 = zero4, cy1 = zero4, ap0 = one4, ap1 = one4;
            const int lo = grp * kc / 3, hi = (grp + 1) * kc / 3;
            for (int kk = lo; kk < hi; kk += 4) {
                u32x4 aw[4], hw[4];
#pragma unroll
                for (int q = 0; q < 4; ++q) { aw[q] = (u32x4){0x3f803f80u, 0x3f803f80u, 0x3f803f80u, 0x3f803f80u}; hw[q] = (u32x4){0u, 0u, 0u, 0u};
                    if (kk + q < hi) { const size_t mr = (size_t)(b * SEQ + (kk + q) * 64 + 63) * DRNN + c; aw[q] = *(const u32x4*)(AC + mr); hw[q] = *(const u32x4*)(HL + mr); } }
#pragma unroll
                for (int q = 0; q < 4; ++q) { f32x4 a0, a1, h0, h1; unpack8(aw[q], a0, a1); unpack8(hw[q], h0, h1); cy0 = a0 * cy0 + h0; cy1 = a1 * cy1 + h1; ap0 *= a0; ap1 *= a1; }
            }
            *(LAS f32x4*)(cmb + (grp * 2 + 0) * 1280 + c) = ap0; *(LAS f32x4*)(cmb + (grp * 2 + 0) * 1280 + c + 4) = ap1;
            *(LAS f32x4*)(cmb + (grp * 2 + 1) * 1280 + c) = cy0; *(LAS f32x4*)(cmb + (grp * 2 + 1) * 1280 + c + 4) = cy1;
        }
        __syncthreads();
        if (act) {
            f32x4 cy0 = zero4, cy1 = zero4;
#pragma unroll
            for (int g2 = 0; g2 < 3; ++g2) {
                const f32x4 A0 = *(const LAS f32x4*)(cmb + (g2 * 2 + 0) * 1280 + c), A1 = *(const LAS f32x4*)(cmb + (g2 * 2 + 0) * 1280 + c + 4);
                const f32x4 H0 = *(const LAS f32x4*)(cmb + (g2 * 2 + 1) * 1280 + c), H1 = *(const LAS f32x4*)(cmb + (g2 * 2 + 1) * 1280 + c + 4);
                cy0 = A0 * cy0 + H0; cy1 = A1 * cy1 + H1; }
            const int nr = smp ? MS : 64;
            for (int r0 = grp; r0 < nr; r0 += 12) {
                u32x4 hlw[4], acw[4], yw[4];
#pragma unroll
                for (int q = 0; q < 4; ++q) { const int r = r0 + 3 * q; hlw[q] = (u32x4){0u, 0u, 0u, 0u}; acw[q] = hlw[q]; yw[q] = hlw[q];
                    if (r < nr) { const size_t mr = (size_t)(m0 + r) * DRNN + c; hlw[q] = *(const u32x4*)(HL + mr); acw[q] = *(const u32x4*)(AC + mr); yw[q] = *(const u32x4*)(Y + mr); } }
#pragma unroll
                for (int q = 0; q < 4; ++q) { const int r = r0 + 3 * q;
                    if (r < nr) { const size_t mr = (size_t)(m0 + r) * DRNN + c;
                        f32x4 hl0, hl1, ac0, ac1; unpack8(hlw[q], hl0, hl1); unpack8(acw[q], ac0, ac1);
                        const f32x4 h0 = hl0 + ac0 * cy0, h1 = hl1 + ac1 * cy1; u32x4 o;
                        o.x = pk2(__builtin_bit_cast(float, yw[q].x << 16) * h0[0], __builtin_bit_cast(float, yw[q].x & 0xffff0000u) * h0[1]);
                        o.y = pk2(__builtin_bit_cast(float, yw[q].y << 16) * h0[2], __builtin_bit_cast(float, yw[q].y & 0xffff0000u) * h0[3]);
                        o.z = pk2(__builtin_bit_cast(float, yw[q].z << 16) * h1[0], __builtin_bit_cast(float, yw[q].z & 0xffff0000u) * h1[1]);
                        o.w = pk2(__builtin_bit_cast(float, yw[q].w << 16) * h1[2], __builtin_bit_cast(float, yw[q].w & 0xffff0000u) * h1[3]);
                        *(u32x4*)(Gb + mr) = o;
                        if (smp) { float* op = P->out + O_RGH_S + (size_t)(L * MS + r) * DRNN + c; *(f32x4*)op = h0; *(f32x4*)(op + 4) = h1; }
                        else if (kc == 63 && r == 63) { float* op = P->out + O_RGH_P + (size_t)(L * NB + b) * DRNN + c; *(f32x4*)op = h0; *(f32x4*)(op + 4) = h1; } } }
            }
        }
        __syncthreads();
    }
}
__device__ __forceinline__ void cmp2_phase(KP P, LAS unsigned char* lds, int tid, int lane, int wave, int G) {
    unsigned char* ws = P->ws;
    const bf16* T = (const bf16*)(ws + WS_T); const float* B1P = (const float*)(ws + WS_B1F); const float* b1 = (const float*)P->in[28]; const float* w2 = (const float*)P->in[29];
    bf16* KC = (bf16*)(ws + WS_KC); bf16* VCT = (bf16*)(ws + WS_VCT); float* KCS = (float*)(ws + WS_KCS); float* VCS = (float*)(ws + WS_VCS);
    LAS bf16* w2b = (LAS bf16*)lds;
    LAS float* b1s = (LAS float*)(lds + 34816);
    LAS bf16* hidb = (LAS bf16*)(lds + 35840);
    for (int i = tid; i < 2 * 128 * 64; i += 512) { const int d = i & 63, e = (i >> 6) & 127, j = i >> 13; w2b[(j * 64 + d) * 136 + e] = (bf16)f2bf(w2[i]); }
    if (tid < 256) { float s = b1[tid];
        for (int l = 0; l < 32; ++l) s += B1P[l * 256 + tid];
        b1s[tid] = s; }
    __syncthreads();
    const int NU = 2 * CMP_ROWS / 64;
    const int mt = wave & 3, nh = wave >> 2, fr = lane & 15, fq = lane >> 4;
    for (int un = launder_s(blockIdx.x); un < NU; un += G) {
        const int slot0 = un * 64, j = slot0 / CMP_ROWS, row0 = slot0 % CMP_ROWS;
#pragma unroll
        for (int q = 0; q < 4; ++q) { const int idx = tid + 512 * q, r = idx >> 5, e4 = (idx & 31) * 4; const int row = row0 + r;
            const bool smp = row >= CMP_ROWS_P; const int cb = smp ? ((row - CMP_ROWS_P) & 511) : (row & 255); const bool valid = cb < (smp ? NCB_S : NCB_P);
            f32x4 h = (f32x4){0.f, 0.f, 0.f, 0.f};
            if (valid) { const f32x4 a = unpack4(*(const u32x2*)(T + (size_t)(slot0 + r) * 256 + e4)), bq = unpack4(*(const u32x2*)(T + (size_t)(slot0 + r + 1) * 256 + 128 + e4)), bb = *(const LAS f32x4*)(b1s + j * 128 + e4);
#pragma unroll
                for (int k = 0; k < 4; ++k) h[k] = gelu_tanh(a[k] + bq[k] + bb[k]); }
            *(LAS u32x2*)(hidb + r * 136 + e4) = (u32x2){pk2(h[0], h[1]), pk2(h[2], h[3])}; }
        __syncthreads();
        f32x4 acc[2];
#pragma unroll
        for (int n = 0; n < 2; ++n) { acc[n] = (f32x4){0.f, 0.f, 0.f, 0.f};
#pragma unroll
            for (int ks = 0; ks < 4; ++ks) { const bf16x8 a = *(const LAS bf16x8*)(hidb + (16 * mt + fr) * 136 + 32 * ks + 8 * fq);
                const bf16x8 b = *(const LAS bf16x8*)(w2b + (j * 64 + 16 * (2 * nh + n) + fr) * 136 + 32 * ks + 8 * fq);
                acc[n] = __builtin_amdgcn_mfma_f32_16x16x32_bf16(a, b, acc[n], 0, 0, 0); } }
#pragma unroll
        for (int n = 0; n < 2; ++n) { const int d = 16 * (2 * nh + n) + fr;
#pragma unroll
            for (int e = 0; e < 4; ++e) { const int row = row0 + 16 * mt + 4 * fq + e; const float o = acc[n][e];
                if (row < CMP_ROWS_P) { const int g = row >> 10, bb = (row >> 8) & 3, cb = row & 255;
                    if (j == 0) KC[((size_t)(bb * NG + g) * 256 + cb) * 64 + 2 * (d & 31) + (d >> 5)] = (bf16)f2bf(o);
                    else VCT[((size_t)(bb * NG + g) * 64 + d) * 256 + cb] = (bf16)f2bf(o); }
                else { const int rr = row - CMP_ROWS_P, g = rr >> 14, sb = (rr >> 9) & 31, cb = rr & 511;
                    (j == 0 ? KCS : VCS)[((size_t)(sb * NG + g) * 512 + cb) * 64 + d] = o; } } }
        __syncthreads();
    }
}
__device__ __forceinline__ void final_phase(KP P, const float* PSScur, const float* SPcur, int lane, int wave, int G) {
    const bf16* X = (const bf16*)(P->ws + xb_off(4)); const float* gf = (const float*)P->in[14];
    f32x4 gg[4];
#pragma unroll
    for (int jj = 0; jj < 4; ++jj) gg[jj] = *(const f32x4*)(gf + 4 * lane + 256 * jj);
    const int NGW = G * 8;
    for (int m0 = launder_s(blockIdx.x) * 8 + wave; m0 < MTOT; m0 += 2 * NGW) {
        float sp[2]; u32x2 xv[2][4];
#pragma unroll
        for (int q = 0; q < 2; ++q) { const int m = m0 + q * NGW; sp[q] = 0.f;
            if (m < MTOT) {
                if (m < MP) { if (lane < 16) sp[q] = PSScur[(size_t)lane * MPAD + m]; } else sp[q] = SPcur[lane * 32 + (m - MP)];
#pragma unroll
                for (int jj = 0; jj < 4; ++jj) xv[q][jj] = *(const u32x2*)(X + (size_t)m * DM + 4 * lane + 256 * jj); } }
#pragma unroll
        for (int q = 0; q < 2; ++q) { const int m = m0 + q * NGW;
            if (m < MTOT) {
                const float rs = rsqrtf(wave_sum(sp[q]) * (1.0f / 1024.0f) + EPS);
                float* o = m < MP ? P->out + O_Y_P + (size_t)m * DM : P->out + O_Y_S + (size_t)(m - MP) * DM;
#pragma unroll
                for (int jj = 0; jj < 4; ++jj) { const int c = 4 * lane + 256 * jj; __builtin_nontemporal_store(unpack4(xv[q][jj]) * rs * gg[jj], (f32x4*)(o + c)); } } }
    }
}

constexpr int AT_KT = 0, AT_KTB = 18432, AT_VT = 36864, AT_VTB = 17408, AT_QS = 71680, AT_LS = 79872, AT_MASK = 88064, AT_QF = 88320, AT_STASH = 121088;
constexpr int AT_ROWB = 144, AT_VROWB = 272;
__device__ __forceinline__ unsigned cvtpk(float lo, float hi) { return pk2(lo, hi); }

template <int MODE>
__device__ __forceinline__ void attn_pass(LAS unsigned char* lds, const bf16* __restrict__ Kg, const bf16* __restrict__ Vtg, int vstride, int tb, int te, const LAS unsigned char* qfl,
                                          int klo, int khi, unsigned long long selmask, float& m_run, float& l_run, f32x16& o0, f32x16& o1, float inv_l, int tokrow, int tid, int lane) {
    if (te <= tb) return;
    const int r32 = lane & 31, hi = lane >> 5, lrow = tid >> 3, lch = tid & 7;
    const unsigned kofs = (unsigned)(lrow * AT_ROWB + lch * 16), vofs = (unsigned)(lrow * AT_VROWB + lch * 16);
    const bf16* kp = Kg + (size_t)lrow * 64 + lch * 8; const bf16* vp = Vtg + (size_t)lrow * vstride + lch * 8;
    u32x4 kreg0 = *(const u32x4*)(kp + (size_t)tb * 8192), kreg1 = *(const u32x4*)(kp + (size_t)tb * 8192 + 4096);
    u32x4 vreg0 = (u32x4){0u, 0u, 0u, 0u}, vreg1 = vreg0;
    if (MODE != 0) { vreg0 = *(const u32x4*)(vp + tb * 128); vreg1 = *(const u32x4*)(vp + tb * 128 + 64); }
    *(LAS u32x4*)(lds + AT_KT + kofs) = kreg0; *(LAS u32x4*)(lds + AT_KT + 64 * AT_ROWB + kofs) = kreg1;
    if (MODE != 0) { *(LAS u32x4*)(lds + AT_VT + vofs) = vreg0; *(LAS u32x4*)(lds + AT_VT + 128 + vofs) = vreg1; }
    __syncthreads();
    for (int t = tb; t < te; ++t) {
        const int buf = (t - tb) & 1, key0 = t * 128;
        if (t + 1 < te) { kreg0 = *(const u32x4*)(kp + (size_t)(t + 1) * 8192); kreg1 = *(const u32x4*)(kp + (size_t)(t + 1) * 8192 + 4096);
            if (MODE != 0) { vreg0 = *(const u32x4*)(vp + (t + 1) * 128); vreg1 = *(const u32x4*)(vp + (t + 1) * 128 + 64); } }
        const bool selA = (MODE == 2) ? ((selmask >> (2 * t)) & 1ull) != 0ull : true, selB = (MODE == 2) ? ((selmask >> (2 * t + 1)) & 1ull) != 0ull : true;
        const bool anyA = selA && (key0 <= khi) && (key0 + 63 >= klo), anyB = selB && (key0 + 64 <= khi) && (key0 + 127 >= klo);
        if (__builtin_amdgcn_ballot_w64(anyA || anyB) != 0ull) {
            const LAS unsigned char* Kb = lds + AT_KT + buf * AT_KTB; const LAS unsigned char* Vb = lds + AT_VT + buf * AT_VTB;
            const bool fullA = selA && (key0 >= klo) && (key0 + 63 <= khi), fullB = selB && (key0 + 64 >= klo) && (key0 + 127 <= khi);
            const bool partial = __builtin_amdgcn_ballot_w64((anyA && !fullA) || (anyB && !fullB)) != 0ull;
            const float base = (m_run == -INFINITY) ? 0.f : -m_run;
            const float ciA = (MODE >= 2) ? ((fullA || (partial && anyA)) ? base : -INFINITY) : 0.f, ciB = (MODE >= 2) ? ((fullB || (partial && anyB)) ? base : -INFINITY) : 0.f;
            f32x16 p[4];
#pragma unroll
            for (int r = 0; r < 16; ++r) { p[0][r] = ciA; p[1][r] = ciA; p[2][r] = ciB; p[3][r] = ciB; }
            __builtin_amdgcn_s_setprio(1);
#pragma unroll
            for (int c = 0; c < 4; ++c)
#pragma unroll
                for (int i = 0; i < 4; ++i) { const bf16x8 a = *(const LAS bf16x8*)(Kb + (32 * i + r32) * AT_ROWB + c * 32 + hi * 16);
                    p[i] = __builtin_amdgcn_mfma_f32_32x32x16_bf16(a, *(const LAS bf16x8*)(qfl + c * 1024), p[i], 0, 0, 0);
                    if (i == 3 && (c & 1)) __builtin_amdgcn_sched_barrier(0); }
            __builtin_amdgcn_s_setprio(0);
            float mx = -INFINITY;
            if (!partial && MODE >= 2) {
#pragma unroll
                for (int r = 0; r < 16; ++r) mx = fmaxf(fmaxf(mx, fmaxf(p[0][r], p[1][r])), fmaxf(p[2][r], p[3][r]));
            } else {
#pragma unroll
                for (int i = 0; i < 4; ++i) { const bool sl = (i < 2) ? selA : selB; const int kb0 = key0 + 32 * i + 4 * hi;
#pragma unroll
                    for (int r = 0; r < 16; ++r) { const int k = kb0 + (r & 3) + 8 * (r >> 2); p[i][r] = (sl && k >= klo && k <= khi) ? p[i][r] : -INFINITY; mx = fmaxf(mx, p[i][r]); } }
            }
            float ls = 0.f;
            if (MODE >= 2) {
                mx = fmaxf(mx, __shfl_xor(mx, 32));
                const bool moved = (m_run == -INFINITY) ? (mx != -INFINITY) : (mx > 0.f);
                if (__builtin_amdgcn_ballot_w64(moved) != 0ull) {
                    const float delta = moved ? mx : 0.f;
                    const float alpha = (m_run == -INFINITY) ? 1.f : __builtin_amdgcn_exp2f(-delta);
                    m_run = moved ? ((m_run == -INFINITY) ? mx : m_run + mx) : m_run;
                    l_run *= alpha;
#pragma unroll
                    for (int r = 0; r < 16; ++r) { o0[r] *= alpha; o1[r] *= alpha; p[0][r] -= delta; p[1][r] -= delta; p[2][r] -= delta; p[3][r] -= delta; }
                }
#pragma unroll
                for (int i = 0; i < 4; ++i)
#pragma unroll
                    for (int r = 0; r < 16; ++r) { p[i][r] = __builtin_amdgcn_exp2f(p[i][r]); ls += p[i][r]; }
            } else {
                float m_use;
                if (MODE == 1) { m_use = (m_run == -INFINITY) ? 0.f : m_run; }
                else {
                    mx = fmaxf(mx, __shfl_xor(mx, 32));
                    const float m_new = fmaxf(m_run, mx); m_use = (m_new == -INFINITY) ? 0.f : m_new;
                    const float alpha = __builtin_amdgcn_exp2f(m_run - m_use);
                    l_run *= alpha; m_run = m_new;
                }
#pragma unroll
                for (int i = 0; i < 4; ++i)
#pragma unroll
                    for (int r = 0; r < 16; ++r) { p[i][r] = __builtin_amdgcn_exp2f(p[i][r] - m_use); ls += p[i][r]; }
            }
            if (MODE != 1) l_run += ls;
            if (MODE == 1) {
                LAS float* QS = (LAS float*)(lds + AT_QS); LAS float* LS = (LAS float*)(lds + AT_LS);
#pragma unroll
                for (int i = 0; i < 4; ++i) {
#pragma unroll
                    for (int r = 0; r < 16; ++r) p[i][r] *= inv_l;
#pragma unroll
                    for (int jq = 0; jq < 4; ++jq) {
                        float q0 = (p[i][4 * jq] + p[i][4 * jq + 1]) + (p[i][4 * jq + 2] + p[i][4 * jq + 3]), l0 = p[i][4 * jq + 3];
#pragma unroll
                        for (int o = 1; o < 8; o <<= 1) { q0 += __shfl_xor(q0, o); l0 += __shfl_xor(l0, o); }
                        if ((lane & 7) == 0) { const int qd = 32 * t + 8 * i + 2 * jq + hi; QS[tokrow * 64 + qd] = q0; LS[tokrow * 64 + qd] = l0; }
                    }
                }
            }
            if (MODE != 0) {
#pragma unroll
                for (int j = 0; j < 8; ++j) {
                    const int i = j >> 1, rb = 8 * (j & 1);
                    u32x4 pw; pw.x = cvtpk(p[i][rb], p[i][rb + 1]); pw.y = cvtpk(p[i][rb + 2], p[i][rb + 3]); pw.z = cvtpk(p[i][rb + 4], p[i][rb + 5]); pw.w = cvtpk(p[i][rb + 6], p[i][rb + 7]);
                    const bf16x8 pb = __builtin_bit_cast(bf16x8, pw);
                    { const LAS unsigned char* vq = Vb + r32 * AT_VROWB + (16 * j + 4 * hi) * 2;
                      const u32x2 lo = *(const LAS u32x2*)vq, hh = *(const LAS u32x2*)(vq + 16);
                      o0 = __builtin_amdgcn_mfma_f32_32x32x16_bf16(__builtin_bit_cast(bf16x8, (u32x4){lo.x, lo.y, hh.x, hh.y}), pb, o0, 0, 0, 0); }
                    { const LAS unsigned char* vq = Vb + (32 + r32) * AT_VROWB + (16 * j + 4 * hi) * 2;
                      const u32x2 lo = *(const LAS u32x2*)vq, hh = *(const LAS u32x2*)(vq + 16);
                      o1 = __builtin_amdgcn_mfma_f32_32x32x16_bf16(__builtin_bit_cast(bf16x8, (u32x4){lo.x, lo.y, hh.x, hh.y}), pb, o1, 0, 0, 0); }
                    if (j & 1) __builtin_amdgcn_sched_barrier(0);
                }
            }
        }
        if (t + 1 < te) { LAS unsigned char* kd = lds + AT_KT + (buf ^ 1) * AT_KTB; *(LAS u32x4*)(kd + kofs) = kreg0; *(LAS u32x4*)(kd + 64 * AT_ROWB + kofs) = kreg1;
            if (MODE != 0) { LAS unsigned char* vd = lds + AT_VT + (buf ^ 1) * AT_VTB; *(LAS u32x4*)(vd + vofs) = vreg0; *(LAS u32x4*)(vd + 128 + vofs) = vreg1; } }
        __syncthreads();
    }
}

__device__ __forceinline__ void attn_prompt_unit(KP P, LAS unsigned char* lds, int b, int g, int t0, int tid, int lane, int wave) {
    unsigned char* ws = P->ws;
    const bf16* Q = (const bf16*)(ws + WS_Q); const bf16* QR = (const bf16*)(ws + WS_QR); const float* GT = (const float*)(ws + WS_GT); bf16* O = (bf16*)(ws + WS_O);
    const int bg = b * NG + g;
    const bf16* KS = (const bf16*)(ws + WS_KS) + (size_t)bg * SEQ * 64; const bf16* VTS = (const bf16*)(ws + WS_VTS) + (size_t)bg * 64 * SEQ;
    const bf16* KW = (const bf16*)(ws + WS_KW) + (size_t)bg * SEQ * 64; const bf16* VTW = (const bf16*)(ws + WS_VTW) + (size_t)bg * 64 * SEQ;
    const bf16* KC = (const bf16*)(ws + WS_KC) + (size_t)bg * 256 * 64; const bf16* VCT = (const bf16*)(ws + WS_VCT) + (size_t)bg * 64 * 256;
    const int r32 = lane & 31, hi = lane >> 5, tok_l = r32 >> 3, hl = r32 & 7, tokrow = wave * 4 + tok_l;
    const int t = t0 + tokrow, mrow = b * SEQ + t, h = g * HPG + hl;
    LAS float* QSb = (LAS float*)(lds + AT_QS); LAS float* LSb = (LAS float*)(lds + AT_LS); LAS unsigned long long* MK = (LAS unsigned long long*)(lds + AT_MASK);
    for (int i = tid; i < 32 * 64; i += 512) { QSb[i] = 0.f; LSb[i] = 0.f; }
    LAS unsigned char* qfl = lds + AT_QF + wave * 4096 + lane * 16;
#pragma unroll
    for (int c = 0; c < 4; ++c) *(LAS bf16x8*)(qfl + c * 1024) = *(const bf16x8*)(Q + (size_t)mrow * DM + h * 64 + c * 16 + hi * 8);
    __syncthreads();
    f32x16 o0, o1;
#pragma unroll
    for (int r = 0; r < 16; ++r) { o0[r] = 0.f; o1[r] = 0.f; }
    LAS unsigned* stash = (LAS unsigned*)(lds + AT_STASH) + wave * 1024 + lane;
    const int cmax = (t >= 31) ? ((t - 31) >> 4) : -1;
    const int ntc = (t0 >> 11) + 1;
    {
        float mc = -INFINITY, lc = 0.f;
        attn_pass<0>(lds, KC, VCT, 256, 0, ntc, qfl, 0, cmax, 0ull, mc, lc, o0, o1, 0.f, tokrow, tid, lane);
        lc += __shfl_xor(lc, 32);
        const float invl = lc > 0.f ? 1.0f / lc : 0.f;
        attn_pass<1>(lds, KC, VCT, 256, 0, ntc, qfl, 0, cmax, 0ull, mc, lc, o0, o1, invl, tokrow, tid, lane);
        const float g0 = GT[(size_t)mrow * 48 + h * 3 + 0];
#pragma unroll
        for (int r = 0; r < 16; ++r) { stash[r * 64] = pk2(g0 * o0[r], g0 * o1[r]); o0[r] = 0.f; o1[r] = 0.f; }
    }
    asm volatile("s_waitcnt lgkmcnt(0)" ::: "memory");
    unsigned long long mymask = 0ull;
    {
        const int cur_w = (t0 + wave * 4) >> 6;
#pragma unroll
        for (int tk = 0; tk < 4; ++tk) {
            const int tr = wave * 4 + tk, s = lane;
            float v = QSb[tr * 64 + s] + (s > 0 ? LSb[tr * 64 + s - 1] : 0.f);
            if (s == 0 || s == cur_w || s + 1 == cur_w) v = INFINITY;
            if (s > cur_w) v = -INFINITY;
            int rank = 0;
            for (int i = 0; i < 64; ++i) { const float x = __builtin_bit_cast(float, __builtin_amdgcn_readlane(__builtin_bit_cast(int, v), i)); rank += (x > v || (x == v && i < s)) ? 1 : 0; }
            const unsigned long long mk = __builtin_amdgcn_ballot_w64(rank < 16);
            if (tok_l == tk) mymask = mk;
        }
    }
    (void)MK;
#pragma unroll
    for (int c = 0; c < 4; ++c) *(LAS bf16x8*)(qfl + c * 1024) = *(const bf16x8*)(QR + (size_t)mrow * DM + h * 64 + c * 16 + hi * 8);
    const int cur = t0 >> 6;
    {
        float ms = -INFINITY, lsum = 0.f;
        attn_pass<2>(lds, KS, VTS, SEQ, 0, (cur >> 1) + 1, qfl, 0, t, mymask, ms, lsum, o0, o1, 0.f, tokrow, tid, lane);
        lsum += __shfl_xor(lsum, 32);
        const float sc = GT[(size_t)mrow * 48 + h * 3 + 1] / lsum;
#pragma unroll
        for (int r = 0; r < 16; ++r) { const unsigned w = stash[r * 64]; stash[r * 64] = pk2(__builtin_bit_cast(float, w << 16) + sc * o0[r], __builtin_bit_cast(float, w & 0xffff0000u) + sc * o1[r]); o0[r] = 0.f; o1[r] = 0.f; }
    }
    f32x16 out0, out1;
    {
        float mw = -INFINITY, lw = 0.f;
        const int wlo = (t0 - 511) > 0 ? (t0 - 511) >> 7 : 0;
        attn_pass<3>(lds, KW, VTW, SEQ, wlo, (cur >> 1) + 1, qfl, t - 511, t, 0ull, mw, lw, o0, o1, 0.f, tokrow, tid, lane);
        lw += __shfl_xor(lw, 32);
        const float sc = GT[(size_t)mrow * 48 + h * 3 + 2] / lw;
#pragma unroll
        for (int r = 0; r < 16; ++r) { const unsigned w = stash[r * 64]; out0[r] = __builtin_bit_cast(float, w << 16) + sc * o0[r]; out1[r] = __builtin_bit_cast(float, w & 0xffff0000u) + sc * o1[r]; }
    }
    bf16* op = O + (size_t)mrow * DM + h * 64 + 4 * hi;
#pragma unroll
    for (int jq = 0; jq < 4; ++jq) {
        u32x2 w0; w0.x = cvtpk(out0[4 * jq], out0[4 * jq + 1]); w0.y = cvtpk(out0[4 * jq + 2], out0[4 * jq + 3]); *(u32x2*)(op + 8 * jq) = w0;
        u32x2 w1; w1.x = cvtpk(out1[4 * jq], out1[4 * jq + 1]); w1.y = cvtpk(out1[4 * jq + 2], out1[4 * jq + 3]); *(u32x2*)(op + 32 + 8 * jq) = w1;
    }
}

constexpr int SM_QN = 0, SM_QR = 2048, SM_SC = 4096, SM_IMP = 36864, SM_SEL = 37888, SM_PTR = 38144, SM_OP = 46336;
__device__ __forceinline__ void smp_scores(const float* __restrict__ kp, const LAS float* q, LAS float* sc, int col, bool valid) {
    float s[8];
#pragma unroll
    for (int hl = 0; hl < 8; ++hl) s[hl] = 0.f;
    if (valid) {
#pragma unroll 4
        for (int d4 = 0; d4 < 16; ++d4) { const f32x4 kv = *(const f32x4*)(kp + 4 * d4);
#pragma unroll
            for (int hl = 0; hl < 8; ++hl) { const f32x4 qv = *(const LAS f32x4*)(q + hl * 64 + 4 * d4); s[hl] += (kv[0] * qv[0] + kv[1] * qv[1]) + (kv[2] * qv[2] + kv[3] * qv[3]); } }
    }
#pragma unroll
    for (int hl = 0; hl < 8; ++hl) sc[hl * 1024 + col] = valid ? s[hl] : -INFINITY;
}
__device__ __forceinline__ void smp_softmax(LAS float* sc, int n, int lane, int wave) {
    LAS float* row = sc + wave * 1024; float mx = -INFINITY;
    for (int i = lane; i < n; i += 64) mx = fmaxf(mx, row[i]);
#pragma unroll
    for (int o = 1; o < 64; o <<= 1) mx = fmaxf(mx, __shfl_xor(mx, o));
    float sum = 0.f;
    for (int i = lane; i < n; i += 64) { const float e = __builtin_amdgcn_exp2f(row[i] - mx); row[i] = e; sum += e; }
    sum = wave_sum(sum); const float inv = 1.0f / sum;
    for (int i = lane; i < n; i += 64) row[i] *= inv;
}
template <bool PTR> __device__ __forceinline__ void smp_pv(const LAS float* sc, const LAS unsigned long long* rp, const float* __restrict__ vbase, int n, LAS float* opart, int tid) {
    const int sl = tid >> 4, dq = tid & 15;
    f32x4 acc[8];
#pragma unroll
    for (int q = 0; q < 8; ++q) acc[q] = (f32x4){0.f, 0.f, 0.f, 0.f};
#pragma unroll 4
    for (int kk = sl; kk < n; kk += 32) {
        f32x4 v = (f32x4){0.f, 0.f, 0.f, 0.f};
        if (PTR) { const float* kp = (const float*)(uintptr_t)rp[kk]; if (kp) v = *(const f32x4*)(kp + 128 + 4 * dq); }
        else v = *(const f32x4*)(vbase + (size_t)kk * 64 + 4 * dq);
#pragma unroll
        for (int q = 0; q < 8; ++q) acc[q] += sc[q * 1024 + kk] * v;
    }
#pragma unroll
    for (int q = 0; q < 8; ++q) *(LAS f32x4*)(opart + (sl * 8 + q) * 64 + 4 * dq) = acc[q];
}
__device__ __forceinline__ float smp_pv_reduce(const LAS float* opart, int hl, int d) {
    float s = 0.f;
#pragma unroll 8
    for (int k = 0; k < 32; ++k) s += opart[(k * 8 + hl) * 64 + d];
    return s;
}
__device__ __forceinline__ void attn_sample_unit(KP P, LAS unsigned char* lds, int sb, int g, int tid, int lane, int wave) {
    unsigned char* ws = P->ws;
    const bf16* Q = (const bf16*)(ws + WS_Q); const bf16* QR = (const bf16*)(ws + WS_QR); const float* GT = (const float*)(ws + WS_GT); bf16* O = (bf16*)(ws + WS_O);
    const float* KCS = (const float*)(ws + WS_KCS) + (size_t)(sb * NG + g) * 512 * 64; const float* VCS = (const float*)(ws + WS_VCS) + (size_t)(sb * NG + g) * 512 * 64;
    const float* cslc = (const float*)P->in[5]; const float* cwin = (const float*)P->in[6]; const int* pt = (const int*)P->in[10] + sb * NPG;
    LAS float* qn = (LAS float*)(lds + SM_QN); LAS float* qr = (LAS float*)(lds + SM_QR); LAS float* sc = (LAS float*)(lds + SM_SC); LAS float* imp = (LAS float*)(lds + SM_IMP);
    LAS int* sel = (LAS int*)(lds + SM_SEL); LAS unsigned long long* rp = (LAS unsigned long long*)(lds + SM_PTR); LAS float* opart = (LAS float*)(lds + SM_OP);
    const int mrow = MP + sb, hl = tid >> 6, d = tid & 63, h = g * HPG + hl;
    { const int e = 2 * (d & 31) + (d >> 5);
      qn[hl * 64 + d] = bf2f(Q[(size_t)mrow * DM + h * 64 + e]); qr[hl * 64 + d] = bf2f(QR[(size_t)mrow * DM + h * 64 + e]); }
    __syncthreads();
    smp_scores(KCS + (size_t)tid * 64, qn, sc, tid, tid < NCB_S);
    __syncthreads();
    smp_softmax(sc, 512, lane, wave);
    __syncthreads();
    smp_pv<false>(sc, rp, VCS, NCB_S, opart, tid);
    if (tid < NSB_S) { float v = 0.f; const int c0 = tid * 4 - 1;
        for (int c = (c0 < 0 ? 0 : c0); c <= c0 + 4 && c < NCB_S; ++c)
#pragma unroll
            for (int q = 0; q < 8; ++q) v += sc[q * 1024 + c];
        if (tid == 0 || tid == 127 || tid == 128) v = INFINITY;
        imp[tid] = v; }
    __syncthreads();
    const float oc = smp_pv_reduce(opart, hl, d);
    if (tid < NSB_S) { const float v = imp[tid]; int rank = 0;
        for (int i = 0; i < NSB_S; ++i) { const float x = imp[i]; rank += (x > v || (x == v && i < tid)) ? 1 : 0; }
        if (rank < 16) sel[rank] = tid; }
    __syncthreads();
#pragma unroll
    for (int q = 0; q < 2; ++q) { const int kk = tid + 512 * q, blk = sel[kk >> 6], pos = blk * 64 + (kk & 63);
        const float* kp = nullptr;
        if (pos < PAST) kp = cslc + ((size_t)pt[pos >> 7] * PGSZ + (pos & 127)) * 256 + g * 64;
        else if (pos == PAST) kp = P->out + O_SLC_S + (size_t)sb * 256 + g * 64;
        rp[kk] = (unsigned long long)(uintptr_t)kp;
        smp_scores(kp, qr, sc, kk, kp != nullptr); }
    __syncthreads();
    smp_softmax(sc, 1024, lane, wave);
    __syncthreads();
    smp_pv<true>(sc, rp, nullptr, 1024, opart, tid);
    __syncthreads();
    const float os = smp_pv_reduce(opart, hl, d);
    __syncthreads();
    { const float* kp = (tid < 511) ? cwin + ((size_t)sb * 512 + tid + 1) * 256 + g * 64 : P->out + O_WIN_S + ((size_t)sb * 512 + 511) * 256 + g * 64;
      rp[tid] = (unsigned long long)(uintptr_t)kp;
      smp_scores(kp, qr, sc, tid, true); }
    __syncthreads();
    smp_softmax(sc, 512, lane, wave);
    __syncthreads();
    smp_pv<true>(sc, rp, nullptr, 512, opart, tid);
    __syncthreads();
    const float ow = smp_pv_reduce(opart, hl, d);
    const float g0 = GT[(size_t)mrow * 48 + h * 3 + 0], g1 = GT[(size_t)mrow * 48 + h * 3 + 1], g2 = GT[(size_t)mrow * 48 + h * 3 + 2];
    O[(size_t)mrow * DM + h * 64 + d] = (bf16)f2bf(g0 * oc + g1 * os + g2 * ow);
    __syncthreads();
}

__device__ __forceinline__ void attn_phase(KP P, LAS unsigned char* lds, int qidx, int tid, int lane, int wave, int G) {
    unsigned* head = (unsigned*)(P->ws + WS_CTL) + 4096 + 64 * qidx;
    volatile LAS int* slot = (volatile LAS int*)(lds + LDS_MISC + 64);
    for (;;) {
        if (tid == 0) slot[0] = (int)__hip_atomic_fetch_add(head, 1u, __ATOMIC_RELAXED, __HIP_MEMORY_SCOPE_AGENT);
        __syncthreads();
        const int un = slot[0];
        __syncthreads();
        if (un >= 64 + 1024) break;
        if (un < 64) attn_sample_unit(P, lds, un >> 1, un & 1, tid, lane, wave);
        else { const int k = un - 64, bg = k & 7, tb = 127 - (k >> 3);
            attn_prompt_unit(P, lds, bg >> 1, bg & 1, tb * 32, tid, lane, wave); }
        __syncthreads();
    }
}

constexpr int NPHASES = 30;
#define DUPK(k) for (int dup_ = 0; dup_ < 1 + ((PROBE_DUP >> (k)) & 1); ++dup_)
#ifndef MK_MULTI
#define MK_MULTI 0
#endif
__global__ void __launch_bounds__(512, 2) mega(Params Pv) {
    extern __shared__ __attribute__((aligned(16))) unsigned char lds_raw[];
    LAS unsigned char* lds = (LAS unsigned char*)lds_raw;

    const KP Pk = (KP)__builtin_amdgcn_kernarg_segment_ptr();
    LAS float* rsb = (LAS float*)(lds + LDS_RS);
    int ph = 0, cur = 0;
    bool thin_slack_ = true;
    if (Pk->ph_hi - Pk->ph_lo > 1) {
        if (blockIdx.x == 0) { unsigned* ctl = (unsigned*)(Pk->ws + WS_CTL); for (int i = threadIdx.x; i < 8192; i += 512) ctl[i] = 0u; }
        if (threadIdx.x < 16) ((volatile LAS unsigned*)(lds + LDS_MISC))[threadIdx.x] = 0u;
        __syncthreads();
    }
#define RUN (ph >= Pk->ph_lo && ph < Pk->ph_hi)
#define FRESH const int tid = launder_v(threadIdx.x), lane = tid & 63, wave = __builtin_amdgcn_readfirstlane(tid >> 6), G = launder_s(gridDim.x), bid = launder_s(blockIdx.x); (void)lane; (void)wave; (void)bid
#define GRID_BAR do { if (ph == 0) { seam0_barrier(); (void)xcd_barrier_post((unsigned*)(Pk->ws + WS_CTL), (volatile LAS unsigned*)(lds + LDS_MISC) + 8); } else { XcdBarrier b_; b_.bar = (unsigned*)(launder(Pk)->ws + WS_CTL); b_.x = xb_xcc_id(); b_.st = (volatile LAS unsigned*)(lds + LDS_MISC) + 8; xcd_barrier(b_); } } while (0)
#define END_PHASE do { if (RUN && ph + 1 < Pk->ph_hi) { GRID_BAR; if ((PROBE_DUP >> 20) & 1) { if (ph > 0) GRID_BAR; } } ++ph; } while (0)
#define PSS_OF(ws_, c_) ((float*)((ws_) + WS_PSS) + (size_t)(c_) * 16 * MPAD)
#define GEMM_RS(EpiT_, AOFF, BOFF, N_, NTHIN_, K_, ...) GEMM_RS_B(0, EpiT_, AOFF, BOFF, N_, NTHIN_, K_, __VA_ARGS__)
#define GEMM_RS_B(REV_, EpiT_, AOFF, BOFF, N_, NTHIN_, K_, ...) do { const int tid = launder_v(threadIdx.x), G = launder_s(gridDim.x), bid = (REV_) ? G - 1 - launder_s(blockIdx.x) : launder_s(blockIdx.x); const KP P = launder(Pk); unsigned char* ws = P->ws; \
        pg8::Gemm g_{(const bf16*)(ws + (AOFF)), (const bf16*)(ws + (BOFF)), MP, (N_), (K_)}; pg8::StaticOrder S_; S_.init(MP, (N_), G, bid); \
        const int tcg_ = G - 1 - bid; const bool thin_ = tcg_ < (NTHIN_); \
        rs_prepare(S_, PSS_OF(ws, cur), (const float*)(ws + WS_SPSS) + cur * 2048, rsb, tid, thin_); EpiT_ E_{__VA_ARGS__}; \
          \
          \
        { const int tstr_ = (thin_slack_ && (NTHIN_) > G / 2 && (NTHIN_) < G && ((N_) / 256) * (MP / 256) % G == G / 2) ? G / 2 : G; \
          if (tcg_ < tstr_) for (int cg_ = tcg_; cg_ < (NTHIN_); cg_ += tstr_) { E_.slot = 7; thin_unit<(K_)>(lds, g_.A, g_.Bt, cg_, E_); } } E_.slot = 0; \
        pg8::gemm_phase<EpiT_, pg8::StaticOrder, true, true>(lds, g_, S_, E_); } while (0)
#define GEMM_RES(KIND, AOFF, BOFF, K_, SOFF) DUPK(KIND) { FRESH; const KP P = launder(Pk); unsigned char* ws = P->ws; \
        pg8::Gemm g_{(const bf16*)(ws + (AOFF)), (const bf16*)(ws + (BOFF)), MP, 1024, (K_)}; pg8::StaticOrder S_; S_.init(MP, 1024, G, bid); \
        EpiRes E_{ws, PSS_OF(ws, cur ^ 1), (SOFF), dup_ ? 0.0f : 1.0f, xb_off(L)}; \
        const int tcg_ = G - 1 - bid; if (tcg_ < 64) thin_unit<(K_)>(lds, g_.A, g_.Bt, tcg_, E_); \
        pg8::gemm_phase<EpiRes, pg8::StaticOrder, true, true>(lds, g_, S_, E_); }

    if (RUN) DUPK(0) { FRESH; phase0(launder(Pk), lds, tid, lane, wave, G); }
    END_PHASE;

#pragma unroll
    for (int L = 0; L < 4; ++L) {
        if (L < 2) {
            thin_slack_ = (L == 0);
            if (RUN) { GEMM_RS(EpiRG1, xb_off(L), WS_WIN + (size_t)L * 2560 * 1024 * 2, 2560, 160, 1024, ws, rsb, 0);
                if (L == 0) { FRESH; const KP P = launder(Pk); unsigned char* ws = P->ws; const int Gh = G >> 1;
                  pg8::Gemm g_{(const bf16*)(ws + WS_PB), (const bf16*)(ws + WS_WPI), 4 * MPAD, 4096, 256}; EpiPin E_{ws};
                  { PinOrder S_; S_.Lb = 0; S_.stride = 1;
                    if (G == 256) { if (bid < 128) { S_.start = bid; S_.count = 1; } else { S_.start = 128 + (bid - 128) * 3; S_.count = 3; } }
                    else { const int per = (512 + G - 1) / G; S_.start = bid * per; S_.count = per; }
                    pg8::gemm_phase<EpiPin, PinOrder, true, true>(lds, g_, S_, E_); }
                  if (bid < Gh) for (int q_ = bid; q_ < 128; q_ += Gh) { const int L_ = (q_ >> 6), cg_ = q_ & 63; E_.Lthin = L_; thin_unit<256>(lds, g_.A + (size_t)L_ * MPAD * 256, g_.Bt + (size_t)L_ * 1024 * 256, cg_, E_); } }
                if (L == 1) { FRESH; const KP P = launder(Pk); unsigned char* ws = P->ws;
                  if (G == 256 && bid >= 128) { constexpr int NCU_ = 2 * (CMP_ROWS / 256);
                    pg8::Gemm g_{(const bf16*)(ws + WS_CMPA), (const bf16*)(ws + WS_WC1), 2 * CMP_ROWS, 256, 1024}; CmpOrder S_{G, bid - 128, NCU_ - 128, NCU_}; EpiT E_{(bf16*)(ws + WS_T)};
                    pg8::gemm_phase<EpiT, CmpOrder, true, true>(lds, g_, S_, E_); } } }
            END_PHASE;
            if (RUN) DUPK(2) { FRESH; rg2_phase(launder(Pk), lds, L, tid, lane, wave, G); }
            END_PHASE;
            if (RUN) DUPK(3) { FRESH; rg3_phase(launder(Pk), lds, L, tid, G); }
            END_PHASE;
            if (RUN) GEMM_RES(13, WS_G, WS_WOUT + (size_t)L * 1024 * 1280 * 2, 1280, (size_t)0);
            END_PHASE; cur ^= 1;
        } else {
            const int j = L - 2;
            if (L == 2) {
                if (RUN) { GEMM_RS(EpiKV, xb_off(L), WS_WKV, NKV, 48, 1024, P->out, ws, rsb, 0);
                    GEMM_RS_B(1, EpiQ, xb_off(L), WS_WQG, NQGP, 67, 1024, ws, rsb, 0); }
                END_PHASE;
                if (RUN) DUPK(8) { FRESH; const KP P = launder(Pk); unsigned char* ws = P->ws;
                    constexpr int NCU_ = 2 * (CMP_ROWS / 256), NSV_ = 128;
                    const bool early_ = (G == 256);
                    pg8::Gemm g_{(const bf16*)(ws + WS_CMPA), (const bf16*)(ws + WS_WC1), 2 * CMP_ROWS, 256, 1024}; CmpOrder S_{G, bid, 0, early_ ? NCU_ - NSV_ : NCU_}; EpiT E_{(bf16*)(ws + WS_T)};
                    pg8::gemm_phase<EpiT, CmpOrder, true, true>(lds, g_, S_, E_);
                    { const int nb2 = 2 * (CMP_ROWS / 256) - G, nf = G - (nb2 > 0 ? nb2 : 0);
                      pg8::Gemm gp_{(const bf16*)(ws + WS_PB), (const bf16*)(ws + WS_WPI), 4 * MPAD, 4096, 256}; EpiPin Ep_{ws};
                      if (early_) {
                          PinOrder Sp_; Sp_.Lb = 2; Sp_.start = 0; Sp_.stride = 1; Sp_.count = 0;
                          if (bid >= NCU_ - NSV_) { Sp_.start = bid - (NCU_ - NSV_); Sp_.stride = G - (NCU_ - NSV_); Sp_.count = 4; }
                          else if (bid < 512 - 4 * (G - (NCU_ - NSV_))) { Sp_.start = 4 * (G - (NCU_ - NSV_)) + bid; Sp_.count = 1; }
                          pg8::gemm_phase<EpiPin, PinOrder, true, true>(lds, gp_, Sp_, Ep_); }
                      else if (nf > 0 && bid >= G - nf) { PinOrder Sp_; Sp_.Lb = 2; Sp_.start = bid - (G - nf); Sp_.stride = nf; Sp_.count = (512 + nf - 1) / nf;
                          pg8::gemm_phase<EpiPin, PinOrder, true, true>(lds, gp_, Sp_, Ep_); }
                      else if (nf <= 0) { PinOrder Sp_; Sp_.Lb = 2; Sp_.start = bid; Sp_.stride = G; Sp_.count = (512 + G - 1) / G; pg8::gemm_phase<EpiPin, PinOrder, true, true>(lds, gp_, Sp_, Ep_); }
                      for (int q_ = bid; q_ < 128; q_ += G) { const int L_ = 2 + (q_ >> 6), cg_ = q_ & 63; Ep_.Lthin = L_; thin_unit<256>(lds, gp_.A + (size_t)L_ * MPAD * 256, gp_.Bt + (size_t)L_ * 1024 * 256, cg_, Ep_); } } }
                END_PHASE;
                if (RUN) DUPK(9) { FRESH; cmp2_phase(launder(Pk), lds, tid, lane, wave, G); }
                END_PHASE;
            }
            if (L == 3) { if (RUN) DUPK(10) GEMM_RS(EpiQ, xb_off(L), WS_WQG + (size_t)j * NQGP * 1024 * 2, NQGP, 67, 1024, ws, rsb, 0);
            END_PHASE; }
            if (RUN) DUPK(11) { FRESH; attn_phase(launder(Pk), lds, j + 2 * dup_, tid, lane, wave, G); }
            END_PHASE;
            if (RUN) GEMM_RES(16, WS_O, WS_WO + (size_t)j * 1024 * 1024 * 2, 1024, (size_t)0);
            END_PHASE; cur ^= 1;
        }
        if (RUN) DUPK(4) { FRESH; const KP P = launder(Pk); unsigned char* ws = P->ws;
            pg8::Gemm g_{(const bf16*)(ws + xb_off(L)), (const bf16*)(ws + WS_WUP + (size_t)L * 6144 * 1024 * 2), MP, DFF2, 1024}; pg8::StaticOrder S_; S_.init(MP, DFF2, G, bid);
            const int tpg_ = G - 1 - bid; const bool thin_ = tpg_ < 192;
            rs_prepare(S_, PSS_OF(ws, cur), (const float*)(ws + WS_SPSS) + cur * 2048, rsb, tid, thin_);
            const float* cw_ = (const float*)P->in[33] + (size_t)L * 3 * DFF2; const float* cb_ = (const float*)P->in[34] + (size_t)L * DFF2;
            EpiUp E_{ws, rsb, P->out, cw_, cb_, (LAS float*)(lds + LDS_HALO), L, 0};
            if (thin_) thin_unit_up(lds, g_.A, g_.Bt, tpg_, ws, rsb + 7 * 256, P->out, cw_, cb_, (const float*)P->in[9], L);
            pg8::gemm_phase<EpiUp, pg8::StaticOrder, true, true>(lds, g_, S_, E_); }
        END_PHASE;
        if (RUN) DUPK(14) { FRESH; const KP P = launder(Pk); unsigned char* ws = P->ws;
            pg8::Gemm g_{(const bf16*)(ws + WS_ACT), (const bf16*)(ws + WS_WDN + (size_t)L * 1024 * 3072 * 2), MP, 1024, 3072}; pg8::StaticOrder S_; S_.init(MP, 1024, G, bid);
            { pg8::Unit u_; for (int i_ = 0; S_.next(i_, u_); ++i_) act_fixup(ws, (const float*)P->in[33] + (size_t)L * 3 * DFF2, (const float*)P->in[34] + (size_t)L * DFF2, u_.pm, tid); }
            asm volatile("s_waitcnt vmcnt(0)" ::: "memory"); __syncthreads();
            EpiRes E_{ws, PSS_OF(ws, cur ^ 1), (size_t)0, dup_ ? 0.0f : 1.0f, xb_off(L)};
            const int tcg_ = G - 1 - bid; if (tcg_ < 64) thin_unit<3072>(lds, g_.A, g_.Bt, tcg_, E_);
            pg8::gemm_phase<EpiRes, pg8::StaticOrder, true, true>(lds, g_, S_, E_); }
        END_PHASE; cur ^= 1;
        if (RUN) GEMM_RS(EpiGate, xb_off(L), WS_WPG + (size_t)L * 1024 * 1024 * 2, 1024, 64, 1024, ws, rsb, PSS_OF(ws, cur ^ 1), WS_PIN + (size_t)L * MPAD * DM * 2, xb_off(L), xb_off(L + 1), 0);
        END_PHASE; cur ^= 1;
    }
    if (RUN) DUPK(12) { FRESH; const KP P = launder(Pk); final_phase(P, PSS_OF(P->ws, cur), (const float*)(P->ws + WS_SPSS) + cur * 2048, lane, wave, G); }
    END_PHASE;
}

extern "C" void kernel_launch(void* const* d_in, const int* in_sizes, int n_in, void* d_out, int out_size, void* d_ws, size_t ws_size, hipStream_t stream) {
    static int grid = 0;
    if (grid == 0) {
        if (n_in != 38 || (size_t)out_size != O_END || ws_size < WS_END) { fprintf(stderr, "kernel_launch: unexpected problem: n_in %d out %d ws %zu (need %zu)\n", n_in, out_size, ws_size, (size_t)WS_END); grid = -1; return; }
        int dev = 0, cus = 0, per_cu = 0;
        (void)hipGetDevice(&dev); (void)hipDeviceGetAttribute(&cus, hipDeviceAttributeMultiprocessorCount, dev);
        if (hipFuncSetAttribute((const void*)mega, hipFuncAttributeMaxDynamicSharedMemorySize, LDS_BYTES) != hipSuccess) { fprintf(stderr, "kernel_launch: hipFuncSetAttribute failed\n"); grid = -1; return; }
        if (hipOccupancyMaxActiveBlocksPerMultiprocessor(&per_cu, (const void*)mega, 512, LDS_BYTES) != hipSuccess || per_cu < 1) { fprintf(stderr, "kernel_launch: occupancy query says %d\n", per_cu); per_cu = 1; }
        (void)hipGetLastError();
        grid = cus;
        if (grid > 256) grid = 256;
    }
    if (grid < 0) return;
    Params p{};
    for (int i = 0; i < 38; ++i) p.in[i] = d_in[i];
    p.out = (float*)d_out; p.ws = (unsigned char*)d_ws;
#if MK_MULTI
    for (int ph = 0; ph < NPHASES; ++ph) { p.ph_lo = ph; p.ph_hi = ph + 1; hipLaunchKernelGGL(mega, dim3(grid), dim3(512), LDS_BYTES, stream, p); }
#else
    p.ph_lo = 0; p.ph_hi = NPHASES;
    void* args[] = {&p};
    hipError_t e = hipLaunchCooperativeKernel((const void*)mega, dim3(grid), dim3(512), args, LDS_BYTES, stream);
    if (e != hipSuccess) fprintf(stderr, "kernel_launch: cooperative launch failed: %s (grid %d)\n", hipGetErrorString(e), grid);
#endif
}
```

```cpp
#include <hip/hip_runtime.h>
#include <hip/hip_cooperative_groups.h>
#include <cstdio>
#include <cstdint>
#include <cmath>
namespace cg = cooperative_groups;
#ifndef PROBE_DUP
#define PROBE_DUP 0
#endif


#define LAS __attribute__((address_space(3)))
#define GAS __attribute__((address_space(1)))
typedef unsigned short bf16;
typedef short bf16x8 __attribute__((ext_vector_type(8)));
typedef float f32x4 __attribute__((ext_vector_type(4)));
typedef float f32x2 __attribute__((ext_vector_type(2)));
typedef float f32x16 __attribute__((ext_vector_type(16)));
typedef unsigned u32x4 __attribute__((ext_vector_type(4)));
typedef unsigned u32x2 __attribute__((ext_vector_type(2)));

constexpr int DM = 1024, SEQ = 4096, NB = 4, MP = NB * SEQ, MS = 32, MTOT = MP + MS, MPAD = 16640, NMT = MPAD / 256;
constexpr int DRNN = 1280, DFF = 3072, DFF2 = 6144, DPLE = 256, NRGB = 16, RGB = 80;
constexpr int PAST = 8192, NPG = 64, PGSZ = 128, HD = 64, NH = 16, NG = 2, HPG = 8;
constexpr int NCB_P = 255, NCB_S = 511, NSB_S = 129;
constexpr int NQG = 1072, NQGP = 1280, NKV = 768;
constexpr float EPS = 1e-6f;
constexpr float C2 = 0.125f * 1.4426950408889634f;
constexpr int CMP_ROWS_P = NG * NB * 256, CMP_ROWS_S = NG * MS * 512, CMP_ROWS = CMP_ROWS_P + CMP_ROWS_S;

constexpr size_t O_Y_P = 0;
constexpr size_t O_Y_S = O_Y_P + (size_t)MP * DM;
constexpr size_t O_CMP_P = O_Y_S + (size_t)MS * DM;
constexpr size_t O_CMP_S = O_CMP_P + (size_t)MP * 256;
constexpr size_t O_SLC_P = O_CMP_S + (size_t)MS * 256;
constexpr size_t O_SLC_S = O_SLC_P + (size_t)MP * 256;
constexpr size_t O_WIN_P = O_SLC_S + (size_t)MS * 256;
constexpr size_t O_WIN_S = O_WIN_P + (size_t)NB * 512 * 256;
constexpr size_t O_RGC_P = O_WIN_S + (size_t)MS * 512 * 256;
constexpr size_t O_RGC_S = O_RGC_P + (size_t)2 * NB * 3 * DRNN;
constexpr size_t O_RGH_P = O_RGC_S + (size_t)2 * MS * 3 * DRNN;
constexpr size_t O_RGH_S = O_RGH_P + (size_t)2 * NB * DRNN;
constexpr size_t O_FFC_P = O_RGH_S + (size_t)2 * MS * DRNN;
constexpr size_t O_FFC_S = O_FFC_P + (size_t)4 * NB * 2 * DFF2;
constexpr size_t O_END = O_FFC_S + (size_t)4 * MS * 2 * DFF2;
static_assert(O_END == 32071680, "d_out size");

constexpr size_t al256(size_t x) { return (x + 255) & ~(size_t)255; }
constexpr size_t WS_CTL = 0;
constexpr size_t WS_WIN = WS_CTL + 65536;
constexpr size_t WS_WOUT = WS_WIN + (size_t)2 * 2560 * 1024 * 2;
constexpr size_t WS_WUP = WS_WOUT + (size_t)2 * 1024 * 1280 * 2;
constexpr size_t WS_WDN = WS_WUP + (size_t)4 * 6144 * 1024 * 2;
constexpr size_t WS_WPI = WS_WDN + (size_t)4 * 1024 * 3072 * 2;
constexpr size_t WS_WPG = WS_WPI + (size_t)4 * 1024 * 256 * 2;
constexpr size_t WS_WKV = WS_WPG + (size_t)4 * 1024 * 1024 * 2;
constexpr size_t WS_WQG = WS_WKV + (size_t)768 * 1024 * 2;
constexpr size_t WS_WO = WS_WQG + (size_t)2 * 1280 * 1024 * 2;
constexpr size_t WS_WC1 = WS_WO + (size_t)2 * 1024 * 1024 * 2;
constexpr size_t WS_WGA = WS_WC1 + (size_t)2 * 256 * 1024 * 2;
constexpr size_t WS_B1F = al256(WS_WGA + (size_t)2 * 2 * 16 * 80 * 96 * 2);
constexpr size_t WS_ROPE = al256(WS_B1F + 32 * 2 * 128 * 4);
constexpr size_t WS_PSS = al256(WS_ROPE + (size_t)4097 * 64 * 4);
constexpr size_t WS_X = al256(WS_PSS + (size_t)2 * 16 * MPAD * 4);
constexpr size_t WS_XB = WS_X + (size_t)MPAD * 1024 * 4;
__host__ __device__ constexpr size_t xb_off(int L) { return (L & 1) ? WS_X : WS_XB; }
constexpr size_t WS_PB = WS_XB + (size_t)MPAD * 1024 * 2;
constexpr size_t WS_Y = WS_PB + (size_t)4 * MPAD * 256 * 2;
constexpr size_t WS_G = WS_Y + (size_t)MPAD * 1280 * 2;
constexpr size_t WS_S = WS_G + (size_t)MPAD * 1280 * 2;
constexpr size_t WS_Q = WS_S + (size_t)MPAD * 1024 * 2;
constexpr size_t WS_QR = WS_Q + (size_t)MPAD * 1024 * 2;
constexpr size_t WS_O = WS_QR + (size_t)MPAD * 1024 * 2;
constexpr size_t WS_GT = WS_O + (size_t)MPAD * 1024 * 2;
constexpr size_t WS_KS = al256(WS_GT + (size_t)MPAD * 48 * 4);
constexpr size_t WS_VTS = WS_KS + (size_t)NB * NG * SEQ * 64 * 2;
constexpr size_t WS_KW = WS_VTS + (size_t)NB * NG * SEQ * 64 * 2;
constexpr size_t WS_VTW = WS_KW + (size_t)NB * NG * SEQ * 64 * 2;
constexpr size_t WS_KC = WS_VTW + (size_t)NB * NG * SEQ * 64 * 2;
constexpr size_t WS_VCT = WS_KC + (size_t)NB * NG * 256 * 64 * 2;
constexpr size_t WS_KCS = WS_VCT + (size_t)NB * NG * 256 * 64 * 2;
constexpr size_t WS_VCS = WS_KCS + (size_t)MS * NG * 512 * 64 * 4;
constexpr size_t WS_CMPA = WS_VCS + (size_t)MS * NG * 512 * 64 * 4;
constexpr size_t WS_T = WS_CMPA + (size_t)2 * CMP_ROWS * 1024 * 2;
constexpr size_t WS_BIG = WS_T + (size_t)2 * CMP_ROWS * 256 * 4;
constexpr size_t WS_XR = WS_BIG;
constexpr size_t WS_HL = WS_XR + (size_t)MPAD * 1280 * 4;
constexpr size_t WS_AC = WS_HL + (size_t)MPAD * 1280 * 4;
constexpr size_t WS_UP = WS_BIG;
constexpr size_t WS_ACT = WS_UP + (size_t)MPAD * 6144 * 2;
constexpr size_t WS_UPH = WS_ACT + (size_t)MPAD * 3072 * 2;
constexpr size_t WS_PIN = WS_UPH + (size_t)64 * 4 * 6144 * 4;
constexpr size_t WS_STASH = WS_PIN + (size_t)4 * MPAD * 1024 * 2;
constexpr size_t WS_SPSS = WS_STASH + (size_t)256 * 8 * 2048 * 4;
constexpr size_t WS_END_A = WS_AC + (size_t)MPAD * 1280 * 4, WS_END_B = WS_SPSS + (size_t)2 * 64 * 32 * 4;
constexpr size_t WS_END = WS_END_A > WS_END_B ? WS_END_A : WS_END_B;
static_assert(WS_END < (size_t)1300 * 1024 * 1024, "workspace budget");

constexpr int LDS_RING = 0, LDS_RING_BYTES = 131072;
constexpr int LDS_RS = LDS_RING_BYTES;
constexpr int LDS_MISC = 163840 - 256;
constexpr int LDS_HALO = LDS_RS + 8 * 1024;
constexpr int LDS_BYTES = 163840;

struct Params { const void* in[38]; float* out; unsigned char* ws; int ph_lo, ph_hi; };
typedef const __attribute__((address_space(4))) Params* KP;
__device__ __forceinline__ KP launder(KP p) { asm volatile("" : "+s"(p)); return p; }
__device__ __forceinline__ int launder_v(int x) { asm volatile("" : "+v"(x)); return x; }
__device__ __forceinline__ int launder_s(int x) { asm volatile("" : "+s"(x)); return x; }

__device__ __forceinline__ unsigned f2bf(float f) { unsigned u = __builtin_bit_cast(unsigned, f); return (u + 0x7fffu + ((u >> 16) & 1u)) >> 16; }
typedef __bf16 bf16x2_t __attribute__((ext_vector_type(2)));
__device__ __forceinline__ unsigned pk2(float lo, float hi) { const f32x2 v = {lo, hi}; return __builtin_bit_cast(unsigned, __builtin_convertvector(v, bf16x2_t)); }
__device__ __forceinline__ f32x4 unpack4(u32x2 w);
__device__ __forceinline__ void unpack8(u32x4 w, f32x4& lo, f32x4& hi) { lo = unpack4((u32x2){w.x, w.y}); hi = unpack4((u32x2){w.z, w.w}); }
__device__ __forceinline__ f32x4 unpack4(u32x2 w) { f32x4 v; v[0] = __builtin_bit_cast(float, w.x << 16); v[1] = __builtin_bit_cast(float, w.x & 0xffff0000u); v[2] = __builtin_bit_cast(float, w.y << 16); v[3] = __builtin_bit_cast(float, w.y & 0xffff0000u); return v; }
__device__ __forceinline__ float bf2f(unsigned short b) { return __builtin_bit_cast(float, ((unsigned)b) << 16); }
__device__ __forceinline__ float gelu_tanh(float x) {
    const float u = 0.7978845608028654f * (x + 0.044715f * x * x * x);
    return x * __builtin_amdgcn_rcpf(1.0f + __expf(-2.0f * u));
}
__device__ __forceinline__ float sigmoidf_(float x) { return __builtin_amdgcn_rcpf(1.0f + __expf(-x)); }
__device__ __forceinline__ float wave_sum(float v) {
#pragma unroll
    for (int o = 1; o < 64; o <<= 1) v += __shfl_xor(v, o);
    return v;
}
namespace pg8 {
#define PG8_LAS __attribute__((address_space(3)))
typedef unsigned short bf16_t;
typedef short bf16x8 __attribute__((ext_vector_type(8)));
typedef float f32x4 __attribute__((ext_vector_type(4)));
typedef unsigned u32x4 __attribute__((ext_vector_type(4)));
constexpr int BM = 256, BK = 64, HALF = 128, HTB = HALF * BK * 2  , STAGE_BYTES = 8 * HTB, NXCD = 8, WGM = 8;

__host__ __device__ __forceinline__ int lds_byte(int r, int c) { const int st = (r >> 4) * 2 + (c >> 5), rr = r & 15, cc = c & 31, ob = rr * 64 + cc * 2; return st * 1024 + (ob ^ (((ob >> 9) & 1) << 5)); }
__host__ __device__ __forceinline__ void stage_rc(int b, int& R, int& C) { const int st = b / 1024, sb = b % 1024, swz = sb ^ (((sb >> 9) & 1) << 5); R = (st >> 1) * 16 + swz / 64; C = (st & 1) * 32 + (swz % 64) / 2; }
__host__ __device__ __forceinline__ int perm32(int rho) { const int n = rho >> 4, i = rho & 15; return 8 * (i >> 2) + 4 * n + (i & 3); }

struct Unit { int pm, pn; };
struct Gemm { const bf16_t* A; const bf16_t* Bt; int M, N, K; };

struct StaticOrder {
    int nM, nN, nwg, G, c;
    __host__ __device__ __forceinline__ void init(int M, int N, int G_, int c_) { nM = M / BM; nN = N / BM; nwg = nM * nN; G = G_; c = c_; }
    __host__ __device__ __forceinline__ bool next(int i, Unit& u) const {
        const long L = (long)i * G + c; if (L >= nwg) return false;
        int wgid = (int)L; { const int q = nwg / NXCD, r = nwg % NXCD, xcd = wgid % NXCD, off = wgid / NXCD; wgid = (xcd < r ? xcd * (q + 1) : r * (q + 1) + (xcd - r) * q) + off; }
        const int nig = WGM * nN, gid = wgid / nig, fm = gid * WGM, gsz = (nM - fm) < WGM ? (nM - fm) : WGM;
        u.pm = fm + ((wgid % nig) % gsz); u.pn = (wgid % nig) / gsz; return true;
    }
    __device__ __forceinline__ void a_ready(const Unit&) const {}
    __device__ __forceinline__ void done(const Unit&) const {}
};
__device__ __forceinline__ unsigned cvt_pk_bf16(float lo, float hi) { unsigned r; asm volatile("v_cvt_pk_bf16_f32 %0, %1, %2" : "=v"(r) : "v"(lo), "v"(hi)); return r; }
typedef float f32x2 __attribute__((ext_vector_type(2)));
template <class Epi, class Sched, bool ALIGN_EPI = false, bool SP2 = false>
__device__ __forceinline__ void gemm_phase(PG8_LAS unsigned char* lds, const Gemm g, const Sched& S, const Epi& E) {
    int tid = threadIdx.x; asm volatile("" : "+v"(tid));
    const int wid = __builtin_amdgcn_readfirstlane(tid >> 6), lane = tid & 63, wr = wid >> 2, wc = wid & 3, fr = lane & 15, fq = lane >> 4;
    const int K = g.K, nt = K / BK;
    unsigned voffA[2], voffB[2];
#pragma unroll
    for (int i = 0; i < 2; ++i) { int R, C; stage_rc(tid * 16 + i * 8192, R, C); const int Rb = Epi::PERM ? ((R & ~31) + perm32(R & 31)) : R;
        voffA[i] = (unsigned)(R * K + C) * 2u; voffB[i] = (unsigned)(Rb * K + C) * 2u; }
    const size_t kstep = (size_t)(BK * 2);
    const size_t hstep = (size_t)HALF * K * 2;
    const size_t tstep = 2 * hstep;
    const unsigned ldsw = (unsigned)wid * 1024u;
    const int aoff = lds_byte(wr * 64 + fr, fq * 8), boff = lds_byte(wc * 32 + fr, fq * 8);
#define PG8_SA(b, h) (((b) * 2 + (h)) * HTB)
#define PG8_SB(b, h) ((4 + (b) * 2 + (h)) * HTB)
#define PG8_STAGE(bufoff, gbase, voff) do { _Pragma("unroll") for (int _i = 0; _i < 2; ++_i) \
        __builtin_amdgcn_global_load_lds((const unsigned*)((const char*)(gbase) + (voff)[_i]), (PG8_LAS unsigned*)(lds + (bufoff) + ldsw + _i * 8192), 16, 0, 0); } while (0)
#define PG8_LDA(dst, b, h) do { _Pragma("unroll") for (int m = 0; m < 4; ++m) _Pragma("unroll") for (int k = 0; k < 2; ++k) dst[m][k] = *(const PG8_LAS bf16x8*)(lds + PG8_SA(b, h) + aoff + m * 2048 + k * 1024); } while (0)
#define PG8_LDB(dst, b, h) do { _Pragma("unroll") for (int n = 0; n < 2; ++n) _Pragma("unroll") for (int k = 0; k < 2; ++k) dst[n][k] = *(const PG8_LAS bf16x8*)(lds + PG8_SB(b, h) + boff + n * 2048 + k * 1024); } while (0)
#define PG8_MMA(ai, bj, At, Bt) do { __builtin_amdgcn_s_setprio(1); _Pragma("unroll") for (int m = 0; m < 4; ++m) _Pragma("unroll") for (int n = 0; n < 2; ++n) _Pragma("unroll") for (int k = 0; k < 2; ++k) \
        acc[ai][bj][m][n] = __builtin_amdgcn_mfma_f32_16x16x32_bf16(Bt[n][k], At[m][k], acc[ai][bj][m][n], 0, 0, 0); __builtin_amdgcn_s_setprio(0); } while (0)
#define PG8_WAIT_V(n) asm volatile("s_waitcnt vmcnt(" #n ")" ::: "memory")
#define PG8_WAIT_L(n) asm volatile("s_waitcnt lgkmcnt(" #n ")" ::: "memory")
#define PG8_BAR __builtin_amdgcn_s_barrier()
#define PG8_SCHED __builtin_amdgcn_sched_barrier(0)
    Unit cur, nxt; int ui = 0;
    if (!S.next(0, cur)) return;
    f32x4 acc[2][2][4][2];
#pragma unroll
    for (int a = 0; a < 2; ++a)
#pragma unroll
        for (int b = 0; b < 2; ++b)
#pragma unroll
            for (int m = 0; m < 4; ++m)
#pragma unroll
                for (int n = 0; n < 2; ++n) acc[a][b][m][n] = (f32x4){0.f, 0.f, 0.f, 0.f};
    bf16x8 At[4][2], B0[2][2], B1[2][2];
    const char* cA = (const char*)g.A + (size_t)cur.pm * tstep; const char* cB = (const char*)g.Bt + (size_t)cur.pn * tstep;
    S.a_ready(cur);
    if constexpr (SP2) {
        PG8_STAGE(PG8_SB(0, 0), cB, voffB); PG8_STAGE(PG8_SB(0, 1), cB + hstep, voffB); PG8_STAGE(PG8_SA(0, 0), cA, voffA); PG8_STAGE(PG8_SA(0, 1), cA + hstep, voffA);
        if (wr == 1) PG8_BAR;
        PG8_WAIT_V(2); PG8_BAR;
        PG8_STAGE(PG8_SB(1, 0), cB + kstep, voffB); PG8_STAGE(PG8_SA(1, 0), cA + kstep, voffA); PG8_STAGE(PG8_SB(1, 1), cB + hstep + kstep, voffB);
        PG8_WAIT_V(6); PG8_BAR;
    } else {
        PG8_STAGE(PG8_SB(0, 0), cB, voffB); PG8_STAGE(PG8_SA(0, 0), cA, voffA); PG8_STAGE(PG8_SB(0, 1), cB + hstep, voffB); PG8_STAGE(PG8_SA(0, 1), cA + hstep, voffA);
        if (wr == 1) PG8_BAR;
        PG8_WAIT_V(4); PG8_BAR;
        PG8_STAGE(PG8_SB(1, 0), cB + kstep, voffB); PG8_STAGE(PG8_SA(1, 0), cA + kstep, voffA); PG8_STAGE(PG8_SB(1, 1), cB + hstep + kstep, voffB);
        PG8_WAIT_V(6); PG8_BAR;
    }
    for (;;) {
        const bool has_next = S.next(ui + 1, nxt);
        const char* nA = has_next ? (const char*)g.A + (size_t)nxt.pm * tstep : cA; const char* nB = has_next ? (const char*)g.Bt + (size_t)nxt.pn * tstep : cB;
        for (int t = 0; t < nt; t += 2) {
            const bool last = (t == nt - 2);
            const char* a1 = cA + (size_t)(t + 1) * kstep;
            const char* a2 = last ? nA : cA + (size_t)(t + 2) * kstep; const char* b2 = last ? nB : cB + (size_t)(t + 2) * kstep;
            const char* a3 = a2 + kstep; const char* b3 = b2 + kstep;
            if (last && has_next) S.a_ready(nxt);
            if constexpr (SP2) {
            PG8_LDB(B0, 0, 0); PG8_LDB(B1, 0, 1); PG8_SCHED; PG8_LDA(At, 0, 0); PG8_STAGE(PG8_SA(1, 1), a1 + hstep, voffA);
            PG8_WAIT_V(8); PG8_WAIT_L(0); PG8_BAR; PG8_MMA(0, 0, At, B0); PG8_MMA(0, 1, At, B1); PG8_BAR; PG8_SCHED;
            PG8_LDA(At, 0, 1); PG8_STAGE(PG8_SB(0, 0), b2, voffB); PG8_STAGE(PG8_SB(0, 1), b2 + hstep, voffB); PG8_STAGE(PG8_SA(0, 0), a2, voffA);
            PG8_WAIT_V(8); PG8_WAIT_L(0); PG8_BAR; PG8_MMA(1, 0, At, B0); PG8_MMA(1, 1, At, B1); PG8_BAR; PG8_SCHED;
            PG8_LDB(B0, 1, 0); PG8_LDB(B1, 1, 1); PG8_SCHED; PG8_LDA(At, 1, 0); PG8_STAGE(PG8_SA(0, 1), a2 + hstep, voffA);
            PG8_WAIT_V(8); PG8_WAIT_L(0); PG8_BAR; PG8_MMA(0, 0, At, B0); PG8_MMA(0, 1, At, B1); PG8_BAR; PG8_SCHED;
            PG8_LDA(At, 1, 1); PG8_STAGE(PG8_SB(1, 0), b3, voffB); PG8_STAGE(PG8_SB(1, 1), b3 + hstep, voffB); PG8_STAGE(PG8_SA(1, 0), a3, voffA);
            PG8_WAIT_V(8); PG8_WAIT_L(0); PG8_BAR; PG8_MMA(1, 0, At, B0); PG8_MMA(1, 1, At, B1); PG8_BAR; PG8_SCHED;
            } else {
            PG8_LDB(B0, 0, 0); PG8_SCHED; PG8_LDA(At, 0, 0); PG8_STAGE(PG8_SA(1, 1), a1 + hstep, voffA);
            PG8_WAIT_L(8); PG8_BAR; PG8_WAIT_L(0); PG8_MMA(0, 0, At, B0); PG8_BAR; PG8_SCHED;
            PG8_LDB(B1, 0, 1); PG8_STAGE(PG8_SB(0, 0), b2, voffB);
            PG8_BAR; PG8_WAIT_L(0); PG8_MMA(0, 1, At, B1); PG8_BAR;
            PG8_LDA(At, 0, 1); PG8_STAGE(PG8_SA(0, 0), a2, voffA);
            PG8_BAR; PG8_WAIT_L(0); PG8_MMA(1, 0, At, B0); PG8_BAR; PG8_SCHED;
            PG8_STAGE(PG8_SB(0, 1), b2 + hstep, voffB);
            PG8_WAIT_V(6); PG8_BAR; PG8_MMA(1, 1, At, B1); PG8_BAR;
            PG8_LDB(B0, 1, 0); PG8_SCHED; PG8_LDA(At, 1, 0); PG8_STAGE(PG8_SA(0, 1), a2 + hstep, voffA);
            PG8_WAIT_L(8); PG8_BAR; PG8_WAIT_L(0); PG8_MMA(0, 0, At, B0); PG8_BAR; PG8_SCHED;
            PG8_LDB(B1, 1, 1); PG8_STAGE(PG8_SB(1, 0), b3, voffB);
            PG8_BAR; PG8_WAIT_L(0); PG8_MMA(0, 1, At, B1); PG8_BAR;
            PG8_LDA(At, 1, 1); PG8_STAGE(PG8_SA(1, 0), a3, voffA);
            PG8_BAR; PG8_WAIT_L(0); PG8_MMA(1, 0, At, B0); PG8_BAR; PG8_SCHED;
            PG8_STAGE(PG8_SB(1, 1), b3 + hstep, voffB);
            PG8_WAIT_V(6); PG8_BAR; PG8_MMA(1, 1, At, B1); PG8_BAR;
            }
        }
        if constexpr (ALIGN_EPI) { if (wr == 0) PG8_BAR; }
        if constexpr (!Epi::AFTER_DRAIN) { E(acc, cur, wr, wc, fr, fq); S.done(cur); }
        if (!has_next) break;
#pragma unroll
        for (int a = 0; a < 2; ++a)
#pragma unroll
            for (int b = 0; b < 2; ++b)
#pragma unroll
                for (int m = 0; m < 4; ++m)
#pragma unroll
                    for (int n = 0; n < 2; ++n) acc[a][b][m][n] = (f32x4){0.f, 0.f, 0.f, 0.f};
        cur = nxt; cA = nA; cB = nB; ++ui;
        if constexpr (ALIGN_EPI) { if (wr == 1) PG8_BAR; }
    }
    PG8_WAIT_V(0);
    if constexpr (!ALIGN_EPI) { if (wr == 0) PG8_BAR; }
    PG8_BAR;
    if constexpr (Epi::AFTER_DRAIN) { E.fused(acc, cur, wr, wc, fr, fq, lds, wid, lane); S.done(cur); }
#undef PG8_SA
#undef PG8_SB
#undef PG8_STAGE
#undef PG8_LDA
#undef PG8_LDB
#undef PG8_MMA
#undef PG8_WAIT_V
#undef PG8_WAIT_L
#undef PG8_BAR
#undef PG8_SCHED
}
}
#define XB_TMO      128
#define XB_XCNT(j)  (256  + 64 * (j))
#define XB_XSUB(j)  (1280 + 64 * (j))
#define XB_XGEN(j)  (2304 + 64 * (j))
#define XB_TOP      3328
#define XB_TOPGEN   3392
#define XCD_BAR_WORDS 3456
#define XB_SPIN_CAP (1u << 18)

__device__ __forceinline__ unsigned xb_ld(unsigned* p)              { return __hip_atomic_load(p, __ATOMIC_RELAXED, __HIP_MEMORY_SCOPE_AGENT); }
__device__ __forceinline__ unsigned xb_add(unsigned* p, unsigned v) { return __hip_atomic_fetch_add(p, v, __ATOMIC_RELAXED, __HIP_MEMORY_SCOPE_AGENT); }
__device__ __forceinline__ unsigned xb_xcc_id() { return (unsigned)__builtin_amdgcn_s_getreg((3 << 11) | 20) & 0xFu; }
#define XB_SPIN(cond, bar) do { unsigned _sp = 0; while (cond) { __builtin_amdgcn_s_sleep(1); \
    if ((++_sp & 255u) == 0u) { if (xb_ld(&(bar)[XB_TMO])) break; if (_sp > XB_SPIN_CAP) { atomicAdd(&(bar)[XB_TMO], 1u); break; } } } } while (0)

struct XcdBarrier {
    unsigned* bar; unsigned x;
    volatile LAS unsigned* st;
};

__device__ __forceinline__ XcdBarrier xcd_barrier_post(unsigned* bar, volatile LAS unsigned* st) {
    XcdBarrier b; b.bar = bar; b.x = xb_xcc_id(); b.st = st;
    if (threadIdx.x == 0) (void)xb_add(&bar[XB_XCNT(b.x)], 1u);
    return b;
}
__device__ __forceinline__ void xcd_barrier_complete(unsigned* bar, unsigned x, unsigned& nloc, unsigned& nx) {
    const unsigned G = gridDim.x * gridDim.y * gridDim.z;
    unsigned sum, cnt, mine, sp = 0u;
    for (;;) {
        sum = 0u; cnt = 0u; mine = 0u;
#pragma unroll
        for (unsigned j = 0; j < 16; ++j) { const unsigned c = xb_ld(&bar[XB_XCNT(j)]); sum += c; cnt += (c > 0u) ? 1u : 0u; mine = (j == x) ? c : mine; }
        if (sum == G) break;
        __builtin_amdgcn_s_sleep(1);
        if ((++sp & 255u) == 0u) { if (xb_ld(&bar[XB_TMO])) break; if (sp > XB_SPIN_CAP) { atomicAdd(&bar[XB_TMO], 1u); break; } }
    }
    nloc = mine > 0u ? mine : 1u; nx = cnt > 0u ? cnt : 1u;
}

__device__ __forceinline__ void xcd_barrier(const XcdBarrier& b) {
    asm volatile("s_waitcnt vmcnt(0)" ::: "memory");
    __syncthreads();
    if (threadIdx.x == 0) {
        unsigned* bar = b.bar;
        __builtin_amdgcn_s_waitcnt(0);
        unsigned nloc = b.st[0], nx = b.st[1];
        if (nloc == 0u) { xcd_barrier_complete(bar, b.x, nloc, nx); b.st[0] = nloc; b.st[1] = nx; }
        const unsigned old = xb_add(&bar[XB_XSUB(b.x)], 1u);
        const unsigned gen = old / nloc;
        if (old + 1u == (gen + 1u) * nloc) {
            __builtin_amdgcn_fence(__ATOMIC_RELEASE, "agent");
            asm volatile("s_waitcnt vmcnt(0)" ::: "memory");
            const unsigned og = xb_add(&bar[XB_TOP], 1u);
            const unsigned tg = og / nx;
            if (og + 1u == (tg + 1u) * nx) xb_add(&bar[XB_TOPGEN], 1u);
            else XB_SPIN(xb_ld(&bar[XB_TOPGEN]) == tg, bar);
            __builtin_amdgcn_fence(__ATOMIC_ACQUIRE, "agent");
            xb_add(&bar[XB_XGEN(b.x)], 1u);
            asm volatile("s_waitcnt vmcnt(0)" ::: "memory");
        } else {
            XB_SPIN(xb_ld(&bar[XB_XGEN(b.x)]) == gen, bar);
            __builtin_amdgcn_fence(__ATOMIC_ACQUIRE, "agent");
            asm volatile("s_waitcnt vmcnt(0)" ::: "memory");
        }
    }
    __syncthreads();
}


__device__ unsigned g_seam0[10 * 64];
__device__ __forceinline__ void seam0_barrier() {
    asm volatile("s_waitcnt vmcnt(0)" ::: "memory");
    __syncthreads();
    if (threadIdx.x == 0) {
        __builtin_amdgcn_fence(__ATOMIC_RELEASE, "agent");
        asm volatile("s_waitcnt vmcnt(0)" ::: "memory");
        const unsigned G = gridDim.x, s = blockIdx.x & 7u, ns = (G - s + 7u) >> 3, nsh = G < 8u ? G : 8u;
        const unsigned old = xb_add(&g_seam0[s * 64], 1u);
        const unsigned round = old / ns;
        if (old + 1u == (round + 1u) * ns) {
            const unsigned o2 = xb_add(&g_seam0[8 * 64], 1u);
            if ((o2 + 1u) % nsh == 0u) xb_add(&g_seam0[9 * 64], 1u);
        }
        unsigned sp = 0u;
        while ((int)(xb_ld(&g_seam0[9 * 64]) - (round + 1u)) < 0) { __builtin_amdgcn_s_sleep(2); if (++sp > (1u << 24)) break; }
        __builtin_amdgcn_fence(__ATOMIC_ACQUIRE, "agent");
        asm volatile("s_waitcnt vmcnt(0)" ::: "memory");
    }
    __syncthreads();
}
__device__ __forceinline__ int rowmap(int mode, int nn) {
    const int il = (nn & ~63) + 2 * (nn & 31) + ((nn >> 5) & 1);
    if (mode == 1) return nn < 1024 ? il : nn;
    if (mode == 2) { const int j = nn >> 7; return (j == 2 || j == 4) ? il : nn; }
    if (mode == 3) { const int half = nn >= DFF ? 1 : 0, ka = nn - half * DFF; return (ka >> 7) * 256 + half * 128 + (ka & 127); }
    return nn;
}
__device__ __forceinline__ void tr_item(const float* __restrict__ W, int ldn, int Nsrc, bf16* __restrict__ WT, int dstK, const float* __restrict__ gain, int mode, int item, int nblk,
                                        LAS float* scr, int lane) {
    const int kb = item / nblk, nb = item % nblk, k0 = 64 * kb, n0 = 32 * nb;
    const int n = n0 + (lane & 31);
    float wv[32];
#pragma unroll
    for (int i = 0; i < 32; ++i) { const int kk = 2 * i + (lane >> 5); wv[i] = (n < Nsrc) ? __builtin_nontemporal_load(W + (size_t)(k0 + kk) * ldn + n) : 0.f; }
#pragma unroll
    for (int i = 0; i < 32; ++i) { const int kk = 2 * i + (lane >> 5); float v = wv[i]; if (gain) v *= gain[k0 + kk]; scr[kk * 33 + (lane & 31)] = v; }
    asm volatile("s_waitcnt lgkmcnt(0)" ::: "memory");
    const int c = lane & 7;
#pragma unroll
    for (int j = 0; j < 4; ++j) {
        const int nl = (lane >> 3) + 8 * j; const LAS float* s = scr + (8 * c) * 33 + nl;
        u32x4 o; o.x = pk2(s[0 * 33], s[1 * 33]); o.y = pk2(s[2 * 33], s[3 * 33]); o.z = pk2(s[4 * 33], s[5 * 33]); o.w = pk2(s[6 * 33], s[7 * 33]);
        const int row = rowmap(mode, n0 + nl);
        *(u32x4*)(WT + (size_t)row * dstK + k0 + 8 * c) = o;
    }
    asm volatile("s_waitcnt lgkmcnt(0)" ::: "memory");
}

__device__ __forceinline__ void phase0(KP P, LAS unsigned char* lds, int tid, int lane, int wave, int G) {
    unsigned char* ws = P->ws;
    const int gw = launder_s(blockIdx.x) * 8 + wave, NGW = G * 8;
    const size_t gt = (size_t)launder_s(blockIdx.x) * 512 + tid, NGT = (size_t)G * 512;
    LAS float* scr = (LAS float*)(lds + wave * 16384);
    {
        const float* g_mix = (const float*)P->in[11]; const float* g_ffn = (const float*)P->in[12]; const float* g_ple = (const float*)P->in[13];
        constexpr int C_WIN = 16 * 80, C_WOUT = 20 * 32, C_WUP = 16 * 192, C_WDN = 48 * 32, C_WPI = 4 * 32, C_WPG = 16 * 32, C_WKV = 16 * 24, C_WQG = 16 * 40, C_WO = 16 * 32, C_WC1 = 16 * 4;
        constexpr int NITEMS = 2 * C_WIN + 2 * C_WOUT + 4 * C_WUP + 4 * C_WDN + 4 * C_WPI + 4 * C_WPG + C_WKV + 2 * C_WQG + 2 * C_WO + 4 * C_WC1;
        for (int it = gw; it < NITEMS; it += NGW) {
            int r = it;
            if (r < 2 * C_WIN) { const int L = r / C_WIN; r %= C_WIN;
                tr_item((const float*)P->in[15] + (size_t)L * 1024 * 2560, 2560, 2560, (bf16*)(ws + WS_WIN) + (size_t)L * 2560 * 1024, 1024, g_mix + L * 1024, 0, r, 80, scr, lane); continue; }
            r -= 2 * C_WIN;
            if (r < 2 * C_WOUT) { const int L = r / C_WOUT; r %= C_WOUT;
                tr_item((const float*)P->in[23] + (size_t)L * 1280 * 1024, 1024, 1024, (bf16*)(ws + WS_WOUT) + (size_t)L * 1024 * 1280, 1280, nullptr, 0, r, 32, scr, lane); continue; }
            r -= 2 * C_WOUT;
            if (r < 4 * C_WUP) { const int L = r / C_WUP; r %= C_WUP;
                tr_item((const float*)P->in[32] + (size_t)L * 1024 * 6144, 6144, 6144, (bf16*)(ws + WS_WUP) + (size_t)L * 6144 * 1024, 1024, g_ffn + L * 1024, 3, r, 192, scr, lane); continue; }
            r -= 4 * C_WUP;
            if (r < 4 * C_WDN) { const int L = r / C_WDN; r %= C_WDN;
                tr_item((const float*)P->in[35] + (size_t)L * 3072 * 1024, 1024, 1024, (bf16*)(ws + WS_WDN) + (size_t)L * 1024 * 3072, 3072, nullptr, 0, r, 32, scr, lane); continue; }
            r -= 4 * C_WDN;
            if (r < 4 * C_WPI) { const int L = r / C_WPI; r %= C_WPI;
                tr_item((const float*)P->in[36] + (size_t)L * 256 * 1024, 1024, 1024, (bf16*)(ws + WS_WPI) + (size_t)L * 1024 * 256, 256, nullptr, 0, r, 32, scr, lane); continue; }
            r -= 4 * C_WPI;
            if (r < 4 * C_WPG) { const int L = r / C_WPG; r %= C_WPG;
                tr_item((const float*)P->in[37] + (size_t)L * 1024 * 1024, 1024, 1024, (bf16*)(ws + WS_WPG) + (size_t)L * 1024 * 1024, 1024, g_ple + L * 1024, 0, r, 32, scr, lane); continue; }
            r -= 4 * C_WPG;
            if (r < C_WKV) { tr_item((const float*)P->in[25], 768, 768, (bf16*)(ws + WS_WKV), 1024, (const float*)P->in[24], 2, r, 24, scr, lane); continue; }
            r -= C_WKV;
            if (r < 2 * C_WQG) { const int L = r / C_WQG; r %= C_WQG;
                tr_item((const float*)P->in[30] + (size_t)L * 1024 * NQG, NQG, NQG, (bf16*)(ws + WS_WQG) + (size_t)L * NQGP * 1024, 1024, g_mix + (2 + L) * 1024, 1, r, 40, scr, lane); continue; }
            r -= 2 * C_WQG;
            if (r < 2 * C_WO) { const int L = r / C_WO; r %= C_WO;
                tr_item((const float*)P->in[31] + (size_t)L * 1024 * 1024, 1024, 1024, (bf16*)(ws + WS_WO) + (size_t)L * 1024 * 1024, 1024, nullptr, 0, r, 32, scr, lane); continue; }
            r -= 2 * C_WO;
            { const int q = r / C_WC1; r %= C_WC1; const int j = q >> 1, half = q & 1;
                tr_item((const float*)P->in[27] + (size_t)j * 2048 * 128 + (size_t)half * 1024 * 128, 128, 128, (bf16*)(ws + WS_WC1) + (size_t)j * 256 * 1024 + (size_t)half * 128 * 1024, 1024, nullptr, 0, r, 4, scr, lane); }
        }
    }
    {
        bf16* XB = (bf16*)(ws + WS_XB); bf16* XB1 = (bf16*)(ws + WS_X); float* PSS = (float*)(ws + WS_PSS);
        for (int m0 = gw; m0 < MPAD; m0 += 2 * NGW) {
          f32x4 vv[2][4];
#pragma unroll
          for (int q = 0; q < 2; ++q) { const int m = m0 + q * NGW;
            const float* src = m < MP ? (const float*)P->in[0] + (size_t)m * 1024 : (const float*)P->in[1] + (size_t)(m - MP) * 1024;
#pragma unroll
            for (int j = 0; j < 4; ++j) { vv[q][j] = (f32x4){0.f, 0.f, 0.f, 0.f}; if (m < MTOT) vv[q][j] = __builtin_nontemporal_load((const f32x4*)(src + 4 * lane + 256 * j)); } }
#pragma unroll
          for (int q = 0; q < 2; ++q) { const int m = m0 + q * NGW; if (m >= MPAD) break;
            float ss = 0.f;
#pragma unroll
            for (int j = 0; j < 4; ++j) {
                f32x4 v = vv[q][j];
                u32x2 w; w.x = pk2(v[0], v[1]); w.y = pk2(v[2], v[3]);
                *(u32x2*)(XB + (size_t)m * 1024 + 4 * lane + 256 * j) = w;
                if (m >= MTOT) *(u32x2*)(XB1 + (size_t)m * 1024 + 4 * lane + 256 * j) = w;
                v = unpack4(w);
                ss += (v[0] * v[0] + v[1] * v[1]) + (v[2] * v[2] + v[3] * v[3]);
            }
            ss = wave_sum(ss);
            if (lane < 16) PSS[(size_t)lane * MPAD + m] = (lane == 0) ? ss : 0.f;
            if (m >= MP && m < MTOT) ((float*)(ws + WS_SPSS))[lane * 32 + (m - MP)] = (lane == 0) ? ss : 0.f;
          }
        }
    }
    {
        bf16* PB = (bf16*)(ws + WS_PB);
        for (size_t i0 = gt; i0 < (size_t)4 * MPAD * 64; i0 += 8 * NGT) {
            f32x4 v[8];
#pragma unroll
            for (int q = 0; q < 8; ++q) { const size_t i = i0 + q * NGT; v[q] = (f32x4){0.f, 0.f, 0.f, 0.f};
                if (i < (size_t)4 * MPAD * 64) { const int c4 = (int)(i & 63); const size_t rm = i >> 6; const int m = (int)(rm % MPAD), L = (int)(rm / MPAD);
                    if (m < MP) v[q] = __builtin_nontemporal_load((const f32x4*)((const float*)P->in[2] + ((size_t)L * MP + m) * 256 + 4 * c4));
                    else if (m < MTOT) v[q] = *(const f32x4*)((const float*)P->in[3] + ((size_t)L * MS + (m - MP)) * 256 + 4 * c4); } }
#pragma unroll
            for (int q = 0; q < 8; ++q) { const size_t i = i0 + q * NGT;
                if (i < (size_t)4 * MPAD * 64) { u32x2 w; w.x = pk2(v[q][0], v[q][1]); w.y = pk2(v[q][2], v[q][3]); *(u32x2*)(PB + i * 4) = w; } }
        }
    }
    {
        const float* cache = (const float*)P->in[4]; const int* pt = (const int*)P->in[10]; bf16* CA = (bf16*)(ws + WS_CMPA);
        for (int item = launder_s(blockIdx.x); item < MS * NPG; item += G) {
            const int sb = item / NPG, pg = item % NPG;
            const float* src = cache + (size_t)pt[item] * (PGSZ * 256);
            static_assert(PGSZ * 64 == 16 * 512, "page = 16 float4 per thread");
#pragma unroll
            for (int hb = 0; hb < 2; ++hb) {
                f32x4 v[8];
#pragma unroll
                for (int q = 0; q < 8; ++q) v[q] = __builtin_nontemporal_load((const f32x4*)(src + (size_t)(tid + 512 * (8 * hb + q)) * 4));
#pragma unroll
                for (int q = 0; q < 8; ++q) { const int c = tid + 512 * (8 * hb + q);
                    const int f = c * 4, tl = f >> 8, rem = f & 255, j = rem >> 7, g = (rem >> 6) & 1, d = rem & 63;
                    u32x2 w; w.x = pk2(v[q][0], v[q][1]); w.y = pk2(v[q][2], v[q][3]);
                    const size_t row = (size_t)CMP_ROWS_P + (size_t)(g * MS + sb) * 512 + pg * 8 + (tl >> 4);
                    *(u32x2*)(CA + ((size_t)j * CMP_ROWS + row) * 1024 + (tl & 15) * 64 + d) = w; }
            }
        }
    }
    {
        float* RT = (float*)(ws + WS_ROPE);
        for (size_t i = gt; i < (size_t)4097 * 32; i += NGT) {
            const int fi = (int)(i & 31), pi = (int)(i >> 5); const int pos = pi < 4096 ? pi : PAST;
            double f = 1.0; for (int k = 0; k < fi; ++k) f *= 0.7498942093324559;
            const float ang = (float)pos * (float)f;
            const double x = (double)ang; const double kq = __builtin_rint(x * 0.6366197723675814);
            const double r = (x - kq * 1.5707963267948966) - kq * 6.123233995736766e-17, r2 = r * r;
            const double sn = r * (1.0 + r2 * (-1.0 / 6 + r2 * (1.0 / 120 + r2 * (-1.0 / 5040 + r2 * (1.0 / 362880 + r2 * (-1.0 / 39916800 + r2 * (1.0 / 6227020800.0)))))));
            const double cs = 1.0 + r2 * (-0.5 + r2 * (1.0 / 24 + r2 * (-1.0 / 720 + r2 * (1.0 / 40320 + r2 * (-1.0 / 3628800 + r2 * (1.0 / 479001600.0 + r2 * (-1.0 / 87178291200.0)))))));
            const int q = ((int)kq) & 3;
            const double s_ = (q == 0) ? sn : (q == 1) ? cs : (q == 2) ? -sn : -cs;
            const double c_ = (q == 0) ? cs : (q == 1) ? -sn : (q == 2) ? -cs : sn;
            RT[i * 2] = (float)c_; RT[i * 2 + 1] = (float)s_;
        }
    }
    {
        float* B1P = (float*)(ws + WS_B1F); const float* pos = (const float*)P->in[26]; const float* w1 = (const float*)P->in[27];
        for (size_t i = gt; i < (size_t)32 * 2 * 128; i += NGT) {
            const int e = (int)(i & 127), j = (int)((i >> 7) & 1), l = (int)(i >> 8);
            float s = 0.f;
#pragma unroll 16
            for (int d = 0; d < 64; ++d) s += pos[(l * 2 + j) * 64 + d] * w1[((size_t)j * 2048 + l * 64 + d) * 128 + e];
            B1P[i] = s;
        }
    }
    {
        bf16* WG = (bf16*)(ws + WS_WGA);
        for (size_t i = gt; i < (size_t)2 * 2 * 16 * 80 * 96; i += NGT) {
            const int k = (int)(i % 96); size_t r = i / 96; const int j = (int)(r % 80); r /= 80; const int n = (int)(r % 16); r /= 16; const int ax = (int)(r & 1), L = (int)(r >> 1);
            const float* src = (const float*)P->in[ax ? 20 : 18];
            const float v = k < 80 ? src[(((size_t)L * 16 + n) * 80 + k) * 80 + j] : 0.f;
            WG[i] = (bf16)f2bf(v);
        }
    }
    {
        const float* cw = (const float*)P->in[6]; float* o = P->out + O_WIN_S;
        for (size_t i0 = gt; i0 < (size_t)MS * 511 * 64; i0 += 4 * NGT) {
            f32x4 v[4];
#pragma unroll
            for (int q = 0; q < 4; ++q) { const size_t i = i0 + q * NGT; v[q] = (f32x4){0.f, 0.f, 0.f, 0.f};
                if (i < (size_t)MS * 511 * 64) { const int c4 = (int)(i & 63); const size_t rw = i >> 6; const int w = (int)(rw % 511), sb = (int)(rw / 511);
                    v[q] = __builtin_nontemporal_load((const f32x4*)(cw + ((size_t)sb * 512 + w + 1) * 256 + 4 * c4)); } }
#pragma unroll
            for (int q = 0; q < 4; ++q) { const size_t i = i0 + q * NGT;
                if (i < (size_t)MS * 511 * 64) { const int c4 = (int)(i & 63); const size_t rw = i >> 6; const int w = (int)(rw % 511), sb = (int)(rw / 511);
                    __builtin_nontemporal_store(v[q], (f32x4*)(o + ((size_t)sb * 512 + w) * 256 + 4 * c4)); } }
        }
    }
}

#define EPI_FOR_ROWS _Pragma("unroll") for (int ai = 0; ai < 2; ++ai) _Pragma("unroll") for (int m = 0; m < 4; ++m)
#define EPI_FOR_COLS _Pragma("unroll") for (int bj = 0; bj < 2; ++bj) _Pragma("unroll") for (int n = 0; n < 2; ++n) if (only < 0 || only == bj * 2 + n)
#define EPI_ROWL (ai * 128 + wr * 64 + m * 16 + fr)
#define EPI_COLL (bj * 128 + wc * 32 + n * 16 + 4 * fq)
typedef const f32x4 (&AccRef)[2][2][4][2];

__device__ __forceinline__ u32x2 pack4(f32x4 v) { u32x2 w; w.x = pk2(v[0], v[1]); w.y = pk2(v[2], v[3]); return w; }

__device__ __forceinline__ void rs_sample(const float* SP, LAS float* dst, int tid) {
    const int row = tid >> 4, part = tid & 15; float s = 0.f;
#pragma unroll
    for (int i = 0; i < 4; ++i) s += SP[(part * 4 + i) * 32 + row];
    s += __shfl_xor(s, 1); s += __shfl_xor(s, 2); s += __shfl_xor(s, 4); s += __shfl_xor(s, 8);
    if (part == 0) dst[row] = rsqrtf(s * (1.0f / 1024.0f) + EPS);
}
template <class Sched> __device__ __forceinline__ void rs_prepare(const Sched& S, const float* PSScur, const float* X, LAS float* rsb, int tid, bool thin) {
    pg8::Unit u;
    for (int i = 0; i < 7 && S.next(i, u); ++i) {
        if (tid < 256) { const int mrow = u.pm * 256 + tid; float s = 0.f;
#pragma unroll
            for (int k = 0; k < 16; ++k) s += PSScur[(size_t)k * MPAD + mrow];
            rsb[i * 256 + tid] = rsqrtf(s * (1.0f / 1024.0f) + EPS); }
    }
    if (thin) rs_sample(X, rsb + 7 * 256, tid);
    __syncthreads();
}
template <class E> __device__ __forceinline__ auto warm_call(const E& e, int fr, int fq, int cg, int) -> decltype(e.warm(fr, fq, cg)) { return e.warm(fr, fq, cg); }
template <class E> __device__ __forceinline__ float warm_call(const E&, int, int, int, long) { return 0.f; }
template <class E> __device__ __forceinline__ auto thin_epi(const E& e, f32x4 s0, f32x4 s1, int cg, int fr, int fq, int) -> decltype(e.thin(s0, s1, cg, fr, fq), true) { e.thin(s0, s1, cg, fr, fq); return true; }
template <class E> __device__ __forceinline__ bool thin_epi(const E&, f32x4, f32x4, int, int, int, long) { return false; }
template <int K, class Epi> __device__ __forceinline__ void thin_unit(LAS unsigned char* lds, const bf16* __restrict__ A, const bf16* __restrict__ Bt, int cg, const Epi& E) {
    int tid = threadIdx.x; asm volatile("" : "+v"(tid));
    const int wid = __builtin_amdgcn_readfirstlane(tid >> 6), lane = tid & 63, fr = lane & 15, fq = lane >> 4;
    f32x4 c0 = (f32x4){0.f, 0.f, 0.f, 0.f}, c1 = c0;
    float warm = 0.f; if (wid == 0) warm = warm_call(E, fr, fq, cg, 0);
    const bf16* ap = A + (size_t)(MP + fr) * K + fq * 8;
    const bf16* bp = Bt + (size_t)(cg * 16 + fr) * K + fq * 8;
    constexpr int NI = (K / 32) / 8;
    static_assert((K / 32) % 8 == 0, "thin unit K");
    bf16x8 bb[NI], aa0[NI], aa1[NI];
#pragma unroll
    for (int i = 0; i < NI; ++i) { const int ks = wid + 8 * i; bb[i] = *(const bf16x8*)(bp + ks * 32); aa0[i] = *(const bf16x8*)(ap + ks * 32); aa1[i] = *(const bf16x8*)(ap + (size_t)16 * K + ks * 32); }
#pragma unroll
    for (int i = 0; i < NI; ++i) { c0 = __builtin_amdgcn_mfma_f32_16x16x32_bf16(bb[i], aa0[i], c0, 0, 0, 0); c1 = __builtin_amdgcn_mfma_f32_16x16x32_bf16(bb[i], aa1[i], c1, 0, 0, 0); }
    LAS f32x4* red = (LAS f32x4*)lds;
    red[(wid * 2 + 0) * 64 + lane] = c0; red[(wid * 2 + 1) * 64 + lane] = c1;
    asm volatile("" :: "v"(warm));
    __syncthreads();
    if (wid == 0) {
        f32x4 s0 = red[lane], s1 = red[64 + lane];
#pragma unroll
        for (int w = 1; w < 8; ++w) { s0 += red[(w * 2) * 64 + lane]; s1 += red[(w * 2 + 1) * 64 + lane]; }
      if (!thin_epi(E, s0, s1, cg, fr, fq, 0)) {
        f32x4 acc[2][2][4][2];
        const float z_ = __builtin_bit_cast(float, launder_v(0));
#pragma unroll
        for (int a = 0; a < 2; ++a)
#pragma unroll
            for (int b = 0; b < 2; ++b)
#pragma unroll
                for (int m = 0; m < 4; ++m)
#pragma unroll
                    for (int n = 0; n < 2; ++n) acc[a][b][m][n] = (f32x4){z_, z_, z_, z_};
        const int bj = (cg >> 3) & 1, n = cg & 1;
#pragma unroll
        for (int b = 0; b < 2; ++b)
#pragma unroll
            for (int nn = 0; nn < 2; ++nn) if (b == bj && nn == n) { acc[0][b][0][nn] = s0; acc[0][b][1][nn] = s1; }
        pg8::Unit u; u.pm = MP / 256; u.pn = cg >> 4;
        E.only = bj * 2 + n;
        E(acc, u, 0, (cg >> 1) & 3, fr, fq);
        E.only = -1;
      }
    }
    __syncthreads();
}

struct EpiRG1 {
    static constexpr bool PERM = false, AFTER_DRAIN = false;
    unsigned char* ws; const LAS float* rs; mutable int slot; mutable int only = -1;
    __device__ __forceinline__ void operator()(AccRef acc, const pg8::Unit& u, int wr, int wc, int fr, int fq) const {
        fr = launder_v(fr); fq = launder_v(fq);
        const LAS float* rsl = rs + slot * 256; ++slot;
        bf16* Y = (bf16*)(ws + WS_Y); bf16* XR = (bf16*)(ws + WS_XR);
        EPI_FOR_ROWS { const int rl = EPI_ROWL, row = u.pm * 256 + rl; const float r = rsl[rl];
            EPI_FOR_COLS { const int col = u.pn * 256 + EPI_COLL; f32x4 v = acc[ai][bj][m][n] * r;
                if (row < MTOT) { if (u.pn < 5) { v[0] = gelu_tanh(v[0]); v[1] = gelu_tanh(v[1]); v[2] = gelu_tanh(v[2]); v[3] = gelu_tanh(v[3]); *(u32x2*)(Y + (size_t)row * DRNN + col) = pack4(v); }
                else *(u32x2*)(XR + (size_t)row * DRNN + (col - DRNN)) = pack4(v); } } }
    }
};
struct EpiRes {
    static constexpr bool PERM = false, AFTER_DRAIN = false;
    unsigned char* ws; float* PSSn; size_t soff; float scale; size_t xoff; mutable int only = -1;
    __device__ __forceinline__ float warm(int fr, int fq, int cg) const {
        const bf16* XB = (const bf16*)(ws + xoff); const size_t o0 = (size_t)(MP + fr) * DM + cg * 16 + 4 * fq, o1 = o0 + (size_t)16 * DM;
        float w = bf2f(XB[o0]) + bf2f(XB[o1]);
        if (soff) { const bf16* S = (const bf16*)(ws + soff); w += bf2f(S[o0]) + bf2f(S[o1]); }
        return w; }
    __device__ __forceinline__ void thin(f32x4 s0, f32x4 s1, int cg, int fr, int fq) const {
        bf16* XB = (bf16*)(ws + xoff); const bf16* S = soff ? (const bf16*)(ws + soff) : nullptr;
        const int nx = (int)((PSSn - (float*)(ws + WS_PSS)) / (16 * MPAD));
#pragma unroll
        for (int m = 0; m < 2; ++m) { const size_t o = (size_t)(MP + 16 * m + fr) * DM + cg * 16 + 4 * fq; f32x4 a = (m ? s1 : s0) * scale;
            if (S) a *= unpack4(*(const u32x2*)(S + o));
            const u32x2 xw = pack4(unpack4(*(const u32x2*)(XB + o)) + a); const f32x4 x = unpack4(xw);
            *(u32x2*)(XB + o) = xw;
            float ssq = (x[0] * x[0] + x[1] * x[1]) + (x[2] * x[2] + x[3] * x[3]);
            ssq += __shfl_xor(ssq, 16); ssq += __shfl_xor(ssq, 32);
            if (fq == 0) ((float*)(ws + WS_SPSS))[nx * 2048 + cg * 32 + 16 * m + fr] = ssq; }
    }
    __device__ __forceinline__ void operator()(AccRef acc, const pg8::Unit& u, int wr, int wc, int fr, int fq) const {
        fr = launder_v(fr); fq = launder_v(fq);
        bf16* XB = (bf16*)(ws + xoff); const bf16* S = soff ? (const bf16*)(ws + soff) : nullptr;
#pragma unroll
        for (int ai = 0; ai < 2; ++ai) {
#pragma unroll
          for (int mh = 0; mh < 2; ++mh) {
            u32x2 xv[4][2][2];
#pragma unroll
            for (int m = 2 * mh; m < 2 * mh + 2; ++m) { const int row = u.pm * 256 + EPI_ROWL;
                EPI_FOR_COLS { const int col = u.pn * 256 + EPI_COLL; if (row < MTOT) xv[m][bj][n] = *(const u32x2*)(XB + (size_t)row * DM + col); } }
#pragma unroll
            for (int m = 2 * mh; m < 2 * mh + 2; ++m) { const int rl = EPI_ROWL, row = u.pm * 256 + rl; float ssq = 0.f;
                EPI_FOR_COLS { const int col = u.pn * 256 + EPI_COLL; f32x4 a = acc[ai][bj][m][n] * scale;
                    if (row < MTOT) {
                    if (S) { const u32x2 sw = *(const u32x2*)(S + (size_t)row * DM + col);
                        a[0] *= __builtin_bit_cast(float, sw.x << 16); a[1] *= __builtin_bit_cast(float, sw.x & 0xffff0000u); a[2] *= __builtin_bit_cast(float, sw.y << 16); a[3] *= __builtin_bit_cast(float, sw.y & 0xffff0000u); }
                    const u32x2 xw = pack4(unpack4(xv[m][bj][n]) + a); const f32x4 x = unpack4(xw);
                    *(u32x2*)(XB + (size_t)row * DM + col) = xw;
                    ssq += (x[0] * x[0] + x[1] * x[1]) + (x[2] * x[2] + x[3] * x[3]); } }
                ssq += __shfl_xor(ssq, 16); ssq += __shfl_xor(ssq, 32);
                if (fq == 0) { if (row < MP) PSSn[(size_t)(u.pn * 4 + wc) * MPAD + row] = ssq;
                    else if (only >= 0 && row < MTOT) { const int nx = (int)((PSSn - (float*)(ws + WS_PSS)) / (16 * MPAD));
                        ((float*)(ws + WS_SPSS))[nx * 2048 + (u.pn * 16 + (only >> 1) * 8 + wc * 2 + (only & 1)) * 32 + (row - MP)] = ssq; } } }
          }
        }
    }
};
template <int CTRL> __device__ __forceinline__ float dppf(float x) { return __builtin_bit_cast(float, __builtin_amdgcn_update_dpp(0, __builtin_bit_cast(int, x), CTRL, 0xf, 0xf, true)); }
#define DPPF(src, ctrl) dppf<ctrl>(src)
template <int CTRL> __device__ __forceinline__ float dppf_old(float old, float x) { return __builtin_bit_cast(float, __builtin_amdgcn_update_dpp(__builtin_bit_cast(int, old), __builtin_bit_cast(int, x), CTRL, 0xf, 0xf, false)); }
struct EpiUp {
    static constexpr bool PERM = false, AFTER_DRAIN = false;
    unsigned char* ws; const LAS float* rs; float* out; const float* cw; const float* cb; LAS float* halo; int L; mutable int slot; mutable int only = -1;
    __device__ __forceinline__ void operator()(AccRef acc, const pg8::Unit& u, int wr, int wc, int fr, int fq) const {
        fr = launder_v(fr); fq = launder_v(fq);
        const LAS float* rsl = rs + slot * 256; ++slot;
        bf16* ACT = (bf16*)(ws + WS_ACT); float* UPH = (float*)(ws + WS_UPH) + (size_t)u.pm * 4 * DFF2 + u.pn * 256;
#pragma unroll
        for (int ai = 0; ai < 2; ++ai) { const int band = ai * 2 + wr; const float r3 = rsl[ai * 128 + wr * 64 + 48 + fr], r0 = rsl[ai * 128 + wr * 64 + fr];
#pragma unroll
            for (int bj = 0; bj < 2; ++bj)
#pragma unroll
                for (int n = 0; n < 2; ++n) { const int ci = bj * 128 + wc * 32 + n * 16 + 4 * fq;
                    if (fr >= 14) { const f32x4 v = acc[ai][bj][3][n] * r3; *(LAS f32x4*)(halo + (band * 2 + (fr - 14)) * 256 + ci) = v;
                        if (band == 3) *(f32x4*)(UPH + (size_t)(2 + fr - 14) * DFF2 + ci) = v; }
                    if (band == 0 && fr < 2) *(f32x4*)(UPH + (size_t)fr * DFF2 + ci) = acc[0][bj][0][n] * r0; } }
        asm volatile("s_waitcnt lgkmcnt(0)" ::: "memory"); __builtin_amdgcn_s_barrier(); asm volatile("" ::: "memory");
        const int b = u.pm >> 4; const bool last_tile = (u.pm & 15) == 15, first_tile = (u.pm & 15) == 0;
#pragma unroll
        for (int n = 0; n < 2; ++n) {
            const int ci = wc * 32 + n * 16 + 4 * fq, lca = u.pn * 128 + ci;
            f32x4 w[2][3], bs[2];
#pragma unroll
            for (int bj = 0; bj < 2; ++bj) { bs[bj] = *(const f32x4*)(cb + bj * DFF + lca);
#pragma unroll
                for (int k = 0; k < 3; ++k) w[bj][k] = *(const f32x4*)(cw + k * DFF2 + bj * DFF + lca); }
#pragma unroll
            for (int ai = 0; ai < 2; ++ai) {
                const int band = ai * 2 + wr;
                f32x4 s[4][2];
#pragma unroll
                for (int m = 0; m < 4; ++m) { const float r = rsl[ai * 128 + wr * 64 + m * 16 + fr]; s[m][0] = acc[ai][0][m][n] * r; s[m][1] = acc[ai][1][m][n] * r; }
#pragma unroll
                for (int m = 0; m < 4; ++m) {
                    const int rl = ai * 128 + wr * 64 + m * 16 + fr, row = u.pm * 256 + rl;
                    f32x4 uc[2];
#pragma unroll
                    for (int bj = 0; bj < 2; ++bj) {
                        f32x4 p1, p2;
                        if (m > 0) {
#pragma unroll
                            for (int e = 0; e < 4; ++e) { const float cur_ = s[m][bj][e], prv_ = s[m - 1][bj][e];
                                p1[e] = dppf_old<0x111>(dppf<0x121>(prv_), cur_); p2[e] = dppf_old<0x112>(dppf<0x122>(prv_), cur_); }
                        } else {
                            f32x4 h0 = (f32x4){0.f, 0.f, 0.f, 0.f}, h1 = h0;
                            if (band > 0) { h0 = *(const LAS f32x4*)(halo + ((band - 1) * 2 + 0) * 256 + bj * 128 + ci); h1 = *(const LAS f32x4*)(halo + ((band - 1) * 2 + 1) * 256 + bj * 128 + ci); }
#pragma unroll
                            for (int e = 0; e < 4; ++e) { const float cur_ = s[0][bj][e], h0_ = h0[e], h1_ = h1[e];
                                p1[e] = dppf_old<0x111>(h1_, cur_); p2[e] = dppf_old<0x112>((fr == 0) ? h0_ : h1_, cur_); }
                        }
                        uc[bj] = bs[bj] + w[bj][0] * p2 + w[bj][1] * p1 + w[bj][2] * s[m][bj];
                    }
                    f32x4 a;
#pragma unroll
                    for (int e = 0; e < 4; ++e) a[e] = gelu_tanh(uc[0][e]) * uc[1][e];
                    if (first_tile || rl >= 2) *(u32x2*)(ACT + (size_t)row * DFF + lca) = pack4(a);
                    if (last_tile && rl >= 254) {
                        float* o = out + O_FFC_P + ((size_t)(L * NB + b) * 2 + (rl - 254)) * DFF2 + lca;
                        *(f32x4*)o = s[m][0]; *(f32x4*)(o + DFF) = s[m][1]; }
                }
            }
        }
    }
};
__device__ __forceinline__ void act_fixup(unsigned char* ws, const float* cw, const float* cb, int pm, int tid) {
    if ((pm & 15) == 0) return;
    const float* own = (const float*)(ws + WS_UPH) + (size_t)pm * 4 * DFF2; const float* prv = own - (size_t)4 * DFF2; bf16* ACT = (bf16*)(ws + WS_ACT) + (size_t)pm * 256 * DFF;
#pragma unroll
    for (int k = tid; k < DFF; k += 512) {
        const int pa = (k >> 7) * 256 + (k & 127);
        float uc0[2], uc1[2];
#pragma unroll
        for (int h = 0; h < 2; ++h) { const int p = pa + h * 128, lc = h * DFF + k;
            const float w0 = cw[lc], w1 = cw[DFF2 + lc], w2 = cw[2 * DFF2 + lc], bb = cb[lc];
            const float q2 = prv[2 * DFF2 + p], q3 = prv[3 * DFF2 + p], o0 = own[p], o1 = own[DFF2 + p];
            uc0[h] = bb + w0 * q2 + w1 * q3 + w2 * o0; uc1[h] = bb + w0 * q3 + w1 * o0 + w2 * o1; }
        ACT[k] = (bf16)f2bf(gelu_tanh(uc0[0]) * uc0[1]); ACT[DFF + k] = (bf16)f2bf(gelu_tanh(uc1[0]) * uc1[1]);
    }
}
__device__ __forceinline__ void thin_unit_up(LAS unsigned char* lds, const bf16* __restrict__ A, const bf16* __restrict__ Bt, int pg, unsigned char* ws, const LAS float* rs32, float* out,
                                             const float* cw, const float* cb, const float* st, int L) {
    int tid = threadIdx.x; asm volatile("" : "+v"(tid));
    const int wid = __builtin_amdgcn_readfirstlane(tid >> 6), lane = tid & 63, fr = lane & 15, fq = lane >> 4, K = 1024;
    const int pn = pg >> 3, cgi = pg & 7;
    f32x4 c[2][2];
#pragma unroll
    for (int i = 0; i < 2; ++i) { c[i][0] = (f32x4){0.f, 0.f, 0.f, 0.f}; c[i][1] = c[i][0]; }
    const bf16* ap = A + (size_t)(MP + fr) * K + fq * 8;
    const bf16* bp = Bt + (size_t)(pn * 256 + cgi * 16 + fr) * K + fq * 8;
#pragma unroll
    for (int ks = wid; ks < 32; ks += 8) {
        const bf16x8 a0 = *(const bf16x8*)(ap + ks * 32), a1 = *(const bf16x8*)(ap + (size_t)16 * K + ks * 32);
        const bf16x8 b0 = *(const bf16x8*)(bp + ks * 32), b1 = *(const bf16x8*)(bp + (size_t)128 * K + ks * 32);
        c[0][0] = __builtin_amdgcn_mfma_f32_16x16x32_bf16(b0, a0, c[0][0], 0, 0, 0); c[0][1] = __builtin_amdgcn_mfma_f32_16x16x32_bf16(b0, a1, c[0][1], 0, 0, 0);
        c[1][0] = __builtin_amdgcn_mfma_f32_16x16x32_bf16(b1, a0, c[1][0], 0, 0, 0); c[1][1] = __builtin_amdgcn_mfma_f32_16x16x32_bf16(b1, a1, c[1][1], 0, 0, 0);
    }
    LAS f32x4* red = (LAS f32x4*)lds;
#pragma unroll
    for (int i = 0; i < 2; ++i)
#pragma unroll
        for (int m = 0; m < 2; ++m) red[(wid * 4 + i * 2 + m) * 64 + lane] = c[i][m];
    __syncthreads();
    if (wid == 0) {
        const int lca = pn * 128 + cgi * 16 + 4 * fq;
#pragma unroll
        for (int m = 0; m < 2; ++m) { const int sb = m * 16 + fr; const float r = rs32[sb];
            f32x4 uc[2];
#pragma unroll
            for (int i = 0; i < 2; ++i) { f32x4 s = red[(i * 2 + m) * 64 + lane];
#pragma unroll
                for (int w = 1; w < 8; ++w) s += red[(w * 4 + i * 2 + m) * 64 + lane];
                s = s * r; const int lc = i * DFF + lca; const size_t so = ((size_t)(L * MS + sb) * 2) * DFF2 + lc;
                const f32x4 s0 = *(const f32x4*)(st + so), s1 = *(const f32x4*)(st + so + DFF2);
                uc[i] = *(const f32x4*)(cb + lc) + *(const f32x4*)(cw + lc) * s0 + *(const f32x4*)(cw + DFF2 + lc) * s1 + *(const f32x4*)(cw + 2 * DFF2 + lc) * s;
                *(f32x4*)(out + O_FFC_S + so) = s1; *(f32x4*)(out + O_FFC_S + so + DFF2) = s; }
            f32x4 a;
#pragma unroll
            for (int e = 0; e < 4; ++e) a[e] = gelu_tanh(uc[0][e]) * uc[1][e];
            *(u32x2*)((bf16*)(ws + WS_ACT) + (size_t)(MP + sb) * DFF + lca) = pack4(a); }
    }
    __syncthreads();
}
struct EpiGate {
    static constexpr bool PERM = false, AFTER_DRAIN = false;
    unsigned char* ws; const LAS float* rs; float* PSSn; size_t pinoff; size_t xin, xout; mutable int slot; mutable int only = -1;
    __device__ __forceinline__ float warm(int fr, int fq, int cg) const {
        const bf16* Xr = (const bf16*)(ws + xin); const bf16* PIN = (const bf16*)(ws + pinoff); const size_t o0 = (size_t)(MP + fr) * DM + cg * 16 + 4 * fq, o1 = o0 + (size_t)16 * DM;
        return (bf2f(Xr[o0]) + bf2f(Xr[o1])) + (bf2f(PIN[o0]) + bf2f(PIN[o1])); }
    __device__ __forceinline__ void thin(f32x4 s0, f32x4 s1, int cg, int fr, int fq) const {
        const LAS float* rsl = rs + 7 * 256;
        const bf16* Xr = (const bf16*)(ws + xin); bf16* XB = (bf16*)(ws + xout); const bf16* PIN = (const bf16*)(ws + pinoff);
        const int nx = (int)((PSSn - (float*)(ws + WS_PSS)) / (16 * MPAD));
#pragma unroll
        for (int m = 0; m < 2; ++m) { const size_t o = (size_t)(MP + 16 * m + fr) * DM + cg * 16 + 4 * fq; f32x4 v = (m ? s1 : s0) * rsl[16 * m + fr];
            const f32x4 pv = unpack4(*(const u32x2*)(PIN + o));
            v[0] = sigmoidf_(v[0]) * pv[0]; v[1] = sigmoidf_(v[1]) * pv[1]; v[2] = sigmoidf_(v[2]) * pv[2]; v[3] = sigmoidf_(v[3]) * pv[3];
            const u32x2 xw = pack4(unpack4(*(const u32x2*)(Xr + o)) + v); const f32x4 x = unpack4(xw);
            *(u32x2*)(XB + o) = xw;
            float ssq = (x[0] * x[0] + x[1] * x[1]) + (x[2] * x[2] + x[3] * x[3]);
            ssq += __shfl_xor(ssq, 16); ssq += __shfl_xor(ssq, 32);
            if (fq == 0) ((float*)(ws + WS_SPSS))[nx * 2048 + cg * 32 + 16 * m + fr] = ssq; }
    }
    __device__ __forceinline__ void operator()(AccRef acc, const pg8::Unit& u, int wr, int wc, int fr, int fq) const {
        fr = launder_v(fr); fq = launder_v(fq);
        const LAS float* rsl = rs + slot * 256; ++slot;
        const bf16* __restrict__ Xr = (const bf16*)(ws + xin); bf16* __restrict__ XB = (bf16*)(ws + xout); const bf16* __restrict__ PIN = (const bf16*)(ws + pinoff);
#pragma unroll
        for (int ai = 0; ai < 2; ++ai) {
#pragma unroll
          for (int mh = 0; mh < 2; ++mh) {
            u32x2 xv[4][2][2]; u32x2 pv[4][2][2];
#pragma unroll
            for (int m = 2 * mh; m < 2 * mh + 2; ++m) { const int row = u.pm * 256 + EPI_ROWL;
                EPI_FOR_COLS { const int col = u.pn * 256 + EPI_COLL; if (row < MTOT) { xv[m][bj][n] = *(const u32x2*)(Xr + (size_t)row * DM + col); pv[m][bj][n] = *(const u32x2*)(PIN + (size_t)row * DM + col); } } }
#pragma unroll
            for (int m = 2 * mh; m < 2 * mh + 2; ++m) { const int rl = EPI_ROWL, row = u.pm * 256 + rl; const float r = rsl[rl]; float ssq = 0.f;
                EPI_FOR_COLS { const int col = u.pn * 256 + EPI_COLL;
                    if (row < MTOT) { f32x4 v = acc[ai][bj][m][n] * r; const u32x2 pw = pv[m][bj][n];
                        v[0] = sigmoidf_(v[0]) * __builtin_bit_cast(float, pw.x << 16); v[1] = sigmoidf_(v[1]) * __builtin_bit_cast(float, pw.x & 0xffff0000u);
                        v[2] = sigmoidf_(v[2]) * __builtin_bit_cast(float, pw.y << 16); v[3] = sigmoidf_(v[3]) * __builtin_bit_cast(float, pw.y & 0xffff0000u);
                        const u32x2 xw = pack4(unpack4(xv[m][bj][n]) + v); const f32x4 x = unpack4(xw);
                        *(u32x2*)(XB + (size_t)row * DM + col) = xw;
                        ssq += (x[0] * x[0] + x[1] * x[1]) + (x[2] * x[2] + x[3] * x[3]); } }
                ssq += __shfl_xor(ssq, 16); ssq += __shfl_xor(ssq, 32);
                if (fq == 0) { if (row < MP) PSSn[(size_t)(u.pn * 4 + wc) * MPAD + row] = ssq;
                    else if (only >= 0 && row < MTOT) { const int nx = (int)((PSSn - (float*)(ws + WS_PSS)) / (16 * MPAD));
                        ((float*)(ws + WS_SPSS))[nx * 2048 + (u.pn * 16 + (only >> 1) * 8 + wc * 2 + (only & 1)) * 32 + (row - MP)] = ssq; } } }
          }
        }
    }
};
struct EpiPin {
    static constexpr bool PERM = false, AFTER_DRAIN = false;
    unsigned char* ws; mutable int Lthin = -1; mutable int only = -1;
    __device__ __forceinline__ void operator()(AccRef acc, const pg8::Unit& u, int wr, int wc, int fr, int fq) const {
        fr = launder_v(fr); fq = launder_v(fq);
        const int L = Lthin >= 0 ? Lthin : u.pn >> 2, pm = Lthin >= 0 ? u.pm : u.pm - L * NMT, pn = Lthin >= 0 ? u.pn : u.pn & 3;
        bf16* PIN = (bf16*)(ws + WS_PIN) + (size_t)L * MPAD * DM;
        EPI_FOR_ROWS { const int rl = EPI_ROWL, row = pm * 256 + rl;
            if (row < MTOT) EPI_FOR_COLS { const int col = pn * 256 + EPI_COLL; *(u32x2*)(PIN + (size_t)row * DM + col) = pack4(acc[ai][bj][m][n]); } }
    }
};
struct PinOrder {
    int start, stride, count, Lb;
    __device__ __forceinline__ bool next(int i, pg8::Unit& u) const { if (i >= count) return false; const int idx = start + i * stride; if (idx >= 512) return false; const int L = Lb + (idx >> 8), w = idx & 255; u.pm = L * NMT + (w >> 2); u.pn = L * 4 + (w & 3); return true; }
    __device__ __forceinline__ void a_ready(const pg8::Unit&) const {}
    __device__ __forceinline__ void done(const pg8::Unit&) const {}
};
struct EpiT {
    static constexpr bool PERM = false, AFTER_DRAIN = false;
    bf16* T; mutable int only = -1;
    __device__ __forceinline__ void operator()(AccRef acc, const pg8::Unit& u, int wr, int wc, int fr, int fq) const {
        fr = launder_v(fr); fq = launder_v(fq);
        bf16* Tt = T + (size_t)u.pm * 65536;
        EPI_FOR_ROWS { const int rl = EPI_ROWL;
            EPI_FOR_COLS { *(u32x2*)(Tt + rl * 256 + EPI_COLL) = pack4(acc[ai][bj][m][n]); } }
    }
};
__device__ __forceinline__ f32x4 rope4(f32x4 v, const float* rt  , int d0) {
    const f32x4 cs = *(const f32x4*)(rt + 2 * d0);
    f32x4 o; o[0] = v[0] * cs[0] - v[1] * cs[1]; o[1] = v[1] * cs[0] + v[0] * cs[1]; o[2] = v[2] * cs[2] - v[3] * cs[3]; o[3] = v[3] * cs[2] + v[2] * cs[3]; return o;
}
struct EpiQ {
    static constexpr bool PERM = false, AFTER_DRAIN = false;
    unsigned char* ws; const LAS float* rs; mutable int slot; mutable int only = -1;
    __device__ __forceinline__ void operator()(AccRef acc, const pg8::Unit& u, int wr, int wc, int fr, int fq) const {
        fr = launder_v(fr); fq = launder_v(fq);
        const LAS float* rsl = rs + slot * 256; ++slot;
        bf16* Q = (bf16*)(ws + WS_Q); bf16* QR = (bf16*)(ws + WS_QR); float* GT = (float*)(ws + WS_GT); const float* RT = (const float*)(ws + WS_ROPE);
        EPI_FOR_ROWS { const int rl = EPI_ROWL, row = u.pm * 256 + rl; const float r = rsl[rl];
            const float* rt = RT + (size_t)(row < MP ? (row & (SEQ - 1)) : SEQ) * 64;
            if (row < MTOT) EPI_FOR_COLS { const int col = u.pn * 256 + EPI_COLL;
                if (u.pn < 4) { const f32x4 v = acc[ai][bj][m][n] * (r * C2);
                    *(u32x2*)(Q + (size_t)row * DM + col) = pack4(v);
                    *(u32x2*)(QR + (size_t)row * DM + col) = pack4(rope4(v, rt, (col & 63) >> 1)); }
                else if (col < NQG) { f32x4 v = acc[ai][bj][m][n] * r;
                    v[0] = sigmoidf_(v[0]); v[1] = sigmoidf_(v[1]); v[2] = sigmoidf_(v[2]); v[3] = sigmoidf_(v[3]);
                    *(f32x4*)(GT + (size_t)row * 48 + (col - 1024)) = v; } } }
    }
};
struct EpiKV {
    static constexpr bool PERM = false, AFTER_DRAIN = false;
    float* out; unsigned char* ws; const LAS float* rs; mutable int slot; mutable int only = -1;
    __device__ __forceinline__ void operator()(AccRef acc, const pg8::Unit& u, int wr, int wc, int fr, int fq) const {
        fr = launder_v(fr); fq = launder_v(fq);
        const LAS float* rsl = rs + slot * 256; ++slot;
        bf16* CA = (bf16*)(ws + WS_CMPA); bf16* KS = (bf16*)(ws + WS_KS); bf16* VTS = (bf16*)(ws + WS_VTS); bf16* KW = (bf16*)(ws + WS_KW); bf16* VTW = (bf16*)(ws + WS_VTW); const float* RT = (const float*)(ws + WS_ROPE);
        EPI_FOR_ROWS { const int rl = EPI_ROWL, row = u.pm * 256 + rl; const float r = rsl[rl];
            if (row < MTOT) {
            const bool smp = row >= MP; const int b = row >> 12, t = row & (SEQ - 1), sb = row - MP;
            const float* rt = RT + (size_t)(smp ? SEQ : t) * 64;
            EPI_FOR_COLS { const int col = u.pn * 256 + EPI_COLL; const int j = col >> 7, g = (col >> 6) & 1, e0 = col & 63;
                f32x4 v = acc[ai][bj][m][n] * r;
                if (j < 2) {
                    if (!smp) { *(f32x4*)(out + O_CMP_P + (size_t)row * 256 + col) = v;
                        *(u32x2*)(CA + ((size_t)j * CMP_ROWS + (size_t)(g * NB + b) * 256 + (t >> 4)) * 1024 + (t & 15) * 64 + e0) = pack4(v); }
                    else *(f32x4*)(out + O_CMP_S + (size_t)sb * 256 + col) = v;
                } else if (j == 2 || j == 4) {
                    const int d0 = e0 >> 1; const f32x4 q = rope4(v, rt, d0);
                    const int lc = (j - 2) * 128 + g * 64;
                    float* orow = nullptr;
                    if (j == 2) orow = smp ? out + O_SLC_S + (size_t)sb * 256 : out + O_SLC_P + (size_t)row * 256;
                    else if (smp) orow = out + O_WIN_S + ((size_t)sb * 512 + 511) * 256;
                    else if (t >= SEQ - 512) orow = out + O_WIN_P + ((size_t)b * 512 + (t - (SEQ - 512))) * 256;
                    if (orow) { float* p = orow + (lc & 255) + d0; *(f32x2*)p = (f32x2){q[0], q[2]}; *(f32x2*)(p + 32) = (f32x2){q[1], q[3]}; }
                    if (!smp) *(u32x2*)((j == 2 ? KS : KW) + ((size_t)(b * NG + g) * SEQ + t) * 64 + e0) = pack4(q);
                } else {
                    const int lc = 128 + g * 64 + e0;
                    float* orow = nullptr;
                    if (j == 3) orow = smp ? out + O_SLC_S + (size_t)sb * 256 : out + O_SLC_P + (size_t)row * 256;
                    else if (smp) orow = out + O_WIN_S + ((size_t)sb * 512 + 511) * 256;
                    else if (t >= SEQ - 512) orow = out + O_WIN_P + ((size_t)b * 512 + (t - (SEQ - 512))) * 256;
                    if (orow) *(f32x4*)(orow + lc) = v;
                    if (!smp) { bf16* vt = (j == 3 ? VTS : VTW) + ((size_t)(b * NG + g) * 64 + e0) * SEQ + t;
                        vt[0] = (bf16)f2bf(v[0]); vt[SEQ] = (bf16)f2bf(v[1]); vt[2 * SEQ] = (bf16)f2bf(v[2]); vt[3 * SEQ] = (bf16)f2bf(v[3]); }
                } } } }
    }
};

struct CmpOrder {
    int G, c, lo, hi;
    __device__ __forceinline__ bool next(int i, pg8::Unit& u) const { const int L = lo + i * G + c; if (L >= hi) return false; u.pm = L; u.pn = L / (CMP_ROWS / 256); return true; }
    __device__ __forceinline__ void a_ready(const pg8::Unit&) const {}
    __device__ __forceinline__ void done(const pg8::Unit&) const {}
};

__device__ __forceinline__ float rcp_fast(float x) { return __builtin_amdgcn_rcpf(x); }
__device__ __forceinline__ float softplus_neg(float lam) { const float e = __expf(-lam); return e < 0.03f ? e * (1.0f - e * (0.5f - e * ((1.0f / 3.0f) - 0.25f * e))) : (lam < -20.f ? -lam : __logf(1.0f + e)); }
__device__ __forceinline__ float sigmoid_fast(float x) { return rcp_fast(1.0f + __expf(-x)); }
__device__ __forceinline__ int rg2_unit(int bid, int G, int k) {
    constexpr int NU = 257 * 16;
    if (G != 256) { const int un = bid + k * G; return un < NU ? un : -1; }
    if (bid < 16) return k < 14 ? bid + 256 * k : (k == 14 ? 4096 + bid : -1);
    if (bid < 48) return k < 16 ? bid + 256 * k : (k == 16 ? (bid & 15) + 256 * (14 + ((bid >> 4) - 1)) : -1);
    return k < 16 ? bid + 256 * k : -1;
}
__device__ __forceinline__ void rg2_phase(KP P, LAS unsigned char* lds, int L, int tid, int lane, int wave, int G) {
    unsigned char* ws = P->ws;
    const bf16* XR = (const bf16*)(ws + WS_XR); bf16* HL = (bf16*)(ws + WS_HL); bf16* AC = (bf16*)(ws + WS_AC);
    const bf16* WG = (const bf16*)(ws + WS_WGA) + (size_t)L * 2 * 16 * 80 * 96;
    const float* cw = (const float*)P->in[16] + (size_t)L * 4 * DRNN; const float* cb = (const float*)P->in[17] + (size_t)L * DRNN;
    const float* b_a = (const float*)P->in[19] + (size_t)L * DRNN; const float* b_x = (const float*)P->in[21] + (size_t)L * DRNN; const float* lam = (const float*)P->in[22] + (size_t)L * DRNN;
    const float* st_c = (const float*)P->in[7] + (size_t)L * MS * 3 * DRNN; const float* st_h = (const float*)P->in[8] + (size_t)L * MS * DRNN;
    LAS bf16* wab = (LAS bf16*)(lds);
    LAS float* xrt = (LAS float*)(lds + 33280);
    LAS float* xcf = (LAS float*)(lds + 54720);
    LAS bf16* xcb = (LAS bf16*)(lds + 75200);
    LAS float* af = (LAS float*)(lds + 88512);
    LAS float* uf = (LAS float*)(lds + 108992);
    LAS float* agg = (LAS float*)(lds + 129472);
    LAS float* cws = (LAS float*)(lds + 132032);
    const int NU = 257 * 16, bid = launder_s(blockIdx.x);
    int cur_n = -1; bool have_pf = false; u32x2 pf[3];
    for (int uk = 0, un = rg2_unit(bid, G, 0); un >= 0; ++uk, un = rg2_unit(bid, G, uk)) {
        const int tl = un >> 4, n = un & 15, c0 = n * RGB; const bool smp = (tl == 256);
        const int m0 = tl * 64, t0 = m0 & (SEQ - 1), b = m0 >> 12;
        if (n != cur_n) {
            cur_n = n;
            for (int i = tid; i < 2 * 80 * 12; i += 512) { const int ck = i % 12, rw = i / 12; const int ax = rw / 80, j = rw % 80;
                *(LAS u32x4*)(wab + (size_t)rw * 104 + ck * 8) = *(const u32x4*)(WG + ((size_t)(ax * 16 + n) * 80 + j) * 96 + ck * 8); }
            for (int i = tid; i < 8 * 80; i += 512) { const int k = i / 80, c = i % 80, ch = c0 + c;
                cws[i] = (k < 4) ? cw[k * DRNN + ch] : (k == 4) ? cb[ch] : (k == 5) ? b_a[ch] : (k == 6) ? b_x[ch] : softplus_neg(lam[ch]); }
            for (int i = tid; i < 64 * 24; i += 512) xcb[(i / 24) * 104 + 80 + (i % 24)] = 0;
        }
        if (!smp) {
            if (!have_pf) {
#pragma unroll
                for (int k = 0; k < 3; ++k) { const int i = tid + 512 * k, r = i / 20, q = i % 20; pf[k] = (u32x2){0u, 0u};
                    if (i < 67 * 20 && t0 + r - 3 >= 0) pf[k] = *(const u32x2*)(XR + (size_t)(m0 + r - 3) * DRNN + c0 + 4 * q); } }
#pragma unroll
            for (int k = 0; k < 3; ++k) { const int i = tid + 512 * k, r = i / 20, q = i % 20; if (i < 67 * 20) *(LAS f32x4*)(xrt + r * 80 + 4 * q) = unpack4(pf[k]); }
            { const int un2 = rg2_unit(bid, G, uk + 1); have_pf = false;
              if (un2 >= 0 && (un2 >> 4) != 256) { const int m2 = (un2 >> 4) * 64, t2 = m2 & (SEQ - 1), c2 = (un2 & 15) * RGB; have_pf = true;
#pragma unroll
                for (int k = 0; k < 3; ++k) { const int i = tid + 512 * k, r = i / 20, q = i % 20; pf[k] = (u32x2){0u, 0u};
                    if (i < 67 * 20 && t2 + r - 3 >= 0) pf[k] = *(const u32x2*)(XR + (size_t)(m2 + r - 3) * DRNN + c2 + 4 * q); } } }
            __syncthreads();
            for (int rep_ = 0; rep_ < 1 + 4 * ((PROBE_DUP >> 23) & 1); ++rep_)
#pragma unroll
            for (int i = 0; i < 10; ++i) { const int e = tid + 512 * i, r = e / 80, c = e % 80;
                const float xc = cws[320 + c] + cws[c] * xrt[r * 80 + c] + cws[80 + c] * xrt[(r + 1) * 80 + c] + cws[160 + c] * xrt[(r + 2) * 80 + c] + cws[240 + c] * xrt[(r + 3) * 80 + c];
                xcf[e] = xc; xcb[r * 104 + c] = (bf16)f2bf(xc); }
        } else {
            __syncthreads();
            for (int e = tid; e < 64 * 80; e += 512) { const int r = e / 80, c = e % 80, ch = c0 + c; float xc = 0.f;
                if (r < MS) { xc = cws[320 + c] + cws[240 + c] * bf2f(XR[(size_t)(MP + r) * DRNN + ch]);
#pragma unroll
                    for (int k = 0; k < 3; ++k) xc += cws[k * 80 + c] * st_c[((size_t)r * 3 + k) * DRNN + ch]; }
                xcf[e] = xc; xcb[r * 104 + c] = (bf16)f2bf(xc); }
        }
        __syncthreads();
        for (int rep3_ = 0; rep3_ < 1 + 4 * ((PROBE_DUP >> 24) & 1); ++rep3_)
        { const int mt = wave & 3, jt0 = (wave >> 2) ? 3 : 0, jt1 = (wave >> 2) ? 5 : 3, fr = lane & 15, fq = lane >> 4;
            for (int jt = jt0; jt < jt1; ++jt) {
                f32x4 accA = (f32x4){0.f, 0.f, 0.f, 0.f}, accX = accA;
#pragma unroll
                for (int ks = 0; ks < 3; ++ks) {
                    const bf16x8 a = *(const LAS bf16x8*)(xcb + (size_t)(16 * mt + fr) * 104 + 32 * ks + 8 * fq);
                    const bf16x8 ba = *(const LAS bf16x8*)(wab + (size_t)(16 * jt + fr) * 104 + 32 * ks + 8 * fq);
                    const bf16x8 bx = *(const LAS bf16x8*)(wab + (size_t)(80 + 16 * jt + fr) * 104 + 32 * ks + 8 * fq);
                    accA = __builtin_amdgcn_mfma_f32_16x16x32_bf16(a, ba, accA, 0, 0, 0);
                    accX = __builtin_amdgcn_mfma_f32_16x16x32_bf16(a, bx, accX, 0, 0, 0);
                }
                const int c = 16 * jt + fr, ch = c0 + c;
                const float ba_ = cws[400 + c], bx_ = cws[480 + c], sp = cws[560 + c];
#pragma unroll
                for (int e = 0; e < 4; ++e) { const int r = 16 * mt + 4 * fq + e;
                    const float rg = sigmoid_fast(accA[e] + ba_), ig = sigmoid_fast(accX[e] + bx_);
                    const float la = -8.0f * rg * sp, a = __expf(la), x2 = 2.0f * la;
                    const float em = x2 * (1.0f + x2 * 0.5f * (1.0f + x2 * (1.0f / 3.0f) * (1.0f + x2 * 0.25f * (1.0f + x2 * 0.2f))));
                    float mult = __builtin_amdgcn_sqrtf(-em); if (!smp && t0 + r == 0) mult = 1.0f;
                    const float u = mult * (ig * xcf[r * 80 + c]);
                    if (!smp) { af[r * 80 + c] = a; uf[r * 80 + c] = u; }
                    else if (r < MS) { HL[(size_t)(MP + r) * DRNN + ch] = (bf16)f2bf(a * st_h[(size_t)r * DRNN + ch] + u); AC[(size_t)(MP + r) * DRNN + ch] = 0; } }
            } }
        __syncthreads();
        for (int rep4_ = 0; rep4_ < 1 + 4 * ((PROBE_DUP >> 25) & 1); ++rep4_)
        if (!smp) {
            const int ch = tid % 80, seg = tid / 80; float hs[16], ps[16];
            if (tid < 320) { float h = 0.f, p = 1.f;
#pragma unroll
                for (int r = 0; r < 16; ++r) { const float a = af[(seg * 16 + r) * 80 + ch], u = uf[(seg * 16 + r) * 80 + ch]; h = a * h + u; p *= a; hs[r] = h; ps[r] = p; }
                agg[(seg * 80 + ch) * 2] = p; agg[(seg * 80 + ch) * 2 + 1] = h; }
            __syncthreads();
            if (tid < 320) { float cy = 0.f, pc = 1.f;
                for (int s = 0; s < seg; ++s) { const float pp = agg[(s * 80 + ch) * 2], hh = agg[(s * 80 + ch) * 2 + 1]; cy = pp * cy + hh; pc *= pp; }
                bf16* hp = HL + (size_t)(m0 + seg * 16) * DRNN + c0 + ch; bf16* ap = AC + (size_t)(m0 + seg * 16) * DRNN + c0 + ch;
#pragma unroll
                for (int r = 0; r < 16; ++r) { hp[(size_t)r * DRNN] = (bf16)f2bf(hs[r] + ps[r] * cy); ap[(size_t)r * DRNN] = (bf16)f2bf(ps[r] * pc); } }
            else if (t0 == SEQ - 64 && tid >= 320 && tid < 320 + 80) { const int c = tid - 320;
#pragma unroll
                for (int k = 0; k < 3; ++k) P->out[O_RGC_P + ((size_t)(L * NB + b) * 3 + k) * DRNN + c0 + c] = xrt[(64 + k) * 80 + c]; }
        }
        __syncthreads();
    }
}
__device__ __forceinline__ void rg3_phase(KP P, LAS unsigned char* lds, int L, int tid, int G) {
    unsigned char* ws = P->ws;
    const bf16* HL = (const bf16*)(ws + WS_HL); const bf16* AC = (const bf16*)(ws + WS_AC); const bf16* Y = (const bf16*)(ws + WS_Y); bf16* Gb = (bf16*)(ws + WS_G);
    LAS float* cmb = (LAS float*)lds;
    const int oc = tid % 160, grp = tid / 160, c = oc * 8; const bool act = grp < 3;
    const f32x4 one4 = (f32x4){1.f, 1.f, 1.f, 1.f}, zero4 = (f32x4){0.f, 0.f, 0.f, 0.f};
    {
        const float* st_c = (const float*)P->in[7] + (size_t)L * MS * 3 * DRNN; const bf16* XR = (const bf16*)(ws + WS_XR);
        for (int e = launder_s(blockIdx.x) * 512 + tid; e < MS * 3 * DRNN; e += G * 512) { const int sb = e / (3 * DRNN), k = (e / DRNN) % 3, ch = e % DRNN;
            P->out[O_RGC_S + ((size_t)(L * MS + sb) * 3 + k) * DRNN + ch] = (k < 2) ? st_c[((size_t)sb * 3 + k + 1) * DRNN + ch] : bf2f(XR[(size_t)(MP + sb) * DRNN + ch]); }
    }
    for (int tl = launder_s(blockIdx.x); tl < 257; tl += G) {
        const bool smp = (tl == 256); const int m0 = tl * 64, b = m0 >> 12, kc = smp ? 0 : ((m0 & (SEQ - 1)) >> 6);
        if (act) {
            f32x4 cy0 = zero4, cy1 = zero4, ap0 = one4, ap1 = one4;
            const int lo = grp * kc / 3, hi = (grp + 1) * kc / 3;
            for (int kk = lo; kk < hi; kk += 4) {
                u32x4 aw[4], hw[4];
#pragma unroll
                for (int q = 0; q < 4; ++q) { aw[q] = (u32x4){0x3f803f80u, 0x3f803f80u, 0x3f803f80u, 0x3f803f80u}; hw[q] = (u32x4){0u, 0u, 0u, 0u};
                    if (kk + q < hi) { const size_t mr = (size_t)(b * SEQ + (kk + q) * 64 + 63) * DRNN + c; aw[q] = *(const u32x4*)(AC + mr); hw[q] = *(const u32x4*)(HL + mr); } }
#pragma unroll
                for (int q = 0; q < 4; ++q) { f32x4 a0, a1, h0, h1; unpack8(aw[q], a0, a1); unpack8(hw[q], h0, h1); cy0 = a0 * cy0 + h0; cy1 = a1 * cy1 + h1; ap0 *= a0; ap1 *= a1; }
            }
            *(LAS f32x4*)(cmb + (grp * 2 + 0) * 1280 + c) = ap0; *(LAS f32x4*)(cmb + (grp * 2 + 0) * 1280 + c + 4) = ap1;
            *(LAS f32x4*)(cmb + (grp * 2 + 1) * 1280 + c) = cy0; *(LAS f32x4*)(cmb + (grp * 2 + 1) * 1280 + c + 4) = cy1;
        }
        __syncthreads();
        if (act) {
            f32x4 cy0 = zero4, cy1 = zero4;
#pragma unroll
            for (int g2 = 0; g2 < 3; ++g2) {
                const f32x4 A0 = *(const LAS f32x4*)(cmb + (g2 * 2 + 0) * 1280 + c), A1 = *(const LAS f32x4*)(cmb + (g2 * 2 + 0) * 1280 + c + 4);
                const f32x4 H0 = *(const LAS f32x4*)(cmb + (g2 * 2 + 1) * 1280 + c), H1 = *(const LAS f32x4*)(cmb + (g2 * 2 + 1) * 1280 + c + 4);
                cy0 = A0 * cy0 + H0; cy1 = A1 * cy1 + H1; }
            const int nr = smp ? MS : 64;
            for (int r0 = grp; r0 < nr; r0 += 12) {
                u32x4 hlw[4], acw[4], yw[4];
#pragma unroll
                for (int q = 0; q < 4; ++q) { const int r = r0 + 3 * q; hlw[q] = (u32x4){0u, 0u, 0u, 0u}; acw[q] = hlw[q]; yw[q] = hlw[q];
                    if (r < nr) { const size_t mr = (size_t)(m0 + r) * DRNN + c; hlw[q] = *(const u32x4*)(HL + mr); acw[q] = *(const u32x4*)(AC + mr); yw[q] = *(const u32x4*)(Y + mr); } }
#pragma unroll
                for (int q = 0; q < 4; ++q) { const int r = r0 + 3 * q;
                    if (r < nr) { const size_t mr = (size_t)(m0 + r) * DRNN + c;
                        f32x4 hl0, hl1, ac0, ac1; unpack8(hlw[q], hl0, hl1); unpack8(acw[q], ac0, ac1);
                        const f32x4 h0 = hl0 + ac0 * cy0, h1 = hl1 + ac1 * cy1; u32x4 o;
                        o.x = pk2(__builtin_bit_cast(float, yw[q].x << 16) * h0[0], __builtin_bit_cast(float, yw[q].x & 0xffff0000u) * h0[1]);
                        o.y = pk2(__builtin_bit_cast(float, yw[q].y << 16) * h0[2], __builtin_bit_cast(float, yw[q].y & 0xffff0000u) * h0[3]);
                        o.z = pk2(__builtin_bit_cast(float, yw[q].z << 16) * h1[0], __builtin_bit_cast(float, yw[q].z & 0xffff0000u) * h1[1]);
                        o.w = pk2(__builtin_bit_cast(float, yw[q].w << 16) * h1[2], __builtin_bit_cast(float, yw[q].w & 0xffff0000u) * h1[3]);
                        *(u32x4*)(Gb + mr) = o;
                        if (smp) { float* op = P->out + O_RGH_S + (size_t)(L * MS + r) * DRNN + c; *(f32x4*)op = h0; *(f32x4*)(op + 4) = h1; }
                        else if (kc == 63 && r == 63) { float* op = P->out + O_RGH_P + (size_t)(L * NB + b) * DRNN + c; *(f32x4*)op = h0; *(f32x4*)(op + 4) = h1; } } }
            }
        }
        __syncthreads();
    }
}
__device__ __forceinline__ void cmp2_phase(KP P, LAS unsigned char* lds, int tid, int lane, int wave, int G) {
    unsigned char* ws = P->ws;
    const bf16* T = (const bf16*)(ws + WS_T); const float* B1P = (const float*)(ws + WS_B1F); const float* b1 = (const float*)P->in[28]; const float* w2 = (const float*)P->in[29];
    bf16* KC = (bf16*)(ws + WS_KC); bf16* VCT = (bf16*)(ws + WS_VCT); float* KCS = (float*)(ws + WS_KCS); float* VCS = (float*)(ws + WS_VCS);
    LAS bf16* w2b = (LAS bf16*)lds;
    LAS float* b1s = (LAS float*)(lds + 34816);
    LAS bf16* hidb = (LAS bf16*)(lds + 35840);
    for (int i = tid; i < 2 * 128 * 64; i += 512) { const int d = i & 63, e = (i >> 6) & 127, j = i >> 13; w2b[(j * 64 + d) * 136 + e] = (bf16)f2bf(w2[i]); }
    if (tid < 256) { float s = b1[tid];
        for (int l = 0; l < 32; ++l) s += B1P[l * 256 + tid];
        b1s[tid] = s; }
    __syncthreads();
    const int NU = 2 * CMP_ROWS / 64;
    const int mt = wave & 3, nh = wave >> 2, fr = lane & 15, fq = lane >> 4;
    for (int un = launder_s(blockIdx.x); un < NU; un += G) {
        const int slot0 = un * 64, j = slot0 / CMP_ROWS, row0 = slot0 % CMP_ROWS;
#pragma unroll
        for (int q = 0; q < 4; ++q) { const int idx = tid + 512 * q, r = idx >> 5, e4 = (idx & 31) * 4; const int row = row0 + r;
            const bool smp = row >= CMP_ROWS_P; const int cb = smp ? ((row - CMP_ROWS_P) & 511) : (row & 255); const bool valid = cb < (smp ? NCB_S : NCB_P);
            f32x4 h = (f32x4){0.f, 0.f, 0.f, 0.f};
            if (valid) { const f32x4 a = unpack4(*(const u32x2*)(T + (size_t)(slot0 + r) * 256 + e4)), bq = unpack4(*(const u32x2*)(T + (size_t)(slot0 + r + 1) * 256 + 128 + e4)), bb = *(const LAS f32x4*)(b1s + j * 128 + e4);
#pragma unroll
                for (int k = 0; k < 4; ++k) h[k] = gelu_tanh(a[k] + bq[k] + bb[k]); }
            *(LAS u32x2*)(hidb + r * 136 + e4) = (u32x2){pk2(h[0], h[1]), pk2(h[2], h[3])}; }
        __syncthreads();
        f32x4 acc[2];
#pragma unroll
        for (int n = 0; n < 2; ++n) { acc[n] = (f32x4){0.f, 0.f, 0.f, 0.f};
#pragma unroll
            for (int ks = 0; ks < 4; ++ks) { const bf16x8 a = *(const LAS bf16x8*)(hidb + (16 * mt + fr) * 136 + 32 * ks + 8 * fq);
                const bf16x8 b = *(const LAS bf16x8*)(w2b + (j * 64 + 16 * (2 * nh + n) + fr) * 136 + 32 * ks + 8 * fq);
                acc[n] = __builtin_amdgcn_mfma_f32_16x16x32_bf16(a, b, acc[n], 0, 0, 0); } }
#pragma unroll
        for (int n = 0; n < 2; ++n) { const int d = 16 * (2 * nh + n) + fr;
#pragma unroll
            for (int e = 0; e < 4; ++e) { const int row = row0 + 16 * mt + 4 * fq + e; const float o = acc[n][e];
                if (row < CMP_ROWS_P) { const int g = row >> 10, bb = (row >> 8) & 3, cb = row & 255;
                    if (j == 0) KC[((size_t)(bb * NG + g) * 256 + cb) * 64 + 2 * (d & 31) + (d >> 5)] = (bf16)f2bf(o);
                    else VCT[((size_t)(bb * NG + g) * 64 + d) * 256 + cb] = (bf16)f2bf(o); }
                else { const int rr = row - CMP_ROWS_P, g = rr >> 14, sb = (rr >> 9) & 31, cb = rr & 511;
                    (j == 0 ? KCS : VCS)[((size_t)(sb * NG + g) * 512 + cb) * 64 + d] = o; } } }
        __syncthreads();
    }
}
__device__ __forceinline__ void final_phase(KP P, const float* PSScur, const float* SPcur, int lane, int wave, int G) {
    const bf16* X = (const bf16*)(P->ws + xb_off(4)); const float* gf = (const float*)P->in[14];
    f32x4 gg[4];
#pragma unroll
    for (int jj = 0; jj < 4; ++jj) gg[jj] = *(const f32x4*)(gf + 4 * lane + 256 * jj);
    const int NGW = G * 8;
    for (int m0 = launder_s(blockIdx.x) * 8 + wave; m0 < MTOT; m0 += 2 * NGW) {
        float sp[2]; u32x2 xv[2][4];
#pragma unroll
        for (int q = 0; q < 2; ++q) { const int m = m0 + q * NGW; sp[q] = 0.f;
            if (m < MTOT) {
                if (m < MP) { if (lane < 16) sp[q] = PSScur[(size_t)lane * MPAD + m]; } else sp[q] = SPcur[lane * 32 + (m - MP)];
#pragma unroll
                for (int jj = 0; jj < 4; ++jj) xv[q][jj] = *(const u32x2*)(X + (size_t)m * DM + 4 * lane + 256 * jj); } }
#pragma unroll
        for (int q = 0; q < 2; ++q) { const int m = m0 + q * NGW;
            if (m < MTOT) {
                const float rs = rsqrtf(wave_sum(sp[q]) * (1.0f / 1024.0f) + EPS);
                float* o = m < MP ? P->out + O_Y_P + (size_t)m * DM : P->out + O_Y_S + (size_t)(m - MP) * DM;
#pragma unroll
                for (int jj = 0; jj < 4; ++jj) { const int c = 4 * lane + 256 * jj; __builtin_nontemporal_store(unpack4(xv[q][jj]) * rs * gg[jj], (f32x4*)(o + c)); } } }
    }
}

constexpr int AT_KT = 0, AT_KTB = 18432, AT_VT = 36864, AT_VTB = 17408, AT_QS = 71680, AT_LS = 79872, AT_MASK = 88064, AT_QF = 88320, AT_STASH = 121088;
constexpr int AT_ROWB = 144, AT_VROWB = 272;
__device__ __forceinline__ unsigned cvtpk(float lo, float hi) { return pk2(lo, hi); }

template <int MODE>
__device__ __forceinline__ void attn_pass(LAS unsigned char* lds, const bf16* __restrict__ Kg, const bf16* __restrict__ Vtg, int vstride, int tb, int te, const LAS unsigned char* qfl,
                                          int klo, int khi, unsigned long long selmask, float& m_run, float& l_run, f32x16& o0, f32x16& o1, float inv_l, int tokrow, int tid, int lane) {
    if (te <= tb) return;
    const int r32 = lane & 31, hi = lane >> 5, lrow = tid >> 3, lch = tid & 7;
    const unsigned kofs = (unsigned)(lrow * AT_ROWB + lch * 16), vofs = (unsigned)(lrow * AT_VROWB + lch * 16);
    const bf16* kp = Kg + (size_t)lrow * 64 + lch * 8; const bf16* vp = Vtg + (size_t)lrow * vstride + lch * 8;
    u32x4 kreg0 = *(const u32x4*)(kp + (size_t)tb * 8192), kreg1 = *(const u32x4*)(kp + (size_t)tb * 8192 + 4096);
    u32x4 vreg0 = (u32x4){0u, 0u, 0u, 0u}, vreg1 = vreg0;
    if (MODE != 0) { vreg0 = *(const u32x4*)(vp + tb * 128); vreg1 = *(const u32x4*)(vp + tb * 128 + 64); }
    *(LAS u32x4*)(lds + AT_KT + kofs) = kreg0; *(LAS u32x4*)(lds + AT_KT + 64 * AT_ROWB + kofs) = kreg1;
    if (MODE != 0) { *(LAS u32x4*)(lds + AT_VT + vofs) = vreg0; *(LAS u32x4*)(lds + AT_VT + 128 + vofs) = vreg1; }
    __syncthreads();
    for (int t = tb; t < te; ++t) {
        const int buf = (t - tb) & 1, key0 = t * 128;
        if (t + 1 < te) { kreg0 = *(const u32x4*)(kp + (size_t)(t + 1) * 8192); kreg1 = *(const u32x4*)(kp + (size_t)(t + 1) * 8192 + 4096);
            if (MODE != 0) { vreg0 = *(const u32x4*)(vp + (t + 1) * 128); vreg1 = *(const u32x4*)(vp + (t + 1) * 128 + 64); } }
        const bool selA = (MODE == 2) ? ((selmask >> (2 * t)) & 1ull) != 0ull : true, selB = (MODE == 2) ? ((selmask >> (2 * t + 1)) & 1ull) != 0ull : true;
        const bool anyA = selA && (key0 <= khi) && (key0 + 63 >= klo), anyB = selB && (key0 + 64 <= khi) && (key0 + 127 >= klo);
        if (__builtin_amdgcn_ballot_w64(anyA || anyB) != 0ull) {
            const LAS unsigned char* Kb = lds + AT_KT + buf * AT_KTB; const LAS unsigned char* Vb = lds + AT_VT + buf * AT_VTB;
            const bool fullA = selA && (key0 >= klo) && (key0 + 63 <= khi), fullB = selB && (key0 + 64 >= klo) && (key0 + 127 <= khi);
            const bool partial = __builtin_amdgcn_ballot_w64((anyA && !fullA) || (anyB && !fullB)) != 0ull;
            const float base = (m_run == -INFINITY) ? 0.f : -m_run;
            const float ciA = (MODE >= 2) ? ((fullA || (partial && anyA)) ? base : -INFINITY) : 0.f, ciB = (MODE >= 2) ? ((fullB || (partial && anyB)) ? base : -INFINITY) : 0.f;
            f32x16 p[4];
#pragma unroll
            for (int r = 0; r < 16; ++r) { p[0][r] = ciA; p[1][r] = ciA; p[2][r] = ciB; p[3][r] = ciB; }
            __builtin_amdgcn_s_setprio(1);
#pragma unroll
            for (int c = 0; c < 4; ++c)
#pragma unroll
                for (int i = 0; i < 4; ++i) { const bf16x8 a = *(const LAS bf16x8*)(Kb + (32 * i + r32) * AT_ROWB + c * 32 + hi * 16);
                    p[i] = __builtin_amdgcn_mfma_f32_32x32x16_bf16(a, *(const LAS bf16x8*)(qfl + c * 1024), p[i], 0, 0, 0);
                    if (i == 3 && (c & 1)) __builtin_amdgcn_sched_barrier(0); }
            __builtin_amdgcn_s_setprio(0);
            float mx = -INFINITY;
            if (!partial && MODE >= 2) {
#pragma unroll
                for (int r = 0; r < 16; ++r) mx = fmaxf(fmaxf(mx, fmaxf(p[0][r], p[1][r])), fmaxf(p[2][r], p[3][r]));
            } else {
#pragma unroll
                for (int i = 0; i < 4; ++i) { const bool sl = (i < 2) ? selA : selB; const int kb0 = key0 + 32 * i + 4 * hi;
#pragma unroll
                    for (int r = 0; r < 16; ++r) { const int k = kb0 + (r & 3) + 8 * (r >> 2); p[i][r] = (sl && k >= klo && k <= khi) ? p[i][r] : -INFINITY; mx = fmaxf(mx, p[i][r]); } }
            }
            float ls = 0.f;
            if (MODE >= 2) {
                mx = fmaxf(mx, __shfl_xor(mx, 32));
                const bool moved = (m_run == -INFINITY) ? (mx != -INFINITY) : (mx > 0.f);
                if (__builtin_amdgcn_ballot_w64(moved) != 0ull) {
                    const float delta = moved ? mx : 0.f;
                    const float alpha = (m_run == -INFINITY) ? 1.f : __builtin_amdgcn_exp2f(-delta);
                    m_run = moved ? ((m_run == -INFINITY) ? mx : m_run + mx) : m_run;
                    l_run *= alpha;
#pragma unroll
                    for (int r = 0; r < 16; ++r) { o0[r] *= alpha; o1[r] *= alpha; p[0][r] -= delta; p[1][r] -= delta; p[2][r] -= delta; p[3][r] -= delta; }
                }
#pragma unroll
                for (int i = 0; i < 4; ++i)
#pragma unroll
                    for (int r = 0; r < 16; ++r) { p[i][r] = __builtin_amdgcn_exp2f(p[i][r]); ls += p[i][r]; }
            } else {
                float m_use;
                if (MODE == 1) { m_use = (m_run == -INFINITY) ? 0.f : m_run; }
                else {
                    mx = fmaxf(mx, __shfl_xor(mx, 32));
                    const float m_new = fmaxf(m_run, mx); m_use = (m_new == -INFINITY) ? 0.f : m_new;
                    const float alpha = __builtin_amdgcn_exp2f(m_run - m_use);
                    l_run *= alpha; m_run = m_new;
                }
#pragma unroll
                for (int i = 0; i < 4; ++i)
#pragma unroll
                    for (int r = 0; r < 16; ++r) { p[i][r] = __builtin_amdgcn_exp2f(p[i][r] - m_use); ls += p[i][r]; }
            }
            if (MODE != 1) l_run += ls;
            if (MODE == 1) {
                LAS float* QS = (LAS float*)(lds + AT_QS); LAS float* LS = (LAS float*)(lds + AT_LS);
#pragma unroll
                for (int i = 0; i < 4; ++i) {
#pragma unroll
                    for (int r = 0; r < 16; ++r) p[i][r] *= inv_l;
#pragma unroll
                    for (int jq = 0; jq < 4; ++jq) {
                        float q0 = (p[i][4 * jq] + p[i][4 * jq + 1]) + (p[i][4 * jq + 2] + p[i][4 * jq + 3]), l0 = p[i][4 * jq + 3];
#pragma unroll
                        for (int o = 1; o < 8; o <<= 1) { q0 += __shfl_xor(q0, o); l0 += __shfl_xor(l0, o); }
                        if ((lane & 7) == 0) { const int qd = 32 * t + 8 * i + 2 * jq + hi; QS[tokrow * 64 + qd] = q0; LS[tokrow * 64 + qd] = l0; }
                    }
                }
            }
            if (MODE != 0) {
#pragma unroll
                for (int j = 0; j < 8; ++j) {
                    const int i = j >> 1, rb = 8 * (j & 1);
                    u32x4 pw; pw.x = cvtpk(p[i][rb], p[i][rb + 1]); pw.y = cvtpk(p[i][rb + 2], p[i][rb + 3]); pw.z = cvtpk(p[i][rb + 4], p[i][rb + 5]); pw.w = cvtpk(p[i][rb + 6], p[i][rb + 7]);
                    const bf16x8 pb = __builtin_bit_cast(bf16x8, pw);
                    { const LAS unsigned char* vq = Vb + r32 * AT_VROWB + (16 * j + 4 * hi) * 2;
                      const u32x2 lo = *(const LAS u32x2*)vq, hh = *(const LAS u32x2*)(vq + 16);
                      o0 = __builtin_amdgcn_mfma_f32_32x32x16_bf16(__builtin_bit_cast(bf16x8, (u32x4){lo.x, lo.y, hh.x, hh.y}), pb, o0, 0, 0, 0); }
                    { const LAS unsigned char* vq = Vb + (32 + r32) * AT_VROWB + (16 * j + 4 * hi) * 2;
                      const u32x2 lo = *(const LAS u32x2*)vq, hh = *(const LAS u32x2*)(vq + 16);
                      o1 = __builtin_amdgcn_mfma_f32_32x32x16_bf16(__builtin_bit_cast(bf16x8, (u32x4){lo.x, lo.y, hh.x, hh.y}), pb, o1, 0, 0, 0); }
                    if (j & 1) __builtin_amdgcn_sched_barrier(0);
                }
            }
        }
        if (t + 1 < te) { LAS unsigned char* kd = lds + AT_KT + (buf ^ 1) * AT_KTB; *(LAS u32x4*)(kd + kofs) = kreg0; *(LAS u32x4*)(kd + 64 * AT_ROWB + kofs) = kreg1;
            if (MODE != 0) { LAS unsigned char* vd = lds + AT_VT + (buf ^ 1) * AT_VTB; *(LAS u32x4*)(vd + vofs) = vreg0; *(LAS u32x4*)(vd + 128 + vofs) = vreg1; } }
        __syncthreads();
    }
}

__device__ __forceinline__ void attn_prompt_unit(KP P, LAS unsigned char* lds, int b, int g, int t0, int tid, int lane, int wave) {
    unsigned char* ws = P->ws;
    const bf16* Q = (const bf16*)(ws + WS_Q); const bf16* QR = (const bf16*)(ws + WS_QR); const float* GT = (const float*)(ws + WS_GT); bf16* O = (bf16*)(ws + WS_O);
    const int bg = b * NG + g;
    const bf16* KS = (const bf16*)(ws + WS_KS) + (size_t)bg * SEQ * 64; const bf16* VTS = (const bf16*)(ws + WS_VTS) + (size_t)bg * 64 * SEQ;
    const bf16* KW = (const bf16*)(ws + WS_KW) + (size_t)bg * SEQ * 64; const bf16* VTW = (const bf16*)(ws + WS_VTW) + (size_t)bg * 64 * SEQ;
    const bf16* KC = (const bf16*)(ws + WS_KC) + (size_t)bg * 256 * 64; const bf16* VCT = (const bf16*)(ws + WS_VCT) + (size_t)bg * 64 * 256;
    const int r32 = lane & 31, hi = lane >> 5, tok_l = r32 >> 3, hl = r32 & 7, tokrow = wave * 4 + tok_l;
    const int t = t0 + tokrow, mrow = b * SEQ + t, h = g * HPG + hl;
    LAS float* QSb = (LAS float*)(lds + AT_QS); LAS float* LSb = (LAS float*)(lds + AT_LS); LAS unsigned long long* MK = (LAS unsigned long long*)(lds + AT_MASK);
    for (int i = tid; i < 32 * 64; i += 512) { QSb[i] = 0.f; LSb[i] = 0.f; }
    LAS unsigned char* qfl = lds + AT_QF + wave * 4096 + lane * 16;
#pragma unroll
    for (int c = 0; c < 4; ++c) *(LAS bf16x8*)(qfl + c * 1024) = *(const bf16x8*)(Q + (size_t)mrow * DM + h * 64 + c * 16 + hi * 8);
    __syncthreads();
    f32x16 o0, o1;
#pragma unroll
    for (int r = 0; r < 16; ++r) { o0[r] = 0.f; o1[r] = 0.f; }
    LAS unsigned* stash = (LAS unsigned*)(lds + AT_STASH) + wave * 1024 + lane;
    const int cmax = (t >= 31) ? ((t - 31) >> 4) : -1;
    const int ntc = (t0 >> 11) + 1;
    {
        float mc = -INFINITY, lc = 0.f;
        attn_pass<0>(lds, KC, VCT, 256, 0, ntc, qfl, 0, cmax, 0ull, mc, lc, o0, o1, 0.f, tokrow, tid, lane);
        lc += __shfl_xor(lc, 32);
        const float invl = lc > 0.f ? 1.0f / lc : 0.f;
        attn_pass<1>(lds, KC, VCT, 256, 0, ntc, qfl, 0, cmax, 0ull, mc, lc, o0, o1, invl, tokrow, tid, lane);
        const float g0 = GT[(size_t)mrow * 48 + h * 3 + 0];
#pragma unroll
        for (int r = 0; r < 16; ++r) { stash[r * 64] = pk2(g0 * o0[r], g0 * o1[r]); o0[r] = 0.f; o1[r] = 0.f; }
    }
    asm volatile("s_waitcnt lgkmcnt(0)" ::: "memory");
    unsigned long long mymask = 0ull;
    {
        const int cur_w = (t0 + wave * 4) >> 6;
#pragma unroll
        for (int tk = 0; tk < 4; ++tk) {
            const int tr = wave * 4 + tk, s = lane;
            float v = QSb[tr * 64 + s] + (s > 0 ? LSb[tr * 64 + s - 1] : 0.f);
            if (s == 0 || s == cur_w || s + 1 == cur_w) v = INFINITY;
            if (s > cur_w) v = -INFINITY;
            int rank = 0;
            for (int i = 0; i < 64; ++i) { const float x = __builtin_bit_cast(float, __builtin_amdgcn_readlane(__builtin_bit_cast(int, v), i)); rank += (x > v || (x == v && i < s)) ? 1 : 0; }
            const unsigned long long mk = __builtin_amdgcn_ballot_w64(rank < 16);
            if (tok_l == tk) mymask = mk;
        }
    }
    (void)MK;
#pragma unroll
    for (int c = 0; c < 4; ++c) *(LAS bf16x8*)(qfl + c * 1024) = *(const bf16x8*)(QR + (size_t)mrow * DM + h * 64 + c * 16 + hi * 8);
    const int cur = t0 >> 6;
    {
        float ms = -INFINITY, lsum = 0.f;
        attn_pass<2>(lds, KS, VTS, SEQ, 0, (cur >> 1) + 1, qfl, 0, t, mymask, ms, lsum, o0, o1, 0.f, tokrow, tid, lane);
        lsum += __shfl_xor(lsum, 32);
        const float sc = GT[(size_t)mrow * 48 + h * 3 + 1] / lsum;
#pragma unroll
        for (int r = 0; r < 16; ++r) { const unsigned w = stash[r * 64]; stash[r * 64] = pk2(__builtin_bit_cast(float, w << 16) + sc * o0[r], __builtin_bit_cast(float, w & 0xffff0000u) + sc * o1[r]); o0[r] = 0.f; o1[r] = 0.f; }
    }
    f32x16 out0, out1;
    {
        float mw = -INFINITY, lw = 0.f;
        const int wlo = (t0 - 511) > 0 ? (t0 - 511) >> 7 : 0;
        attn_pass<3>(lds, KW, VTW, SEQ, wlo, (cur >> 1) + 1, qfl, t - 511, t, 0ull, mw, lw, o0, o1, 0.f, tokrow, tid, lane);
        lw += __shfl_xor(lw, 32);
        const float sc = GT[(size_t)mrow * 48 + h * 3 + 2] / lw;
#pragma unroll
        for (int r = 0; r < 16; ++r) { const unsigned w = stash[r * 64]; out0[r] = __builtin_bit_cast(float, w << 16) + sc * o0[r]; out1[r] = __builtin_bit_cast(float, w & 0xffff0000u) + sc * o1[r]; }
    }
    bf16* op = O + (size_t)mrow * DM + h * 64 + 4 * hi;
#pragma unroll
    for (int jq = 0; jq < 4; ++jq) {
        u32x2 w0; w0.x = cvtpk(out0[4 * jq], out0[4 * jq + 1]); w0.y = cvtpk(out0[4 * jq + 2], out0[4 * jq + 3]); *(u32x2*)(op + 8 * jq) = w0;
        u32x2 w1; w1.x = cvtpk(out1[4 * jq], out1[4 * jq + 1]); w1.y = cvtpk(out1[4 * jq + 2], out1[4 * jq + 3]); *(u32x2*)(op + 32 + 8 * jq) = w1;
    }
}

constexpr int SM_QN = 0, SM_QR = 2048, SM_SC = 4096, SM_IMP = 36864, SM_SEL = 37888, SM_PTR = 38144, SM_OP = 46336;
__device__ __forceinline__ void smp_scores(const float* __restrict__ kp, const LAS float* q, LAS float* sc, int col, bool valid) {
    float s[8];
#pragma unroll
    for (int hl = 0; hl < 8; ++hl) s[hl] = 0.f;
    if (valid) {
#pragma unroll 4
        for (int d4 = 0; d4 < 16; ++d4) { const f32x4 kv = *(const f32x4*)(kp + 4 * d4);
#pragma unroll
            for (int hl = 0; hl < 8; ++hl) { const f32x4 qv = *(const LAS f32x4*)(q + hl * 64 + 4 * d4); s[hl] += (kv[0] * qv[0] + kv[1] * qv[1]) + (kv[2] * qv[2] + kv[3] * qv[3]); } }
    }
#pragma unroll
    for (int hl = 0; hl < 8; ++hl) sc[hl * 1024 + col] = valid ? s[hl] : -INFINITY;
}
__device__ __forceinline__ void smp_softmax(LAS float* sc, int n, int lane, int wave) {
    LAS float* row = sc + wave * 1024; float mx = -INFINITY;
    for (int i = lane; i < n; i += 64) mx = fmaxf(mx, row[i]);
#pragma unroll
    for (int o = 1; o < 64; o <<= 1) mx = fmaxf(mx, __shfl_xor(mx, o));
    float sum = 0.f;
    for (int i = lane; i < n; i += 64) { const float e = __builtin_amdgcn_exp2f(row[i] - mx); row[i] = e; sum += e; }
    sum = wave_sum(sum); const float inv = 1.0f / sum;
    for (int i = lane; i < n; i += 64) row[i] *= inv;
}
template <bool PTR> __device__ __forceinline__ void smp_pv(const LAS float* sc, const LAS unsigned long long* rp, const float* __restrict__ vbase, int n, LAS float* opart, int tid) {
    const int sl = tid >> 4, dq = tid & 15;
    f32x4 acc[8];
#pragma unroll
    for (int q = 0; q < 8; ++q) acc[q] = (f32x4){0.f, 0.f, 0.f, 0.f};
#pragma unroll 4
    for (int kk = sl; kk < n; kk += 32) {
        f32x4 v = (f32x4){0.f, 0.f, 0.f, 0.f};
        if (PTR) { const float* kp = (const float*)(uintptr_t)rp[kk]; if (kp) v = *(const f32x4*)(kp + 128 + 4 * dq); }
        else v = *(const f32x4*)(vbase + (size_t)kk * 64 + 4 * dq);
#pragma unroll
        for (int q = 0; q < 8; ++q) acc[q] += sc[q * 1024 + kk] * v;
    }
#pragma unroll
    for (int q = 0; q < 8; ++q) *(LAS f32x4*)(opart + (sl * 8 + q) * 64 + 4 * dq) = acc[q];
}
__device__ __forceinline__ float smp_pv_reduce(const LAS float* opart, int hl, int d) {
    float s = 0.f;
#pragma unroll 8
    for (int k = 0; k < 32; ++k) s += opart[(k * 8 + hl) * 64 + d];
    return s;
}
__device__ __forceinline__ void attn_sample_unit(KP P, LAS unsigned char* lds, int sb, int g, int tid, int lane, int wave) {
    unsigned char* ws = P->ws;
    const bf16* Q = (const bf16*)(ws + WS_Q); const bf16* QR = (const bf16*)(ws + WS_QR); const float* GT = (const float*)(ws + WS_GT); bf16* O = (bf16*)(ws + WS_O);
    const float* KCS = (const float*)(ws + WS_KCS) + (size_t)(sb * NG + g) * 512 * 64; const float* VCS = (const float*)(ws + WS_VCS) + (size_t)(sb * NG + g) * 512 * 64;
    const float* cslc = (const float*)P->in[5]; const float* cwin = (const float*)P->in[6]; const int* pt = (const int*)P->in[10] + sb * NPG;
    LAS float* qn = (LAS float*)(lds + SM_QN); LAS float* qr = (LAS float*)(lds + SM_QR); LAS float* sc = (LAS float*)(lds + SM_SC); LAS float* imp = (LAS float*)(lds + SM_IMP);
    LAS int* sel = (LAS int*)(lds + SM_SEL); LAS unsigned long long* rp = (LAS unsigned long long*)(lds + SM_PTR); LAS float* opart = (LAS float*)(lds + SM_OP);
    const int mrow = MP + sb, hl = tid >> 6, d = tid & 63, h = g * HPG + hl;
    { const int e = 2 * (d & 31) + (d >> 5);
      qn[hl * 64 + d] = bf2f(Q[(size_t)mrow * DM + h * 64 + e]); qr[hl * 64 + d] = bf2f(QR[(size_t)mrow * DM + h * 64 + e]); }
    __syncthreads();
    smp_scores(KCS + (size_t)tid * 64, qn, sc, tid, tid < NCB_S);
    __syncthreads();
    smp_softmax(sc, 512, lane, wave);
    __syncthreads();
    smp_pv<false>(sc, rp, VCS, NCB_S, opart, tid);
    if (tid < NSB_S) { float v = 0.f; const int c0 = tid * 4 - 1;
        for (int c = (c0 < 0 ? 0 : c0); c <= c0 + 4 && c < NCB_S; ++c)
#pragma unroll
            for (int q = 0; q < 8; ++q) v += sc[q * 1024 + c];
        if (tid == 0 || tid == 127 || tid == 128) v = INFINITY;
        imp[tid] = v; }
    __syncthreads();
    const float oc = smp_pv_reduce(opart, hl, d);
    if (tid < NSB_S) { const float v = imp[tid]; int rank = 0;
        for (int i = 0; i < NSB_S; ++i) { const float x = imp[i]; rank += (x > v || (x == v && i < tid)) ? 1 : 0; }
        if (rank < 16) sel[rank] = tid; }
    __syncthreads();
#pragma unroll
    for (int q = 0; q < 2; ++q) { const int kk = tid + 512 * q, blk = sel[kk >> 6], pos = blk * 64 + (kk & 63);
        const float* kp = nullptr;
        if (pos < PAST) kp = cslc + ((size_t)pt[pos >> 7] * PGSZ + (pos & 127)) * 256 + g * 64;
        else if (pos == PAST) kp = P->out + O_SLC_S + (size_t)sb * 256 + g * 64;
        rp[kk] = (unsigned long long)(uintptr_t)kp;
        smp_scores(kp, qr, sc, kk, kp != nullptr); }
    __syncthreads();
    smp_softmax(sc, 1024, lane, wave);
    __syncthreads();
    smp_pv<true>(sc, rp, nullptr, 1024, opart, tid);
    __syncthreads();
    const float os = smp_pv_reduce(opart, hl, d);
    __syncthreads();
    { const float* kp = (tid < 511) ? cwin + ((size_t)sb * 512 + tid + 1) * 256 + g * 64 : P->out + O_WIN_S + ((size_t)sb * 512 + 511) * 256 + g * 64;
      rp[tid] = (unsigned long long)(uintptr_t)kp;
      smp_scores(kp, qr, sc, tid, true); }
    __syncthreads();
    smp_softmax(sc, 512, lane, wave);
    __syncthreads();
    smp_pv<true>(sc, rp, nullptr, 512, opart, tid);
    __syncthreads();
    const float ow = smp_pv_reduce(opart, hl, d);
    const float g0 = GT[(size_t)mrow * 48 + h * 3 + 0], g1 = GT[(size_t)mrow * 48 + h * 3 + 1], g2 = GT[(size_t)mrow * 48 + h * 3 + 2];
    O[(size_t)mrow * DM + h * 64 + d] = (bf16)f2bf(g0 * oc + g1 * os + g2 * ow);
    __syncthreads();
}

__device__ __forceinline__ void attn_phase(KP P, LAS unsigned char* lds, int qidx, int tid, int lane, int wave, int G) {
    unsigned* head = (unsigned*)(P->ws + WS_CTL) + 4096 + 64 * qidx;
    volatile LAS int* slot = (volatile LAS int*)(lds + LDS_MISC + 64);
    for (;;) {
        if (tid == 0) slot[0] = (int)__hip_atomic_fetch_add(head, 1u, __ATOMIC_RELAXED, __HIP_MEMORY_SCOPE_AGENT);
        __syncthreads();
        const int un = slot[0];
        __syncthreads();
        if (un >= 64 + 1024) break;
        if (un < 64) attn_sample_unit(P, lds, un >> 1, un & 1, tid, lane, wave);
        else { const int k = un - 64, bg = k & 7, tb = 127 - (k >> 3);
            attn_prompt_unit(P, lds, bg >> 1, bg & 1, tb * 32, tid, lane, wave); }
        __syncthreads();
    }
}

constexpr int NPHASES = 30;
#define DUPK(k) for (int dup_ = 0; dup_ < 1 + ((PROBE_DUP >> (k)) & 1); ++dup_)
#ifndef MK_MULTI
#define MK_MULTI 0
#endif
__global__ void __launch_bounds__(512, 2) mega(Params Pv) {
    extern __shared__ __attribute__((aligned(16))) unsigned char lds_raw[];
    LAS unsigned char* lds = (LAS unsigned char*)lds_raw;

    const KP Pk = (KP)__builtin_amdgcn_kernarg_segment_ptr();
    LAS float* rsb = (LAS float*)(lds + LDS_RS);
    int ph = 0, cur = 0;
    bool thin_slack_ = true;
    if (Pk->ph_hi - Pk->ph_lo > 1) {
        if (blockIdx.x == 0) { unsigned* ctl = (unsigned*)(Pk->ws + WS_CTL); for (int i = threadIdx.x; i < 8192; i += 512) ctl[i] = 0u; }
        if (threadIdx.x < 16) ((volatile LAS unsigned*)(lds + LDS_MISC))[threadIdx.x] = 0u;
        __syncthreads();
    }
#define RUN (ph >= Pk->ph_lo && ph < Pk->ph_hi)
#define FRESH const int tid = launder_v(threadIdx.x), lane = tid & 63, wave = __builtin_amdgcn_readfirstlane(tid >> 6), G = launder_s(gridDim.x), bid = launder_s(blockIdx.x); (void)lane; (void)wave; (void)bid
#define GRID_BAR do { if (ph == 0) { seam0_barrier(); (void)xcd_barrier_post((unsigned*)(Pk->ws + WS_CTL), (volatile LAS unsigned*)(lds + LDS_MISC) + 8); } else { XcdBarrier b_; b_.bar = (unsigned*)(launder(Pk)->ws + WS_CTL); b_.x = xb_xcc_id(); b_.st = (volatile LAS unsigned*)(lds + LDS_MISC) + 8; xcd_barrier(b_); } } while (0)
#define END_PHASE do { if (RUN && ph + 1 < Pk->ph_hi) { GRID_BAR; if ((PROBE_DUP >> 20) & 1) { if (ph > 0) GRID_BAR; } } ++ph; } while (0)
#define PSS_OF(ws_, c_) ((float*)((ws_) + WS_PSS) + (size_t)(c_) * 16 * MPAD)
#define GEMM_RS(EpiT_, AOFF, BOFF, N_, NTHIN_, K_, ...) GEMM_RS_B(0, EpiT_, AOFF, BOFF, N_, NTHIN_, K_, __VA_ARGS__)
#define GEMM_RS_B(REV_, EpiT_, AOFF, BOFF, N_, NTHIN_, K_, ...) do { const int tid = launder_v(threadIdx.x), G = launder_s(gridDim.x), bid = (REV_) ? G - 1 - launder_s(blockIdx.x) : launder_s(blockIdx.x); const KP P = launder(Pk); unsigned char* ws = P->ws; \
        pg8::Gemm g_{(const bf16*)(ws + (AOFF)), (const bf16*)(ws + (BOFF)), MP, (N_), (K_)}; pg8::StaticOrder S_; S_.init(MP, (N_), G, bid); \
        const int tcg_ = G - 1 - bid; const bool thin_ = tcg_ < (NTHIN_); \
        rs_prepare(S_, PSS_OF(ws, cur), (const float*)(ws + WS_SPSS) + cur * 2048, rsb, tid, thin_); EpiT_ E_{__VA_ARGS__}; \
          \
          \
        { const int tstr_ = (thin_slack_ && (NTHIN_) > G / 2 && (NTHIN_) < G && ((N_) / 256) * (MP / 256) % G == G / 2) ? G / 2 : G; \
          if (tcg_ < tstr_) for (int cg_ = tcg_; cg_ < (NTHIN_); cg_ += tstr_) { E_.slot = 7; thin_unit<(K_)>(lds, g_.A, g_.Bt, cg_, E_); } } E_.slot = 0; \
        pg8::gemm_phase<EpiT_, pg8::StaticOrder, true, true>(lds, g_, S_, E_); } while (0)
#define GEMM_RES(KIND, AOFF, BOFF, K_, SOFF) DUPK(KIND) { FRESH; const KP P = launder(Pk); unsigned char* ws = P->ws; \
        pg8::Gemm g_{(const bf16*)(ws + (AOFF)), (const bf16*)(ws + (BOFF)), MP, 1024, (K_)}; pg8::StaticOrder S_; S_.init(MP, 1024, G, bid); \
        EpiRes E_{ws, PSS_OF(ws, cur ^ 1), (SOFF), dup_ ? 0.0f : 1.0f, xb_off(L)}; \
        const int tcg_ = G - 1 - bid; if (tcg_ < 64) thin_unit<(K_)>(lds, g_.A, g_.Bt, tcg_, E_); \
        pg8::gemm_phase<EpiRes, pg8::StaticOrder, true, true>(lds, g_, S_, E_); }

    if (RUN) DUPK(0) { FRESH; phase0(launder(Pk), lds, tid, lane, wave, G); }
    END_PHASE;

#pragma unroll
    for (int L = 0; L < 4; ++L) {
        if (L < 2) {
            thin_slack_ = (L == 0);
            if (RUN) { GEMM_RS(EpiRG1, xb_off(L), WS_WIN + (size_t)L * 2560 * 1024 * 2, 2560, 160, 1024, ws, rsb, 0);
                if (L == 0) { FRESH; const KP P = launder(Pk); unsigned char* ws = P->ws; const int Gh = G >> 1;
                  pg8::Gemm g_{(const bf16*)(ws + WS_PB), (const bf16*)(ws + WS_WPI), 4 * MPAD, 4096, 256}; EpiPin E_{ws};
                  { PinOrder S_; S_.Lb = 0; S_.stride = 1;
                    if (G == 256) { if (bid < 128) { S_.start = bid; S_.count = 1; } else { S_.start = 128 + (bid - 128) * 3; S_.count = 3; } }
                    else { const int per = (512 + G - 1) / G; S_.start = bid * per; S_.count = per; }
                    pg8::gemm_phase<EpiPin, PinOrder, true, true>(lds, g_, S_, E_); }
                  if (G == 256 && bid >= 128) { PinOrder S2_; S2_.Lb = 2; S2_.start = (bid - 128) * 2; S2_.stride = 1; S2_.count = 2; pg8::gemm_phase<EpiPin, PinOrder, true, true>(lds, g_, S2_, E_); }
                  if (bid < Gh) for (int q_ = bid; q_ < 128; q_ += Gh) { const int L_ = (q_ >> 6), cg_ = q_ & 63; E_.Lthin = L_; thin_unit<256>(lds, g_.A + (size_t)L_ * MPAD * 256, g_.Bt + (size_t)L_ * 1024 * 256, cg_, E_); } }
                if (L == 1) { FRESH; const KP P = launder(Pk); unsigned char* ws = P->ws;
                  if (G == 256 && bid >= 128) { constexpr int NCU_ = 2 * (CMP_ROWS / 256);
                    pg8::Gemm g_{(const bf16*)(ws + WS_CMPA), (const bf16*)(ws + WS_WC1), 2 * CMP_ROWS, 256, 1024}; CmpOrder S_{G, bid - 128, NCU_ - 128, NCU_}; EpiT E_{(bf16*)(ws + WS_T)};
                    pg8::gemm_phase<EpiT, CmpOrder, true, true>(lds, g_, S_, E_); } } }
            END_PHASE;
            if (RUN) DUPK(2) { FRESH; rg2_phase(launder(Pk), lds, L, tid, lane, wave, G); }
            END_PHASE;
            if (RUN) DUPK(3) { FRESH; rg3_phase(launder(Pk), lds, L, tid, G); }
            END_PHASE;
            if (RUN) GEMM_RES(13, WS_G, WS_WOUT + (size_t)L * 1024 * 1280 * 2, 1280, (size_t)0);
            END_PHASE; cur ^= 1;
        } else {
            const int j = L - 2;
            if (L == 2) {
                if (RUN) { GEMM_RS(EpiKV, xb_off(L), WS_WKV, NKV, 48, 1024, P->out, ws, rsb, 0);
                    GEMM_RS_B(1, EpiQ, xb_off(L), WS_WQG, NQGP, 67, 1024, ws, rsb, 0); }
                END_PHASE;
                if (RUN) DUPK(8) { FRESH; const KP P = launder(Pk); unsigned char* ws = P->ws;
                    constexpr int NCU_ = 2 * (CMP_ROWS / 256), NSV_ = 128;
                    const bool early_ = (G == 256);
                    pg8::Gemm g_{(const bf16*)(ws + WS_CMPA), (const bf16*)(ws + WS_WC1), 2 * CMP_ROWS, 256, 1024}; CmpOrder S_{G, bid, 0, early_ ? NCU_ - NSV_ : NCU_}; EpiT E_{(bf16*)(ws + WS_T)};
                    pg8::gemm_phase<EpiT, CmpOrder, true, true>(lds, g_, S_, E_);
                    { const int nb2 = 2 * (CMP_ROWS / 256) - G, nf = G - (nb2 > 0 ? nb2 : 0);
                      pg8::Gemm gp_{(const bf16*)(ws + WS_PB), (const bf16*)(ws + WS_WPI), 4 * MPAD, 4096, 256}; EpiPin Ep_{ws};
                      if (early_) {
                          PinOrder Sp_; Sp_.Lb = 2; Sp_.start = 0; Sp_.stride = G - (NCU_ - NSV_); Sp_.count = 0;
                          if (bid >= NCU_ - NSV_) { Sp_.start = 256 + bid - (NCU_ - NSV_); Sp_.count = (Sp_.start + 2 * Sp_.stride < 512) ? 3 : 2; }
                          pg8::gemm_phase<EpiPin, PinOrder, true, true>(lds, gp_, Sp_, Ep_); }
                      else if (nf > 0 && bid >= G - nf) { PinOrder Sp_; Sp_.Lb = 2; Sp_.start = bid - (G - nf); Sp_.stride = nf; Sp_.count = (512 + nf - 1) / nf;
                          pg8::gemm_phase<EpiPin, PinOrder, true, true>(lds, gp_, Sp_, Ep_); }
                      else if (nf <= 0) { PinOrder Sp_; Sp_.Lb = 2; Sp_.start = bid; Sp_.stride = G; Sp_.count = (512 + G - 1) / G; pg8::gemm_phase<EpiPin, PinOrder, true, true>(lds, gp_, Sp_, Ep_); }
                      for (int q_ = bid; q_ < 128; q_ += G) { const int L_ = 2 + (q_ >> 6), cg_ = q_ & 63; Ep_.Lthin = L_; thin_unit<256>(lds, gp_.A + (size_t)L_ * MPAD * 256, gp_.Bt + (size_t)L_ * 1024 * 256, cg_, Ep_); } } }
                END_PHASE;
                if (RUN) DUPK(9) { FRESH; cmp2_phase(launder(Pk), lds, tid, lane, wave, G); }
                END_PHASE;
            }
            if (L == 3) { if (RUN) DUPK(10) GEMM_RS(EpiQ, xb_off(L), WS_WQG + (size_t)j * NQGP * 1024 * 2, NQGP, 67, 1024, ws, rsb, 0);
            END_PHASE; }
            if (RUN) DUPK(11) { FRESH; attn_phase(launder(Pk), lds, j + 2 * dup_, tid, lane, wave, G); }
            END_PHASE;
            if (RUN) GEMM_RES(16, WS_O, WS_WO + (size_t)j * 1024 * 1024 * 2, 1024, (size_t)0);
            END_PHASE; cur ^= 1;
        }
        if (RUN) DUPK(4) { FRESH; const KP P = launder(Pk); unsigned char* ws = P->ws;
            pg8::Gemm g_{(const bf16*)(ws + xb_off(L)), (const bf16*)(ws + WS_WUP + (size_t)L * 6144 * 1024 * 2), MP, DFF2, 1024}; pg8::StaticOrder S_; S_.init(MP, DFF2, G, bid);
            const int tpg_ = G - 1 - bid; const bool thin_ = tpg_ < 192;
            rs_prepare(S_, PSS_OF(ws, cur), (const float*)(ws + WS_SPSS) + cur * 2048, rsb, tid, thin_);
            const float* cw_ = (const float*)P->in[33] + (size_t)L * 3 * DFF2; const float* cb_ = (const float*)P->in[34] + (size_t)L * DFF2;
            EpiUp E_{ws, rsb, P->out, cw_, cb_, (LAS float*)(lds + LDS_HALO), L, 0};
            if (thin_) thin_unit_up(lds, g_.A, g_.Bt, tpg_, ws, rsb + 7 * 256, P->out, cw_, cb_, (const float*)P->in[9], L);
            pg8::gemm_phase<EpiUp, pg8::StaticOrder, true, true>(lds, g_, S_, E_); }
        END_PHASE;
        if (RUN) DUPK(14) { FRESH; const KP P = launder(Pk); unsigned char* ws = P->ws;
            pg8::Gemm g_{(const bf16*)(ws + WS_ACT), (const bf16*)(ws + WS_WDN + (size_t)L * 1024 * 3072 * 2), MP, 1024, 3072}; pg8::StaticOrder S_; S_.init(MP, 1024, G, bid);
            { pg8::Unit u_; for (int i_ = 0; S_.next(i_, u_); ++i_) act_fixup(ws, (const float*)P->in[33] + (size_t)L * 3 * DFF2, (const float*)P->in[34] + (size_t)L * DFF2, u_.pm, tid); }
            asm volatile("s_waitcnt vmcnt(0)" ::: "memory"); __syncthreads();
            EpiRes E_{ws, PSS_OF(ws, cur ^ 1), (size_t)0, dup_ ? 0.0f : 1.0f, xb_off(L)};
            const int tcg_ = G - 1 - bid; if (tcg_ < 64) thin_unit<3072>(lds, g_.A, g_.Bt, tcg_, E_);
            pg8::gemm_phase<EpiRes, pg8::StaticOrder, true, true>(lds, g_, S_, E_); }
        END_PHASE; cur ^= 1;
        if (RUN) GEMM_RS(EpiGate, xb_off(L), WS_WPG + (size_t)L * 1024 * 1024 * 2, 1024, 64, 1024, ws, rsb, PSS_OF(ws, cur ^ 1), WS_PIN + (size_t)L * MPAD * DM * 2, xb_off(L), xb_off(L + 1), 0);
        END_PHASE; cur ^= 1;
    }
    if (RUN) DUPK(12) { FRESH; const KP P = launder(Pk); final_phase(P, PSS_OF(P->ws, cur), (const float*)(P->ws + WS_SPSS) + cur * 2048, lane, wave, G); }
    END_PHASE;
}

extern "C" void kernel_launch(void* const* d_in, const int* in_sizes, int n_in, void* d_out, int out_size, void* d_ws, size_t ws_size, hipStream_t stream) {
    static int grid = 0;
    if (grid == 0) {
        if (n_in != 38 || (size_t)out_size != O_END || ws_size < WS_END) { fprintf(stderr, "kernel_launch: unexpected problem: n_in %d out %d ws %zu (need %zu)\n", n_in, out_size, ws_size, (size_t)WS_END); grid = -1; return; }
        int dev = 0, cus = 0, per_cu = 0;
        (void)hipGetDevice(&dev); (void)hipDeviceGetAttribute(&cus, hipDeviceAttributeMultiprocessorCount, dev);
        if (hipFuncSetAttribute((const void*)mega, hipFuncAttributeMaxDynamicSharedMemorySize, LDS_BYTES) != hipSuccess) { fprintf(stderr, "kernel_launch: hipFuncSetAttribute failed\n"); grid = -1; return; }
        if (hipOccupancyMaxActiveBlocksPerMultiprocessor(&per_cu, (const void*)mega, 512, LDS_BYTES) != hipSuccess || per_cu < 1) { fprintf(stderr, "kernel_launch: occupancy query says %d\n", per_cu); per_cu = 1; }
        (void)hipGetLastError();
        grid = cus;
        if (grid > 256) grid = 256;
    }
    if (grid < 0) return;
    Params p{};
    for (int i = 0; i < 38; ++i) p.in[i] = d_in[i];
    p.out = (float*)d_out; p.ws = (unsigned char*)d_ws;
#if MK_MULTI
    for (int ph = 0; ph < NPHASES; ++ph) { p.ph_lo = ph; p.ph_hi = ph + 1; hipLaunchKernelGGL(mega, dim3(grid), dim3(512), LDS_BYTES, stream, p); }
#else
    p.ph_lo = 0; p.ph_hi = NPHASES;
    void* args[] = {&p};
    hipError_t e = hipLaunchCooperativeKernel((const void*)mega, dim3(grid), dim3(512), args, LDS_BYTES, stream);
    if (e != hipSuccess) fprintf(stderr, "kernel_launch: cooperative launch failed: %s (grid %d)\n", hipGetErrorString(e), grid);
#endif
}
```
